# Optimizing an MI355X kernel written in HIP

```python
import jax, jax.numpy as jnp
from jax import lax
import numpy as np

D_MODEL = 1024
BATCH = 4
SEQ = 4096
DEPTH = 1

HEAD_DIM = 64
N_Q_HEADS = D_MODEL // HEAD_DIM
N_KV_HEADS = max(1, N_Q_HEADS // 8)
GROUP = N_Q_HEADS // N_KV_HEADS
WINDOW = 128
ATTN_BLOCK = 128
ROPE_THETA = 500000.0
ROPE_DIM = HEAD_DIM // 4
Q_WIDTH = N_Q_HEADS * HEAD_DIM
KV_WIDTH = N_KV_HEADS * HEAD_DIM
NEG_INF = -1e30

POOL_WINDOWS = (2, 4, 8, 16)
N_POOL_GROUPS = len(POOL_WINDOWS)
POOL_WIDTH = D_MODEL // 2
POOL_GROUP_WIDTH = POOL_WIDTH // N_POOL_GROUPS

IN_WIDTH = Q_WIDTH + 2 * KV_WIDTH + POOL_WIDTH + 2 * D_MODEL

N_EXPERTS = 32
TOP_K = 4
D_FF = D_MODEL
SWIGLU_ALPHA = 1.702
SWIGLU_LIMIT = 7.0
MOE_BLOCK = 128

RMS_EPS = 1e-5

kernel_name = "hybrid_gated_swa_pool_moe"


def rmsnorm(x, g):
    xf = x.astype(jnp.float32)
    y = xf * lax.rsqrt(jnp.mean(xf * xf, axis=-1, keepdims=True) + RMS_EPS)
    return (y * g.astype(jnp.float32)).astype(x.dtype)


def partial_rope(t, positions):
    half = ROPE_DIM // 2
    inv_freq = jnp.power(jnp.float32(ROPE_THETA), -jnp.arange(half, dtype=jnp.float32) * (2.0 / ROPE_DIM))
    ang = positions.astype(jnp.float32)[..., None] * inv_freq
    cos = jnp.cos(ang)[:, :, None, :]
    sin = jnp.sin(ang)[:, :, None, :]
    tr = t[..., :ROPE_DIM].astype(jnp.float32)
    t1, t2 = tr[..., :half], tr[..., half:]
    rot = jnp.concatenate([t1 * cos - t2 * sin, t2 * cos + t1 * sin], axis=-1).astype(t.dtype)
    return jnp.concatenate([rot, t[..., ROPE_DIM:]], axis=-1)


def sliding_window_gqa(q, k, v, sinks):
    B, S = q.shape[0], q.shape[1]
    NB = S // ATTN_BLOCK
    qb = q.reshape(B, NB, ATTN_BLOCK, N_KV_HEADS, GROUP, HEAD_DIM)

    def band(t):
        tb = t.reshape(B, NB, ATTN_BLOCK, N_KV_HEADS, HEAD_DIM)
        prev = jnp.concatenate([jnp.zeros_like(tb[:, :1]), tb[:, :-1]], axis=1)
        return jnp.concatenate([prev, tb], axis=2)

    kb, vb = band(k), band(v)
    scores = jnp.einsum('bnqhgd,bnkhd->bnhgqk', qb, kb,
                        preferred_element_type=jnp.float32) * (HEAD_DIM ** -0.5)
    qi = jnp.arange(ATTN_BLOCK)[:, None]
    kj = jnp.arange(2 * ATTN_BLOCK)[None, :]
    dist = qi + ATTN_BLOCK - kj
    blk = jnp.arange(NB)[:, None, None]
    valid = (dist >= 0) & (dist < WINDOW) & (blk * ATTN_BLOCK + kj[None] - ATTN_BLOCK >= 0)
    scores = jnp.where(valid[None, :, None, None], scores, NEG_INF)
    sink = jnp.broadcast_to(sinks.astype(jnp.float32).reshape(1, 1, N_KV_HEADS, GROUP, 1, 1),
                            scores.shape[:-1] + (1,))
    probs = jax.nn.softmax(jnp.concatenate([scores, sink], axis=-1), axis=-1)[..., :-1]
    out = jnp.einsum('bnhgqk,bnkhd->bnqhgd', probs.astype(v.dtype), vb)
    return out.reshape(B, S, Q_WIDTH)


def multiscale_causal_pool(u, pool_w, pool_scale):
    B, S = u.shape[0], u.shape[1]
    uf = u.astype(jnp.float32)
    cs0 = jnp.pad(jnp.cumsum(uf, axis=1), ((0, 0), (1, 0), (0, 0)))
    outs = []
    for g, w in enumerate(POOL_WINDOWS):
        sl = slice(g * POOL_GROUP_WIDTH, (g + 1) * POOL_GROUP_WIDTH)
        c = cs0[:, :, sl]
        lower = jnp.pad(c, ((0, 0), (w - 1, 0), (0, 0)))[:, :S]
        total = c[:, 1:] - lower
        count = jnp.minimum(jnp.arange(1, S + 1), w).astype(jnp.float32)[None, :, None]
        outs.append(total / count - uf[:, :, sl])
    pooled = jnp.stack(outs, axis=2)
    mixed = jnp.einsum('bsgc,gcd->bsgd', pooled, pool_w.astype(jnp.float32))
    return (mixed.reshape(B, S, POOL_WIDTH) * pool_scale.astype(jnp.float32)).astype(u.dtype)


def clamped_swiglu(u):
    glu, lin = u[..., :D_FF], u[..., D_FF:]
    glu = jnp.minimum(glu, SWIGLU_LIMIT)
    lin = jnp.clip(lin, -SWIGLU_LIMIT, SWIGLU_LIMIT)
    return glu * jax.nn.sigmoid(SWIGLU_ALPHA * glu) * (lin + 1.0)


def moe_ffn(h, w_router, b_router, w_up, b_up, w_down, b_down):
    T, D = h.shape
    logits = (h @ w_router + b_router).astype(jnp.float32)
    top_vals, top_idx = lax.top_k(logits, TOP_K)
    gates = jax.nn.softmax(top_vals, axis=-1)
    A = T * TOP_K
    e_flat = top_idx.reshape(A).astype(jnp.int32)
    tok_flat = jnp.arange(A, dtype=jnp.int32) // TOP_K
    g_flat = gates.reshape(A)
    order = jnp.argsort(e_flat)
    e_sorted = e_flat[order]
    counts = jnp.bincount(e_flat, length=N_EXPERTS).astype(jnp.int32)
    padded = (counts + MOE_BLOCK - 1) // MOE_BLOCK * MOE_BLOCK
    start = jnp.cumsum(counts) - counts
    pend = jnp.cumsum(padded)
    pstart = pend - padded
    dest = pstart[e_sorted] + jnp.arange(A, dtype=jnp.int32) - start[e_sorted]
    n_slots = (A + MOE_BLOCK - 1) // MOE_BLOCK * MOE_BLOCK + N_EXPERTS * MOE_BLOCK
    n_blocks = n_slots // MOE_BLOCK
    slot_tok = jnp.full((n_slots,), T, jnp.int32).at[dest].set(tok_flat[order])
    slot_gate = jnp.zeros((n_slots,), jnp.float32).at[dest].set(g_flat[order])
    blk_expert = jnp.minimum(
        jnp.searchsorted(pend, jnp.arange(n_blocks, dtype=jnp.int32) * MOE_BLOCK, side='right'),
        N_EXPERTS - 1).astype(jnp.int32)
    h_pad = jnp.concatenate([h, jnp.zeros((1, D), h.dtype)], axis=0)
    xs = h_pad[slot_tok].reshape(n_blocks, MOE_BLOCK, D)

    def expert_block(args):
        xb, e = args
        u = xb @ w_up[e] + b_up[e]
        return clamped_swiglu(u) @ w_down[e] + b_down[e]

    ys = lax.map(expert_block, (xs, blk_expert)).reshape(n_slots, D)
    out = jnp.zeros((T + 1, D), jnp.float32).at[slot_tok].add(
        ys.astype(jnp.float32) * slot_gate[:, None])[:T]
    return out.astype(h.dtype)


def setup_inputs(seed: int = 0) -> dict:
    key = jax.random.key(seed)
    ks = jax.random.split(key, 20)
    L, D = DEPTH, D_MODEL
    nrm = jax.random.normal
    return {
        "x": nrm(ks[0], (BATCH, SEQ, D), jnp.float32),
        "positions": jnp.broadcast_to(jnp.arange(SEQ, dtype=jnp.int32), (BATCH, SEQ)),
        "norm1_g": 1.0 + 0.05 * nrm(ks[1], (L, D), jnp.float32),
        "w_in": nrm(ks[2], (L, D, IN_WIDTH), jnp.float32) * D ** -0.5,
        "b_in": 0.02 * nrm(ks[3], (L, IN_WIDTH), jnp.float32),
        "attn_sinks": nrm(ks[4], (L, N_Q_HEADS), jnp.float32),
        "w_attn_br": nrm(ks[5], (L, Q_WIDTH, D), jnp.float32) * Q_WIDTH ** -0.5,
        "pool_w": nrm(ks[6], (L, N_POOL_GROUPS, POOL_GROUP_WIDTH, POOL_GROUP_WIDTH), jnp.float32) * POOL_GROUP_WIDTH ** -0.5,
        "pool_scale": 1.0 + 0.1 * nrm(ks[7], (L, POOL_WIDTH), jnp.float32),
        "w_pool_br": nrm(ks[8], (L, POOL_WIDTH, D), jnp.float32) * POOL_WIDTH ** -0.5,
        "w_out": nrm(ks[9], (L, D, D), jnp.float32) * D ** -0.5,
        "norm2_g": 1.0 + 0.05 * nrm(ks[10], (L, D), jnp.float32),
        "w_router": nrm(ks[11], (L, D, N_EXPERTS), jnp.float32) * D ** -0.5,
        "b_router": 0.01 * nrm(ks[12], (L, N_EXPERTS), jnp.float32),
        "w_up": nrm(ks[13], (L, N_EXPERTS, D, 2 * D_FF), jnp.float32) * D ** -0.5,
        "b_up": 0.02 * nrm(ks[14], (L, N_EXPERTS, 2 * D_FF), jnp.float32),
        "w_down": nrm(ks[15], (L, N_EXPERTS, D_FF, D), jnp.float32) * D_FF ** -0.5,
        "b_down": 0.02 * nrm(ks[16], (L, N_EXPERTS, D), jnp.float32),
        "normf_g": 1.0 + 0.05 * nrm(ks[17], (D,), jnp.float32),
    }


def reference(x, positions, norm1_g, w_in, b_in, attn_sinks, w_attn_br, pool_w, pool_scale,
              w_pool_br, w_out, norm2_g, w_router, b_router, w_up, b_up, w_down, b_down, normf_g):
    B, S, D = x.shape
    o_q = Q_WIDTH
    o_k = o_q + KV_WIDTH
    o_v = o_k + KV_WIDTH
    o_p = o_v + POOL_WIDTH
    o_ga = o_p + D_MODEL
    for l in range(DEPTH):
        h = rmsnorm(x, norm1_g[l])
        proj = jnp.einsum('bsd,de->bse', h, w_in[l]) + b_in[l]
        q = proj[..., :o_q].reshape(B, S, N_Q_HEADS, HEAD_DIM)
        k = proj[..., o_q:o_k].reshape(B, S, N_KV_HEADS, HEAD_DIM)
        v = proj[..., o_k:o_v].reshape(B, S, N_KV_HEADS, HEAD_DIM)
        u_pool = proj[..., o_v:o_p]
        g_attn = jax.nn.sigmoid(proj[..., o_p:o_ga].astype(jnp.float32))
        g_pool = jax.nn.sigmoid(proj[..., o_ga:].astype(jnp.float32))
        q = partial_rope(q, positions)
        k = partial_rope(k, positions)
        y_attn = sliding_window_gqa(q, k, v, attn_sinks[l]) @ w_attn_br[l]
        y_pool = multiscale_causal_pool(u_pool, pool_w[l], pool_scale[l]) @ w_pool_br[l]
        merged = (g_attn * y_attn.astype(jnp.float32) + g_pool * y_pool.astype(jnp.float32)).astype(x.dtype)
        x = x + merged @ w_out[l]
        h2 = rmsnorm(x, norm2_g[l]).reshape(B * S, D)
        x = x + moe_ffn(h2, w_router[l], b_router[l], w_up[l], b_up[l], w_down[l], b_down[l]).reshape(B, S, D)
    return rmsnorm(x, normf_g)
```

```cpp
#include <hip/hip_runtime.h>
#include <cstdio>
#include <cstdint>

constexpr int BATCH = 4, SEQ = 4096, T = BATCH * SEQ, D = 1024;
constexpr int NQH = 16, NKVH = 2, HD = 64, WINDOW = 128;
constexpr int INW = 3840, O_K = 1024, O_V = 1152, O_P = 1280, O_GA = 1792, O_GP = 2816, PW = 512;
constexpr int NE = 32, TOPK = 4, DFF = 1024, CAP = T;
constexpr int NSLOT = T * TOPK + NE * 256;
constexpr float RMS_EPS = 1e-5f;

typedef unsigned short bf16;
typedef unsigned char fp8;
constexpr float W8_SCALE = 32.0f, W8_INV = 1.0f / 32.0f;
typedef float f32x4 __attribute__((ext_vector_type(4)));
typedef unsigned u32x4 __attribute__((ext_vector_type(4)));
typedef unsigned u32x2 __attribute__((ext_vector_type(2)));

constexpr size_t MiB = 1u << 20;
constexpr size_t WS_CTL = 0, CTL_ZERO_BYTES = 65536;
constexpr size_t WS_WIN = 2 * MiB;
constexpr size_t WS_WATT = 10 * MiB;
constexpr size_t WS_WEFF = 12 * MiB;
constexpr size_t WS_WOUT = 13 * MiB;
constexpr size_t WS_CS = 15 * MiB;
constexpr size_t WS_WUP = 16 * MiB;
constexpr size_t WS_WDN = 144 * MiB;
constexpr size_t WS_H = 208 * MiB;
constexpr size_t WS_Q = 240 * MiB;
constexpr size_t WS_KB = 272 * MiB;
constexpr size_t WS_VB = 276 * MiB;
constexpr size_t WS_U = 280 * MiB;
constexpr size_t WS_PO = 296 * MiB;
constexpr size_t WS_GA = 312 * MiB;
constexpr size_t WS_GP = 344 * MiB;
constexpr size_t WS_AO = 376 * MiB;
constexpr size_t WS_T1 = 408 * MiB;
constexpr size_t WS_MG = 440 * MiB;
constexpr size_t WS_X1 = 472 * MiB;
constexpr size_t WS_STOK = 536 * MiB;
constexpr size_t WS_TOKE = 538 * MiB;
constexpr size_t WS_TOKG = 539 * MiB;
constexpr size_t WS_WRH = 538 * MiB + 512 * 1024, WS_WRL = WS_WRH + 64 * 1024;
constexpr size_t WS_ACT = 540 * MiB;
constexpr size_t WS_YS = 684 * MiB;
constexpr size_t WS_H2 = 828 * MiB;
constexpr size_t WS_END = 844 * MiB;
constexpr size_t WS_TMP = WS_ACT;
constexpr int CW_TMO = 0, CW_CODE = 1, CW_CNT = 64, CW_DONE = 128  , CW_BAR = 4096;

__device__ __forceinline__ float bf2f(bf16 v) { return __uint_as_float((unsigned)v << 16); }
__device__ __forceinline__ bf16 f2bf(float f) { unsigned u = __float_as_uint(f); return (bf16)((u + 0x7fffu + ((u >> 16) & 1u)) >> 16); }
__device__ __forceinline__ float sigmoidf_(float v) { return 1.0f / (1.0f + __expf(-v)); }
__device__ __forceinline__ float wave_sum(float v) {
#pragma unroll
    for (int o = 1; o < 64; o <<= 1) v += __shfl_xor(v, o);
    return v;
}
__device__ __forceinline__ float fp82f(fp8 v) { return __builtin_amdgcn_cvt_f32_fp8((int)v, 0); }
__device__ __forceinline__ fp8 f2fp8(float f) { return (fp8)(__builtin_amdgcn_cvt_pk_fp8_f32(f, f, 0, false) & 0xff); }
__device__ __forceinline__ int up_src_col(int np) { const int t = np >> 8, c = np & 255; return c < 128 ? 128 * t + c : 1024 + 128 * t + (c - 128); }

__global__ void __launch_bounds__(256) n_transpose(const float* W, int K, int N, bf16* WT, int NT, int upmap) {
    const size_t total = (size_t)NT * K;
    for (size_t idx = (size_t)blockIdx.x * blockDim.x + threadIdx.x; idx < total; idx += (size_t)gridDim.x * blockDim.x) {
        const int n = (int)(idx / K), k = (int)(idx % K); const int sc = upmap ? up_src_col(n) : n;
        WT[idx] = f2bf(W[(size_t)k * N + sc]);
    }
}
__global__ void __launch_bounds__(256) n_transpose8(const float* W, int K, int N, fp8* WT, int NT, int upmap) {
    const size_t total = (size_t)NT * K;
    for (size_t idx = (size_t)blockIdx.x * blockDim.x + threadIdx.x; idx < total; idx += (size_t)gridDim.x * blockDim.x) {
        const int n = (int)(idx / K), k = (int)(idx % K); const int sc = upmap ? up_src_col(n) : n;
        WT[idx] = f2fp8(W[(size_t)k * N + sc] * W8_SCALE);
    }
}
__global__ void __launch_bounds__(256) n_weff(const float* pw, const float* ps, const float* Wpb, bf16* WeffT) {
    const int idx = blockIdx.x * blockDim.x + threadIdx.x; if (idx >= 1024 * 512) return;
    const int n = idx / 512, k = idx % 512, g = k / 128, kk = k % 128; float a = 0.f;
    for (int c = 0; c < 128; ++c) a += pw[(g * 128 + kk) * 128 + c] * ps[g * 128 + c] * Wpb[(size_t)(g * 128 + c) * 1024 + n];
    WeffT[idx] = f2bf(a);
}
__global__ void __launch_bounds__(256) n_wr_split(const float* wr, bf16* WRH, bf16* WRL) {
    const int idx = blockIdx.x * blockDim.x + threadIdx.x; if (idx >= 32 * 1024) return;
    const int e = idx >> 10, k = idx & 1023; const float w = wr[k * 32 + e]; const bf16 h = f2bf(w); WRH[idx] = h; WRL[idx] = f2bf(w - bf2f(h));
}
__global__ void __launch_bounds__(256) n_rope_table(const int* pos, float* cs) {
    const int idx = blockIdx.x * blockDim.x + threadIdx.x; if (idx >= T * 8) return;
    const int t = idx >> 3, i = idx & 7; const float inv = powf(500000.0f, -(float)i * 0.125f); const float a = (float)pos[t] * inv;
    cs[t * 16 + i] = cosf(a); cs[t * 16 + 8 + i] = sinf(a);
}
__global__ void __launch_bounds__(256) n_rms_bf16(const float* x, const float* g, bf16* out) {
    const int row = blockIdx.x * 4 + (threadIdx.x >> 6), lane = threadIdx.x & 63;
    const f32x4* xr = (const f32x4*)(x + (size_t)row * D) + lane; f32x4 v[4]; float s = 0.f;
#pragma unroll
    for (int j = 0; j < 4; ++j) { v[j] = xr[64 * j]; s += v[j].x * v[j].x + v[j].y * v[j].y + v[j].z * v[j].z + v[j].w * v[j].w; }
    const float rstd = rsqrtf(wave_sum(s) * (1.f / D) + RMS_EPS);
#pragma unroll
    for (int j = 0; j < 4; ++j) { const f32x4 gg = ((const f32x4*)g)[lane + 64 * j]; bf16* o = out + (size_t)row * D + 4 * lane + 256 * j;
        o[0] = f2bf(v[j].x * rstd * gg.x); o[1] = f2bf(v[j].y * rstd * gg.y); o[2] = f2bf(v[j].z * rstd * gg.z); o[3] = f2bf(v[j].w * rstd * gg.w); }
}
__global__ void __launch_bounds__(256) n_gemm(const bf16* A, const bf16* Bt, float* C, int M, int N, int K) {
    __shared__ float As[16][65], Bs[16][65];
    const int tx = threadIdx.x & 15, ty = threadIdx.x >> 4, m0 = blockIdx.y * 64, n0 = blockIdx.x * 64;
    float acc[4][4];
#pragma unroll
    for (int i = 0; i < 4; ++i)
#pragma unroll
        for (int j = 0; j < 4; ++j) acc[i][j] = 0.f;
    for (int k0 = 0; k0 < K; k0 += 16) {
        for (int i = threadIdx.x; i < 1024; i += 256) { const int r = i >> 4, c = i & 15;
            As[c][r] = bf2f(A[(size_t)(m0 + r) * K + k0 + c]); Bs[c][r] = bf2f(Bt[(size_t)(n0 + r) * K + k0 + c]); }
        __syncthreads();
#pragma unroll
        for (int kk = 0; kk < 16; ++kk) { float a[4], b[4];
#pragma unroll
            for (int i = 0; i < 4; ++i) { a[i] = As[kk][ty * 4 + i]; b[i] = Bs[kk][tx * 4 + i]; }
#pragma unroll
            for (int i = 0; i < 4; ++i)
#pragma unroll
                for (int j = 0; j < 4; ++j) acc[i][j] += a[i] * b[j]; }
        __syncthreads();
    }
#pragma unroll
    for (int i = 0; i < 4; ++i)
#pragma unroll
        for (int j = 0; j < 4; ++j) C[(size_t)(m0 + ty * 4 + i) * N + n0 + tx * 4 + j] = acc[i][j];
}
__global__ void __launch_bounds__(256) n_post_inproj(const float* P, const float* bias, const float* cs, bf16* Q, bf16* KB, bf16* VB, bf16* U, bf16* GA, bf16* GP) {
    const size_t idx = (size_t)blockIdx.x * blockDim.x + threadIdx.x; if (idx >= (size_t)T * INW) return;
    const int t = (int)(idx / INW), c = (int)(idx % INW); float v = P[idx] + bias[c];
    if (c < O_V) {
        const int d = c & 63;
        if (d < 16) { const int i = d & 7; const int pc = (d < 8) ? c + 8 : c - 8; const float o = P[(size_t)t * INW + pc] + bias[pc];
            const float co = cs[t * 16 + i], si = cs[t * 16 + 8 + i]; v = (d < 8) ? v * co - o * si : v * co + o * si; }
        if (c < O_K) Q[(size_t)t * 1024 + c] = f2bf(v); else KB[(size_t)t * 128 + (c - O_K)] = f2bf(v);
    } else if (c < O_P) VB[(size_t)t * 128 + (c - O_V)] = f2bf(v);
    else if (c < O_GA) U[(size_t)t * 512 + (c - O_P)] = f2bf(v);
    else if (c < O_GP) GA[(size_t)t * 1024 + (c - O_GA)] = f2bf(v);
    else GP[(size_t)t * 1024 + (c - O_GP)] = f2bf(v);
}
__global__ void __launch_bounds__(256) n_attn(const bf16* Q, const bf16* KB, const bf16* VB, const float* sinks, bf16* AO) {
    const int idx = blockIdx.x * blockDim.x + threadIdx.x; if (idx >= T * NQH) return;
    const int t = idx / NQH, hq = idx % NQH, hk = hq / 8, pos = t % SEQ, b0 = t - pos;
    float q[64];
#pragma unroll
    for (int d = 0; d < 64; ++d) q[d] = bf2f(Q[(size_t)t * 1024 + hq * 64 + d]);
    const int lo = pos - (WINDOW - 1) > 0 ? pos - (WINDOW - 1) : 0;
    const float sink = sinks[hq]; float m = sink;
    for (int s = lo; s <= pos; ++s) { float a = 0.f;
#pragma unroll
        for (int d = 0; d < 64; ++d) a += q[d] * bf2f(KB[(size_t)(b0 + s) * 128 + hk * 64 + d]);
        a *= 0.125f; m = fmaxf(m, a); }
    float sum = __expf(sink - m); float o[64];
#pragma unroll
    for (int d = 0; d < 64; ++d) o[d] = 0.f;
    for (int s = lo; s <= pos; ++s) { float a = 0.f;
#pragma unroll
        for (int d = 0; d < 64; ++d) a += q[d] * bf2f(KB[(size_t)(b0 + s) * 128 + hk * 64 + d]);
        const float p = __expf(a * 0.125f - m); sum += p; const float pb = bf2f(f2bf(p));
#pragma unroll
        for (int d = 0; d < 64; ++d) o[d] += pb * bf2f(VB[(size_t)(b0 + s) * 128 + hk * 64 + d]); }
    const float inv = 1.f / sum;
#pragma unroll
    for (int d = 0; d < 64; ++d) AO[(size_t)t * 1024 + hq * 64 + d] = f2bf(o[d] * inv);
}
__global__ void __launch_bounds__(256) n_pool(const bf16* U, bf16* PO) {
    const int idx = blockIdx.x * blockDim.x + threadIdx.x; if (idx >= T * PW) return;
    const int t = idx / PW, c = idx % PW, g = c / 128, w = 2 << g, pos = t % SEQ; const int cnt = pos + 1 < w ? pos + 1 : w; float s = 0.f;
    for (int j = 0; j < cnt; ++j) s += bf2f(U[(size_t)(t - j) * PW + c]);
    PO[idx] = f2bf(s / (float)cnt - bf2f(U[idx]));
}
__global__ void __launch_bounds__(256) n_merge(const float* C1, const float* C2, const bf16* GA, const bf16* GP, bf16* MG) {
    const size_t idx = (size_t)blockIdx.x * blockDim.x + threadIdx.x; if (idx >= (size_t)T * D) return;
    const float t1 = bf2f(f2bf(sigmoidf_(bf2f(GA[idx])) * C1[idx]));
    MG[idx] = f2bf(t1 + sigmoidf_(bf2f(GP[idx])) * C2[idx]);
}
__global__ void __launch_bounds__(256) n_x1(const float* x, const float* C, bf16* X1) {
    const size_t idx = (size_t)blockIdx.x * blockDim.x + threadIdx.x; if (idx >= (size_t)T * D) return;
    X1[idx] = f2bf(C[idx]); (void)x;
}
__global__ void __launch_bounds__(256) n_router(const float* x, const bf16* X1, const float* g2, const float* wr, const float* br, fp8* H2, unsigned* counts, int* stok, int* toke, float* tokg) {
    const int t = blockIdx.x * 4 + (threadIdx.x >> 6), lane = threadIdx.x & 63;
    const f32x4* xr = (const f32x4*)(x + (size_t)t * D) + lane; const bf16* dr = X1 + (size_t)t * D + 4 * lane; f32x4 v[4]; float s = 0.f;
#pragma unroll
    for (int j = 0; j < 4; ++j) { v[j] = xr[64 * j]; v[j].x += bf2f(dr[256 * j]); v[j].y += bf2f(dr[256 * j + 1]); v[j].z += bf2f(dr[256 * j + 2]); v[j].w += bf2f(dr[256 * j + 3]); s += v[j].x * v[j].x + v[j].y * v[j].y + v[j].z * v[j].z + v[j].w * v[j].w; }
    const float rstd = rsqrtf(wave_sum(s) * (1.f / D) + RMS_EPS);
    float h[16];
#pragma unroll
    for (int j = 0; j < 4; ++j) { const f32x4 gg = ((const f32x4*)g2)[lane + 64 * j];
        h[4 * j + 0] = v[j].x * rstd * gg.x; h[4 * j + 1] = v[j].y * rstd * gg.y; h[4 * j + 2] = v[j].z * rstd * gg.z; h[4 * j + 3] = v[j].w * rstd * gg.w;
        fp8* o = H2 + (size_t)t * D + 4 * lane + 256 * j;
#pragma unroll
        for (int q = 0; q < 4; ++q) o[q] = f2fp8(h[4 * j + q]); }
    float lg[32];
#pragma unroll
    for (int e = 0; e < 32; ++e) { float a = 0.f;
#pragma unroll
        for (int j = 0; j < 4; ++j)
#pragma unroll
            for (int q = 0; q < 4; ++q) a += h[4 * j + q] * wr[(size_t)(4 * lane + 256 * j + q) * 32 + e];
        lg[e] = wave_sum(a) + br[e]; }
    int be[4]; float bv[4]; unsigned used = 0u;
#pragma unroll
    for (int k = 0; k < 4; ++k) { float best = -3.0e38f; int bi = 0;
#pragma unroll
        for (int e = 0; e < 32; ++e) { const bool ok = !((used >> e) & 1u) && lg[e] > best; best = ok ? lg[e] : best; bi = ok ? e : bi; }
        be[k] = bi; bv[k] = best; used |= 1u << bi; }
    float ex[4], se = 0.f;
#pragma unroll
    for (int k = 0; k < 4; ++k) { ex[k] = __expf(bv[k] - bv[0]); se += ex[k]; }
    if (lane == 0) {
#pragma unroll
        for (int k = 0; k < 4; ++k) { const unsigned pos = atomicAdd(&counts[be[k]], 1u);
            stok[be[k] * CAP + pos] = t; toke[t * 4 + k] = be[k] | (int)(pos << 8); tokg[t * 4 + k] = ex[k] / se; }
    }
}
__device__ __forceinline__ int moe_rowoff(const unsigned* counts, int e) { int o = 0; for (int i = 0; i < e; ++i) o += (int)((counts[i] + 255u) >> 8) << 8; return o; }
__global__ void __launch_bounds__(256) n_moe_up(const fp8* H2, const int* stok, const unsigned* counts, const fp8* WupT, const float* bup, fp8* ACT) {
    const int e = blockIdx.z, cnt = (int)counts[e], m0 = blockIdx.y * 64, n0 = blockIdx.x * 64; if (m0 >= cnt) return;
    __shared__ float As[16][65], Bg[16][65], Bl[16][65]; __shared__ int rowtok[64];
    const int tx = threadIdx.x & 15, ty = threadIdx.x >> 4; const int roff = moe_rowoff(counts, e);
    if (threadIdx.x < 64) rowtok[threadIdx.x] = (m0 + (int)threadIdx.x < cnt) ? stok[e * CAP + m0 + threadIdx.x] : 0;
    __syncthreads();
    float ag[4][4], al[4][4];
#pragma unroll
    for (int i = 0; i < 4; ++i)
#pragma unroll
        for (int j = 0; j < 4; ++j) { ag[i][j] = 0.f; al[i][j] = 0.f; }
    const fp8* W = WupT + (size_t)e * 2048 * 1024;
    for (int k0 = 0; k0 < 1024; k0 += 16) {
        for (int i = threadIdx.x; i < 1024; i += 256) { const int r = i >> 4, c = i & 15; const int j = n0 + r, ng = (j >> 7) * 256 + (j & 127);
            As[c][r] = fp82f(H2[(size_t)rowtok[r] * 1024 + k0 + c]); Bg[c][r] = fp82f(W[(size_t)ng * 1024 + k0 + c]) * W8_INV; Bl[c][r] = fp82f(W[(size_t)(ng + 128) * 1024 + k0 + c]) * W8_INV; }
        __syncthreads();
#pragma unroll
        for (int kk = 0; kk < 16; ++kk) { float a[4], g[4], l[4];
#pragma unroll
            for (int i = 0; i < 4; ++i) { a[i] = As[kk][ty * 4 + i]; g[i] = Bg[kk][tx * 4 + i]; l[i] = Bl[kk][tx * 4 + i]; }
#pragma unroll
            for (int i = 0; i < 4; ++i)
#pragma unroll
                for (int j = 0; j < 4; ++j) { ag[i][j] += a[i] * g[j]; al[i][j] += a[i] * l[j]; } }
        __syncthreads();
    }
#pragma unroll
    for (int i = 0; i < 4; ++i) { const int m = m0 + ty * 4 + i; if (m >= cnt) continue;
#pragma unroll
        for (int j = 0; j < 4; ++j) { const int c = n0 + tx * 4 + j; float gl = ag[i][j] + bup[e * 2048 + c], li = al[i][j] + bup[e * 2048 + 1024 + c];
            gl = fminf(gl, 7.f); li = fminf(fmaxf(li, -7.f), 7.f);
            ACT[(size_t)(roff + m) * 1024 + c] = f2fp8(gl * sigmoidf_(1.702f * gl) * (li + 1.f)); } }
}
__global__ void __launch_bounds__(256) n_moe_down(const fp8* ACT, const unsigned* counts, const fp8* WdnT, const float* bdn, fp8* YS) {
    const int e = blockIdx.z, cnt = (int)counts[e], m0 = blockIdx.y * 64, n0 = blockIdx.x * 64; if (m0 >= cnt) return;
    __shared__ float As[16][65], Bs[16][65];
    const int tx = threadIdx.x & 15, ty = threadIdx.x >> 4; const int roff = moe_rowoff(counts, e);
    float acc[4][4];
#pragma unroll
    for (int i = 0; i < 4; ++i)
#pragma unroll
        for (int j = 0; j < 4; ++j) acc[i][j] = 0.f;
    const fp8* W = WdnT + (size_t)e * 1024 * 1024;
    for (int k0 = 0; k0 < 1024; k0 += 16) {
        for (int i = threadIdx.x; i < 1024; i += 256) { const int r = i >> 4, c = i & 15; const int m = (m0 + r < cnt) ? m0 + r : m0;
            As[c][r] = fp82f(ACT[(size_t)(roff + m) * 1024 + k0 + c]); Bs[c][r] = fp82f(W[(size_t)(n0 + r) * 1024 + k0 + c]) * W8_INV; }
        __syncthreads();
#pragma unroll
        for (int kk = 0; kk < 16; ++kk) { float a[4], b[4];
#pragma unroll
            for (int i = 0; i < 4; ++i) { a[i] = As[kk][ty * 4 + i]; b[i] = Bs[kk][tx * 4 + i]; }
#pragma unroll
            for (int i = 0; i < 4; ++i)
#pragma unroll
                for (int j = 0; j < 4; ++j) acc[i][j] += a[i] * b[j]; }
        __syncthreads();
    }
#pragma unroll
    for (int i = 0; i < 4; ++i) { const int m = m0 + ty * 4 + i; if (m >= cnt) continue;
#pragma unroll
        for (int j = 0; j < 4; ++j) { const int c = n0 + tx * 4 + j; YS[(size_t)(roff + m) * 1024 + c] = f2fp8(acc[i][j] + bdn[e * 1024 + c]); } }
}
__global__ void __launch_bounds__(256) n_combine(const float* x, const bf16* X1, const fp8* YS, const unsigned* counts, const int* toke, const float* tokg, const float* gf, float* out) {
    const int t = blockIdx.x * 4 + (threadIdx.x >> 6), lane = threadIdx.x & 63;
    f32x4 v[4];
#pragma unroll
    for (int j = 0; j < 4; ++j) { v[j] = ((const f32x4*)(x + (size_t)t * D))[lane + 64 * j]; const bf16* dp = X1 + (size_t)t * D + 4 * lane + 256 * j; v[j].x += bf2f(dp[0]); v[j].y += bf2f(dp[1]); v[j].z += bf2f(dp[2]); v[j].w += bf2f(dp[3]); }
    for (int k = 0; k < 4; ++k) { const int te = toke[t * 4 + k], e = te & 255, pos = te >> 8; const float g = tokg[t * 4 + k];
        const fp8* y = YS + (size_t)(moe_rowoff(counts, e) + pos) * 1024;
#pragma unroll
        for (int j = 0; j < 4; ++j) { const fp8* p = y + 4 * lane + 256 * j; v[j].x += g * fp82f(p[0]); v[j].y += g * fp82f(p[1]); v[j].z += g * fp82f(p[2]); v[j].w += g * fp82f(p[3]); } }
    float s = 0.f;
#pragma unroll
    for (int j = 0; j < 4; ++j) s += v[j].x * v[j].x + v[j].y * v[j].y + v[j].z * v[j].z + v[j].w * v[j].w;
    const float rstd = rsqrtf(wave_sum(s) * (1.f / D) + RMS_EPS);
#pragma unroll
    for (int j = 0; j < 4; ++j) { const f32x4 gg = ((const f32x4*)gf)[lane + 64 * j]; f32x4 o = v[j] * rstd * gg; ((f32x4*)(out + (size_t)t * D))[lane + 64 * j] = o; }
}

#define GAS __attribute__((address_space(1)))
#define LAS __attribute__((address_space(3)))
typedef short bf16x8 __attribute__((ext_vector_type(8)));
typedef float f32x16 __attribute__((ext_vector_type(16)));
typedef short s16x4 __attribute__((ext_vector_type(4)));
typedef float f32x2 __attribute__((ext_vector_type(2)));
typedef GAS unsigned gu32;
#define RLX_AGENT __ATOMIC_RELAXED, __HIP_MEMORY_SCOPE_AGENT
#define LDS_WAIT() asm volatile("s_waitcnt lgkmcnt(0)" ::: "memory")
#define VM_WAIT() asm volatile("s_waitcnt vmcnt(0)" ::: "memory")

constexpr int NWAVES = 8, NTHR = 512;
constexpr int RING_BYTES = 131072;
constexpr int HB_STRIDE = 4112, HB_BYTES = 32 * HB_STRIDE;
constexpr int TBL_OFF = 132096;
constexpr int RT_LOGIT = 133120, RT_TOKE = RT_LOGIT + 8448, RT_TOKR = RT_TOKE + 1024, RT_TOKG = RT_TOKR + 1024, RT_HIST = RT_TOKG + 1024, RT_BASE = RT_HIST + 128;
constexpr int BIAS_OFF = 133120;
constexpr int MISC_OFF = 145408;
constexpr int LDS_BYTES = 147456;
static_assert(RT_BASE + 128 <= MISC_OFF && HB_BYTES <= TBL_OFF && MISC_OFF + 128 <= LDS_BYTES, "LDS map");

__device__ __forceinline__ unsigned cvt_pk_bf16(float lo, float hi) { unsigned r; asm volatile("v_cvt_pk_bf16_f32 %0, %1, %2" : "=v"(r) : "v"(lo), "v"(hi)); return r; }
__device__ __forceinline__ float bflo(unsigned w) { return __uint_as_float(w << 16); }
__device__ __forceinline__ float bfhi(unsigned w) { return __uint_as_float(w & 0xffff0000u); }
__device__ __forceinline__ float fast_sigmoid(float v) { return __builtin_amdgcn_rcpf(1.0f + __builtin_amdgcn_exp2f(-1.44269504089f * v)); }

#define XB_TMO      128
#define XB_XCNT(j)  (256  + 64 * (j))
#define XB_XSUB(j)  (1280 + 64 * (j))
#define XB_XGEN(j)  (2304 + 64 * (j))
#define XB_TOP      3328
#define XB_TOPGEN   3392
#define XCD_BAR_WORDS 3456
#define XB_SPIN_CAP (1u << 18)
__device__ __forceinline__ unsigned xb_ld(unsigned* p)              { return __hip_atomic_load(p, __ATOMIC_RELAXED, __HIP_MEMORY_SCOPE_AGENT); }
__device__ __forceinline__ unsigned xb_add(unsigned* p, unsigned v) { return __hip_atomic_fetch_add(p, v, __ATOMIC_RELAXED, __HIP_MEMORY_SCOPE_AGENT); }
__device__ __forceinline__ unsigned xb_xcc_id() { return (unsigned)__builtin_amdgcn_s_getreg((3 << 11) | 20) & 0xFu; }
#define XB_SPIN(cond, bar) do { unsigned _sp = 0; while (cond) { __builtin_amdgcn_s_sleep(1); \
    if ((++_sp & 255u) == 0u) { if (xb_ld(&(bar)[XB_TMO])) break; if (_sp > XB_SPIN_CAP) { atomicAdd(&(bar)[XB_TMO], 1u); break; } } } } while (0)
struct XcdBarrier { unsigned* bar; unsigned x; volatile LAS unsigned* st; };
__device__ __forceinline__ XcdBarrier xcd_barrier_post(unsigned* bar, volatile LAS unsigned* st) {
    XcdBarrier b; b.bar = bar; b.x = xb_xcc_id(); b.st = st;
    if (threadIdx.x == 0) (void)xb_add(&bar[XB_XCNT(b.x)], 1u);
    return b;
}
__device__ __forceinline__ void xcd_barrier_complete(unsigned* bar, unsigned x, unsigned& nloc, unsigned& nx) {
    const unsigned G = gridDim.x * gridDim.y * gridDim.z;
    unsigned sum, cnt, mine, sp = 0u;
    for (;;) {
        sum = 0u; cnt = 0u; mine = 0u;
#pragma unroll
        for (unsigned j = 0; j < 16; ++j) { const unsigned c = xb_ld(&bar[XB_XCNT(j)]); sum += c; cnt += (c > 0u) ? 1u : 0u; mine = (j == x) ? c : mine; }
        if (sum == G) break;
        __builtin_amdgcn_s_sleep(1);
        if ((++sp & 255u) == 0u) { if (xb_ld(&bar[XB_TMO])) break; if (sp > XB_SPIN_CAP) { atomicAdd(&bar[XB_TMO], 1u); break; } }
    }
    nloc = mine > 0u ? mine : 1u; nx = cnt > 0u ? cnt : 1u;
}
__device__ __forceinline__ void xcd_barrier(const XcdBarrier& b) {
    asm volatile("s_waitcnt vmcnt(0)" ::: "memory");
    __syncthreads();
    if (threadIdx.x == 0) {
        unsigned* bar = b.bar;
        __builtin_amdgcn_s_waitcnt(0);
        unsigned nloc = b.st[0], nx = b.st[1];
        if (nloc == 0u) { xcd_barrier_complete(bar, b.x, nloc, nx); b.st[0] = nloc; b.st[1] = nx; }
        const unsigned old = xb_add(&bar[XB_XSUB(b.x)], 1u);
        const unsigned gen = old / nloc;
        if (old + 1u == (gen + 1u) * nloc) {
            __builtin_amdgcn_fence(__ATOMIC_RELEASE, "agent");
            asm volatile("s_waitcnt vmcnt(0)" ::: "memory");
            const unsigned og = xb_add(&bar[XB_TOP], 1u);
            const unsigned tg = og / nx;
            if (og + 1u == (tg + 1u) * nx) xb_add(&bar[XB_TOPGEN], 1u);
            else XB_SPIN(xb_ld(&bar[XB_TOPGEN]) == tg, bar);
            __builtin_amdgcn_fence(__ATOMIC_ACQUIRE, "agent");
            xb_add(&bar[XB_XGEN(b.x)], 1u);
            asm volatile("s_waitcnt vmcnt(0)" ::: "memory");
        } else {
            XB_SPIN(xb_ld(&bar[XB_XGEN(b.x)]) == gen, bar);
            __builtin_amdgcn_fence(__ATOMIC_ACQUIRE, "agent");
            asm volatile("s_waitcnt vmcnt(0)" ::: "memory");
        }
    }
    __syncthreads();
}

namespace pg8 {
constexpr int BM = 256, BK = 64, HALF = 128, HTB = HALF * BK * 2, STAGE_BYTES = 8 * HTB, NXCD = 8, WGM = 8;
__host__ __device__ __forceinline__ int lds_byte(int r, int c) { const int st = (r >> 4) * 2 + (c >> 5), rr = r & 15, cc = c & 31, ob = rr * 64 + cc * 2; return st * 1024 + (ob ^ (((ob >> 9) & 1) << 5)); }
__host__ __device__ __forceinline__ void stage_rc(int b, int& R, int& C) { const int st = b / 1024, sb = b % 1024, swz = sb ^ (((sb >> 9) & 1) << 5); R = (st >> 1) * 16 + swz / 64; C = (st & 1) * 32 + (swz % 64) / 2; }
__host__ __device__ __forceinline__ int perm32(int rho) { const int n = rho >> 4, i = rho & 15; return 8 * (i >> 2) + 4 * n + (i & 3); }

struct GUnit { int row0, pn, e, grow, nvalid; };

struct DenseOrder {
    int nM, nN, nwg, G, c;
    __device__ void init(int M, int N, int G_, int c_) { nM = M / BM; nN = N / BM; nwg = nM * nN; G = G_; c = c_; }
    __device__ bool next(int i, GUnit& u) const {
        const long L = (long)i * G + c; if (L >= nwg) return false;
        int wgid = (int)L; { const int q = nwg / NXCD, r = nwg % NXCD, xcd = wgid % NXCD, off = wgid / NXCD; wgid = (xcd < r ? xcd * (q + 1) : r * (q + 1) + (xcd - r) * q) + off; }
        const int nig = WGM * nN, gid = wgid / nig, fm = gid * WGM, gsz = (nM - fm) < WGM ? (nM - fm) : WGM;
        u.row0 = (fm + ((wgid % nig) % gsz)) * BM; u.pn = (wgid % nig) / gsz; u.e = 0; u.grow = 0; u.nvalid = BM; return true;
    }
};
struct MoeOrder {
    const LAS int* ust; const LAS int* rowoff; const LAS int* cnt; int lognN, G, c;
    __device__ bool next(int i, GUnit& u) const {
        const int L = i * G + c; const int total = __builtin_amdgcn_readfirstlane(ust[32]); if (L >= total) return false;
        int e = 0;
#pragma unroll
        for (int j = 1; j < 32; ++j) e += (L >= __builtin_amdgcn_readfirstlane(ust[j])) ? 1 : 0;
        const int idx = L - __builtin_amdgcn_readfirstlane(ust[e]); const int r = idx >> lognN, pn = idx & ((1 << lognN) - 1);
        u.row0 = __builtin_amdgcn_readfirstlane(rowoff[e]) + BM * r; u.pn = pn; u.e = e; u.grow = e * CAP + BM * r; u.nvalid = __builtin_amdgcn_readfirstlane(cnt[e]) - BM * r; return true;
    }
};

template <bool VEC> struct MoeOrderX {
    const LAS int* rowoff; const LAS int* cnt; int lognN, G, c;
    __device__ bool next(int i, GUnit& u) const {
        int rem = i;
        for (int v = c; v < 256; v += G) {
            const int x8 = v & 7, j = v >> 3, e = x8 + 8 * (j >> 3), pn = (lognN == 3) ? (j & 7) : ((j & 7) >> 1), r0 = (lognN == 3) ? 0 : (j & 1), rs = (lognN == 3) ? 1 : 2;
            const int ce = __builtin_amdgcn_readfirstlane(cnt[e]), R = (ce + 255) >> 8, n = (R > r0) ? (R - r0 + rs - 1) / rs : 0;
            if (rem < n) { const int r = r0 + rem * rs; u.row0 = __builtin_amdgcn_readfirstlane(rowoff[e]) + BM * r; u.pn = pn; u.e = e; u.grow = e * CAP + BM * r; u.nvalid = ce - BM * r;
                if (VEC) { int ev = e; asm volatile("" : "+v"(ev)); u.e = ev; }
                return true; }
            rem -= n;
        }
        return false;
    }
};
struct MoeOrderOwn {
    const LAS int* rowoff; const LAS int* cnt; unsigned mx, mh; int G, c;
    __device__ bool next(int i, GUnit& u) const {
        int rem = i; const int ns = 8 * __builtin_popcount(mh);
        for (int v = c; v < 256; v += G) {
            const int x8 = v & 7, j = v >> 3, e = x8 + 8 * (j >> 3), jl = j & 7, pn = jl >> 1, rpar = jl & 1;
            const int ce = __builtin_amdgcn_readfirstlane(cnt[e]), R = (ce + 255) >> 8, n2 = R >> 1;
            const bool stolen = ((mx >> e) & 1u) && (4 * __builtin_popcount(mx & ((1u << e) - 1u)) + pn < ns);
            const int n = n2 + (((R & 1) && rpar == 0 && !stolen) ? 1 : 0);
            if (rem < n) { const int r = rem < n2 ? rpar + 2 * rem : R - 1; u.row0 = __builtin_amdgcn_readfirstlane(rowoff[e]) + BM * r; u.pn = pn; u.e = e; u.grow = e * CAP + BM * r; u.nvalid = ce - BM * r; return true; }
            rem -= n;
        }
        return false;
    }
};
struct MoeOrderSteal {
    const LAS int* rowoff; const LAS int* cnt; unsigned mx, mh; int G, c;
    __device__ bool next(int i, GUnit& u) const {
        int rem = i; const int nx = 4 * __builtin_popcount(mx);
        for (int v = c; v < 256; v += G) {
            const int x8 = v & 7, j = v >> 3, e = x8 + 8 * (j >> 3), jl = j & 7;
            if (!((mh >> e) & 1u)) continue;
            const int s = 8 * __builtin_popcount(mh & ((1u << e) - 1u)) + jl;
            if (s >= nx) continue;
            if (rem == 0) { unsigned m = mx; for (int q = 0; q < (s >> 2); ++q) m &= m - 1u;
                const int o = __builtin_ctz(m), pn = s & 3, ce = __builtin_amdgcn_readfirstlane(cnt[o]), r = ((ce + 255) >> 8) - 1;
                u.row0 = __builtin_amdgcn_readfirstlane(rowoff[o]) + BM * r; u.pn = pn; u.e = o; u.grow = o * CAP + BM * r; u.nvalid = ce - BM * r; return true; }
            --rem;
        }
        return false;
    }
};
__host__ __device__ __forceinline__ int sig8(int p) { return (p & 1) | (((p >> 2) & 1) * 6); }
typedef int v8i __attribute__((ext_vector_type(8)));
typedef int i32x4 __attribute__((ext_vector_type(4)));

template <class Epi, class Sched, int K, bool GATHER, bool F8>
__device__ __forceinline__ void gemm_phase(LAS unsigned char* lds, const void* A, const void* Bt, size_t bexp  , const Sched& S, const Epi& E, const int* gidx) {
    const int tid = threadIdx.x, wid = __builtin_amdgcn_readfirstlane(tid >> 6), lane = tid & 63, wr = wid >> 2, wc = wid & 3, fr = lane & 15, fq = lane >> 4;
    constexpr int ES = F8 ? 1 : 2, KB = K * ES, nt = KB / 128;
    static_assert(nt >= 4 && nt % 2 == 0, "K");
    int R0, C0b;
    if constexpr (F8) { R0 = tid >> 3; C0b = ((tid & 7) ^ sig8((R0 >> 1) & 7)) << 4; }
    else { int C0; stage_rc(tid * 16, R0, C0); C0b = C0 * 2; }
    unsigned voffA[2], voffB[2];
#pragma unroll
    for (int i = 0; i < 2; ++i) { const int R = R0 + 64 * i; const int Rb = Epi::PERM ? ((R & ~31) + perm32(R & 31)) : R;
        voffA[i] = (unsigned)(R * KB + C0b); voffB[i] = (unsigned)(Rb * KB + C0b); }
    constexpr size_t kstep = 128, hstep = (size_t)HALF * KB;
    const unsigned ldsw = (unsigned)wid * 1024u;
    int aoff, boff, aoff1 = 0, boff1 = 0;
    if constexpr (F8) { const int sg = sig8((fr >> 1) & 7);
        aoff = (wr * 64 + fr) * 128 + (((2 * fq) ^ sg) << 4); aoff1 = (wr * 64 + fr) * 128 + (((2 * fq + 1) ^ sg) << 4);
        boff = (wc * 32 + fr) * 128 + (((2 * fq) ^ sg) << 4); boff1 = (wc * 32 + fr) * 128 + (((2 * fq + 1) ^ sg) << 4); }
    else { aoff = lds_byte(wr * 64 + fr, fq * 8); boff = lds_byte(wc * 32 + fr, fq * 8); }
    unsigned gcur[2][2], gnxt[2][2];
#define PG8_LOADG(u_, g_) do { _Pragma("unroll") for (int _h = 0; _h < 2; ++_h) _Pragma("unroll") for (int _i = 0; _i < 2; ++_i) { const int _r = _h * HALF + R0 + 64 * _i; int _tok = 0; \
        if (_r < (u_).nvalid) _tok = gidx[(u_).grow + _r]; (g_)[_h][_i] = (unsigned)_tok * (unsigned)KB + (unsigned)C0b; } } while (0)
#define PG8_PING(g_) asm volatile("" : "+v"((g_)[0][0]), "+v"((g_)[0][1]), "+v"((g_)[1][0]), "+v"((g_)[1][1]))
#define PG8_SA(b, h) (((b) * 2 + (h)) * HTB)
#define PG8_SB(b, h) ((4 + (b) * 2 + (h)) * HTB)
#define PG8_STAGE(bufoff, rs, soff, voff) do { _Pragma("unroll") for (int _i = 0; _i < 2; ++_i) \
        __builtin_amdgcn_raw_ptr_buffer_load_lds(rs, (LAS void*)(lds + (bufoff) + ldsw + _i * 8192), 16, (int)(voff)[_i], (int)(soff), 0, 0); } while (0)
#define PG8_STAGE_A(bufoff, h, nx, kb) do { if constexpr (GATHER) { _Pragma("unroll") for (int _i = 0; _i < 2; ++_i) { const unsigned _o = (nx) ? gnxt[h][_i] : gcur[h][_i]; \
            __builtin_amdgcn_raw_ptr_buffer_load_lds(rsA, (LAS void*)(lds + (bufoff) + ldsw + _i * 8192), 16, (int)_o, (int)(kb), 0, 0); } } \
        else { PG8_STAGE(bufoff, rsA, ((nx) ? nA : cA) + (unsigned)((h) * hstep) + (unsigned)(kb), voffA); } } while (0)
#define PG8_LDA(b, h) do { if constexpr (F8) { _Pragma("unroll") for (int m = 0; m < 4; ++m) { const i32x4 _l = *(const LAS i32x4*)(lds + PG8_SA(b, h) + aoff + m * 2048), _h2 = *(const LAS i32x4*)(lds + PG8_SA(b, h) + aoff1 + m * 2048); \
            At8[m] = __builtin_shufflevector(_l, _h2, 0, 1, 2, 3, 4, 5, 6, 7); } } \
        else { _Pragma("unroll") for (int m = 0; m < 4; ++m) _Pragma("unroll") for (int k = 0; k < 2; ++k) At[m][k] = *(const LAS bf16x8*)(lds + PG8_SA(b, h) + aoff + m * 2048 + k * 1024); } } while (0)
#define PG8_LDB(dst, dst8, b, h) do { if constexpr (F8) { _Pragma("unroll") for (int n = 0; n < 2; ++n) { const i32x4 _l = *(const LAS i32x4*)(lds + PG8_SB(b, h) + boff + n * 2048), _h2 = *(const LAS i32x4*)(lds + PG8_SB(b, h) + boff1 + n * 2048); \
            dst8[n] = __builtin_shufflevector(_l, _h2, 0, 1, 2, 3, 4, 5, 6, 7); } } \
        else { _Pragma("unroll") for (int n = 0; n < 2; ++n) _Pragma("unroll") for (int k = 0; k < 2; ++k) dst[n][k] = *(const LAS bf16x8*)(lds + PG8_SB(b, h) + boff + n * 2048 + k * 1024); } } while (0)
#define PG8_MMA(ai, bj, Bt_, Bt8_) do { __builtin_amdgcn_s_setprio(1); if constexpr (F8) { _Pragma("unroll") for (int m = 0; m < 4; ++m) _Pragma("unroll") for (int n = 0; n < 2; ++n) \
            acc[ai][bj][m][n] = __builtin_amdgcn_mfma_scale_f32_16x16x128_f8f6f4(Bt8_[n], At8[m], acc[ai][bj][m][n], 0, 0, 0, 0, 0, 0); } \
        else { _Pragma("unroll") for (int m = 0; m < 4; ++m) _Pragma("unroll") for (int n = 0; n < 2; ++n) _Pragma("unroll") for (int k = 0; k < 2; ++k) \
            acc[ai][bj][m][n] = __builtin_amdgcn_mfma_f32_16x16x32_bf16(Bt_[n][k], At[m][k], acc[ai][bj][m][n], 0, 0, 0); } __builtin_amdgcn_s_setprio(0); } while (0)
#define PG8_WAIT_V(n) asm volatile("s_waitcnt vmcnt(" #n ")" ::: "memory")
#define PG8_WAIT_L(n) asm volatile("s_waitcnt lgkmcnt(" #n ")" ::: "memory")
#define PG8_BAR __builtin_amdgcn_s_barrier()
#define PG8_SCHED __builtin_amdgcn_sched_barrier(0)
    GUnit cur, nxt, nn; int ui = 0;
    if (!S.next(0, cur)) return;
    bool has_next = S.next(1, nxt);
    f32x4 acc[2][2][4][2];
#pragma unroll
    for (int a = 0; a < 2; ++a)
#pragma unroll
        for (int b = 0; b < 2; ++b)
#pragma unroll
            for (int m = 0; m < 4; ++m)
#pragma unroll
                for (int n = 0; n < 2; ++n) acc[a][b][m][n] = (f32x4){0.f, 0.f, 0.f, 0.f};
    bf16x8 At[4][2], B0[2][2], B1[2][2]; v8i At8[4], B08[2], B18[2];
    const __amdgpu_buffer_rsrc_t rsA = __builtin_amdgcn_make_buffer_rsrc((void*)A, 0, 0x7fffffff, 0x00020000), rsB = __builtin_amdgcn_make_buffer_rsrc((void*)Bt, 0, 0x7fffffff, 0x00020000);
    unsigned cA = (unsigned)cur.row0 * (unsigned)KB;
    unsigned cB = (unsigned)(((size_t)cur.e * bexp + (size_t)cur.pn * BM * K) * ES);
    unsigned nA = cA, nB = cB;
    if constexpr (GATHER) {
        PG8_LOADG(cur, gcur);
        if (has_next) PG8_LOADG(nxt, gnxt); else { gnxt[0][0] = gcur[0][0]; gnxt[0][1] = gcur[0][1]; gnxt[1][0] = gcur[1][0]; gnxt[1][1] = gcur[1][1]; }
        PG8_PING(gcur); PG8_PING(gnxt);
    }
    PG8_STAGE(PG8_SB(0, 0), rsB, cB, voffB); PG8_STAGE(PG8_SB(0, 1), rsB, cB + (unsigned)hstep, voffB); PG8_STAGE_A(PG8_SA(0, 0), 0, false, 0u); PG8_STAGE_A(PG8_SA(0, 1), 1, false, 0u);
    if (wr == 1) PG8_BAR;
    PG8_WAIT_V(2); PG8_BAR;
    PG8_STAGE(PG8_SB(1, 0), rsB, cB + (unsigned)kstep, voffB); PG8_STAGE_A(PG8_SA(1, 0), 0, false, (unsigned)kstep); PG8_STAGE(PG8_SB(1, 1), rsB, cB + (unsigned)(hstep + kstep), voffB);
    PG8_WAIT_V(6); PG8_BAR;
    for (;;) {
        if (has_next) { nA = (unsigned)nxt.row0 * (unsigned)KB; nB = (unsigned)(((size_t)nxt.e * bexp + (size_t)nxt.pn * BM * K) * ES); } else { nA = cA; nB = cB; }
#define PG8_KBODY(LAST, T_) do { \
            const unsigned kb1 = (unsigned)((T_) + 1) * (unsigned)kstep, kb2 = (LAST) ? 0u : (unsigned)((T_) + 2) * (unsigned)kstep, kb3 = kb2 + (unsigned)kstep; \
            const unsigned b2 = ((LAST) ? nB : cB) + kb2, b3 = b2 + (unsigned)kstep; \
              \
            PG8_LDB(B0, B08, 0, 0); PG8_LDB(B1, B18, 0, 1); PG8_SCHED; PG8_LDA(0, 0); PG8_STAGE_A(PG8_SA(1, 1), 1, false, kb1); \
            PG8_WAIT_V(8); PG8_WAIT_L(0); PG8_BAR; PG8_MMA(0, 0, B0, B08); PG8_MMA(0, 1, B1, B18); PG8_BAR; PG8_SCHED; \
              \
            PG8_LDA(0, 1); PG8_STAGE(PG8_SB(0, 0), rsB, b2, voffB); PG8_STAGE(PG8_SB(0, 1), rsB, b2 + (unsigned)hstep, voffB); PG8_STAGE_A(PG8_SA(0, 0), 0, LAST, kb2); \
            PG8_WAIT_V(8); PG8_WAIT_L(0); PG8_BAR; PG8_MMA(1, 0, B0, B08); PG8_MMA(1, 1, B1, B18); PG8_BAR; PG8_SCHED; \
              \
            PG8_LDB(B0, B08, 1, 0); PG8_LDB(B1, B18, 1, 1); PG8_SCHED; PG8_LDA(1, 0); PG8_STAGE_A(PG8_SA(0, 1), 1, LAST, kb2); \
            PG8_WAIT_V(8); PG8_WAIT_L(0); PG8_BAR; PG8_MMA(0, 0, B0, B08); PG8_MMA(0, 1, B1, B18); PG8_BAR; PG8_SCHED; \
              \
            PG8_LDA(1, 1); PG8_STAGE(PG8_SB(1, 0), rsB, b3, voffB); PG8_STAGE(PG8_SB(1, 1), rsB, b3 + (unsigned)hstep, voffB); PG8_STAGE_A(PG8_SA(1, 0), 0, LAST, kb3); \
            PG8_WAIT_V(8); PG8_WAIT_L(0); PG8_BAR; PG8_MMA(1, 0, B0, B08); PG8_MMA(1, 1, B1, B18); PG8_BAR; PG8_SCHED; } while (0)
        bool has_nn = false; unsigned gnn[2][2]; int gtok[2][2] = {{0, 0}, {0, 0}};
#pragma unroll 1
        for (int t = 0; t < nt; t += 2) {
            const bool last = (t == nt - 2);
            if (last) {
                has_nn = has_next && S.next(ui + 2, nn);
                if constexpr (GATHER) { if (has_nn) {
#pragma unroll
                    for (int _h = 0; _h < 2; ++_h)
#pragma unroll
                        for (int _i = 0; _i < 2; ++_i) { const int _r = _h * HALF + R0 + 64 * _i; if (_r < nn.nvalid) gtok[_h][_i] = gidx[nn.grow + _r]; } } }
                if (wid == 0) E.stage(cur, lds + BIAS_OFF, lane);
            }
            PG8_KBODY(last, t);
        }
        if constexpr (GATHER) {
#pragma unroll
            for (int _h = 0; _h < 2; ++_h)
#pragma unroll
                for (int _i = 0; _i < 2; ++_i) gnn[_h][_i] = has_nn ? (unsigned)gtok[_h][_i] * (unsigned)KB + (unsigned)C0b : gnxt[_h][_i];
            PG8_PING(gnn);
        }
        if (wr == 0) PG8_BAR;
        E(acc, cur, wr, wc, fr, fq, (const LAS float*)(lds + BIAS_OFF));
        if (!has_next) break;
#pragma unroll
        for (int a = 0; a < 2; ++a)
#pragma unroll
            for (int b = 0; b < 2; ++b)
#pragma unroll
                for (int m = 0; m < 4; ++m)
#pragma unroll
                    for (int n = 0; n < 2; ++n) acc[a][b][m][n] = (f32x4){0.f, 0.f, 0.f, 0.f};
        cur = nxt; nxt = nn; has_next = has_nn; cA = nA; cB = nB; ++ui;
        if constexpr (GATHER) {
#pragma unroll
            for (int h = 0; h < 2; ++h)
#pragma unroll
                for (int i = 0; i < 2; ++i) { gcur[h][i] = gnxt[h][i]; gnxt[h][i] = gnn[h][i]; }
        }
        if (wr == 1) PG8_BAR;
    }
    PG8_WAIT_V(0);
    PG8_BAR;
    (void)At; (void)B0; (void)B1; (void)At8; (void)B08; (void)B18; (void)aoff1; (void)boff1;
#undef PG8_KBODY
#undef PG8_LOADG
#undef PG8_PING
#undef PG8_SA
#undef PG8_SB
#undef PG8_STAGE
#undef PG8_STAGE_A
#undef PG8_LDA
#undef PG8_LDB
#undef PG8_MMA
#undef PG8_WAIT_V
#undef PG8_WAIT_L
#undef PG8_BAR
#undef PG8_SCHED
}

typedef f32x4 Acc[2][2][4][2];
__device__ __forceinline__ u32x4 pack8(const f32x4 v0, const f32x4 v1) { u32x4 w; w.x = cvt_pk_bf16(v0[0], v0[1]); w.y = cvt_pk_bf16(v0[2], v0[3]); w.z = cvt_pk_bf16(v1[0], v1[1]); w.w = cvt_pk_bf16(v1[2], v1[3]); return w; }

struct EpiInProj {
    static constexpr bool PERM = true;
    const float* bias; const float* cs; bf16 *Q, *KB, *VB, *U, *GA, *GP;
    __device__ __forceinline__ void stage(const GUnit& u, LAS unsigned char* slot, int lane) const {
        const __amdgpu_buffer_rsrc_t rs = __builtin_amdgcn_make_buffer_rsrc((void*)bias, 0, 0x7fffffff, 0x00020000);
        __builtin_amdgcn_raw_ptr_buffer_load_lds(rs, (LAS void*)slot, 16, lane * 16, u.pn * 1024, 0, 0); }
    __device__ __forceinline__ void operator()(const Acc& acc, const GUnit& u, int wr, int wc, int fr, int fq, const LAS float* bl) const {
        const int pn = u.pn; const bool rw = (wc & 1) == 0;
        bf16 *d0, *d1; int c0, pitch; bool rp0, rp1, nt;
        if (pn < 4) { d0 = d1 = Q; c0 = pn * 256; pitch = 1024; rp0 = rp1 = rw; nt = false; }
        else if (pn == 4) { d0 = KB; d1 = VB - 128; c0 = 0; pitch = 128; rp0 = rw; rp1 = false; nt = false; }
        else if (pn < 7) { d0 = d1 = U; c0 = (pn - 5) * 256; pitch = 512; rp0 = rp1 = false; nt = false; }
        else if (pn < 11) { d0 = d1 = GA; c0 = (pn - 7) * 256; pitch = 1024; rp0 = rp1 = false; nt = true; }
        else { d0 = d1 = GP; c0 = (pn - 11) * 256; pitch = 1024; rp0 = rp1 = false; nt = true; }
        const int rowl = wr * 64 + fr;
        const __amdgpu_buffer_rsrc_t r0 = __builtin_amdgcn_make_buffer_rsrc((void*)(d0 + (size_t)u.row0 * pitch), 0, 0x7fffffff, 0x00020000);
        const __amdgpu_buffer_rsrc_t r1 = __builtin_amdgcn_make_buffer_rsrc((void*)(d1 + (size_t)u.row0 * pitch), 0, 0x7fffffff, 0x00020000);
        const int vo = (rowl * pitch + c0 + wc * 32 + 8 * fq) * 2;
        f32x4 bb[2][2];
#pragma unroll
        for (int bj = 0; bj < 2; ++bj) { bb[bj][0] = *(const LAS f32x4*)(bl + bj * 128 + wc * 32 + 8 * fq); bb[bj][1] = *(const LAS f32x4*)(bl + bj * 128 + wc * 32 + 8 * fq + 4); }
        const float sg = (fq == 0) ? -1.f : 1.f;
        const int rstep = pitch * 32;
#pragma unroll
        for (int am = 0; am < 8; am += 2) {
            f32x4 csr[2][4];
            if (rp0) {
#pragma unroll
                for (int mm = 0; mm < 2; ++mm)
#pragma unroll
                    for (int q = 0; q < 4; ++q) csr[mm][q] = *(const f32x4*)(cs + (size_t)(u.row0 + rowl + ((am + mm) >> 2) * 128 + ((am + mm) & 3) * 16) * 16 + 4 * q);
            }
#pragma unroll
            for (int mm = 0; mm < 2; ++mm)
#pragma unroll
                for (int bj = 0; bj < 2; ++bj) { const int ai = (am + mm) >> 2, m = (am + mm) & 3;
                    f32x4 v0 = acc[ai][bj][m][0] + bb[bj][0], v1 = acc[ai][bj][m][1] + bb[bj][1];
                    if (bj == 0 ? rp0 : rp1) {
                        f32x4 o0, o1;
#pragma unroll
                        for (int j = 0; j < 4; ++j) { o0[j] = __shfl_xor(v0[j], 16); o1[j] = __shfl_xor(v1[j], 16); }
                        const f32x4 q0 = v0 * csr[mm][0] + (o0 * csr[mm][2]) * sg, q1 = v1 * csr[mm][1] + (o1 * csr[mm][3]) * sg;
                        if (fq < 2) { v0 = q0; v1 = q1; } }
                    const u32x4 w = pack8(v0, v1); const int so = (ai * 8 + m) * rstep;
                    if (nt) __builtin_amdgcn_raw_buffer_store_b128(w, bj == 0 ? r0 : r1, vo + bj * 256, so, 2);
                    else __builtin_amdgcn_raw_buffer_store_b128(w, bj == 0 ? r0 : r1, vo + bj * 256, so, 0);
                }
        }
    }
};
struct EpiGateA {
    static constexpr bool PERM = true;
    const bf16* GA; bf16* T1;
    __device__ __forceinline__ void stage(const GUnit&, LAS unsigned char*, int) const {}
    __device__ __forceinline__ void operator()(const Acc& acc, const GUnit& u, int wr, int wc, int fr, int fq, const LAS float*) const {
        const int row0 = u.row0 + wr * 64 + fr;
        u32x4 gg[16];
#pragma unroll
        for (int ai = 0; ai < 2; ++ai)
#pragma unroll
            for (int m = 0; m < 4; ++m)
#pragma unroll
                for (int bj = 0; bj < 2; ++bj) gg[(ai * 4 + m) * 2 + bj] = *(const u32x4*)(GA + (size_t)(row0 + ai * 128 + m * 16) * 1024 + u.pn * 256 + bj * 128 + wc * 32 + 8 * fq);
#pragma unroll
        for (int ai = 0; ai < 2; ++ai)
#pragma unroll
            for (int m = 0; m < 4; ++m)
#pragma unroll
                for (int bj = 0; bj < 2; ++bj) { const size_t off = (size_t)(row0 + ai * 128 + m * 16) * 1024 + u.pn * 256 + bj * 128 + wc * 32 + 8 * fq;
                    const u32x4 g = gg[(ai * 4 + m) * 2 + bj]; f32x4 v0 = acc[ai][bj][m][0], v1 = acc[ai][bj][m][1];
                    v0[0] *= fast_sigmoid(bflo(g.x)); v0[1] *= fast_sigmoid(bfhi(g.x)); v0[2] *= fast_sigmoid(bflo(g.y)); v0[3] *= fast_sigmoid(bfhi(g.y)); v1[0] *= fast_sigmoid(bflo(g.z)); v1[1] *= fast_sigmoid(bfhi(g.z)); v1[2] *= fast_sigmoid(bflo(g.w)); v1[3] *= fast_sigmoid(bfhi(g.w));
                    *(u32x4*)(T1 + off) = pack8(v0, v1); }
    }
};
struct EpiMerge {
    static constexpr bool PERM = true;
    const bf16* GP; const bf16* T1; bf16* MG;
    __device__ __forceinline__ void stage(const GUnit&, LAS unsigned char*, int) const {}
    __device__ __forceinline__ void operator()(const Acc& acc, const GUnit& u, int wr, int wc, int fr, int fq, const LAS float*) const {
        const int row0 = u.row0 + wr * 64 + fr;
#pragma unroll
        for (int ai = 0; ai < 2; ++ai) {
            u32x4 gg[8], tt[8];
#pragma unroll
            for (int m = 0; m < 4; ++m)
#pragma unroll
                for (int bj = 0; bj < 2; ++bj) { const size_t off = (size_t)(row0 + ai * 128 + m * 16) * 1024 + u.pn * 256 + bj * 128 + wc * 32 + 8 * fq;
                    gg[m * 2 + bj] = *(const u32x4*)(GP + off); tt[m * 2 + bj] = *(const u32x4*)(T1 + off); }
#pragma unroll
            for (int m = 0; m < 4; ++m)
#pragma unroll
                for (int bj = 0; bj < 2; ++bj) { const size_t off = (size_t)(row0 + ai * 128 + m * 16) * 1024 + u.pn * 256 + bj * 128 + wc * 32 + 8 * fq;
                    const u32x4 g = gg[m * 2 + bj]; const u32x4 t = tt[m * 2 + bj]; f32x4 v0 = acc[ai][bj][m][0], v1 = acc[ai][bj][m][1];
                    v0[0] = v0[0] * fast_sigmoid(bflo(g.x)) + bflo(t.x); v0[1] = v0[1] * fast_sigmoid(bfhi(g.x)) + bfhi(t.x); v0[2] = v0[2] * fast_sigmoid(bflo(g.y)) + bflo(t.y); v0[3] = v0[3] * fast_sigmoid(bfhi(g.y)) + bfhi(t.y);
                    v1[0] = v1[0] * fast_sigmoid(bflo(g.z)) + bflo(t.z); v1[1] = v1[1] * fast_sigmoid(bfhi(g.z)) + bfhi(t.z); v1[2] = v1[2] * fast_sigmoid(bflo(g.w)) + bflo(t.w); v1[3] = v1[3] * fast_sigmoid(bfhi(g.w)) + bfhi(t.w);
                    *(u32x4*)(MG + off) = pack8(v0, v1); }
        }
    }
};
struct EpiX1 {
    static constexpr bool PERM = true;
    bf16* X1;
    __device__ __forceinline__ void stage(const GUnit&, LAS unsigned char*, int) const {}
    __device__ __forceinline__ void operator()(const Acc& acc, const GUnit& u, int wr, int wc, int fr, int fq, const LAS float*) const {
        const int row0 = u.row0 + wr * 64 + fr;
#pragma unroll
        for (int ai = 0; ai < 2; ++ai)
#pragma unroll
            for (int m = 0; m < 4; ++m)
#pragma unroll
                for (int bj = 0; bj < 2; ++bj) *(u32x4*)(X1 + (size_t)(row0 + ai * 128 + m * 16) * 1024 + u.pn * 256 + bj * 128 + wc * 32 + 8 * fq) = pack8(acc[ai][bj][m][0], acc[ai][bj][m][1]);
    }
};
struct EpiSwiglu {
    static constexpr bool PERM = true;
    const float* bup; fp8* ACT;
    __device__ __forceinline__ void stage(const GUnit& u, LAS unsigned char* slot, int lane) const {
        const __amdgpu_buffer_rsrc_t rs = __builtin_amdgcn_make_buffer_rsrc((void*)bup, 0, 0x7fffffff, 0x00020000);
        __builtin_amdgcn_raw_ptr_buffer_load_lds(rs, (LAS void*)slot, 16, (lane & 31) * 16 + (lane >> 5) * 4096, (u.e * 2048 + u.pn * 128) * 4, 0, 0); }
    __device__ __forceinline__ void operator()(const Acc& acc, const GUnit& u, int wr, int wc, int fr, int fq, const LAS float* bl) const {
        const int row0 = u.row0 + wr * 64 + fr, col = u.pn * 128 + wc * 32 + 8 * fq;
        const LAS float* bg = bl + wc * 32 + 8 * fq;
        const f32x4 g0 = *(const LAS f32x4*)bg, g1 = *(const LAS f32x4*)(bg + 4), l0 = *(const LAS f32x4*)(bg + 128), l1 = *(const LAS f32x4*)(bg + 132);
#pragma unroll
        for (int ai = 0; ai < 2; ++ai)
#pragma unroll
            for (int m = 0; m < 4; ++m) {
                f32x4 a0 = acc[ai][0][m][0] * W8_INV + g0, a1 = acc[ai][0][m][1] * W8_INV + g1, c0 = acc[ai][1][m][0] * W8_INV + l0, c1 = acc[ai][1][m][1] * W8_INV + l1, r0, r1;
#pragma unroll
                for (int j = 0; j < 4; ++j) {
                    const float ga = fminf(a0[j], 7.f), la = fminf(fmaxf(c0[j], -7.f), 7.f); r0[j] = ga * fast_sigmoid(1.702f * ga) * (la + 1.f);
                    const float gb = fminf(a1[j], 7.f), lb = fminf(fmaxf(c1[j], -7.f), 7.f); r1[j] = gb * fast_sigmoid(1.702f * gb) * (lb + 1.f); }
                int w0 = 0, w1 = 0;
                w0 = __builtin_amdgcn_cvt_pk_fp8_f32(r0[0], r0[1], w0, false); w0 = __builtin_amdgcn_cvt_pk_fp8_f32(r0[2], r0[3], w0, true);
                w1 = __builtin_amdgcn_cvt_pk_fp8_f32(r1[0], r1[1], w1, false); w1 = __builtin_amdgcn_cvt_pk_fp8_f32(r1[2], r1[3], w1, true);
                u32x2 w; w.x = (unsigned)w0; w.y = (unsigned)w1;
                *(u32x2*)(ACT + (size_t)(row0 + ai * 128 + m * 16) * 1024 + col) = w;
            }
    }
};
struct EpiDown {
    static constexpr bool PERM = true;
    const float* bdn; fp8* YS;
    __device__ __forceinline__ void stage(const GUnit& u, LAS unsigned char* slot, int lane) const {
        const __amdgpu_buffer_rsrc_t rs = __builtin_amdgcn_make_buffer_rsrc((void*)bdn, 0, 0x7fffffff, 0x00020000);
        __builtin_amdgcn_raw_ptr_buffer_load_lds(rs, (LAS void*)slot, 16, lane * 16, (u.e * 1024 + u.pn * 256) * 4, 0, 0); }
    __device__ __forceinline__ void operator()(const Acc& acc, const GUnit& u, int wr, int wc, int fr, int fq, const LAS float* bl) const {
        const int row0 = u.row0 + wr * 64 + fr;
#pragma unroll
        for (int bj = 0; bj < 2; ++bj) { const int col = u.pn * 256 + bj * 128 + wc * 32 + 8 * fq;
            const f32x4 b0 = *(const LAS f32x4*)(bl + bj * 128 + wc * 32 + 8 * fq), b1 = *(const LAS f32x4*)(bl + bj * 128 + wc * 32 + 8 * fq + 4);
#pragma unroll
            for (int ai = 0; ai < 2; ++ai)
#pragma unroll
                for (int m = 0; m < 4; ++m) { const f32x4 r0 = acc[ai][bj][m][0] * W8_INV + b0, r1 = acc[ai][bj][m][1] * W8_INV + b1; int w0 = 0, w1 = 0;
                    w0 = __builtin_amdgcn_cvt_pk_fp8_f32(r0[0], r0[1], w0, false); w0 = __builtin_amdgcn_cvt_pk_fp8_f32(r0[2], r0[3], w0, true);
                    w1 = __builtin_amdgcn_cvt_pk_fp8_f32(r1[0], r1[1], w1, false); w1 = __builtin_amdgcn_cvt_pk_fp8_f32(r1[2], r1[3], w1, true);
                    u32x2 w; w.x = (unsigned)w0; w.y = (unsigned)w1; *(u32x2*)(YS + (size_t)(row0 + ai * 128 + m * 16) * 1024 + col) = w; } }
    }
};
}

struct Args { const float* in[19]; float* out; unsigned char* ws; int ph_lo, ph_hi, li, pad; };
struct Frame {
    LAS unsigned char* lds; int tid, lane, wave, G, bx;
    unsigned char* ws; gu32* ctl;
};

__device__ __forceinline__ void conv_item(const float* W, int N, bf16* WT, int K, int k0, int n_src0, int n_dst0, int lane, LAS unsigned char* scr) {
    const int hw = lane >> 5, l5 = lane & 31;
    const float* src = W + (size_t)(k0 + 16 * hw) * N + n_src0 + 4 * l5;
#pragma unroll
    for (int half = 0; half < 2; ++half) {
        f32x4 v[16];
#pragma unroll
        for (int j = 0; j < 16; ++j) v[j] = *(const f32x4*)(src + (size_t)(32 * half + j) * N);
#pragma unroll
        for (int q = 0; q < 4; ++q) { const int row = 4 * l5 + q;
#pragma unroll
            for (int cc = 0; cc < 2; ++cc) { u32x4 w; w.x = cvt_pk_bf16(v[8 * cc + 0][q], v[8 * cc + 1][q]); w.y = cvt_pk_bf16(v[8 * cc + 2][q], v[8 * cc + 3][q]);
                w.z = cvt_pk_bf16(v[8 * cc + 4][q], v[8 * cc + 5][q]); w.w = cvt_pk_bf16(v[8 * cc + 6][q], v[8 * cc + 7][q]);
                const int c = 4 * half + 2 * hw + cc;
                *(LAS u32x4*)(scr + row * 128 + ((c ^ (l5 & 7)) << 4)) = w; } }
    }
    LDS_WAIT(); asm volatile("" ::: "memory");
    bf16* dst = WT + (size_t)(n_dst0 + (lane >> 3)) * K + k0 + 8 * (lane & 7);
#pragma unroll
    for (int i = 0; i < 16; ++i) { const int n = 8 * i + (lane >> 3), c = lane & 7;
        const u32x4 w = *(const LAS u32x4*)(scr + n * 128 + ((c ^ ((n >> 2) & 7)) << 4));
        *(u32x4*)(dst + (size_t)(8 * i) * K) = w; }
    LDS_WAIT(); asm volatile("" ::: "memory");
}
__device__ __forceinline__ int pk4_fp8(float a, float b, float c, float d) { int w = 0; w = __builtin_amdgcn_cvt_pk_fp8_f32(a * W8_SCALE, b * W8_SCALE, w, false); w = __builtin_amdgcn_cvt_pk_fp8_f32(c * W8_SCALE, d * W8_SCALE, w, true); return w; }
template <int UNR> __device__ __forceinline__ void conv_item8(const float* W, int N, fp8* WT, int K, int k0, int n_src0, int n_dst0, int lane, LAS unsigned char* scr) {
    const int hw = lane >> 5, l5 = lane & 31;
    const float* src = W + (size_t)(k0 + 16 * hw) * N + n_src0 + 4 * l5;
#pragma unroll UNR
    for (int qt = 0; qt < 4; ++qt) {
        f32x4 v[16];
#pragma unroll
        for (int j = 0; j < 16; ++j) v[j] = __builtin_nontemporal_load((const f32x4*)(src + (size_t)(32 * qt + j) * N));
#pragma unroll
        for (int q = 0; q < 4; ++q) { const int row = 4 * l5 + q; u32x4 w;
            w.x = (unsigned)pk4_fp8(v[0][q], v[1][q], v[2][q], v[3][q]); w.y = (unsigned)pk4_fp8(v[4][q], v[5][q], v[6][q], v[7][q]);
            w.z = (unsigned)pk4_fp8(v[8][q], v[9][q], v[10][q], v[11][q]); w.w = (unsigned)pk4_fp8(v[12][q], v[13][q], v[14][q], v[15][q]);
            const int c = 2 * qt + hw;
            *(LAS u32x4*)(scr + row * 128 + ((c ^ (l5 & 7)) << 4)) = w; }
    }
    LDS_WAIT(); asm volatile("" ::: "memory");
    fp8* dst = WT + (size_t)(n_dst0 + (lane >> 3)) * K + k0 + 16 * (lane & 7);
#pragma unroll
    for (int i = 0; i < 16; ++i) { const int n = 8 * i + (lane >> 3), c = lane & 7;
        const u32x4 w = *(const LAS u32x4*)(scr + n * 128 + ((c ^ ((n >> 2) & 7)) << 4));
        __builtin_nontemporal_store(w, (u32x4*)(dst + (size_t)(8 * i) * K)); }
    LDS_WAIT(); asm volatile("" ::: "memory");
}
__device__ __forceinline__ void p0b_weights(const Frame& F, const Args& a, int widx, int nw) {
    const int gw = widx * NWAVES + F.wave, NGW = nw * NWAVES, lane = F.lane;
    unsigned char* ws = F.ws;
    bf16* WATT = (bf16*)(ws + WS_WATT); bf16* WEFF = (bf16*)(ws + WS_WEFF); bf16* WOUT = (bf16*)(ws + WS_WOUT);
    LAS unsigned char* scr = F.lds + F.wave * 16384;
    fp8* WUP8 = (fp8*)(ws + WS_WUP);
    constexpr int I_UP = 32 * 8 * 16, I_AT = 16 * 8, I_OUT = 16 * 8;
    for (int it = gw; it < I_UP; it += NGW) {
        int r = it;
        { const int e = r >> 7, q = r & 127, kb = q >> 4, nb = q & 15; conv_item8<2>(a.in[14] + (size_t)e * 1024 * 2048, 2048, WUP8 + (size_t)e * 2048 * 1024, 1024, kb * 128, up_src_col(nb * 128), nb * 128, lane, scr); }
    }
    for (int it = gw; it < I_AT + I_OUT; it += NGW) {
        int r = it;
        if (r < I_AT) { const int kb = r >> 3, nb = r & 7; conv_item(a.in[6], 1024, WATT, 1024, kb * 64, nb * 128, nb * 128, lane, scr); continue; } r -= I_AT;
        { const int kb = r >> 3, nb = r & 7; conv_item(a.in[10], 1024, WOUT, 1024, kb * 64, nb * 128, nb * 128, lane, scr); }
    }
    for (int it = NGW - 1 - gw; it < 64 * 16; it += NGW) {
        const int k0 = (it >> 4) * 8, n0 = (it & 15) * 64, g = k0 >> 7, kk0 = k0 & 127;
        const float* pw = a.in[7] + (size_t)(g * 128 + kk0) * 128; const float* ps = a.in[8] + g * 128; const float* wp = a.in[9] + (size_t)(g * 128) * 1024 + n0 + lane;
        float acc8[8];
#pragma unroll
        for (int q = 0; q < 8; ++q) acc8[q] = 0.f;
#pragma unroll 16
        for (int c = 0; c < 128; ++c) { const float wv = wp[(size_t)c * 1024] * ps[c];
#pragma unroll
            for (int q = 0; q < 8; ++q) acc8[q] += pw[q * 128 + c] * wv; }
        u32x4 w; w.x = cvt_pk_bf16(acc8[0], acc8[1]); w.y = cvt_pk_bf16(acc8[2], acc8[3]); w.z = cvt_pk_bf16(acc8[4], acc8[5]); w.w = cvt_pk_bf16(acc8[6], acc8[7]);
        *(u32x4*)(WEFF + (size_t)(n0 + lane) * 512 + k0) = w;
    }
}
__device__ __forceinline__ void p0_prologue(const Frame& F, const Args& a) {
    const int gw = F.bx * NWAVES + F.wave, NGW = F.G * NWAVES, lane = F.lane;
    unsigned char* ws = F.ws;
    bf16* WIN = (bf16*)(ws + WS_WIN); float* CS = (float*)(ws + WS_CS); bf16* H = (bf16*)(ws + WS_H);
    LAS unsigned char* scr = F.lds + F.wave * 16384;
    for (int it = gw; it < 16 * 30; it += NGW) { const int kb = it / 30, nb = it % 30; conv_item(a.in[3], INW, WIN, 1024, kb * 64, nb * 128, nb * 128, lane, scr); }
    { const float* wr = a.in[12]; bf16* WRH = (bf16*)(ws + WS_WRH); bf16* WRL = (bf16*)(ws + WS_WRL);
      for (int idx = gw * 64 + lane; idx < 32 * 1024; idx += NGW * 64) { const int e = idx >> 10, k = idx & 1023; const float w = wr[k * 32 + e]; const unsigned h = cvt_pk_bf16(w, 0.f) & 0xffffu;
          WRH[idx] = (bf16)h; WRL[idx] = (bf16)(cvt_pk_bf16(w - __uint_as_float(h << 16), 0.f) & 0xffffu); } }
    { const int* pos = (const int*)a.in[1];
      for (int idx = gw * 64 + lane; idx < T * 8; idx += NGW * 64) { const int t = idx >> 3, i = idx & 7; const float inv = powf(500000.0f, -(float)i * 0.125f); const float an = (float)pos[t] * inv;
          CS[t * 16 + i] = cosf(an); CS[t * 16 + 8 + i] = sinf(an); } }
    { const float* x = a.in[0]; const float* g1 = a.in[2];
      f32x4 gg[4];
#pragma unroll
      for (int j = 0; j < 4; ++j) gg[j] = ((const f32x4*)g1)[lane + 64 * j];
      for (int row = gw; row < T; row += 2 * NGW) {
          const int row2 = row + NGW;
          const f32x4* xr = (const f32x4*)(x + (size_t)row * D) + lane; const f32x4* xr2 = (const f32x4*)(x + (size_t)(row2 < T ? row2 : row) * D) + lane; f32x4 v[4], v2[4]; float s = 0.f, s2 = 0.f;
#pragma unroll
          for (int j = 0; j < 4; ++j) { v[j] = __builtin_nontemporal_load(xr + 64 * j); v2[j] = __builtin_nontemporal_load(xr2 + 64 * j); }
#pragma unroll
          for (int j = 0; j < 4; ++j) { s += v[j].x * v[j].x + v[j].y * v[j].y + v[j].z * v[j].z + v[j].w * v[j].w; s2 += v2[j].x * v2[j].x + v2[j].y * v2[j].y + v2[j].z * v2[j].z + v2[j].w * v2[j].w; }
          const float rstd = rsqrtf(wave_sum(s) * (1.f / D) + RMS_EPS), rstd2 = rsqrtf(wave_sum(s2) * (1.f / D) + RMS_EPS);
#pragma unroll
          for (int j = 0; j < 4; ++j) { const f32x4 o = v[j] * rstd * gg[j]; u32x2 w; w.x = cvt_pk_bf16(o[0], o[1]); w.y = cvt_pk_bf16(o[2], o[3]); *(u32x2*)(H + (size_t)row * D + 4 * lane + 256 * j) = w; }
          if (row2 < T) {
#pragma unroll
              for (int j = 0; j < 4; ++j) { const f32x4 o = v2[j] * rstd2 * gg[j]; u32x2 w; w.x = cvt_pk_bf16(o[0], o[1]); w.y = cvt_pk_bf16(o[2], o[3]); *(u32x2*)(H + (size_t)row2 * D + 4 * lane + 256 * j) = w; } }
      } }
}

template <int W> __device__ __forceinline__ void pool_rows(const bf16* U, bf16* PO, int t0, int wave, int lane) {
    const int c4 = 64 * wave + 4 * (lane & 15), r0 = t0 + 16 * (lane >> 4);
    const int pos0 = r0 % SEQ;
    u32x2 v[15 + W];
#pragma unroll
    for (int i = 0; i < 15 + W; ++i) { const int rr = r0 - (W - 1) + i; u32x2 z = {0u, 0u}; if (i >= W - 1 || pos0 != 0) z = *(const u32x2*)(U + (size_t)rr * PW + c4); v[i] = z; }
#pragma unroll
    for (int i = 0; i < 16; ++i) {
        float s0 = 0.f, s1 = 0.f, s2 = 0.f, s3 = 0.f;
#pragma unroll
        for (int jj = 0; jj < W; ++jj) { const u32x2 x = v[i + W - 1 - jj]; s0 += bflo(x.x); s1 += bfhi(x.x); s2 += bflo(x.y); s3 += bfhi(x.y); }
        const int pos = pos0 + i; const float rc = 1.0f / (float)(pos + 1 < W ? pos + 1 : W);
        const u32x2 c = v[i + W - 1]; u32x2 o;
        o.x = cvt_pk_bf16(s0 * rc - bflo(c.x), s1 * rc - bfhi(c.x)); o.y = cvt_pk_bf16(s2 * rc - bflo(c.y), s3 * rc - bfhi(c.y));
        *(u32x2*)(PO + (size_t)(r0 + i) * PW + c4) = o;
    }
}
__device__ __forceinline__ void attn_unit(const Frame& F, int unit, const bf16* Q, const bf16* KB, const bf16* VB, const float* sinks, bf16* AO, const bf16* U, bf16* PO, int pool_chunk, const float* w_down, fp8* WDN8) {
    const int tid = F.tid, lane = F.lane, wid = F.wave, r32 = lane & 31, hi = lane >> 5;
    const int b = unit >> 6, n = (unit >> 1) & 31, hkv = unit & 1;
    LAS unsigned char* Kt = F.lds; LAS unsigned char* Vt = F.lds + 32768;
    const int tok0 = b * SEQ + 128 * (n - 1);
    int hq = hkv * 8 + 2 * (wid & 3);
    u32x4 kreg[4], vreg[4];
#pragma unroll
    for (int c = 0; c < 4; ++c) { const int id = tid + 512 * c, row = id >> 3, ch = id & 7; int tok = tok0 + row; tok = tok < b * SEQ ? b * SEQ + row : tok;
        kreg[c] = *(const u32x4*)(KB + (size_t)tok * 128 + hkv * 64 + ch * 8); vreg[c] = *(const u32x4*)(VB + (size_t)tok * 128 + hkv * 64 + ch * 8); }
    bf16x8 qn[4];
    { const size_t qrow = (size_t)b * SEQ + 128 * n + r32;
#pragma unroll
      for (int ks = 0; ks < 4; ++ks) qn[ks] = *(const bf16x8*)(Q + qrow * 1024 + hq * 64 + ks * 16 + hi * 8); }
    if (pool_chunk >= 0) { const int g = wid >> 1, t0 = pool_chunk * 64;
        if (g == 0) pool_rows<2>(U, PO, t0, wid, lane); else if (g == 1) pool_rows<4>(U, PO, t0, wid, lane); else if (g == 2) pool_rows<8>(U, PO, t0, wid, lane); else pool_rows<16>(U, PO, t0, wid, lane); }
    __syncthreads();
#pragma unroll
    for (int c = 0; c < 4; ++c) { const int id = tid + 512 * c, row = id >> 3, ch = id & 7;
        *(LAS u32x4*)(Kt + row * 128 + ((ch ^ ((row >> 1) & 7)) << 4)) = kreg[c];
        *(LAS u32x4*)(Vt + row * 128 + ((ch * 16) ^ (((row >> 1) & 1) << 6))) = vreg[c]; }
    __syncthreads();
    if (wid >= 4) {
#pragma unroll 1
        for (int k = 0; k < 2; ++k) { const int it = unit * 4 + (wid - 4) + 1024 * k, e = it >> 6, q = it & 63, kb = q >> 3, nb = q & 7;
            conv_item8<1>(w_down + (size_t)e * 1024 * 1024, 1024, WDN8 + (size_t)e * 1024 * 1024, 1024, kb * 128, nb * 128, nb * 128, lane, F.lds + 65536 + (wid - 4) * 16384); }
        return;
    }
    constexpr float LOG2E = 1.44269504089f, C2 = 0.125f * LOG2E;
#pragma unroll 1
    for (int hsel = 0; hsel < 2; ++hsel) {
    const float sink = sinks[hq];
    if (hsel == 1) { const size_t qrow = (size_t)b * SEQ + 128 * n + r32;
#pragma unroll
        for (int ks = 0; ks < 4; ++ks) qn[ks] = *(const bf16x8*)(Q + qrow * 1024 + hq * 64 + ks * 16 + hi * 8); }
#pragma unroll 1
    for (int j = 0; j < 4; ++j) {
        const size_t qrow = (size_t)b * SEQ + 128 * n + 32 * j + r32;
        bf16x8 qf[4];
#pragma unroll
        for (int ks = 0; ks < 4; ++ks) qf[ks] = qn[ks];
        if (j < 3) {
#pragma unroll
            for (int ks = 0; ks < 4; ++ks) qn[ks] = *(const bf16x8*)(Q + (qrow + 32) * 1024 + hq * 64 + ks * 16 + hi * 8); }
        int r32v = r32; asm volatile("" : "+v"(r32v));
        f32x16 s[5];
#pragma unroll
        for (int tau = 0; tau < 5; ++tau) {
            const int kt = j + tau; const int krow = 32 * kt + r32;
            f32x16 a = {0.f, 0.f, 0.f, 0.f, 0.f, 0.f, 0.f, 0.f, 0.f, 0.f, 0.f, 0.f, 0.f, 0.f, 0.f, 0.f};
#pragma unroll
            for (int ks = 0; ks < 4; ++ks) { const bf16x8 kf = *(const LAS bf16x8*)(Kt + krow * 128 + (((2 * ks + hi) ^ ((krow >> 1) & 7)) << 4));
                a = __builtin_amdgcn_mfma_f32_32x32x16_bf16(kf, qf[ks], a, 0, 0, 0); }
            s[tau] = a;
        }
        float mx = -1.0e30f;
#pragma unroll
        for (int tau = 0; tau < 5; ++tau) { const bool dead = (n == 0) && (j + tau < 4);
#pragma unroll
            for (int r = 0; r < 16; ++r) { const int kk = (r & 3) + 8 * (r >> 2) + 4 * hi; bool ok = !dead; if (tau == 0) ok = ok && (kk > r32v); if (tau == 4) ok = ok && (kk <= r32v);
                s[tau][r] = ok ? s[tau][r] : -1.0e30f; mx = fmaxf(mx, s[tau][r]); } }
        mx = fmaxf(mx, __shfl_xor(mx, 32));
        const float mm = fmaxf(mx * 0.125f, sink), mml = mm * LOG2E;
        float sum = 0.f;
#pragma unroll
        for (int tau = 0; tau < 5; ++tau)
#pragma unroll
            for (int r = 0; r < 16; ++r) { const float p = __builtin_amdgcn_exp2f(s[tau][r] * C2 - mml); s[tau][r] = p; sum += p; }
        sum += __shfl_xor(sum, 32);
        sum += __builtin_amdgcn_exp2f((sink - mm) * LOG2E);
        const float inv = 1.0f / sum;
        unsigned pk[5][8];
#pragma unroll
        for (int tau = 0; tau < 5; ++tau)
#pragma unroll
            for (int q = 0; q < 8; ++q) pk[tau][q] = cvt_pk_bf16(s[tau][2 * q], s[tau][2 * q + 1]);
        bf16* orow = AO + qrow * 1024 + hq * 64;
#pragma unroll
        for (int d0 = 0; d0 < 2; ++d0) {
            f32x16 o = {0.f, 0.f, 0.f, 0.f, 0.f, 0.f, 0.f, 0.f, 0.f, 0.f, 0.f, 0.f, 0.f, 0.f, 0.f, 0.f};
#pragma unroll
            for (int tau = 0; tau < 5; ++tau) {
                const int kt = j + tau;
#pragma unroll
                for (int s2 = 0; s2 < 2; ++s2) {
                    bf16x8 pf; { const u32x4 w = {pk[tau][4 * s2 + 0], pk[tau][4 * s2 + 1], pk[tau][4 * s2 + 2], pk[tau][4 * s2 + 3]}; pf = __builtin_bit_cast(bf16x8, w); }
                    const int vrow = 32 * kt + 16 * s2 + 4 * hi + ((lane & 15) >> 2);
                    const int vcb = 64 * d0 + 32 * ((lane >> 4) & 1) + 8 * (lane & 3);
                    const int vaddr = vrow * 128 + (vcb ^ (((vrow >> 1) & 1) << 6));
                    const s16x4 lo = __builtin_bit_cast(s16x4, __builtin_amdgcn_ds_read_tr16_b64_v4i16((LAS s16x4*)(Vt + vaddr)));
                    const s16x4 hh = __builtin_bit_cast(s16x4, __builtin_amdgcn_ds_read_tr16_b64_v4i16((LAS s16x4*)(Vt + vaddr + 1024)));
                    const bf16x8 vf = {lo[0], lo[1], lo[2], lo[3], hh[0], hh[1], hh[2], hh[3]};
                    o = __builtin_amdgcn_mfma_f32_32x32x16_bf16(vf, pf, o, 0, 0, 0);
                }
            }
#pragma unroll
            for (int rg = 0; rg < 4; ++rg) { u32x2 w; w.x = cvt_pk_bf16(o[4 * rg] * inv, o[4 * rg + 1] * inv); w.y = cvt_pk_bf16(o[4 * rg + 2] * inv, o[4 * rg + 3] * inv);
                *(u32x2*)(orow + 32 * d0 + 8 * rg + 4 * hi) = w; }
        }
    }
    ++hq;
    }
}

__device__ __forceinline__ void moe_tables(const Frame& F) {
    LAS int* tb = (LAS int*)(F.lds + TBL_OFF);
    __syncthreads();
    if (F.tid < 32) tb[192 + F.tid] = (int)__hip_atomic_load(F.ctl + CW_CNT + F.tid, RLX_AGENT);
    __syncthreads();
    if (F.tid == 0) { int u8 = 0, u4 = 0, ro = 0;
        for (int e = 0; e < 32; ++e) { const int c = tb[192 + e], r = (c + 255) >> 8; tb[e] = u8; tb[64 + e] = u4; tb[128 + e] = ro; u8 += r * 8; u4 += r * 4; ro += r * 256; }
        tb[32] = u8; tb[64 + 32] = u4; tb[128 + 32] = ro; }
    if (F.wave == 0) {
        const int e = F.lane & 31, R = (tb[192 + e] + 255) >> 8, L = R + (R >> 1); const bool odd = (R & 1) != 0;
        int lm = odd ? L : 0;
#pragma unroll
        for (int o = 16; o >= 1; o >>= 1) lm = max(lm, __shfl_xor(lm, o));
        const unsigned long long bx = __ballot(odd && L == lm), bh = __ballot(!odd && L + 1 <= lm);
        if (F.lane == 0) { tb[224] = (int)(unsigned)bx; tb[225] = (int)(unsigned)bh; }
    }
    __syncthreads();
}

__device__ __forceinline__ void router_chunk(const Frame& F, int chunk, const float* x, const bf16* X1, const float* g2, const bf16* WRH, const bf16* WRL, const float* br, fp8* H2, gu32* counts, int* stok, int* toke, float* tokg) {
    const int tid = F.tid, lane = F.lane, w = F.wave, i32 = lane & 31, hh = lane >> 5;
    LAS unsigned char* lds = F.lds;
    LAS float* logit = (LAS float*)(lds + RT_LOGIT); LAS int* tokE = (LAS int*)(lds + RT_TOKE); LAS int* tokR = (LAS int*)(lds + RT_TOKR); LAS float* tokG = (LAS float*)(lds + RT_TOKG);
    LAS unsigned* hist = (LAS unsigned*)(lds + RT_HIST); LAS unsigned* base = (LAS unsigned*)(lds + RT_BASE);
    LAS float* g2l = (LAS float*)(lds + RT_LOGIT + 4224);
    const __amdgpu_buffer_rsrc_t rsX = __builtin_amdgcn_make_buffer_rsrc((void*)x, 0, 0x7fffffff, 0x00020000), rsD = __builtin_amdgcn_make_buffer_rsrc((void*)X1, 0, 0x7fffffff, 0x00020000), rsH = __builtin_amdgcn_make_buffer_rsrc((void*)H2, 0, 0x7fffffff, 0x00020000);
    const int vx = lane * 16, vd = lane * 8, vh = lane * 4;
    f32x4 xv[4][4];
#pragma unroll
    for (int q = 0; q < 4; ++q) { const int so = (chunk * 64 + 4 * w + q) * (D * 4);
#pragma unroll
        for (int j = 0; j < 4; ++j) xv[q][j] = __builtin_bit_cast(f32x4, __builtin_amdgcn_raw_buffer_load_b128(rsX, vx + 1024 * j, so, 0)); }
    bf16x8 bh[8], bl[8];
    __syncthreads();
    if (tid < 32) hist[tid] = 0u;
    *(LAS f32x2*)(g2l + 2 * tid) = *(const f32x2*)(g2 + 2 * tid);
    __syncthreads();
#pragma unroll
    for (int p = 0; p < 2; ++p) {
        const int r0 = chunk * 64 + 32 * p;
#pragma unroll
        for (int qh = 0; qh < 2; ++qh) {
            u32x2 dv[2][4];
#pragma unroll
            for (int q2 = 0; q2 < 2; ++q2)
#pragma unroll
                for (int j = 0; j < 4; ++j) dv[q2][j] = __builtin_bit_cast(u32x2, __builtin_amdgcn_raw_buffer_load_b64(rsD, vd + 512 * j, (r0 + 4 * w + 2 * qh + q2) * (D * 2), 0));
#pragma unroll
            for (int q2 = 0; q2 < 2; ++q2) { const int q = 2 * qh + q2, rl = 4 * w + q, row = r0 + rl; float s = 0.f;
#pragma unroll
                for (int j = 0; j < 4; ++j) { const u32x2 dw = dv[q2][j]; const f32x4 t = xv[q][j] + (f32x4){bflo(dw.x), bfhi(dw.x), bflo(dw.y), bfhi(dw.y)}; xv[q][j] = t; s += t.x * t.x + t.y * t.y + t.z * t.z + t.w * t.w; }
                const float rstd = rsqrtf(wave_sum(s) * (1.f / D) + RMS_EPS);
#pragma unroll
                for (int j = 0; j < 4; ++j) { const f32x4 o = xv[q][j] * rstd * *(const LAS f32x4*)(g2l + 4 * lane + 256 * j); int pk = 0; pk = __builtin_amdgcn_cvt_pk_fp8_f32(o[0], o[1], pk, false); pk = __builtin_amdgcn_cvt_pk_fp8_f32(o[2], o[3], pk, true);
                    __builtin_amdgcn_raw_buffer_store_b32((unsigned)pk, rsH, vh + 256 * j, row * D, 0); *(LAS f32x4*)(lds + rl * HB_STRIDE + (4 * lane + 256 * j) * 4) = o; } }
        }
        if (p == 0) {
            { const bf16* ph = WRH + (size_t)i32 * 1024 + 128 * w + 8 * hh; const bf16* pl = WRL + (size_t)i32 * 1024 + 128 * w + 8 * hh;
#pragma unroll
              for (int ks = 0; ks < 8; ++ks) { bh[ks] = *(const bf16x8*)(ph + 16 * ks); bl[ks] = *(const bf16x8*)(pl + 16 * ks); } }
#pragma unroll
            for (int q = 0; q < 4; ++q) { const int so = (chunk * 64 + 32 + 4 * w + q) * (D * 4);
#pragma unroll
                for (int j = 0; j < 4; ++j) xv[q][j] = __builtin_bit_cast(f32x4, __builtin_amdgcn_raw_buffer_load_b128(rsX, vx + 1024 * j, so, 0)); } }
        __syncthreads();
        f32x16 acc = {0.f, 0.f, 0.f, 0.f, 0.f, 0.f, 0.f, 0.f, 0.f, 0.f, 0.f, 0.f, 0.f, 0.f, 0.f, 0.f};
#pragma unroll
        for (int ks = 0; ks < 8; ++ks) {
            const LAS float* hp = (const LAS float*)(lds + i32 * HB_STRIDE + (128 * w + 16 * ks + 8 * hh) * 4);
            const f32x4 a0 = *(const LAS f32x4*)hp, a1 = *(const LAS f32x4*)(hp + 4);
            u32x4 whi, wlo;
            whi.x = cvt_pk_bf16(a0[0], a0[1]); whi.y = cvt_pk_bf16(a0[2], a0[3]); whi.z = cvt_pk_bf16(a1[0], a1[1]); whi.w = cvt_pk_bf16(a1[2], a1[3]);
            wlo.x = cvt_pk_bf16(a0[0] - bflo(whi.x), a0[1] - bfhi(whi.x)); wlo.y = cvt_pk_bf16(a0[2] - bflo(whi.y), a0[3] - bfhi(whi.y));
            wlo.z = cvt_pk_bf16(a1[0] - bflo(whi.z), a1[1] - bfhi(whi.z)); wlo.w = cvt_pk_bf16(a1[2] - bflo(whi.w), a1[3] - bfhi(whi.w));
            const bf16x8 ahi = __builtin_bit_cast(bf16x8, whi), alo = __builtin_bit_cast(bf16x8, wlo);
            acc = __builtin_amdgcn_mfma_f32_32x32x16_bf16(ahi, bh[ks], acc, 0, 0, 0);
            acc = __builtin_amdgcn_mfma_f32_32x32x16_bf16(ahi, bl[ks], acc, 0, 0, 0);
            acc = __builtin_amdgcn_mfma_f32_32x32x16_bf16(alo, bh[ks], acc, 0, 0, 0);
        }
        __syncthreads();
        LAS float* part = (LAS float*)lds;
#pragma unroll
        for (int r = 0; r < 16; ++r) { const int tk = (r & 3) + 8 * (r >> 2) + 4 * hh; part[(w * 32 + tk) * 33 + i32] = acc[r]; }
        __syncthreads();
#pragma unroll
        for (int q = 0; q < 2; ++q) { const int o = tid + 512 * q, tk = o >> 5, e = o & 31; float sacc = br[e];
#pragma unroll
            for (int ww = 0; ww < 8; ++ww) sacc += part[(ww * 32 + tk) * 33 + e];
            logit[(32 * p + tk) * 33 + e] = sacc; }
        __syncthreads();
    }
    if (tid < 64) {
        float lg[32];
#pragma unroll
        for (int e = 0; e < 32; ++e) lg[e] = logit[tid * 33 + e];
        int be[4]; float bv[4]; unsigned used = 0u;
#pragma unroll
        for (int k = 0; k < 4; ++k) { float best = -3.0e38f; int bi = 0;
#pragma unroll
            for (int e = 0; e < 32; ++e) { const bool ok = !((used >> e) & 1u) && lg[e] > best; best = ok ? lg[e] : best; bi = ok ? e : bi; }
            be[k] = bi; bv[k] = best; used |= 1u << bi; }
        float ex[4], se = 0.f;
#pragma unroll
        for (int k = 0; k < 4; ++k) { ex[k] = __expf(bv[k] - bv[0]); se += ex[k]; }
        const float rse = 1.0f / se;
#pragma unroll
        for (int k = 0; k < 4; ++k) { const unsigned rk = __hip_atomic_fetch_add(hist + be[k], 1u, __ATOMIC_RELAXED, __HIP_MEMORY_SCOPE_WORKGROUP);
            tokE[tid * 4 + k] = be[k]; tokR[tid * 4 + k] = (int)rk; tokG[tid * 4 + k] = ex[k] * rse; }
    }
    __syncthreads();
    if (tid < 32) { const unsigned hc = hist[tid]; base[tid] = hc ? __hip_atomic_fetch_add(counts + tid, hc, RLX_AGENT) : 0u; }
    __syncthreads();
    if (tid < 256) { const int tk = tid >> 2, k = tid & 3, e = tokE[tk * 4 + k], pos = (int)base[e] + tokR[tk * 4 + k], t = chunk * 64 + tk;
        stok[e * CAP + pos] = t; toke[t * 4 + k] = e | (pos << 8); tokg[t * 4 + k] = tokG[tk * 4 + k]; }
}

__device__ __forceinline__ void combine_rows(const Frame& F, const float* x, const bf16* X1, const fp8* YS, const int* toke, const float* tokg, const float* gf, float* out) {
    const int lane = F.lane; const LAS int* rowoff = (const LAS int*)(F.lds + TBL_OFF) + 128;
    f32x4 gg[4];
#pragma unroll
    for (int j = 0; j < 4; ++j) gg[j] = ((const f32x4*)gf)[lane + 64 * j];
    for (int t = F.bx * NWAVES + F.wave; t < T; t += F.G * NWAVES) {
        f32x4 v[4];
#pragma unroll
        for (int j = 0; j < 4; ++j) { const u32x2 dw = __builtin_nontemporal_load((const u32x2*)(X1 + (size_t)t * D + 4 * lane + 256 * j)); v[j] = __builtin_nontemporal_load((const f32x4*)(x + (size_t)t * D) + lane + 64 * j) + (f32x4){bflo(dw.x), bfhi(dw.x), bflo(dw.y), bfhi(dw.y)}; }
        const int4 te = *(const int4*)(toke + t * 4); const f32x4 tg = *(const f32x4*)(tokg + t * 4);
        const int tes[4] = {te.x, te.y, te.z, te.w};
#pragma unroll
        for (int k = 0; k < 4; ++k) { const int e = tes[k] & 255, pos = tes[k] >> 8; const float g = tg[k];
            const fp8* y = YS + (size_t)(rowoff[e] + pos) * 1024 + 4 * lane;
#pragma unroll
            for (int j = 0; j < 4; ++j) { const int pw = __builtin_nontemporal_load((const int*)(y + 256 * j)); const f32x2 lo = __builtin_amdgcn_cvt_pk_f32_fp8(pw, false), hi2 = __builtin_amdgcn_cvt_pk_f32_fp8(pw, true);
                v[j].x += g * lo[0]; v[j].y += g * lo[1]; v[j].z += g * hi2[0]; v[j].w += g * hi2[1]; } }
        float s = 0.f;
#pragma unroll
        for (int j = 0; j < 4; ++j) s += v[j].x * v[j].x + v[j].y * v[j].y + v[j].z * v[j].z + v[j].w * v[j].w;
        const float rstd = rsqrtf(wave_sum(s) * (1.f / D) + RMS_EPS);
#pragma unroll
        for (int j = 0; j < 4; ++j) __builtin_nontemporal_store(v[j] * rstd * gg[j], (f32x4*)(out + (size_t)t * D) + lane + 64 * j);
    }
}

constexpr int N_PHASES = 9;
__global__ void __launch_bounds__(NTHR, 2) fwd(Args a) {
    extern __shared__ __attribute__((aligned(16))) unsigned char lds_raw[];
    Frame F; F.lds = (LAS unsigned char*)lds_raw; F.tid = threadIdx.x; F.lane = F.tid & 63; F.wave = __builtin_amdgcn_readfirstlane(F.tid >> 6); F.G = gridDim.x; F.bx = blockIdx.x;
    F.ws = a.ws; F.ctl = (gu32*)(a.ws + WS_CTL);
    volatile LAS unsigned* MISC = (volatile LAS unsigned*)(F.lds + MISC_OFF);
    if (F.tid < 32) MISC[F.tid] = 0u;
    __syncthreads();
    XcdBarrier bar = xcd_barrier_post((unsigned*)(F.ctl + CW_BAR) + a.li * 4096, MISC + 8);
    unsigned char* const ws = a.ws;
#define WIN ((bf16*)(ws + WS_WIN))
#define WATT ((bf16*)(ws + WS_WATT))
#define WEFF ((bf16*)(ws + WS_WEFF))
#define WOUT ((bf16*)(ws + WS_WOUT))
#define CS ((float*)(ws + WS_CS))
#define WUP ((fp8*)(ws + WS_WUP))
#define WDN ((fp8*)(ws + WS_WDN))
#define H ((bf16*)(ws + WS_H))
#define H2 ((fp8*)(ws + WS_H2))
#define Q ((bf16*)(ws + WS_Q))
#define KB ((bf16*)(ws + WS_KB))
#define VB ((bf16*)(ws + WS_VB))
#define U ((bf16*)(ws + WS_U))
#define PO ((bf16*)(ws + WS_PO))
#define GA ((bf16*)(ws + WS_GA))
#define GP ((bf16*)(ws + WS_GP))
#define AO ((bf16*)(ws + WS_AO))
#define T1 ((bf16*)(ws + WS_T1))
#define MG ((bf16*)(ws + WS_MG))
#define X1 ((bf16*)(ws + WS_X1))
#define STOK ((int*)(ws + WS_STOK))
#define TOKE ((int*)(ws + WS_TOKE))
#define TOKG ((float*)(ws + WS_TOKG))
#define ACT ((fp8*)(ws + WS_ACT))
#define YS ((fp8*)(ws + WS_YS))
    const int lo = a.ph_lo, hi = a.ph_hi;
#define IN(k) (lo <= (k) && (k) < hi)
#define SEAM(k) do { if (IN(k) && IN((k) + 1)) xcd_barrier(bar); } while (0)
#define FRESH() do { int t_ = (int)threadIdx.x; asm volatile("" : "+v"(t_)); F.tid = t_; F.lane = t_ & 63; F.wave = __builtin_amdgcn_readfirstlane(t_ >> 6); } while (0)

    if (IN(0)) { FRESH(); p0b_weights(F, a, F.bx, F.G); p0_prologue(F, a); }
    SEAM(0);
    if (IN(1)) { FRESH();
        pg8::DenseOrder S; S.init(T, INW, F.G, F.bx);
        pg8::EpiInProj E{a.in[4], CS, Q, KB, VB, U, GA, GP};
        pg8::gemm_phase<pg8::EpiInProj, pg8::DenseOrder, 1024, false, false>(F.lds, H, WIN, 0, S, E, nullptr);
    }
    SEAM(1);
    if (IN(2)) { FRESH();
        for (int u = F.bx; u < 256; u += F.G) attn_unit(F, u, Q, KB, VB, a.in[5], AO, U, PO, u, a.in[16], WDN);
        __syncthreads();
    }
    SEAM(2);
    if (IN(3)) { FRESH();
        pg8::DenseOrder S; S.init(T, 1024, F.G, F.bx);
        { pg8::EpiGateA E{GA, T1}; pg8::gemm_phase<pg8::EpiGateA, pg8::DenseOrder, 1024, false, false>(F.lds, AO, WATT, 0, S, E, nullptr); }
        VM_WAIT(); __syncthreads();
        { pg8::EpiMerge E{GP, T1, MG}; pg8::gemm_phase<pg8::EpiMerge, pg8::DenseOrder, 512, false, false>(F.lds, PO, WEFF, 0, S, E, nullptr); }
    }
    SEAM(3);
    if (IN(4)) { FRESH();
        pg8::DenseOrder S; S.init(T, 1024, F.G, F.bx);
        pg8::EpiX1 E{X1};
        pg8::gemm_phase<pg8::EpiX1, pg8::DenseOrder, 1024, false, false>(F.lds, MG, WOUT, 0, S, E, nullptr);
    }
    SEAM(4);
    if (IN(5)) { FRESH();
        for (int ch = F.bx; ch < T / 64; ch += F.G) router_chunk(F, ch, a.in[0], X1, a.in[11], (const bf16*)(ws + WS_WRH), (const bf16*)(ws + WS_WRL), a.in[13], H2, F.ctl + CW_CNT, STOK, TOKE, TOKG);
        __syncthreads();
    }
    SEAM(5);
    if (IN(6)) { FRESH();
        moe_tables(F);
        const LAS int* tb = (const LAS int*)(F.lds + TBL_OFF);
        pg8::EpiSwiglu E{a.in[15], ACT};
        pg8::MoeOrderX<true> S{tb + 128, tb + 192, 3, F.G, F.bx};
        pg8::gemm_phase<pg8::EpiSwiglu, pg8::MoeOrderX<true>, 1024, true, true>(F.lds, H2, WUP, (size_t)2048 * 1024, S, E, STOK);
        VM_WAIT(); __syncthreads();
        if (F.tid == 0) {
            __builtin_amdgcn_fence(__ATOMIC_RELEASE, "agent"); VM_WAIT();
            for (int v = F.bx; v < 256; v += F.G) { const int e = (v & 7) + 8 * ((v >> 3) >> 3); (void)xb_add((unsigned*)(F.ctl + CW_DONE + 64 * e), 1u); }
        }
    }
    if (IN(7)) { FRESH();
        moe_tables(F);
        const LAS int* tb = (const LAS int*)(F.lds + TBL_OFF);
        const unsigned mx = (unsigned)__builtin_amdgcn_readfirstlane(tb[224]), mh = (unsigned)__builtin_amdgcn_readfirstlane(tb[225]);
        pg8::EpiDown E{a.in[17], YS};
        {   pg8::MoeOrderOwn S{tb + 128, tb + 192, mx, mh, F.G, F.bx};
            if (F.tid == 0) { pg8::GUnit u; unsigned seen = 0u;
                for (int i = 0; S.next(i, u); ++i) { if ((seen >> u.e) & 1u) continue; seen |= 1u << u.e; unsigned* p = (unsigned*)(F.ctl + CW_DONE + 64 * u.e); XB_SPIN(xb_ld(p) < 8u, bar.bar); }
                __builtin_amdgcn_fence(__ATOMIC_ACQUIRE, "agent"); VM_WAIT(); }
            __syncthreads();
            pg8::gemm_phase<pg8::EpiDown, pg8::MoeOrderOwn, 1024, false, true>(F.lds, ACT, WDN, (size_t)1024 * 1024, S, E, nullptr);
        }
        {   pg8::MoeOrderSteal S{tb + 128, tb + 192, mx, mh, F.G, F.bx};
            pg8::GUnit u0;
            if (S.next(0, u0)) {
                VM_WAIT(); __syncthreads();
                if (F.tid == 0) { pg8::GUnit u;
                    for (int i = 0; S.next(i, u); ++i) { unsigned* p = (unsigned*)(F.ctl + CW_DONE + 64 * u.e); XB_SPIN(xb_ld(p) < 8u, bar.bar); }
                    __builtin_amdgcn_fence(__ATOMIC_ACQUIRE, "agent"); VM_WAIT(); }
                __syncthreads();
                pg8::gemm_phase<pg8::EpiDown, pg8::MoeOrderSteal, 1024, false, true>(F.lds, ACT, WDN, (size_t)1024 * 1024, S, E, nullptr);
            }
        }
    }
    SEAM(7);
    if (IN(8)) { FRESH();
        moe_tables(F);
        combine_rows(F, a.in[0], X1, YS, TOKE, TOKG, a.in[18], a.out);
    }
#undef IN
#undef SEAM
#undef WIN
#undef WATT
#undef WEFF
#undef WOUT
#undef CS
#undef WUP
#undef WDN
#undef H
#undef H2
#undef Q
#undef KB
#undef VB
#undef U
#undef PO
#undef GA
#undef GP
#undef AO
#undef T1
#undef MG
#undef X1
#undef STOK
#undef TOKE
#undef TOKG
#undef ACT
#undef YS
}

#ifndef REPEAT_MASK
#define REPEAT_MASK 0
#endif
#ifndef FAST_MASK
#define FAST_MASK 0x1ff
#endif
#ifndef ONE_LAUNCH
#define ONE_LAUNCH 1
#endif
extern "C" void kernel_launch(void* const* d_in, const int* in_sizes, int n_in, void* d_out, int out_size, void* d_ws, size_t ws_size, hipStream_t stream) {
    if (n_in != 19 || out_size != T * D || ws_size < WS_END) { fprintf(stderr, "kernel_launch: unexpected shapes / workspace (n_in %d, out %d, ws %zu)\n", n_in, out_size, ws_size); return; }
    const float* x = (const float*)d_in[0]; const int* positions = (const int*)d_in[1]; const float* norm1_g = (const float*)d_in[2];
    const float* w_in = (const float*)d_in[3]; const float* b_in = (const float*)d_in[4]; const float* sinks = (const float*)d_in[5];
    const float* w_attn = (const float*)d_in[6]; const float* pool_w = (const float*)d_in[7]; const float* pool_scale = (const float*)d_in[8];
    const float* w_pool = (const float*)d_in[9]; const float* w_out = (const float*)d_in[10]; const float* norm2_g = (const float*)d_in[11];
    const float* w_router = (const float*)d_in[12]; const float* b_router = (const float*)d_in[13]; const float* w_up = (const float*)d_in[14];
    const float* b_up = (const float*)d_in[15]; const float* w_down = (const float*)d_in[16]; const float* b_down = (const float*)d_in[17];
    const float* normf_g = (const float*)d_in[18];
    unsigned char* ws = (unsigned char*)d_ws; float* out = (float*)d_out;
    unsigned* ctl = (unsigned*)(ws + WS_CTL);
    bf16* WIN = (bf16*)(ws + WS_WIN); bf16* WATT = (bf16*)(ws + WS_WATT); bf16* WEFF = (bf16*)(ws + WS_WEFF); bf16* WOUT = (bf16*)(ws + WS_WOUT);
    float* CS = (float*)(ws + WS_CS); fp8* WUP = (fp8*)(ws + WS_WUP); fp8* WDN = (fp8*)(ws + WS_WDN);
    bf16* H = (bf16*)(ws + WS_H); bf16* Q = (bf16*)(ws + WS_Q); bf16* KB = (bf16*)(ws + WS_KB); bf16* VB = (bf16*)(ws + WS_VB);
    bf16* U = (bf16*)(ws + WS_U); bf16* PO = (bf16*)(ws + WS_PO); bf16* GA = (bf16*)(ws + WS_GA); bf16* GP = (bf16*)(ws + WS_GP);
    bf16* AO = (bf16*)(ws + WS_AO); bf16* MG = (bf16*)(ws + WS_MG); bf16* X1 = (bf16*)(ws + WS_X1);
    int* STOK = (int*)(ws + WS_STOK); int* TOKE = (int*)(ws + WS_TOKE); float* TOKG = (float*)(ws + WS_TOKG);
    fp8* ACT = (fp8*)(ws + WS_ACT); fp8* YS = (fp8*)(ws + WS_YS); float* TMP = (float*)(ws + WS_TMP); float* TMP2 = TMP + (size_t)T * D;
    unsigned* counts = ctl + CW_CNT;

    static int grid = 0;
    if (grid == 0) {
        int dev = 0, cus = 0;
        if (hipGetDevice(&dev) != hipSuccess || hipDeviceGetAttribute(&cus, hipDeviceAttributeMultiprocessorCount, dev) != hipSuccess) { fprintf(stderr, "kernel_launch: device query failed\n"); grid = -1; return; }
        if (hipFuncSetAttribute((const void*)fwd, hipFuncAttributeMaxDynamicSharedMemorySize, LDS_BYTES) != hipSuccess) { fprintf(stderr, "kernel_launch: hipFuncSetAttribute failed\n"); grid = -1; return; }
        int per_cu = 0;
        if (hipOccupancyMaxActiveBlocksPerMultiprocessor(&per_cu, (const void*)fwd, NTHR, LDS_BYTES) != hipSuccess || per_cu < 1) fprintf(stderr, "kernel_launch: occupancy query says %d blocks per CU\n", per_cu);
        (void)hipGetLastError();
        grid = cus > 256 ? 256 : cus;
    }
    if (grid < 0) return;
    (void)hipMemsetAsync(ws + WS_CTL, 0, CTL_ZERO_BYTES, stream);
    Args a{};
    for (int i = 0; i < 19; ++i) a.in[i] = (const float*)d_in[i];
    a.out = out; a.ws = ws; a.pad = 0;
    int li = 0;
#define RUN_FAST(lo_, hi_) do { a.ph_lo = (lo_); a.ph_hi = (hi_); a.li = li < 3 ? li : 2; ++li; for (int rep_ = 0; rep_ < ((((hi_) - (lo_)) == 1 && ((REPEAT_MASK >> (lo_)) & 1) && (lo_) != 5) ? 2 : 1); ++rep_) hipLaunchKernelGGL(fwd, dim3(grid), dim3(NTHR), LDS_BYTES, stream, a); } while (0)
#if ONE_LAUNCH
    RUN_FAST(0, N_PHASES);
#else
    if (FAST_MASK & 1) RUN_FAST(0, 1); else {
        n_transpose<<<2048, 256, 0, stream>>>(w_in, 1024, INW, WIN, INW, 0);
        n_transpose<<<1024, 256, 0, stream>>>(w_attn, 1024, 1024, WATT, 1024, 0);
        n_transpose<<<1024, 256, 0, stream>>>(w_out, 1024, 1024, WOUT, 1024, 0);
        for (int e = 0; e < NE; ++e) {
            n_transpose8<<<2048, 256, 0, stream>>>(w_up + (size_t)e * 1024 * 2048, 1024, 2048, WUP + (size_t)e * 2048 * 1024, 2048, 1);
            n_transpose8<<<1024, 256, 0, stream>>>(w_down + (size_t)e * 1024 * 1024, 1024, 1024, WDN + (size_t)e * 1024 * 1024, 1024, 0);
        }
        n_weff<<<(1024 * 512) / 256, 256, 0, stream>>>(pool_w, pool_scale, w_pool, WEFF);
        n_rope_table<<<(T * 8) / 256, 256, 0, stream>>>(positions, CS);
        n_wr_split<<<128, 256, 0, stream>>>(w_router, (bf16*)(ws + WS_WRH), (bf16*)(ws + WS_WRL));
        n_rms_bf16<<<T / 4, 256, 0, stream>>>(x, norm1_g, H);
    }
    if (FAST_MASK & 2) RUN_FAST(1, 2); else {
        n_gemm<<<dim3(INW / 64, T / 64), 256, 0, stream>>>(H, WIN, TMP, T, INW, 1024);
        n_post_inproj<<<(unsigned)(((size_t)T * INW + 255) / 256), 256, 0, stream>>>(TMP, b_in, CS, Q, KB, VB, U, GA, GP);
    }
    if (FAST_MASK & 4) RUN_FAST(2, 3); else {
        if (FAST_MASK & 1) for (int e = 0; e < NE; ++e) n_transpose8<<<1024, 256, 0, stream>>>(w_down + (size_t)e * 1024 * 1024, 1024, 1024, WDN + (size_t)e * 1024 * 1024, 1024, 0);
        n_attn<<<(T * NQH) / 256, 256, 0, stream>>>(Q, KB, VB, sinks, AO);
        n_pool<<<(T * PW) / 256, 256, 0, stream>>>(U, PO);
    }
    if (FAST_MASK & 8) RUN_FAST(3, 4); else {
        n_gemm<<<dim3(1024 / 64, T / 64), 256, 0, stream>>>(AO, WATT, TMP, T, 1024, 1024);
        n_gemm<<<dim3(1024 / 64, T / 64), 256, 0, stream>>>(PO, WEFF, TMP2, T, 1024, 512);
        n_merge<<<(T * D) / 256, 256, 0, stream>>>(TMP, TMP2, GA, GP, MG);
    }
    if (FAST_MASK & 16) RUN_FAST(4, 5); else {
        n_gemm<<<dim3(1024 / 64, T / 64), 256, 0, stream>>>(MG, WOUT, TMP, T, 1024, 1024);
        n_x1<<<(T * D) / 256, 256, 0, stream>>>(x, TMP, X1);
    }
    if (FAST_MASK & 32) { if (REPEAT_MASK & 32) { a.ph_lo = 5; a.ph_hi = 6; a.li = 2; hipLaunchKernelGGL(fwd, dim3(grid), dim3(NTHR), LDS_BYTES, stream, a); (void)hipMemsetAsync(counts, 0, 128, stream); } RUN_FAST(5, 6); } else n_router<<<T / 4, 256, 0, stream>>>(x, X1, norm2_g, w_router, b_router, (fp8*)(ws + WS_H2), counts, STOK, TOKE, TOKG);
    if (FAST_MASK & 64) RUN_FAST(6, 7); else { n_moe_up<<<dim3(1024 / 64, T / 64, NE), 256, 0, stream>>>((const fp8*)(ws + WS_H2), STOK, counts, WUP, b_up, ACT); (void)hipMemsetAsync(ctl + CW_DONE, 8, 32 * 256, stream); }
    if (FAST_MASK & 128) RUN_FAST(7, 8); else n_moe_down<<<dim3(1024 / 64, T / 64, NE), 256, 0, stream>>>(ACT, counts, WDN, b_down, YS);
    if (FAST_MASK & 256) RUN_FAST(8, 9); else n_combine<<<T / 4, 256, 0, stream>>>(x, X1, YS, counts, TOKE, TOKG, normf_g, out);
#endif
    (void)in_sizes; (void)sinks; (void)positions; (void)norm1_g; (void)norm2_g; (void)w_router; (void)b_router; (void)b_up; (void)b_down; (void)normf_g; (void)b_in; (void)pool_w; (void)pool_scale; (void)w_pool;
    (void)w_in; (void)w_attn; (void)w_out; (void)w_up; (void)w_down; (void)x; (void)WIN; (void)WATT; (void)WEFF; (void)WOUT; (void)CS; (void)WUP; (void)WDN; (void)H; (void)Q; (void)KB; (void)VB; (void)U; (void)PO; (void)GA; (void)GP;
    (void)AO; (void)MG; (void)X1; (void)STOK; (void)TOKE; (void)TOKG; (void)ACT; (void)YS; (void)TMP; (void)TMP2; (void)counts;
}
```

```cpp
#include <hip/hip_runtime.h>
#include <cstdio>
#include <cstdint>

constexpr int BATCH = 4, SEQ = 4096, T = BATCH * SEQ, D = 1024;
constexpr int NQH = 16, NKVH = 2, HD = 64, WINDOW = 128;
constexpr int INW = 3840, O_K = 1024, O_V = 1152, O_P = 1280, O_GA = 1792, O_GP = 2816, PW = 512;
constexpr int NE = 32, TOPK = 4, DFF = 1024, CAP = T;
constexpr int NSLOT = T * TOPK + NE * 256;
constexpr float RMS_EPS = 1e-5f;

typedef unsigned short bf16;
typedef unsigned char fp8;
constexpr float W8_SCALE = 32.0f, W8_INV = 1.0f / 32.0f;
typedef float f32x4 __attribute__((ext_vector_type(4)));
typedef unsigned u32x4 __attribute__((ext_vector_type(4)));
typedef unsigned u32x2 __attribute__((ext_vector_type(2)));

constexpr size_t MiB = 1u << 20;
constexpr size_t WS_CTL = 0, CTL_ZERO_BYTES = 65536;
constexpr size_t WS_WIN = 2 * MiB;
constexpr size_t WS_WATT = 10 * MiB;
constexpr size_t WS_WEFF = 12 * MiB;
constexpr size_t WS_WOUT = 13 * MiB;
constexpr size_t WS_CS = 15 * MiB;
constexpr size_t WS_WUP = 16 * MiB;
constexpr size_t WS_WDN = 144 * MiB;
constexpr size_t WS_H = 208 * MiB;
constexpr size_t WS_Q = 240 * MiB;
constexpr size_t WS_KB = 272 * MiB;
constexpr size_t WS_VB = 276 * MiB;
constexpr size_t WS_U = 280 * MiB;
constexpr size_t WS_PO = 296 * MiB;
constexpr size_t WS_GA = 312 * MiB;
constexpr size_t WS_GP = 344 * MiB;
constexpr size_t WS_AO = 376 * MiB;
constexpr size_t WS_T1 = 408 * MiB;
constexpr size_t WS_MG = 440 * MiB;
constexpr size_t WS_X1 = 472 * MiB;
constexpr size_t WS_STOK = 536 * MiB;
constexpr size_t WS_TOKE = 538 * MiB;
constexpr size_t WS_TOKG = 539 * MiB;
constexpr size_t WS_WRH = 538 * MiB + 512 * 1024, WS_WRL = WS_WRH + 64 * 1024;
constexpr size_t WS_ACT = 540 * MiB;
constexpr size_t WS_YS = 684 * MiB;
constexpr size_t WS_H2 = 828 * MiB;
constexpr size_t WS_END = 844 * MiB;
constexpr size_t WS_TMP = WS_ACT;
constexpr int CW_TMO = 0, CW_CODE = 1, CW_CNT = 64, CW_DONE = 128  , CW_BAR = 4096;

__device__ __forceinline__ float bf2f(bf16 v) { return __uint_as_float((unsigned)v << 16); }
__device__ __forceinline__ bf16 f2bf(float f) { unsigned u = __float_as_uint(f); return (bf16)((u + 0x7fffu + ((u >> 16) & 1u)) >> 16); }
__device__ __forceinline__ float sigmoidf_(float v) { return 1.0f / (1.0f + __expf(-v)); }
__device__ __forceinline__ float wave_sum(float v) {
#pragma unroll
    for (int o = 1; o < 64; o <<= 1) v += __shfl_xor(v, o);
    return v;
}
__device__ __forceinline__ float fp82f(fp8 v) { return __builtin_amdgcn_cvt_f32_fp8((int)v, 0); }
__device__ __forceinline__ fp8 f2fp8(float f) { return (fp8)(__builtin_amdgcn_cvt_pk_fp8_f32(f, f, 0, false) & 0xff); }
__device__ __forceinline__ int up_src_col(int np) { const int t = np >> 8, c = np & 255; return c < 128 ? 128 * t + c : 1024 + 128 * t + (c - 128); }

__global__ void __launch_bounds__(256) n_transpose(const float* W, int K, int N, bf16* WT, int NT, int upmap) {
    const size_t total = (size_t)NT * K;
    for (size_t idx = (size_t)blockIdx.x * blockDim.x + threadIdx.x; idx < total; idx += (size_t)gridDim.x * blockDim.x) {
        const int n = (int)(idx / K), k = (int)(idx % K); const int sc = upmap ? up_src_col(n) : n;
        WT[idx] = f2bf(W[(size_t)k * N + sc]);
    }
}
__global__ void __launch_bounds__(256) n_transpose8(const float* W, int K, int N, fp8* WT, int NT, int upmap) {
    const size_t total = (size_t)NT * K;
    for (size_t idx = (size_t)blockIdx.x * blockDim.x + threadIdx.x; idx < total; idx += (size_t)gridDim.x * blockDim.x) {
        const int n = (int)(idx / K), k = (int)(idx % K); const int sc = upmap ? up_src_col(n) : n;
        WT[idx] = f2fp8(W[(size_t)k * N + sc] * W8_SCALE);
    }
}
__global__ void __launch_bounds__(256) n_weff(const float* pw, const float* ps, const float* Wpb, bf16* WeffT) {
    const int idx = blockIdx.x * blockDim.x + threadIdx.x; if (idx >= 1024 * 512) return;
    const int n = idx / 512, k = idx % 512, g = k / 128, kk = k % 128; float a = 0.f;
    for (int c = 0; c < 128; ++c) a += pw[(g * 128 + kk) * 128 + c] * ps[g * 128 + c] * Wpb[(size_t)(g * 128 + c) * 1024 + n];
    WeffT[idx] = f2bf(a);
}
__global__ void __launch_bounds__(256) n_wr_split(const float* wr, bf16* WRH, bf16* WRL) {
    const int idx = blockIdx.x * blockDim.x + threadIdx.x; if (idx >= 32 * 1024) return;
    const int e = idx >> 10, k = idx & 1023; const float w = wr[k * 32 + e]; const bf16 h = f2bf(w); WRH[idx] = h; WRL[idx] = f2bf(w - bf2f(h));
}
__global__ void __launch_bounds__(256) n_rope_table(const int* pos, float* cs) {
    const int idx = blockIdx.x * blockDim.x + threadIdx.x; if (idx >= T * 8) return;
    const int t = idx >> 3, i = idx & 7; const float inv = powf(500000.0f, -(float)i * 0.125f); const float a = (float)pos[t] * inv;
    cs[t * 16 + i] = cosf(a); cs[t * 16 + 8 + i] = sinf(a);
}
__global__ void __launch_bounds__(256) n_rms_bf16(const float* x, const float* g, bf16* out) {
    const int row = blockIdx.x * 4 + (threadIdx.x >> 6), lane = threadIdx.x & 63;
    const f32x4* xr = (const f32x4*)(x + (size_t)row * D) + lane; f32x4 v[4]; float s = 0.f;
#pragma unroll
    for (int j = 0; j < 4; ++j) { v[j] = xr[64 * j]; s += v[j].x * v[j].x + v[j].y * v[j].y + v[j].z * v[j].z + v[j].w * v[j].w; }
    const float rstd = rsqrtf(wave_sum(s) * (1.f / D) + RMS_EPS);
#pragma unroll
    for (int j = 0; j < 4; ++j) { const f32x4 gg = ((const f32x4*)g)[lane + 64 * j]; bf16* o = out + (size_t)row * D + 4 * lane + 256 * j;
        o[0] = f2bf(v[j].x * rstd * gg.x); o[1] = f2bf(v[j].y * rstd * gg.y); o[2] = f2bf(v[j].z * rstd * gg.z); o[3] = f2bf(v[j].w * rstd * gg.w); }
}
__global__ void __launch_bounds__(256) n_gemm(const bf16* A, const bf16* Bt, float* C, int M, int N, int K) {
    __shared__ float As[16][65], Bs[16][65];
    const int tx = threadIdx.x & 15, ty = threadIdx.x >> 4, m0 = blockIdx.y * 64, n0 = blockIdx.x * 64;
    float acc[4][4];
#pragma unroll
    for (int i = 0; i < 4; ++i)
#pragma unroll
        for (int j = 0; j < 4; ++j) acc[i][j] = 0.f;
    for (int k0 = 0; k0 < K; k0 += 16) {
        for (int i = threadIdx.x; i < 1024; i += 256) { const int r = i >> 4, c = i & 15;
            As[c][r] = bf2f(A[(size_t)(m0 + r) * K + k0 + c]); Bs[c][r] = bf2f(Bt[(size_t)(n0 + r) * K + k0 + c]); }
        __syncthreads();
#pragma unroll
        for (int kk = 0; kk < 16; ++kk) { float a[4], b[4];
#pragma unroll
            for (int i = 0; i < 4; ++i) { a[i] = As[kk][ty * 4 + i]; b[i] = Bs[kk][tx * 4 + i]; }
#pragma unroll
            for (int i = 0; i < 4; ++i)
#pragma unroll
                for (int j = 0; j < 4; ++j) acc[i][j] += a[i] * b[j]; }
        __syncthreads();
    }
#pragma unroll
    for (int i = 0; i < 4; ++i)
#pragma unroll
        for (int j = 0; j < 4; ++j) C[(size_t)(m0 + ty * 4 + i) * N + n0 + tx * 4 + j] = acc[i][j];
}
__global__ void __launch_bounds__(256) n_post_inproj(const float* P, const float* bias, const float* cs, bf16* Q, bf16* KB, bf16* VB, bf16* U, bf16* GA, bf16* GP) {
    const size_t idx = (size_t)blockIdx.x * blockDim.x + threadIdx.x; if (idx >= (size_t)T * INW) return;
    const int t = (int)(idx / INW), c = (int)(idx % INW); float v = P[idx] + bias[c];
    if (c < O_V) {
        const int d = c & 63;
        if (d < 16) { const int i = d & 7; const int pc = (d < 8) ? c + 8 : c - 8; const float o = P[(size_t)t * INW + pc] + bias[pc];
            const float co = cs[t * 16 + i], si = cs[t * 16 + 8 + i]; v = (d < 8) ? v * co - o * si : v * co + o * si; }
        if (c < O_K) Q[(size_t)t * 1024 + c] = f2bf(v); else KB[(size_t)t * 128 + (c - O_K)] = f2bf(v);
    } else if (c < O_P) VB[(size_t)t * 128 + (c - O_V)] = f2bf(v);
    else if (c < O_GA) U[(size_t)t * 512 + (c - O_P)] = f2bf(v);
    else if (c < O_GP) GA[(size_t)t * 1024 + (c - O_GA)] = f2bf(v);
    else GP[(size_t)t * 1024 + (c - O_GP)] = f2bf(v);
}
__global__ void __launch_bounds__(256) n_attn(const bf16* Q, const bf16* KB, const bf16* VB, const float* sinks, bf16* AO) {
    const int idx = blockIdx.x * blockDim.x + threadIdx.x; if (idx >= T * NQH) return;
    const int t = idx / NQH, hq = idx % NQH, hk = hq / 8, pos = t % SEQ, b0 = t - pos;
    float q[64];
#pragma unroll
    for (int d = 0; d < 64; ++d) q[d] = bf2f(Q[(size_t)t * 1024 + hq * 64 + d]);
    const int lo = pos - (WINDOW - 1) > 0 ? pos - (WINDOW - 1) : 0;
    const float sink = sinks[hq]; float m = sink;
    for (int s = lo; s <= pos; ++s) { float a = 0.f;
#pragma unroll
        for (int d = 0; d < 64; ++d) a += q[d] * bf2f(KB[(size_t)(b0 + s) * 128 + hk * 64 + d]);
        a *= 0.125f; m = fmaxf(m, a); }
    float sum = __expf(sink - m); float o[64];
#pragma unroll
    for (int d = 0; d < 64; ++d) o[d] = 0.f;
    for (int s = lo; s <= pos; ++s) { float a = 0.f;
#pragma unroll
        for (int d = 0; d < 64; ++d) a += q[d] * bf2f(KB[(size_t)(b0 + s) * 128 + hk * 64 + d]);
        const float p = __expf(a * 0.125f - m); sum += p; const float pb = bf2f(f2bf(p));
#pragma unroll
        for (int d = 0; d < 64; ++d) o[d] += pb * bf2f(VB[(size_t)(b0 + s) * 128 + hk * 64 + d]); }
    const float inv = 1.f / sum;
#pragma unroll
    for (int d = 0; d < 64; ++d) AO[(size_t)t * 1024 + hq * 64 + d] = f2bf(o[d] * inv);
}
__global__ void __launch_bounds__(256) n_pool(const bf16* U, bf16* PO) {
    const int idx = blockIdx.x * blockDim.x + threadIdx.x; if (idx >= T * PW) return;
    const int t = idx / PW, c = idx % PW, g = c / 128, w = 2 << g, pos = t % SEQ; const int cnt = pos + 1 < w ? pos + 1 : w; float s = 0.f;
    for (int j = 0; j < cnt; ++j) s += bf2f(U[(size_t)(t - j) * PW + c]);
    PO[idx] = f2bf(s / (float)cnt - bf2f(U[idx]));
}
__global__ void __launch_bounds__(256) n_merge(const float* C1, const float* C2, const bf16* GA, const bf16* GP, bf16* MG) {
    const size_t idx = (size_t)blockIdx.x * blockDim.x + threadIdx.x; if (idx >= (size_t)T * D) return;
    const float t1 = bf2f(f2bf(sigmoidf_(bf2f(GA[idx])) * C1[idx]));
    MG[idx] = f2bf(t1 + sigmoidf_(bf2f(GP[idx])) * C2[idx]);
}
__global__ void __launch_bounds__(256) n_x1(const float* x, const float* C, bf16* X1) {
    const size_t idx = (size_t)blockIdx.x * blockDim.x + threadIdx.x; if (idx >= (size_t)T * D) return;
    X1[idx] = f2bf(C[idx]); (void)x;
}
__global__ void __launch_bounds__(256) n_router(const float* x, const bf16* X1, const float* g2, const float* wr, const float* br, fp8* H2, unsigned* counts, int* stok, int* toke, float* tokg) {
    const int t = blockIdx.x * 4 + (threadIdx.x >> 6), lane = threadIdx.x & 63;
    const f32x4* xr = (const f32x4*)(x + (size_t)t * D) + lane; const bf16* dr = X1 + (size_t)t * D + 4 * lane; f32x4 v[4]; float s = 0.f;
#pragma unroll
    for (int j = 0; j < 4; ++j) { v[j] = xr[64 * j]; v[j].x += bf2f(dr[256 * j]); v[j].y += bf2f(dr[256 * j + 1]); v[j].z += bf2f(dr[256 * j + 2]); v[j].w += bf2f(dr[256 * j + 3]); s += v[j].x * v[j].x + v[j].y * v[j].y + v[j].z * v[j].z + v[j].w * v[j].w; }
    const float rstd = rsqrtf(wave_sum(s) * (1.f / D) + RMS_EPS);
    float h[16];
#pragma unroll
    for (int j = 0; j < 4; ++j) { const f32x4 gg = ((const f32x4*)g2)[lane + 64 * j];
        h[4 * j + 0] = v[j].x * rstd * gg.x; h[4 * j + 1] = v[j].y * rstd * gg.y; h[4 * j + 2] = v[j].z * rstd * gg.z; h[4 * j + 3] = v[j].w * rstd * gg.w;
        fp8* o = H2 + (size_t)t * D + 4 * lane + 256 * j;
#pragma unroll
        for (int q = 0; q < 4; ++q) o[q] = f2fp8(h[4 * j + q]); }
    float lg[32];
#pragma unroll
    for (int e = 0; e < 32; ++e) { float a = 0.f;
#pragma unroll
        for (int j = 0; j < 4; ++j)
#pragma unroll
            for (int q = 0; q < 4; ++q) a += h[4 * j + q] * wr[(size_t)(4 * lane + 256 * j + q) * 32 + e];
        lg[e] = wave_sum(a) + br[e]; }
    int be[4]; float bv[4]; unsigned used = 0u;
#pragma unroll
    for (int k = 0; k < 4; ++k) { float best = -3.0e38f; int bi = 0;
#pragma unroll
        for (int e = 0; e < 32; ++e) { const bool ok = !((used >> e) & 1u) && lg[e] > best; best = ok ? lg[e] : best; bi = ok ? e : bi; }
        be[k] = bi; bv[k] = best; used |= 1u << bi; }
    float ex[4], se = 0.f;
#pragma unroll
    for (int k = 0; k < 4; ++k) { ex[k] = __expf(bv[k] - bv[0]); se += ex[k]; }
    if (lane == 0) {
#pragma unroll
        for (int k = 0; k < 4; ++k) { const unsigned pos = atomicAdd(&counts[be[k]], 1u);
            stok[be[k] * CAP + pos] = t; toke[t * 4 + k] = be[k] | (int)(pos << 8); tokg[t * 4 + k] = ex[k] / se; }
    }
}
__device__ __forceinline__ int moe_rowoff(const unsigned* counts, int e) { int o = 0; for (int i = 0; i < e; ++i) o += (int)((counts[i] + 255u) >> 8) << 8; return o; }
__global__ void __launch_bounds__(256) n_moe_up(const fp8* H2, const int* stok, const unsigned* counts, const fp8* WupT, const float* bup, fp8* ACT) {
    const int e = blockIdx.z, cnt = (int)counts[e], m0 = blockIdx.y * 64, n0 = blockIdx.x * 64; if (m0 >= cnt) return;
    __shared__ float As[16][65], Bg[16][65], Bl[16][65]; __shared__ int rowtok[64];
    const int tx = threadIdx.x & 15, ty = threadIdx.x >> 4; const int roff = moe_rowoff(counts, e);
    if (threadIdx.x < 64) rowtok[threadIdx.x] = (m0 + (int)threadIdx.x < cnt) ? stok[e * CAP + m0 + threadIdx.x] : 0;
    __syncthreads();
    float ag[4][4], al[4][4];
#pragma unroll
    for (int i = 0; i < 4; ++i)
#pragma unroll
        for (int j = 0; j < 4; ++j) { ag[i][j] = 0.f; al[i][j] = 0.f; }
    const fp8* W = WupT + (size_t)e * 2048 * 1024;
    for (int k0 = 0; k0 < 1024; k0 += 16) {
        for (int i = threadIdx.x; i < 1024; i += 256) { const int r = i >> 4, c = i & 15; const int j = n0 + r, ng = (j >> 7) * 256 + (j & 127);
            As[c][r] = fp82f(H2[(size_t)rowtok[r] * 1024 + k0 + c]); Bg[c][r] = fp82f(W[(size_t)ng * 1024 + k0 + c]) * W8_INV; Bl[c][r] = fp82f(W[(size_t)(ng + 128) * 1024 + k0 + c]) * W8_INV; }
        __syncthreads();
#pragma unroll
        for (int kk = 0; kk < 16; ++kk) { float a[4], g[4], l[4];
#pragma unroll
            for (int i = 0; i < 4; ++i) { a[i] = As[kk][ty * 4 + i]; g[i] = Bg[kk][tx * 4 + i]; l[i] = Bl[kk][tx * 4 + i]; }
#pragma unroll
            for (int i = 0; i < 4; ++i)
#pragma unroll
                for (int j = 0; j < 4; ++j) { ag[i][j] += a[i] * g[j]; al[i][j] += a[i] * l[j]; } }
        __syncthreads();
    }
#pragma unroll
    for (int i = 0; i < 4; ++i) { const int m = m0 + ty * 4 + i; if (m >= cnt) continue;
#pragma unroll
        for (int j = 0; j < 4; ++j) { const int c = n0 + tx * 4 + j; float gl = ag[i][j] + bup[e * 2048 + c], li = al[i][j] + bup[e * 2048 + 1024 + c];
            gl = fminf(gl, 7.f); li = fminf(fmaxf(li, -7.f), 7.f);
            ACT[(size_t)(roff + m) * 1024 + c] = f2fp8(gl * sigmoidf_(1.702f * gl) * (li + 1.f)); } }
}
__global__ void __launch_bounds__(256) n_moe_down(const fp8* ACT, const unsigned* counts, const fp8* WdnT, const float* bdn, fp8* YS) {
    const int e = blockIdx.z, cnt = (int)counts[e], m0 = blockIdx.y * 64, n0 = blockIdx.x * 64; if (m0 >= cnt) return;
    __shared__ float As[16][65], Bs[16][65];
    const int tx = threadIdx.x & 15, ty = threadIdx.x >> 4; const int roff = moe_rowoff(counts, e);
    float acc[4][4];
#pragma unroll
    for (int i = 0; i < 4; ++i)
#pragma unroll
        for (int j = 0; j < 4; ++j) acc[i][j] = 0.f;
    const fp8* W = WdnT + (size_t)e * 1024 * 1024;
    for (int k0 = 0; k0 < 1024; k0 += 16) {
        for (int i = threadIdx.x; i < 1024; i += 256) { const int r = i >> 4, c = i & 15; const int m = (m0 + r < cnt) ? m0 + r : m0;
            As[c][r] = fp82f(ACT[(size_t)(roff + m) * 1024 + k0 + c]); Bs[c][r] = fp82f(W[(size_t)(n0 + r) * 1024 + k0 + c]) * W8_INV; }
        __syncthreads();
#pragma unroll
        for (int kk = 0; kk < 16; ++kk) { float a[4], b[4];
#pragma unroll
            for (int i = 0; i < 4; ++i) { a[i] = As[kk][ty * 4 + i]; b[i] = Bs[kk][tx * 4 + i]; }
#pragma unroll
            for (int i = 0; i < 4; ++i)
#pragma unroll
                for (int j = 0; j < 4; ++j) acc[i][j] += a[i] * b[j]; }
        __syncthreads();
    }
#pragma unroll
    for (int i = 0; i < 4; ++i) { const int m = m0 + ty * 4 + i; if (m >= cnt) continue;
#pragma unroll
        for (int j = 0; j < 4; ++j) { const int c = n0 + tx * 4 + j; YS[(size_t)(roff + m) * 1024 + c] = f2fp8(acc[i][j] + bdn[e * 1024 + c]); } }
}
__global__ void __launch_bounds__(256) n_combine(const float* x, const bf16* X1, const fp8* YS, const unsigned* counts, const int* toke, const float* tokg, const float* gf, float* out) {
    const int t = blockIdx.x * 4 + (threadIdx.x >> 6), lane = threadIdx.x & 63;
    f32x4 v[4];
#pragma unroll
    for (int j = 0; j < 4; ++j) { v[j] = ((const f32x4*)(x + (size_t)t * D))[lane + 64 * j]; const bf16* dp = X1 + (size_t)t * D + 4 * lane + 256 * j; v[j].x += bf2f(dp[0]); v[j].y += bf2f(dp[1]); v[j].z += bf2f(dp[2]); v[j].w += bf2f(dp[3]); }
    for (int k = 0; k < 4; ++k) { const int te = toke[t * 4 + k], e = te & 255, pos = te >> 8; const float g = tokg[t * 4 + k];
        const fp8* y = YS + (size_t)(moe_rowoff(counts, e) + pos) * 1024;
#pragma unroll
        for (int j = 0; j < 4; ++j) { const fp8* p = y + 4 * lane + 256 * j; v[j].x += g * fp82f(p[0]); v[j].y += g * fp82f(p[1]); v[j].z += g * fp82f(p[2]); v[j].w += g * fp82f(p[3]); } }
    float s = 0.f;
#pragma unroll
    for (int j = 0; j < 4; ++j) s += v[j].x * v[j].x + v[j].y * v[j].y + v[j].z * v[j].z + v[j].w * v[j].w;
    const float rstd = rsqrtf(wave_sum(s) * (1.f / D) + RMS_EPS);
#pragma unroll
    for (int j = 0; j < 4; ++j) { const f32x4 gg = ((const f32x4*)gf)[lane + 64 * j]; f32x4 o = v[j] * rstd * gg; ((f32x4*)(out + (size_t)t * D))[lane + 64 * j] = o; }
}

#define GAS __attribute__((address_space(1)))
#define LAS __attribute__((address_space(3)))
typedef short bf16x8 __attribute__((ext_vector_type(8)));
typedef float f32x16 __attribute__((ext_vector_type(16)));
typedef short s16x4 __attribute__((ext_vector_type(4)));
typedef float f32x2 __attribute__((ext_vector_type(2)));
typedef GAS unsigned gu32;
#define RLX_AGENT __ATOMIC_RELAXED, __HIP_MEMORY_SCOPE_AGENT
#define LDS_WAIT() asm volatile("s_waitcnt lgkmcnt(0)" ::: "memory")
#define VM_WAIT() asm volatile("s_waitcnt vmcnt(0)" ::: "memory")

constexpr int NWAVES = 8, NTHR = 512;
constexpr int RING_BYTES = 131072;
constexpr int HB_STRIDE = 4112, HB_BYTES = 32 * HB_STRIDE;
constexpr int TBL_OFF = 132096;
constexpr int RT_LOGIT = 133120, RT_TOKE = RT_LOGIT + 8448, RT_TOKR = RT_TOKE + 1024, RT_TOKG = RT_TOKR + 1024, RT_HIST = RT_TOKG + 1024, RT_BASE = RT_HIST + 128;
constexpr int BIAS_OFF = 133120;
constexpr int MISC_OFF = 145408;
constexpr int LDS_BYTES = 147456;
static_assert(RT_BASE + 128 <= MISC_OFF && HB_BYTES <= TBL_OFF && MISC_OFF + 128 <= LDS_BYTES, "LDS map");

__device__ __forceinline__ unsigned cvt_pk_bf16(float lo, float hi) { unsigned r; asm volatile("v_cvt_pk_bf16_f32 %0, %1, %2" : "=v"(r) : "v"(lo), "v"(hi)); return r; }
__device__ __forceinline__ float bflo(unsigned w) { return __uint_as_float(w << 16); }
__device__ __forceinline__ float bfhi(unsigned w) { return __uint_as_float(w & 0xffff0000u); }
__device__ __forceinline__ float fast_sigmoid(float v) { return __builtin_amdgcn_rcpf(1.0f + __builtin_amdgcn_exp2f(-1.44269504089f * v)); }

#define XB_TMO      128
#define XB_XCNT(j)  (256  + 64 * (j))
#define XB_XSUB(j)  (1280 + 64 * (j))
#define XB_XGEN(j)  (2304 + 64 * (j))
#define XB_TOP      3328
#define XB_TOPGEN   3392
#define XCD_BAR_WORDS 3456
#define XB_SPIN_CAP (1u << 18)
__device__ __forceinline__ unsigned xb_ld(unsigned* p)              { return __hip_atomic_load(p, __ATOMIC_RELAXED, __HIP_MEMORY_SCOPE_AGENT); }
__device__ __forceinline__ unsigned xb_add(unsigned* p, unsigned v) { return __hip_atomic_fetch_add(p, v, __ATOMIC_RELAXED, __HIP_MEMORY_SCOPE_AGENT); }
__device__ __forceinline__ unsigned xb_xcc_id() { return (unsigned)__builtin_amdgcn_s_getreg((3 << 11) | 20) & 0xFu; }
#define XB_SPIN(cond, bar) do { unsigned _sp = 0; while (cond) { __builtin_amdgcn_s_sleep(1); \
    if ((++_sp & 255u) == 0u) { if (xb_ld(&(bar)[XB_TMO])) break; if (_sp > XB_SPIN_CAP) { atomicAdd(&(bar)[XB_TMO], 1u); break; } } } } while (0)
struct XcdBarrier { unsigned* bar; unsigned x; volatile LAS unsigned* st; };
__device__ __forceinline__ XcdBarrier xcd_barrier_post(unsigned* bar, volatile LAS unsigned* st) {
    XcdBarrier b; b.bar = bar; b.x = xb_xcc_id(); b.st = st;
    if (threadIdx.x == 0) (void)xb_add(&bar[XB_XCNT(b.x)], 1u);
    return b;
}
__device__ __forceinline__ void xcd_barrier_complete(unsigned* bar, unsigned x, unsigned& nloc, unsigned& nx) {
    const unsigned G = gridDim.x * gridDim.y * gridDim.z;
    unsigned sum, cnt, mine, sp = 0u;
    for (;;) {
        sum = 0u; cnt = 0u; mine = 0u;
#pragma unroll
        for (unsigned j = 0; j < 16; ++j) { const unsigned c = xb_ld(&bar[XB_XCNT(j)]); sum += c; cnt += (c > 0u) ? 1u : 0u; mine = (j == x) ? c : mine; }
        if (sum == G) break;
        __builtin_amdgcn_s_sleep(1);
        if ((++sp & 255u) == 0u) { if (xb_ld(&bar[XB_TMO])) break; if (sp > XB_SPIN_CAP) { atomicAdd(&bar[XB_TMO], 1u); break; } }
    }
    nloc = mine > 0u ? mine : 1u; nx = cnt > 0u ? cnt : 1u;
}
__device__ __forceinline__ void xcd_barrier(const XcdBarrier& b) {
    asm volatile("s_waitcnt vmcnt(0)" ::: "memory");
    __syncthreads();
    if (threadIdx.x == 0) {
        unsigned* bar = b.bar;
        __builtin_amdgcn_s_waitcnt(0);
        unsigned nloc = b.st[0], nx = b.st[1];
        if (nloc == 0u) { xcd_barrier_complete(bar, b.x, nloc, nx); b.st[0] = nloc; b.st[1] = nx; }
        const unsigned old = xb_add(&bar[XB_XSUB(b.x)], 1u);
        const unsigned gen = old / nloc;
        if (old + 1u == (gen + 1u) * nloc) {
            __builtin_amdgcn_fence(__ATOMIC_RELEASE, "agent");
            asm volatile("s_waitcnt vmcnt(0)" ::: "memory");
            const unsigned og = xb_add(&bar[XB_TOP], 1u);
            const unsigned tg = og / nx;
            if (og + 1u == (tg + 1u) * nx) xb_add(&bar[XB_TOPGEN], 1u);
            else XB_SPIN(xb_ld(&bar[XB_TOPGEN]) == tg, bar);
            __builtin_amdgcn_fence(__ATOMIC_ACQUIRE, "agent");
            xb_add(&bar[XB_XGEN(b.x)], 1u);
            asm volatile("s_waitcnt vmcnt(0)" ::: "memory");
        } else {
            XB_SPIN(xb_ld(&bar[XB_XGEN(b.x)]) == gen, bar);
            __builtin_amdgcn_fence(__ATOMIC_ACQUIRE, "agent");
            asm volatile("s_waitcnt vmcnt(0)" ::: "memory");
        }
    }
    __syncthreads();
}

namespace pg8 {
constexpr int BM = 256, BK = 64, HALF = 128, HTB = HALF * BK * 2, STAGE_BYTES = 8 * HTB, NXCD = 8, WGM = 8;
__host__ __device__ __forceinline__ int lds_byte(int r, int c) { const int st = (r >> 4) * 2 + (c >> 5), rr = r & 15, cc = c & 31, ob = rr * 64 + cc * 2; return st * 1024 + (ob ^ (((ob >> 9) & 1) << 5)); }
__host__ __device__ __forceinline__ void stage_rc(int b, int& R, int& C) { const int st = b / 1024, sb = b % 1024, swz = sb ^ (((sb >> 9) & 1) << 5); R = (st >> 1) * 16 + swz / 64; C = (st & 1) * 32 + (swz % 64) / 2; }
__host__ __device__ __forceinline__ int perm32(int rho) { const int n = rho >> 4, i = rho & 15; return 8 * (i >> 2) + 4 * n + (i & 3); }

struct GUnit { int row0, pn, e, grow, nvalid; };

struct DenseOrder {
    int nM, nN, nwg, G, c;
    __device__ void init(int M, int N, int G_, int c_) { nM = M / BM; nN = N / BM; nwg = nM * nN; G = G_; c = c_; }
    __device__ bool next(int i, GUnit& u) const {
        const long L = (long)i * G + c; if (L >= nwg) return false;
        int wgid = (int)L; { const int q = nwg / NXCD, r = nwg % NXCD, xcd = wgid % NXCD, off = wgid / NXCD; wgid = (xcd < r ? xcd * (q + 1) : r * (q + 1) + (xcd - r) * q) + off; }
        const int nig = WGM * nN, gid = wgid / nig, fm = gid * WGM, gsz = (nM - fm) < WGM ? (nM - fm) : WGM;
        u.row0 = (fm + ((wgid % nig) % gsz)) * BM; u.pn = (wgid % nig) / gsz; u.e = 0; u.grow = 0; u.nvalid = BM; return true;
    }
};
struct MoeOrder {
    const LAS int* ust; const LAS int* rowoff; const LAS int* cnt; int lognN, G, c;
    __device__ bool next(int i, GUnit& u) const {
        const int L = i * G + c; const int total = __builtin_amdgcn_readfirstlane(ust[32]); if (L >= total) return false;
        int e = 0;
#pragma unroll
        for (int j = 1; j < 32; ++j) e += (L >= __builtin_amdgcn_readfirstlane(ust[j])) ? 1 : 0;
        const int idx = L - __builtin_amdgcn_readfirstlane(ust[e]); const int r = idx >> lognN, pn = idx & ((1 << lognN) - 1);
        u.row0 = __builtin_amdgcn_readfirstlane(rowoff[e]) + BM * r; u.pn = pn; u.e = e; u.grow = e * CAP + BM * r; u.nvalid = __builtin_amdgcn_readfirstlane(cnt[e]) - BM * r; return true;
    }
};

template <bool VEC> struct MoeOrderX {
    const LAS int* rowoff; const LAS int* cnt; int lognN, G, c;
    __device__ bool next(int i, GUnit& u) const {
        int rem = i;
        for (int v = c; v < 256; v += G) {
            const int x8 = v & 7, j = v >> 3, e = x8 + 8 * (j >> 3), pn = (lognN == 3) ? (j & 7) : ((j & 7) >> 1), r0 = (lognN == 3) ? 0 : (j & 1), rs = (lognN == 3) ? 1 : 2;
            const int ce = __builtin_amdgcn_readfirstlane(cnt[e]), R = (ce + 255) >> 8, n = (R > r0) ? (R - r0 + rs - 1) / rs : 0;
            if (rem < n) { const int r = r0 + rem * rs; u.row0 = __builtin_amdgcn_readfirstlane(rowoff[e]) + BM * r; u.pn = pn; u.e = e; u.grow = e * CAP + BM * r; u.nvalid = ce - BM * r;
                if (VEC) { int ev = e; asm volatile("" : "+v"(ev)); u.e = ev; }
                return true; }
            rem -= n;
        }
        return false;
    }
};
struct MoeOrderOwn {
    const LAS int* rowoff; const LAS int* cnt; unsigned mx, mh; int G, c;
    __device__ bool next(int i, GUnit& u) const {
        int rem = i; const int ns = 8 * __builtin_popcount(mh);
        for (int v = c; v < 256; v += G) {
            const int x8 = v & 7, j = v >> 3, e = x8 + 8 * (j >> 3), jl = j & 7, pn = jl >> 1, rpar = jl & 1;
            const int ce = __builtin_amdgcn_readfirstlane(cnt[e]), R = (ce + 255) >> 8, n2 = R >> 1;
            const bool stolen = ((mx >> e) & 1u) && (4 * __builtin_popcount(mx & ((1u << e) - 1u)) + pn < ns);
            const int n = n2 + (((R & 1) && rpar == 0 && !stolen) ? 1 : 0);
            if (rem < n) { const int r = rem < n2 ? rpar + 2 * rem : R - 1; u.row0 = __builtin_amdgcn_readfirstlane(rowoff[e]) + BM * r; u.pn = pn; u.e = e; u.grow = e * CAP + BM * r; u.nvalid = ce - BM * r; return true; }
            rem -= n;
        }
        return false;
    }
};
struct MoeOrderSteal {
    const LAS int* rowoff; const LAS int* cnt; unsigned mx, mh; int G, c;
    __device__ bool next(int i, GUnit& u) const {
        int rem = i; const int nx = 4 * __builtin_popcount(mx);
        for (int v = c; v < 256; v += G) {
            const int x8 = v & 7, j = v >> 3, e = x8 + 8 * (j >> 3), jl = j & 7;
            if (!((mh >> e) & 1u)) continue;
            const int s = 8 * __builtin_popcount(mh & ((1u << e) - 1u)) + jl;
            if (s >= nx) continue;
            if (rem == 0) { unsigned m = mx; for (int q = 0; q < (s >> 2); ++q) m &= m - 1u;
                const int o = __builtin_ctz(m), pn = s & 3, ce = __builtin_amdgcn_readfirstlane(cnt[o]), r = ((ce + 255) >> 8) - 1;
                u.row0 = __builtin_amdgcn_readfirstlane(rowoff[o]) + BM * r; u.pn = pn; u.e = o; u.grow = o * CAP + BM * r; u.nvalid = ce - BM * r; return true; }
            --rem;
        }
        return false;
    }
};
__host__ __device__ __forceinline__ int sig8(int p) { return (p & 1) | (((p >> 2) & 1) * 6); }
typedef int v8i __attribute__((ext_vector_type(8)));
typedef int i32x4 __attribute__((ext_vector_type(4)));

template <class Epi, class Sched, int K, bool GATHER, bool F8>
__device__ __forceinline__ void gemm_phase(LAS unsigned char* lds, const void* A, const void* Bt, size_t bexp  , const Sched& S, const Epi& E, const int* gidx) {
    const int tid = threadIdx.x, wid = __builtin_amdgcn_readfirstlane(tid >> 6), lane = tid & 63, wr = wid >> 2, wc = wid & 3, fr = lane & 15, fq = lane >> 4;
    constexpr int ES = F8 ? 1 : 2, KB = K * ES, nt = KB / 128;
    static_assert(nt >= 4 && nt % 2 == 0, "K");
    int R0, C0b;
    if constexpr (F8) { R0 = tid >> 3; C0b = ((tid & 7) ^ sig8((R0 >> 1) & 7)) << 4; }
    else { int C0; stage_rc(tid * 16, R0, C0); C0b = C0 * 2; }
    unsigned voffA[2], voffB[2];
#pragma unroll
    for (int i = 0; i < 2; ++i) { const int R = R0 + 64 * i; const int Rb = Epi::PERM ? ((R & ~31) + perm32(R & 31)) : R;
        voffA[i] = (unsigned)(R * KB + C0b); voffB[i] = (unsigned)(Rb * KB + C0b); }
    constexpr size_t kstep = 128, hstep = (size_t)HALF * KB;
    const unsigned ldsw = (unsigned)wid * 1024u;
    int aoff, boff, aoff1 = 0, boff1 = 0;
    if constexpr (F8) { const int sg = sig8((fr >> 1) & 7);
        aoff = (wr * 64 + fr) * 128 + (((2 * fq) ^ sg) << 4); aoff1 = (wr * 64 + fr) * 128 + (((2 * fq + 1) ^ sg) << 4);
        boff = (wc * 32 + fr) * 128 + (((2 * fq) ^ sg) << 4); boff1 = (wc * 32 + fr) * 128 + (((2 * fq + 1) ^ sg) << 4); }
    else { aoff = lds_byte(wr * 64 + fr, fq * 8); boff = lds_byte(wc * 32 + fr, fq * 8); }
    unsigned gcur[2][2], gnxt[2][2];
#define PG8_LOADG(u_, g_) do { _Pragma("unroll") for (int _h = 0; _h < 2; ++_h) _Pragma("unroll") for (int _i = 0; _i < 2; ++_i) { const int _r = _h * HALF + R0 + 64 * _i; int _tok = 0; \
        if (_r < (u_).nvalid) _tok = gidx[(u_).grow + _r]; (g_)[_h][_i] = (unsigned)_tok * (unsigned)KB + (unsigned)C0b; } } while (0)
#define PG8_PING(g_) asm volatile("" : "+v"((g_)[0][0]), "+v"((g_)[0][1]), "+v"((g_)[1][0]), "+v"((g_)[1][1]))
#define PG8_SA(b, h) (((b) * 2 + (h)) * HTB)
#define PG8_SB(b, h) ((4 + (b) * 2 + (h)) * HTB)
#define PG8_STAGE(bufoff, rs, soff, voff) do { _Pragma("unroll") for (int _i = 0; _i < 2; ++_i) \
        __builtin_amdgcn_raw_ptr_buffer_load_lds(rs, (LAS void*)(lds + (bufoff) + ldsw + _i * 8192), 16, (int)(voff)[_i], (int)(soff), 0, 0); } while (0)
#define PG8_STAGE_A(bufoff, h, nx, kb) do { if constexpr (GATHER) { _Pragma("unroll") for (int _i = 0; _i < 2; ++_i) { const unsigned _o = (nx) ? gnxt[h][_i] : gcur[h][_i]; \
            __builtin_amdgcn_raw_ptr_buffer_load_lds(rsA, (LAS void*)(lds + (bufoff) + ldsw + _i * 8192), 16, (int)_o, (int)(kb), 0, 0); } } \
        else { PG8_STAGE(bufoff, rsA, ((nx) ? nA : cA) + (unsigned)((h) * hstep) + (unsigned)(kb), voffA); } } while (0)
#define PG8_LDA(b, h) do { if constexpr (F8) { _Pragma("unroll") for (int m = 0; m < 4; ++m) { const i32x4 _l = *(const LAS i32x4*)(lds + PG8_SA(b, h) + aoff + m * 2048), _h2 = *(const LAS i32x4*)(lds + PG8_SA(b, h) + aoff1 + m * 2048); \
            At8[m] = __builtin_shufflevector(_l, _h2, 0, 1, 2, 3, 4, 5, 6, 7); } } \
        else { _Pragma("unroll") for (int m = 0; m < 4; ++m) _Pragma("unroll") for (int k = 0; k < 2; ++k) At[m][k] = *(const LAS bf16x8*)(lds + PG8_SA(b, h) + aoff + m * 2048 + k * 1024); } } while (0)
#define PG8_LDB(dst, dst8, b, h) do { if constexpr (F8) { _Pragma("unroll") for (int n = 0; n < 2; ++n) { const i32x4 _l = *(const LAS i32x4*)(lds + PG8_SB(b, h) + boff + n * 2048), _h2 = *(const LAS i32x4*)(lds + PG8_SB(b, h) + boff1 + n * 2048); \
            dst8[n] = __builtin_shufflevector(_l, _h2, 0, 1, 2, 3, 4, 5, 6, 7); } } \
        else { _Pragma("unroll") for (int n = 0; n < 2; ++n) _Pragma("unroll") for (int k = 0; k < 2; ++k) dst[n][k] = *(const LAS bf16x8*)(lds + PG8_SB(b, h) + boff + n * 2048 + k * 1024); } } while (0)
#define PG8_MMA(ai, bj, Bt_, Bt8_) do { __builtin_amdgcn_s_setprio(1); if constexpr (F8) { _Pragma("unroll") for (int m = 0; m < 4; ++m) _Pragma("unroll") for (int n = 0; n < 2; ++n) \
            acc[ai][bj][m][n] = __builtin_amdgcn_mfma_scale_f32_16x16x128_f8f6f4(Bt8_[n], At8[m], acc[ai][bj][m][n], 0, 0, 0, 0, 0, 0); } \
        else { _Pragma("unroll") for (int m = 0; m < 4; ++m) _Pragma("unroll") for (int n = 0; n < 2; ++n) _Pragma("unroll") for (int k = 0; k < 2; ++k) \
            acc[ai][bj][m][n] = __builtin_amdgcn_mfma_f32_16x16x32_bf16(Bt_[n][k], At[m][k], acc[ai][bj][m][n], 0, 0, 0); } __builtin_amdgcn_s_setprio(0); } while (0)
#define PG8_WAIT_V(n) asm volatile("s_waitcnt vmcnt(" #n ")" ::: "memory")
#define PG8_WAIT_L(n) asm volatile("s_waitcnt lgkmcnt(" #n ")" ::: "memory")
#define PG8_BAR __builtin_amdgcn_s_barrier()
#define PG8_SCHED __builtin_amdgcn_sched_barrier(0)
    GUnit cur, nxt, nn; int ui = 0;
    if (!S.next(0, cur)) return;
    bool has_next = S.next(1, nxt);
    f32x4 acc[2][2][4][2];
#pragma unroll
    for (int a = 0; a < 2; ++a)
#pragma unroll
        for (int b = 0; b < 2; ++b)
#pragma unroll
            for (int m = 0; m < 4; ++m)
#pragma unroll
                for (int n = 0; n < 2; ++n) acc[a][b][m][n] = (f32x4){0.f, 0.f, 0.f, 0.f};
    bf16x8 At[4][2], B0[2][2], B1[2][2]; v8i At8[4], B08[2], B18[2];
    const __amdgpu_buffer_rsrc_t rsA = __builtin_amdgcn_make_buffer_rsrc((void*)A, 0, 0x7fffffff, 0x00020000), rsB = __builtin_amdgcn_make_buffer_rsrc((void*)Bt, 0, 0x7fffffff, 0x00020000);
    unsigned cA = (unsigned)cur.row0 * (unsigned)KB;
    unsigned cB = (unsigned)(((size_t)cur.e * bexp + (size_t)cur.pn * BM * K) * ES);
    unsigned nA = cA, nB = cB;
    if constexpr (GATHER) {
        PG8_LOADG(cur, gcur);
        if (has_next) PG8_LOADG(nxt, gnxt); else { gnxt[0][0] = gcur[0][0]; gnxt[0][1] = gcur[0][1]; gnxt[1][0] = gcur[1][0]; gnxt[1][1] = gcur[1][1]; }
        PG8_PING(gcur); PG8_PING(gnxt);
    }
    PG8_STAGE(PG8_SB(0, 0), rsB, cB, voffB); PG8_STAGE(PG8_SB(0, 1), rsB, cB + (unsigned)hstep, voffB); PG8_STAGE_A(PG8_SA(0, 0), 0, false, 0u); PG8_STAGE_A(PG8_SA(0, 1), 1, false, 0u);
    if (wr == 1) PG8_BAR;
    PG8_WAIT_V(2); PG8_BAR;
    PG8_STAGE(PG8_SB(1, 0), rsB, cB + (unsigned)kstep, voffB); PG8_STAGE_A(PG8_SA(1, 0), 0, false, (unsigned)kstep); PG8_STAGE(PG8_SB(1, 1), rsB, cB + (unsigned)(hstep + kstep), voffB);
    PG8_WAIT_V(6); PG8_BAR;
    for (;;) {
        if (has_next) { nA = (unsigned)nxt.row0 * (unsigned)KB; nB = (unsigned)(((size_t)nxt.e * bexp + (size_t)nxt.pn * BM * K) * ES); } else { nA = cA; nB = cB; }
#define PG8_KBODY(LAST, T_) do { \
            const unsigned kb1 = (unsigned)((T_) + 1) * (unsigned)kstep, kb2 = (LAST) ? 0u : (unsigned)((T_) + 2) * (unsigned)kstep, kb3 = kb2 + (unsigned)kstep; \
            const unsigned b2 = ((LAST) ? nB : cB) + kb2, b3 = b2 + (unsigned)kstep; \
              \
            PG8_LDB(B0, B08, 0, 0); PG8_LDB(B1, B18, 0, 1); PG8_SCHED; PG8_LDA(0, 0); PG8_STAGE_A(PG8_SA(1, 1), 1, false, kb1); \
            PG8_WAIT_V(8); PG8_WAIT_L(0); PG8_BAR; PG8_MMA(0, 0, B0, B08); PG8_MMA(0, 1, B1, B18); PG8_BAR; PG8_SCHED; \
              \
            PG8_LDA(0, 1); PG8_STAGE(PG8_SB(0, 0), rsB, b2, voffB); PG8_STAGE(PG8_SB(0, 1), rsB, b2 + (unsigned)hstep, voffB); PG8_STAGE_A(PG8_SA(0, 0), 0, LAST, kb2); \
            PG8_WAIT_V(8); PG8_WAIT_L(0); PG8_BAR; PG8_MMA(1, 0, B0, B08); PG8_MMA(1, 1, B1, B18); PG8_BAR; PG8_SCHED; \
              \
            PG8_LDB(B0, B08, 1, 0); PG8_LDB(B1, B18, 1, 1); PG8_SCHED; PG8_LDA(1, 0); PG8_STAGE_A(PG8_SA(0, 1), 1, LAST, kb2); \
            PG8_WAIT_V(8); PG8_WAIT_L(0); PG8_BAR; PG8_MMA(0, 0, B0, B08); PG8_MMA(0, 1, B1, B18); PG8_BAR; PG8_SCHED; \
              \
            PG8_LDA(1, 1); PG8_STAGE(PG8_SB(1, 0), rsB, b3, voffB); PG8_STAGE(PG8_SB(1, 1), rsB, b3 + (unsigned)hstep, voffB); PG8_STAGE_A(PG8_SA(1, 0), 0, LAST, kb3); \
            PG8_WAIT_V(8); PG8_WAIT_L(0); PG8_BAR; PG8_MMA(1, 0, B0, B08); PG8_MMA(1, 1, B1, B18); PG8_BAR; PG8_SCHED; } while (0)
        bool has_nn = false; unsigned gnn[2][2]; int gtok[2][2] = {{0, 0}, {0, 0}};
#pragma unroll 1
        for (int t = 0; t < nt; t += 2) {
            const bool last = (t == nt - 2);
            if (last) {
                has_nn = has_next && S.next(ui + 2, nn);
                if constexpr (GATHER) { if (has_nn) {
#pragma unroll
                    for (int _h = 0; _h < 2; ++_h)
#pragma unroll
                        for (int _i = 0; _i < 2; ++_i) { const int _r = _h * HALF + R0 + 64 * _i; if (_r < nn.nvalid) gtok[_h][_i] = gidx[nn.grow + _r]; } } }
                if (wid == 0) E.stage(cur, lds + BIAS_OFF, lane);
            }
            PG8_KBODY(last, t);
        }
        if constexpr (GATHER) {
#pragma unroll
            for (int _h = 0; _h < 2; ++_h)
#pragma unroll
                for (int _i = 0; _i < 2; ++_i) gnn[_h][_i] = has_nn ? (unsigned)gtok[_h][_i] * (unsigned)KB + (unsigned)C0b : gnxt[_h][_i];
            PG8_PING(gnn);
        }
        if (wr == 0) PG8_BAR;
        E(acc, cur, wr, wc, fr, fq, (const LAS float*)(lds + BIAS_OFF));
        if (!has_next) break;
#pragma unroll
        for (int a = 0; a < 2; ++a)
#pragma unroll
            for (int b = 0; b < 2; ++b)
#pragma unroll
                for (int m = 0; m < 4; ++m)
#pragma unroll
                    for (int n = 0; n < 2; ++n) acc[a][b][m][n] = (f32x4){0.f, 0.f, 0.f, 0.f};
        cur = nxt; nxt = nn; has_next = has_nn; cA = nA; cB = nB; ++ui;
        if constexpr (GATHER) {
#pragma unroll
            for (int h = 0; h < 2; ++h)
#pragma unroll
                for (int i = 0; i < 2; ++i) { gcur[h][i] = gnxt[h][i]; gnxt[h][i] = gnn[h][i]; }
        }
        if (wr == 1) PG8_BAR;
    }
    PG8_WAIT_V(0);
    PG8_BAR;
    (void)At; (void)B0; (void)B1; (void)At8; (void)B08; (void)B18; (void)aoff1; (void)boff1;
#undef PG8_KBODY
#undef PG8_LOADG
#undef PG8_PING
#undef PG8_SA
#undef PG8_SB
#undef PG8_STAGE
#undef PG8_STAGE_A
#undef PG8_LDA
#undef PG8_LDB
#undef PG8_MMA
#undef PG8_WAIT_V
#undef PG8_WAIT_L
#undef PG8_BAR
#undef PG8_SCHED
}

typedef f32x4 Acc[2][2][4][2];
__device__ __forceinline__ u32x4 pack8(const f32x4 v0, const f32x4 v1) { u32x4 w; w.x = cvt_pk_bf16(v0[0], v0[1]); w.y = cvt_pk_bf16(v0[2], v0[3]); w.z = cvt_pk_bf16(v1[0], v1[1]); w.w = cvt_pk_bf16(v1[2], v1[3]); return w; }

struct EpiInProj {
    static constexpr bool PERM = true;
    const float* bias; const float* cs; bf16 *Q, *KB, *VB, *U, *GA, *GP;
    __device__ __forceinline__ void stage(const GUnit& u, LAS unsigned char* slot, int lane) const {
        const __amdgpu_buffer_rsrc_t rs = __builtin_amdgcn_make_buffer_rsrc((void*)bias, 0, 0x7fffffff, 0x00020000);
        __builtin_amdgcn_raw_ptr_buffer_load_lds(rs, (LAS void*)slot, 16, lane * 16, u.pn * 1024, 0, 0); }
    __device__ __forceinline__ void operator()(const Acc& acc, const GUnit& u, int wr, int wc, int fr, int fq, const LAS float* bl) const {
        const int pn = u.pn; const bool rw = (wc & 1) == 0;
        bf16 *d0, *d1; int c0, pitch; bool rp0, rp1, nt;
        if (pn < 4) { d0 = d1 = Q; c0 = pn * 256; pitch = 1024; rp0 = rp1 = rw; nt = false; }
        else if (pn == 4) { d0 = KB; d1 = VB - 128; c0 = 0; pitch = 128; rp0 = rw; rp1 = false; nt = false; }
        else if (pn < 7) { d0 = d1 = U; c0 = (pn - 5) * 256; pitch = 512; rp0 = rp1 = false; nt = false; }
        else if (pn < 11) { d0 = d1 = GA; c0 = (pn - 7) * 256; pitch = 1024; rp0 = rp1 = false; nt = true; }
        else { d0 = d1 = GP; c0 = (pn - 11) * 256; pitch = 1024; rp0 = rp1 = false; nt = true; }
        const int rowl = wr * 64 + fr;
        const __amdgpu_buffer_rsrc_t r0 = __builtin_amdgcn_make_buffer_rsrc((void*)(d0 + (size_t)u.row0 * pitch), 0, 0x7fffffff, 0x00020000);
        const __amdgpu_buffer_rsrc_t r1 = __builtin_amdgcn_make_buffer_rsrc((void*)(d1 + (size_t)u.row0 * pitch), 0, 0x7fffffff, 0x00020000);
        const int vo = (rowl * pitch + c0 + wc * 32 + 8 * fq) * 2;
        f32x4 bb[2][2];
#pragma unroll
        for (int bj = 0; bj < 2; ++bj) { bb[bj][0] = *(const LAS f32x4*)(bl + bj * 128 + wc * 32 + 8 * fq); bb[bj][1] = *(const LAS f32x4*)(bl + bj * 128 + wc * 32 + 8 * fq + 4); }
        const float sg = (fq == 0) ? -1.f : 1.f;
        const int rstep = pitch * 32;
#pragma unroll
        for (int am = 0; am < 8; am += 2) {
            f32x4 csr[2][4];
            if (rp0) {
#pragma unroll
                for (int mm = 0; mm < 2; ++mm)
#pragma unroll
                    for (int q = 0; q < 4; ++q) csr[mm][q] = *(const f32x4*)(cs + (size_t)(u.row0 + rowl + ((am + mm) >> 2) * 128 + ((am + mm) & 3) * 16) * 16 + 4 * q);
            }
#pragma unroll
            for (int mm = 0; mm < 2; ++mm)
#pragma unroll
                for (int bj = 0; bj < 2; ++bj) { const int ai = (am + mm) >> 2, m = (am + mm) & 3;
                    f32x4 v0 = acc[ai][bj][m][0] + bb[bj][0], v1 = acc[ai][bj][m][1] + bb[bj][1];
                    if (bj == 0 ? rp0 : rp1) {
                        f32x4 o0, o1;
#pragma unroll
                        for (int j = 0; j < 4; ++j) { o0[j] = __shfl_xor(v0[j], 16); o1[j] = __shfl_xor(v1[j], 16); }
                        const f32x4 q0 = v0 * csr[mm][0] + (o0 * csr[mm][2]) * sg, q1 = v1 * csr[mm][1] + (o1 * csr[mm][3]) * sg;
                        if (fq < 2) { v0 = q0; v1 = q1; } }
                    const u32x4 w = pack8(v0, v1); const int so = (ai * 8 + m) * rstep;
                    if (nt) __builtin_amdgcn_raw_buffer_store_b128(w, bj == 0 ? r0 : r1, vo + bj * 256, so, 2);
                    else __builtin_amdgcn_raw_buffer_store_b128(w, bj == 0 ? r0 : r1, vo + bj * 256, so, 0);
                }
        }
    }
};
struct EpiGateA {
    static constexpr bool PERM = true;
    const bf16* GA; bf16* T1;
    __device__ __forceinline__ void stage(const GUnit&, LAS unsigned char*, int) const {}
    __device__ __forceinline__ void operator()(const Acc& acc, const GUnit& u, int wr, int wc, int fr, int fq, const LAS float*) const {
        const int row0 = u.row0 + wr * 64 + fr;
        u32x4 gg[16];
#pragma unroll
        for (int ai = 0; ai < 2; ++ai)
#pragma unroll
            for (int m = 0; m < 4; ++m)
#pragma unroll
                for (int bj = 0; bj < 2; ++bj) gg[(ai * 4 + m) * 2 + bj] = *(const u32x4*)(GA + (size_t)(row0 + ai * 128 + m * 16) * 1024 + u.pn * 256 + bj * 128 + wc * 32 + 8 * fq);
#pragma unroll
        for (int ai = 0; ai < 2; ++ai)
#pragma unroll
            for (int m = 0; m < 4; ++m)
#pragma unroll
                for (int bj = 0; bj < 2; ++bj) { const size_t off = (size_t)(row0 + ai * 128 + m * 16) * 1024 + u.pn * 256 + bj * 128 + wc * 32 + 8 * fq;
                    const u32x4 g = gg[(ai * 4 + m) * 2 + bj]; f32x4 v0 = acc[ai][bj][m][0], v1 = acc[ai][bj][m][1];
                    v0[0] *= fast_sigmoid(bflo(g.x)); v0[1] *= fast_sigmoid(bfhi(g.x)); v0[2] *= fast_sigmoid(bflo(g.y)); v0[3] *= fast_sigmoid(bfhi(g.y)); v1[0] *= fast_sigmoid(bflo(g.z)); v1[1] *= fast_sigmoid(bfhi(g.z)); v1[2] *= fast_sigmoid(bflo(g.w)); v1[3] *= fast_sigmoid(bfhi(g.w));
                    *(u32x4*)(T1 + off) = pack8(v0, v1); }
    }
};
struct EpiMerge {
    static constexpr bool PERM = true;
    const bf16* GP; const bf16* T1; bf16* MG;
    __device__ __forceinline__ void stage(const GUnit&, LAS unsigned char*, int) const {}
    __device__ __forceinline__ void operator()(const Acc& acc, const GUnit& u, int wr, int wc, int fr, int fq, const LAS float*) const {
        const int row0 = u.row0 + wr * 64 + fr;
#pragma unroll
        for (int ai = 0; ai < 2; ++ai) {
            u32x4 gg[8], tt[8];
#pragma unroll
            for (int m = 0; m < 4; ++m)
#pragma unroll
                for (int bj = 0; bj < 2; ++bj) { const size_t off = (size_t)(row0 + ai * 128 + m * 16) * 1024 + u.pn * 256 + bj * 128 + wc * 32 + 8 * fq;
                    gg[m * 2 + bj] = *(const u32x4*)(GP + off); tt[m * 2 + bj] = *(const u32x4*)(T1 + off); }
#pragma unroll
            for (int m = 0; m < 4; ++m)
#pragma unroll
                for (int bj = 0; bj < 2; ++bj) { const size_t off = (size_t)(row0 + ai * 128 + m * 16) * 1024 + u.pn * 256 + bj * 128 + wc * 32 + 8 * fq;
                    const u32x4 g = gg[m * 2 + bj]; const u32x4 t = tt[m * 2 + bj]; f32x4 v0 = acc[ai][bj][m][0], v1 = acc[ai][bj][m][1];
                    v0[0] = v0[0] * fast_sigmoid(bflo(g.x)) + bflo(t.x); v0[1] = v0[1] * fast_sigmoid(bfhi(g.x)) + bfhi(t.x); v0[2] = v0[2] * fast_sigmoid(bflo(g.y)) + bflo(t.y); v0[3] = v0[3] * fast_sigmoid(bfhi(g.y)) + bfhi(t.y);
                    v1[0] = v1[0] * fast_sigmoid(bflo(g.z)) + bflo(t.z); v1[1] = v1[1] * fast_sigmoid(bfhi(g.z)) + bfhi(t.z); v1[2] = v1[2] * fast_sigmoid(bflo(g.w)) + bflo(t.w); v1[3] = v1[3] * fast_sigmoid(bfhi(g.w)) + bfhi(t.w);
                    *(u32x4*)(MG + off) = pack8(v0, v1); }
        }
    }
};
struct EpiX1 {
    static constexpr bool PERM = true;
    bf16* X1;
    __device__ __forceinline__ void stage(const GUnit&, LAS unsigned char*, int) const {}
    __device__ __forceinline__ void operator()(const Acc& acc, const GUnit& u, int wr, int wc, int fr, int fq, const LAS float*) const {
        const int row0 = u.row0 + wr * 64 + fr;
#pragma unroll
        for (int ai = 0; ai < 2; ++ai)
#pragma unroll
            for (int m = 0; m < 4; ++m)
#pragma unroll
                for (int bj = 0; bj < 2; ++bj) *(u32x4*)(X1 + (size_t)(row0 + ai * 128 + m * 16) * 1024 + u.pn * 256 + bj * 128 + wc * 32 + 8 * fq) = pack8(acc[ai][bj][m][0], acc[ai][bj][m][1]);
    }
};
struct EpiSwiglu {
    static constexpr bool PERM = true;
    const float* bup; fp8* ACT;
    __device__ __forceinline__ void stage(const GUnit& u, LAS unsigned char* slot, int lane) const {
        const __amdgpu_buffer_rsrc_t rs = __builtin_amdgcn_make_buffer_rsrc((void*)bup, 0, 0x7fffffff, 0x00020000);
        __builtin_amdgcn_raw_ptr_buffer_load_lds(rs, (LAS void*)slot, 16, (lane & 31) * 16 + (lane >> 5) * 4096, (u.e * 2048 + u.pn * 128) * 4, 0, 0); }
    __device__ __forceinline__ void operator()(const Acc& acc, const GUnit& u, int wr, int wc, int fr, int fq, const LAS float* bl) const {
        const int row0 = u.row0 + wr * 64 + fr, col = u.pn * 128 + wc * 32 + 8 * fq;
        const LAS float* bg = bl + wc * 32 + 8 * fq;
        const f32x4 g0 = *(const LAS f32x4*)bg, g1 = *(const LAS f32x4*)(bg + 4), l0 = *(const LAS f32x4*)(bg + 128), l1 = *(const LAS f32x4*)(bg + 132);
#pragma unroll
        for (int ai = 0; ai < 2; ++ai)
#pragma unroll
            for (int m = 0; m < 4; ++m) {
                f32x4 a0 = acc[ai][0][m][0] * W8_INV + g0, a1 = acc[ai][0][m][1] * W8_INV + g1, c0 = acc[ai][1][m][0] * W8_INV + l0, c1 = acc[ai][1][m][1] * W8_INV + l1, r0, r1;
#pragma unroll
                for (int j = 0; j < 4; ++j) {
                    const float ga = fminf(a0[j], 7.f), la = fminf(fmaxf(c0[j], -7.f), 7.f); r0[j] = ga * fast_sigmoid(1.702f * ga) * (la + 1.f);
                    const float gb = fminf(a1[j], 7.f), lb = fminf(fmaxf(c1[j], -7.f), 7.f); r1[j] = gb * fast_sigmoid(1.702f * gb) * (lb + 1.f); }
                int w0 = 0, w1 = 0;
                w0 = __builtin_amdgcn_cvt_pk_fp8_f32(r0[0], r0[1], w0, false); w0 = __builtin_amdgcn_cvt_pk_fp8_f32(r0[2], r0[3], w0, true);
                w1 = __builtin_amdgcn_cvt_pk_fp8_f32(r1[0], r1[1], w1, false); w1 = __builtin_amdgcn_cvt_pk_fp8_f32(r1[2], r1[3], w1, true);
                u32x2 w; w.x = (unsigned)w0; w.y = (unsigned)w1;
                *(u32x2*)(ACT + (size_t)(row0 + ai * 128 + m * 16) * 1024 + col) = w;
            }
    }
};
struct EpiDown {
    static constexpr bool PERM = true;
    const float* bdn; fp8* YS;
    __device__ __forceinline__ void stage(const GUnit& u, LAS unsigned char* slot, int lane) const {
        const __amdgpu_buffer_rsrc_t rs = __builtin_amdgcn_make_buffer_rsrc((void*)bdn, 0, 0x7fffffff, 0x00020000);
        __builtin_amdgcn_raw_ptr_buffer_load_lds(rs, (LAS void*)slot, 16, lane * 16, (u.e * 1024 + u.pn * 256) * 4, 0, 0); }
    __device__ __forceinline__ void operator()(const Acc& acc, const GUnit& u, int wr, int wc, int fr, int fq, const LAS float* bl) const {
        const int row0 = u.row0 + wr * 64 + fr;
#pragma unroll
        for (int bj = 0; bj < 2; ++bj) { const int col = u.pn * 256 + bj * 128 + wc * 32 + 8 * fq;
            const f32x4 b0 = *(const LAS f32x4*)(bl + bj * 128 + wc * 32 + 8 * fq), b1 = *(const LAS f32x4*)(bl + bj * 128 + wc * 32 + 8 * fq + 4);
#pragma unroll
            for (int ai = 0; ai < 2; ++ai)
#pragma unroll
                for (int m = 0; m < 4; ++m) { const f32x4 r0 = acc[ai][bj][m][0] * W8_INV + b0, r1 = acc[ai][bj][m][1] * W8_INV + b1; int w0 = 0, w1 = 0;
                    w0 = __builtin_amdgcn_cvt_pk_fp8_f32(r0[0], r0[1], w0, false); w0 = __builtin_amdgcn_cvt_pk_fp8_f32(r0[2], r0[3], w0, true);
                    w1 = __builtin_amdgcn_cvt_pk_fp8_f32(r1[0], r1[1], w1, false); w1 = __builtin_amdgcn_cvt_pk_fp8_f32(r1[2], r1[3], w1, true);
                    u32x2 w; w.x = (unsigned)w0; w.y = (unsigned)w1; *(u32x2*)(YS + (size_t)(row0 + ai * 128 + m * 16) * 1024 + col) = w; } }
    }
};
}

struct Args { const float* in[19]; float* out; unsigned char* ws; int ph_lo, ph_hi, li, pad; };
struct Frame {
    LAS unsigned char* lds; int tid, lane, wave, G, bx;
    unsigned char* ws; gu32* ctl;
};

__device__ __forceinline__ void conv_item(const float* W, int N, bf16* WT, int K, int k0, int n_src0, int n_dst0, int lane, LAS unsigned char* scr) {
    const int hw = lane >> 5, l5 = lane & 31;
    const float* src = W + (size_t)(k0 + 16 * hw) * N + n_src0 + 4 * l5;
#pragma unroll
    for (int half = 0; half < 2; ++half) {
        f32x4 v[16];
#pragma unroll
        for (int j = 0; j < 16; ++j) v[j] = *(const f32x4*)(src + (size_t)(32 * half + j) * N);
#pragma unroll
        for (int q = 0; q < 4; ++q) { const int row = 4 * l5 + q;
#pragma unroll
            for (int cc = 0; cc < 2; ++cc) { u32x4 w; w.x = cvt_pk_bf16(v[8 * cc + 0][q], v[8 * cc + 1][q]); w.y = cvt_pk_bf16(v[8 * cc + 2][q], v[8 * cc + 3][q]);
                w.z = cvt_pk_bf16(v[8 * cc + 4][q], v[8 * cc + 5][q]); w.w = cvt_pk_bf16(v[8 * cc + 6][q], v[8 * cc + 7][q]);
                const int c = 4 * half + 2 * hw + cc;
                *(LAS u32x4*)(scr + row * 128 + ((c ^ (l5 & 7)) << 4)) = w; } }
    }
    LDS_WAIT(); asm volatile("" ::: "memory");
    bf16* dst = WT + (size_t)(n_dst0 + (lane >> 3)) * K + k0 + 8 * (lane & 7);
#pragma unroll
    for (int i = 0; i < 16; ++i) { const int n = 8 * i + (lane >> 3), c = lane & 7;
        const u32x4 w = *(const LAS u32x4*)(scr + n * 128 + ((c ^ ((n >> 2) & 7)) << 4));
        *(u32x4*)(dst + (size_t)(8 * i) * K) = w; }
    LDS_WAIT(); asm volatile("" ::: "memory");
}
__device__ __forceinline__ int pk4_fp8(float a, float b, float c, float d) { int w = 0; w = __builtin_amdgcn_cvt_pk_fp8_f32(a * W8_SCALE, b * W8_SCALE, w, false); w = __builtin_amdgcn_cvt_pk_fp8_f32(c * W8_SCALE, d * W8_SCALE, w, true); return w; }
constexpr int UP_DEFER0 = 2048, UP_DEFERN = 512;
template <int UNR> __device__ __forceinline__ void conv_item8(const float* W, int N, fp8* WT, int K, int k0, int n_src0, int n_dst0, int lane, LAS unsigned char* scr) {
    const int hw = lane >> 5, l5 = lane & 31;
    const float* src = W + (size_t)(k0 + 16 * hw) * N + n_src0 + 4 * l5;
#pragma unroll UNR
    for (int qt = 0; qt < 4; ++qt) {
        f32x4 v[16];
#pragma unroll
        for (int j = 0; j < 16; ++j) v[j] = __builtin_nontemporal_load((const f32x4*)(src + (size_t)(32 * qt + j) * N));
#pragma unroll
        for (int q = 0; q < 4; ++q) { const int row = 4 * l5 + q; u32x4 w;
            w.x = (unsigned)pk4_fp8(v[0][q], v[1][q], v[2][q], v[3][q]); w.y = (unsigned)pk4_fp8(v[4][q], v[5][q], v[6][q], v[7][q]);
            w.z = (unsigned)pk4_fp8(v[8][q], v[9][q], v[10][q], v[11][q]); w.w = (unsigned)pk4_fp8(v[12][q], v[13][q], v[14][q], v[15][q]);
            const int c = 2 * qt + hw;
            *(LAS u32x4*)(scr + row * 128 + ((c ^ (l5 & 7)) << 4)) = w; }
    }
    LDS_WAIT(); asm volatile("" ::: "memory");
    fp8* dst = WT + (size_t)(n_dst0 + (lane >> 3)) * K + k0 + 16 * (lane & 7);
#pragma unroll
    for (int i = 0; i < 16; ++i) { const int n = 8 * i + (lane >> 3), c = lane & 7;
        const u32x4 w = *(const LAS u32x4*)(scr + n * 128 + ((c ^ ((n >> 2) & 7)) << 4));
        __builtin_nontemporal_store(w, (u32x4*)(dst + (size_t)(8 * i) * K)); }
    LDS_WAIT(); asm volatile("" ::: "memory");
}
__device__ __forceinline__ void p0b_weights(const Frame& F, const Args& a, int widx, int nw) {
    const int gw = widx * NWAVES + F.wave, NGW = nw * NWAVES, lane = F.lane;
    unsigned char* ws = F.ws;
    bf16* WATT = (bf16*)(ws + WS_WATT); bf16* WEFF = (bf16*)(ws + WS_WEFF); bf16* WOUT = (bf16*)(ws + WS_WOUT);
    LAS unsigned char* scr = F.lds + F.wave * 16384;
    fp8* WUP8 = (fp8*)(ws + WS_WUP);
    constexpr int I_UP = 32 * 8 * 16, I_AT = 16 * 8, I_OUT = 16 * 8;
    for (int it = gw; it < I_UP; it += NGW) {
        if (nw == 256 && it >= UP_DEFER0 && it < UP_DEFER0 + UP_DEFERN) continue;
        int r = it;
        { const int e = r >> 7, q = r & 127, kb = q >> 4, nb = q & 15; conv_item8<2>(a.in[14] + (size_t)e * 1024 * 2048, 2048, WUP8 + (size_t)e * 2048 * 1024, 1024, kb * 128, up_src_col(nb * 128), nb * 128, lane, scr); }
    }
    for (int it = gw; it < I_AT + I_OUT; it += NGW) {
        int r = it;
        if (r < I_AT) { const int kb = r >> 3, nb = r & 7; conv_item(a.in[6], 1024, WATT, 1024, kb * 64, nb * 128, nb * 128, lane, scr); continue; } r -= I_AT;
        { const int kb = r >> 3, nb = r & 7; conv_item(a.in[10], 1024, WOUT, 1024, kb * 64, nb * 128, nb * 128, lane, scr); }
    }
    for (int it = NGW - 1 - gw; it < 64 * 16; it += NGW) {
        const int k0 = (it >> 4) * 8, n0 = (it & 15) * 64, g = k0 >> 7, kk0 = k0 & 127;
        const float* pw = a.in[7] + (size_t)(g * 128 + kk0) * 128; const float* ps = a.in[8] + g * 128; const float* wp = a.in[9] + (size_t)(g * 128) * 1024 + n0 + lane;
        float acc8[8];
#pragma unroll
        for (int q = 0; q < 8; ++q) acc8[q] = 0.f;
#pragma unroll 16
        for (int c = 0; c < 128; ++c) { const float wv = wp[(size_t)c * 1024] * ps[c];
#pragma unroll
            for (int q = 0; q < 8; ++q) acc8[q] += pw[q * 128 + c] * wv; }
        u32x4 w; w.x = cvt_pk_bf16(acc8[0], acc8[1]); w.y = cvt_pk_bf16(acc8[2], acc8[3]); w.z = cvt_pk_bf16(acc8[4], acc8[5]); w.w = cvt_pk_bf16(acc8[6], acc8[7]);
        *(u32x4*)(WEFF + (size_t)(n0 + lane) * 512 + k0) = w;
    }
}
__device__ __forceinline__ void p0_prologue(const Frame& F, const Args& a) {
    const int gw = F.bx * NWAVES + F.wave, NGW = F.G * NWAVES, lane = F.lane;
    unsigned char* ws = F.ws;
    bf16* WIN = (bf16*)(ws + WS_WIN); float* CS = (float*)(ws + WS_CS); bf16* H = (bf16*)(ws + WS_H);
    LAS unsigned char* scr = F.lds + F.wave * 16384;
    for (int it = gw; it < 16 * 30; it += NGW) { const int kb = it / 30, nb = it % 30; conv_item(a.in[3], INW, WIN, 1024, kb * 64, nb * 128, nb * 128, lane, scr); }
    { const float* wr = a.in[12]; bf16* WRH = (bf16*)(ws + WS_WRH); bf16* WRL = (bf16*)(ws + WS_WRL);
      for (int idx = gw * 64 + lane; idx < 32 * 1024; idx += NGW * 64) { const int e = idx >> 10, k = idx & 1023; const float w = wr[k * 32 + e]; const unsigned h = cvt_pk_bf16(w, 0.f) & 0xffffu;
          WRH[idx] = (bf16)h; WRL[idx] = (bf16)(cvt_pk_bf16(w - __uint_as_float(h << 16), 0.f) & 0xffffu); } }
    { const int* pos = (const int*)a.in[1];
      for (int idx = gw * 64 + lane; idx < T * 8; idx += NGW * 64) { const int t = idx >> 3, i = idx & 7; const float inv = powf(500000.0f, -(float)i * 0.125f); const float an = (float)pos[t] * inv;
          CS[t * 16 + i] = cosf(an); CS[t * 16 + 8 + i] = sinf(an); } }
    { const float* x = a.in[0]; const float* g1 = a.in[2];
      f32x4 gg[4];
#pragma unroll
      for (int j = 0; j < 4; ++j) gg[j] = ((const f32x4*)g1)[lane + 64 * j];
      for (int row = gw; row < T; row += 2 * NGW) {
          const int row2 = row + NGW;
          const f32x4* xr = (const f32x4*)(x + (size_t)row * D) + lane; const f32x4* xr2 = (const f32x4*)(x + (size_t)(row2 < T ? row2 : row) * D) + lane; f32x4 v[4], v2[4]; float s = 0.f, s2 = 0.f;
#pragma unroll
          for (int j = 0; j < 4; ++j) { v[j] = __builtin_nontemporal_load(xr + 64 * j); v2[j] = __builtin_nontemporal_load(xr2 + 64 * j); }
#pragma unroll
          for (int j = 0; j < 4; ++j) { s += v[j].x * v[j].x + v[j].y * v[j].y + v[j].z * v[j].z + v[j].w * v[j].w; s2 += v2[j].x * v2[j].x + v2[j].y * v2[j].y + v2[j].z * v2[j].z + v2[j].w * v2[j].w; }
          const float rstd = rsqrtf(wave_sum(s) * (1.f / D) + RMS_EPS), rstd2 = rsqrtf(wave_sum(s2) * (1.f / D) + RMS_EPS);
#pragma unroll
          for (int j = 0; j < 4; ++j) { const f32x4 o = v[j] * rstd * gg[j]; u32x2 w; w.x = cvt_pk_bf16(o[0], o[1]); w.y = cvt_pk_bf16(o[2], o[3]); *(u32x2*)(H + (size_t)row * D + 4 * lane + 256 * j) = w; }
          if (row2 < T) {
#pragma unroll
              for (int j = 0; j < 4; ++j) { const f32x4 o = v2[j] * rstd2 * gg[j]; u32x2 w; w.x = cvt_pk_bf16(o[0], o[1]); w.y = cvt_pk_bf16(o[2], o[3]); *(u32x2*)(H + (size_t)row2 * D + 4 * lane + 256 * j) = w; } }
      } }
}

template <int W> __device__ __forceinline__ void pool_rows(const bf16* U, bf16* PO, int t0, int wave, int lane) {
    const int c4 = 64 * wave + 4 * (lane & 15), r0 = t0 + 16 * (lane >> 4);
    const int pos0 = r0 % SEQ;
    u32x2 v[15 + W];
#pragma unroll
    for (int i = 0; i < 15 + W; ++i) { const int rr = r0 - (W - 1) + i; u32x2 z = {0u, 0u}; if (i >= W - 1 || pos0 != 0) z = *(const u32x2*)(U + (size_t)rr * PW + c4); v[i] = z; }
#pragma unroll
    for (int i = 0; i < 16; ++i) {
        float s0 = 0.f, s1 = 0.f, s2 = 0.f, s3 = 0.f;
#pragma unroll
        for (int jj = 0; jj < W; ++jj) { const u32x2 x = v[i + W - 1 - jj]; s0 += bflo(x.x); s1 += bfhi(x.x); s2 += bflo(x.y); s3 += bfhi(x.y); }
        const int pos = pos0 + i; const float rc = 1.0f / (float)(pos + 1 < W ? pos + 1 : W);
        const u32x2 c = v[i + W - 1]; u32x2 o;
        o.x = cvt_pk_bf16(s0 * rc - bflo(c.x), s1 * rc - bfhi(c.x)); o.y = cvt_pk_bf16(s2 * rc - bflo(c.y), s3 * rc - bfhi(c.y));
        *(u32x2*)(PO + (size_t)(r0 + i) * PW + c4) = o;
    }
}
__device__ __forceinline__ void attn_unit(const Frame& F, int unit, const bf16* Q, const bf16* KB, const bf16* VB, const float* sinks, bf16* AO, const bf16* U, bf16* PO, int pool_chunk, const float* w_down, fp8* WDN8) {
    const int tid = F.tid, lane = F.lane, wid = F.wave, r32 = lane & 31, hi = lane >> 5;
    const int b = unit >> 6, n = (unit >> 1) & 31, hkv = unit & 1;
    LAS unsigned char* Kt = F.lds; LAS unsigned char* Vt = F.lds + 32768;
    const int tok0 = b * SEQ + 128 * (n - 1);
    int hq = hkv * 8 + 2 * (wid & 3);
    u32x4 kreg[4], vreg[4];
#pragma unroll
    for (int c = 0; c < 4; ++c) { const int id = tid + 512 * c, row = id >> 3, ch = id & 7; int tok = tok0 + row; tok = tok < b * SEQ ? b * SEQ + row : tok;
        kreg[c] = *(const u32x4*)(KB + (size_t)tok * 128 + hkv * 64 + ch * 8); vreg[c] = *(const u32x4*)(VB + (size_t)tok * 128 + hkv * 64 + ch * 8); }
    bf16x8 qn[4];
    { const size_t qrow = (size_t)b * SEQ + 128 * n + r32;
#pragma unroll
      for (int ks = 0; ks < 4; ++ks) qn[ks] = *(const bf16x8*)(Q + qrow * 1024 + hq * 64 + ks * 16 + hi * 8); }
    if (pool_chunk >= 0) { const int g = wid >> 1, t0 = pool_chunk * 64;
        if (g == 0) pool_rows<2>(U, PO, t0, wid, lane); else if (g == 1) pool_rows<4>(U, PO, t0, wid, lane); else if (g == 2) pool_rows<8>(U, PO, t0, wid, lane); else pool_rows<16>(U, PO, t0, wid, lane); }
    __syncthreads();
#pragma unroll
    for (int c = 0; c < 4; ++c) { const int id = tid + 512 * c, row = id >> 3, ch = id & 7;
        *(LAS u32x4*)(Kt + row * 128 + ((ch ^ ((row >> 1) & 7)) << 4)) = kreg[c];
        *(LAS u32x4*)(Vt + row * 128 + ((ch * 16) ^ (((row >> 1) & 1) << 6))) = vreg[c]; }
    __syncthreads();
    if (wid >= 4) {
#pragma unroll 1
        for (int k = 0; k < 2; ++k) { const int it = unit * 4 + (wid - 4) + 1024 * k, e = it >> 6, q = it & 63, kb = q >> 3, nb = q & 7;
            conv_item8<1>(w_down + (size_t)e * 1024 * 1024, 1024, WDN8 + (size_t)e * 1024 * 1024, 1024, kb * 128, nb * 128, nb * 128, lane, F.lds + 65536 + (wid - 4) * 16384); }
        return;
    }
    constexpr float LOG2E = 1.44269504089f, C2 = 0.125f * LOG2E;
#pragma unroll 1
    for (int hsel = 0; hsel < 2; ++hsel) {
    const float sink = sinks[hq];
    if (hsel == 1) { const size_t qrow = (size_t)b * SEQ + 128 * n + r32;
#pragma unroll
        for (int ks = 0; ks < 4; ++ks) qn[ks] = *(const bf16x8*)(Q + qrow * 1024 + hq * 64 + ks * 16 + hi * 8); }
#pragma unroll 1
    for (int j = 0; j < 4; ++j) {
        const size_t qrow = (size_t)b * SEQ + 128 * n + 32 * j + r32;
        bf16x8 qf[4];
#pragma unroll
        for (int ks = 0; ks < 4; ++ks) qf[ks] = qn[ks];
        if (j < 3) {
#pragma unroll
            for (int ks = 0; ks < 4; ++ks) qn[ks] = *(const bf16x8*)(Q + (qrow + 32) * 1024 + hq * 64 + ks * 16 + hi * 8); }
        int r32v = r32; asm volatile("" : "+v"(r32v));
        f32x16 s[5];
#pragma unroll
        for (int tau = 0; tau < 5; ++tau) {
            const int kt = j + tau; const int krow = 32 * kt + r32;
            f32x16 a = {0.f, 0.f, 0.f, 0.f, 0.f, 0.f, 0.f, 0.f, 0.f, 0.f, 0.f, 0.f, 0.f, 0.f, 0.f, 0.f};
#pragma unroll
            for (int ks = 0; ks < 4; ++ks) { const bf16x8 kf = *(const LAS bf16x8*)(Kt + krow * 128 + (((2 * ks + hi) ^ ((krow >> 1) & 7)) << 4));
                a = __builtin_amdgcn_mfma_f32_32x32x16_bf16(kf, qf[ks], a, 0, 0, 0); }
            s[tau] = a;
        }
        float mx = -1.0e30f;
#pragma unroll
        for (int tau = 0; tau < 5; ++tau) { const bool dead = (n == 0) && (j + tau < 4);
#pragma unroll
            for (int r = 0; r < 16; ++r) { const int kk = (r & 3) + 8 * (r >> 2) + 4 * hi; bool ok = !dead; if (tau == 0) ok = ok && (kk > r32v); if (tau == 4) ok = ok && (kk <= r32v);
                s[tau][r] = ok ? s[tau][r] : -1.0e30f; mx = fmaxf(mx, s[tau][r]); } }
        mx = fmaxf(mx, __shfl_xor(mx, 32));
        const float mm = fmaxf(mx * 0.125f, sink), mml = mm * LOG2E;
        float sum = 0.f;
#pragma unroll
        for (int tau = 0; tau < 5; ++tau)
#pragma unroll
            for (int r = 0; r < 16; ++r) { const float p = (s[tau][r] > -1.0e29f) ? __builtin_amdgcn_exp2f(s[tau][r] * C2 - mml) : 0.f; s[tau][r] = p; sum += p; }
        sum += __shfl_xor(sum, 32);
        sum += __builtin_amdgcn_exp2f((sink - mm) * LOG2E);
        const float inv = 1.0f / sum;
        bf16* orow = AO + qrow * 1024 + hq * 64;
#pragma unroll
        for (int d0 = 0; d0 < 2; ++d0) {
            f32x16 o = {0.f, 0.f, 0.f, 0.f, 0.f, 0.f, 0.f, 0.f, 0.f, 0.f, 0.f, 0.f, 0.f, 0.f, 0.f, 0.f};
#pragma unroll
            for (int tau = 0; tau < 5; ++tau) {
                const int kt = j + tau;
#pragma unroll
                for (int s2 = 0; s2 < 2; ++s2) {
                    bf16x8 pf; { const unsigned w0 = cvt_pk_bf16(s[tau][8 * s2 + 0], s[tau][8 * s2 + 1]), w1 = cvt_pk_bf16(s[tau][8 * s2 + 2], s[tau][8 * s2 + 3]), w2 = cvt_pk_bf16(s[tau][8 * s2 + 4], s[tau][8 * s2 + 5]), w3 = cvt_pk_bf16(s[tau][8 * s2 + 6], s[tau][8 * s2 + 7]);
                        const u32x4 w = {w0, w1, w2, w3}; pf = __builtin_bit_cast(bf16x8, w); }
                    const int vrow = 32 * kt + 16 * s2 + 4 * hi + ((lane & 15) >> 2);
                    const int vcb = 64 * d0 + 32 * ((lane >> 4) & 1) + 8 * (lane & 3);
                    const int vaddr = vrow * 128 + (vcb ^ (((vrow >> 1) & 1) << 6));
                    const s16x4 lo = __builtin_bit_cast(s16x4, __builtin_amdgcn_ds_read_tr16_b64_v4i16((LAS s16x4*)(Vt + vaddr)));
                    const s16x4 hh = __builtin_bit_cast(s16x4, __builtin_amdgcn_ds_read_tr16_b64_v4i16((LAS s16x4*)(Vt + vaddr + 1024)));
                    const bf16x8 vf = {lo[0], lo[1], lo[2], lo[3], hh[0], hh[1], hh[2], hh[3]};
                    o = __builtin_amdgcn_mfma_f32_32x32x16_bf16(vf, pf, o, 0, 0, 0);
                }
            }
#pragma unroll
            for (int rg = 0; rg < 4; ++rg) { u32x2 w; w.x = cvt_pk_bf16(o[4 * rg] * inv, o[4 * rg + 1] * inv); w.y = cvt_pk_bf16(o[4 * rg + 2] * inv, o[4 * rg + 3] * inv);
                *(u32x2*)(orow + 32 * d0 + 8 * rg + 4 * hi) = w; }
        }
    }
    ++hq;
    }
}

__device__ __forceinline__ void moe_tables(const Frame& F) {
    LAS int* tb = (LAS int*)(F.lds + TBL_OFF);
    __syncthreads();
    if (F.tid < 32) tb[192 + F.tid] = (int)__hip_atomic_load(F.ctl + CW_CNT + F.tid, RLX_AGENT);
    __syncthreads();
    if (F.tid == 0) { int u8 = 0, u4 = 0, ro = 0;
        for (int e = 0; e < 32; ++e) { const int c = tb[192 + e], r = (c + 255) >> 8; tb[e] = u8; tb[64 + e] = u4; tb[128 + e] = ro; u8 += r * 8; u4 += r * 4; ro += r * 256; }
        tb[32] = u8; tb[64 + 32] = u4; tb[128 + 32] = ro; }
    if (F.wave == 0) {
        const int e = F.lane & 31, R = (tb[192 + e] + 255) >> 8, L = R + (R >> 1); const bool odd = (R & 1) != 0;
        int lm = odd ? L : 0;
#pragma unroll
        for (int o = 16; o >= 1; o >>= 1) lm = max(lm, __shfl_xor(lm, o));
        const unsigned long long bx = __ballot(odd && L == lm), bh = __ballot(!odd && L + 1 <= lm);
        if (F.lane == 0) { tb[224] = (int)(unsigned)bx; tb[225] = (int)(unsigned)bh; }
    }
    __syncthreads();
}

__device__ __forceinline__ void router_chunk(const Frame& F, int chunk, const float* x, const bf16* X1, const float* g2, const bf16* WRH, const bf16* WRL, const float* br, fp8* H2, gu32* counts, int* stok, int* toke, float* tokg) {
    const int tid = F.tid, lane = F.lane, w = F.wave, i32 = lane & 31, hh = lane >> 5;
    LAS unsigned char* lds = F.lds;
    LAS float* logit = (LAS float*)(lds + RT_LOGIT); LAS int* tokE = (LAS int*)(lds + RT_TOKE); LAS int* tokR = (LAS int*)(lds + RT_TOKR); LAS float* tokG = (LAS float*)(lds + RT_TOKG);
    LAS unsigned* hist = (LAS unsigned*)(lds + RT_HIST); LAS unsigned* base = (LAS unsigned*)(lds + RT_BASE);
    LAS float* g2l = (LAS float*)(lds + RT_LOGIT + 4224);
    const __amdgpu_buffer_rsrc_t rsX = __builtin_amdgcn_make_buffer_rsrc((void*)x, 0, 0x7fffffff, 0x00020000), rsD = __builtin_amdgcn_make_buffer_rsrc((void*)X1, 0, 0x7fffffff, 0x00020000), rsH = __builtin_amdgcn_make_buffer_rsrc((void*)H2, 0, 0x7fffffff, 0x00020000);
    const int vx = lane * 16, vd = lane * 8, vh = lane * 4;
    f32x4 xv[4][4];
#pragma unroll
    for (int q = 0; q < 4; ++q) { const int so = (chunk * 64 + 4 * w + q) * (D * 4);
#pragma unroll
        for (int j = 0; j < 4; ++j) xv[q][j] = __builtin_bit_cast(f32x4, __builtin_amdgcn_raw_buffer_load_b128(rsX, vx + 1024 * j, so, 0)); }
    bf16x8 bh[8], bl[8];
    __syncthreads();
    if (tid < 32) hist[tid] = 0u;
    *(LAS f32x2*)(g2l + 2 * tid) = *(const f32x2*)(g2 + 2 * tid);
    __syncthreads();
#pragma unroll
    for (int p = 0; p < 2; ++p) {
        const int r0 = chunk * 64 + 32 * p;
#pragma unroll
        for (int qh = 0; qh < 2; ++qh) {
            u32x2 dv[2][4];
#pragma unroll
            for (int q2 = 0; q2 < 2; ++q2)
#pragma unroll
                for (int j = 0; j < 4; ++j) dv[q2][j] = __builtin_bit_cast(u32x2, __builtin_amdgcn_raw_buffer_load_b64(rsD, vd + 512 * j, (r0 + 4 * w + 2 * qh + q2) * (D * 2), 0));
#pragma unroll
            for (int q2 = 0; q2 < 2; ++q2) { const int q = 2 * qh + q2, rl = 4 * w + q, row = r0 + rl; float s = 0.f;
#pragma unroll
                for (int j = 0; j < 4; ++j) { const u32x2 dw = dv[q2][j]; const f32x4 t = xv[q][j] + (f32x4){bflo(dw.x), bfhi(dw.x), bflo(dw.y), bfhi(dw.y)}; xv[q][j] = t; s += t.x * t.x + t.y * t.y + t.z * t.z + t.w * t.w; }
                const float rstd = rsqrtf(wave_sum(s) * (1.f / D) + RMS_EPS);
#pragma unroll
                for (int j = 0; j < 4; ++j) { const f32x4 o = xv[q][j] * rstd * *(const LAS f32x4*)(g2l + 4 * lane + 256 * j); int pk = 0; pk = __builtin_amdgcn_cvt_pk_fp8_f32(o[0], o[1], pk, false); pk = __builtin_amdgcn_cvt_pk_fp8_f32(o[2], o[3], pk, true);
                    __builtin_amdgcn_raw_buffer_store_b32((unsigned)pk, rsH, vh + 256 * j, row * D, 0); *(LAS f32x4*)(lds + rl * HB_STRIDE + (4 * lane + 256 * j) * 4) = o; } }
        }
        if (p == 0) {
            { const bf16* ph = WRH + (size_t)i32 * 1024 + 128 * w + 8 * hh; const bf16* pl = WRL + (size_t)i32 * 1024 + 128 * w + 8 * hh;
#pragma unroll
              for (int ks = 0; ks < 8; ++ks) { bh[ks] = *(const bf16x8*)(ph + 16 * ks); bl[ks] = *(const bf16x8*)(pl + 16 * ks); } }
#pragma unroll
            for (int q = 0; q < 4; ++q) { const int so = (chunk * 64 + 32 + 4 * w + q) * (D * 4);
#pragma unroll
                for (int j = 0; j < 4; ++j) xv[q][j] = __builtin_bit_cast(f32x4, __builtin_amdgcn_raw_buffer_load_b128(rsX, vx + 1024 * j, so, 0)); } }
        __syncthreads();
        f32x16 acc = {0.f, 0.f, 0.f, 0.f, 0.f, 0.f, 0.f, 0.f, 0.f, 0.f, 0.f, 0.f, 0.f, 0.f, 0.f, 0.f};
#pragma unroll
        for (int ks = 0; ks < 8; ++ks) {
            const LAS float* hp = (const LAS float*)(lds + i32 * HB_STRIDE + (128 * w + 16 * ks + 8 * hh) * 4);
            const f32x4 a0 = *(const LAS f32x4*)hp, a1 = *(const LAS f32x4*)(hp + 4);
            u32x4 whi, wlo;
            whi.x = cvt_pk_bf16(a0[0], a0[1]); whi.y = cvt_pk_bf16(a0[2], a0[3]); whi.z = cvt_pk_bf16(a1[0], a1[1]); whi.w = cvt_pk_bf16(a1[2], a1[3]);
            wlo.x = cvt_pk_bf16(a0[0] - bflo(whi.x), a0[1] - bfhi(whi.x)); wlo.y = cvt_pk_bf16(a0[2] - bflo(whi.y), a0[3] - bfhi(whi.y));
            wlo.z = cvt_pk_bf16(a1[0] - bflo(whi.z), a1[1] - bfhi(whi.z)); wlo.w = cvt_pk_bf16(a1[2] - bflo(whi.w), a1[3] - bfhi(whi.w));
            const bf16x8 ahi = __builtin_bit_cast(bf16x8, whi), alo = __builtin_bit_cast(bf16x8, wlo);
            acc = __builtin_amdgcn_mfma_f32_32x32x16_bf16(ahi, bh[ks], acc, 0, 0, 0);
            acc = __builtin_amdgcn_mfma_f32_32x32x16_bf16(ahi, bl[ks], acc, 0, 0, 0);
            acc = __builtin_amdgcn_mfma_f32_32x32x16_bf16(alo, bh[ks], acc, 0, 0, 0);
        }
        __syncthreads();
        LAS float* part = (LAS float*)lds;
#pragma unroll
        for (int r = 0; r < 16; ++r) { const int tk = (r & 3) + 8 * (r >> 2) + 4 * hh; part[(w * 32 + tk) * 33 + i32] = acc[r]; }
        __syncthreads();
#pragma unroll
        for (int q = 0; q < 2; ++q) { const int o = tid + 512 * q, tk = o >> 5, e = o & 31; float sacc = br[e];
#pragma unroll
            for (int ww = 0; ww < 8; ++ww) sacc += part[(ww * 32 + tk) * 33 + e];
            logit[(32 * p + tk) * 33 + e] = sacc; }
        __syncthreads();
    }
    if (tid < 64) {
        float lg[32];
#pragma unroll
        for (int e = 0; e < 32; ++e) lg[e] = logit[tid * 33 + e];
        int be[4]; float bv[4]; unsigned used = 0u;
#pragma unroll
        for (int k = 0; k < 4; ++k) { float best = -3.0e38f; int bi = 0;
#pragma unroll
            for (int e = 0; e < 32; ++e) { const bool ok = !((used >> e) & 1u) && lg[e] > best; best = ok ? lg[e] : best; bi = ok ? e : bi; }
            be[k] = bi; bv[k] = best; used |= 1u << bi; }
        float ex[4], se = 0.f;
#pragma unroll
        for (int k = 0; k < 4; ++k) { ex[k] = __expf(bv[k] - bv[0]); se += ex[k]; }
        const float rse = 1.0f / se;
#pragma unroll
        for (int k = 0; k < 4; ++k) { const unsigned rk = __hip_atomic_fetch_add(hist + be[k], 1u, __ATOMIC_RELAXED, __HIP_MEMORY_SCOPE_WORKGROUP);
            tokE[tid * 4 + k] = be[k]; tokR[tid * 4 + k] = (int)rk; tokG[tid * 4 + k] = ex[k] * rse; }
    }
    __syncthreads();
    if (tid < 32) { const unsigned hc = hist[tid]; base[tid] = hc ? __hip_atomic_fetch_add(counts + tid, hc, RLX_AGENT) : 0u; }
    __syncthreads();
    if (tid < 256) { const int tk = tid >> 2, k = tid & 3, e = tokE[tk * 4 + k], pos = (int)base[e] + tokR[tk * 4 + k], t = chunk * 64 + tk;
        stok[e * CAP + pos] = t; toke[t * 4 + k] = e | (pos << 8); tokg[t * 4 + k] = tokG[tk * 4 + k]; }
}

__device__ __forceinline__ void combine_rows(const Frame& F, const float* x, const bf16* X1, const fp8* YS, const int* toke, const float* tokg, const float* gf, float* out) {
    const int lane = F.lane; const LAS int* rowoff = (const LAS int*)(F.lds + TBL_OFF) + 128;
    f32x4 gg[4];
#pragma unroll
    for (int j = 0; j < 4; ++j) gg[j] = ((const f32x4*)gf)[lane + 64 * j];
    for (int t = F.bx * NWAVES + F.wave; t < T; t += F.G * NWAVES) {
        f32x4 v[4];
#pragma unroll
        for (int j = 0; j < 4; ++j) { const u32x2 dw = __builtin_nontemporal_load((const u32x2*)(X1 + (size_t)t * D + 4 * lane + 256 * j)); v[j] = __builtin_nontemporal_load((const f32x4*)(x + (size_t)t * D) + lane + 64 * j) + (f32x4){bflo(dw.x), bfhi(dw.x), bflo(dw.y), bfhi(dw.y)}; }
        const int4 te = *(const int4*)(toke + t * 4); const f32x4 tg = *(const f32x4*)(tokg + t * 4);
        const int tes[4] = {te.x, te.y, te.z, te.w};
#pragma unroll
        for (int k = 0; k < 4; ++k) { const int e = tes[k] & 255, pos = tes[k] >> 8; const float g = tg[k];
            const fp8* y = YS + (size_t)(rowoff[e] + pos) * 1024 + 4 * lane;
#pragma unroll
            for (int j = 0; j < 4; ++j) { const int pw = __builtin_nontemporal_load((const int*)(y + 256 * j)); const f32x2 lo = __builtin_amdgcn_cvt_pk_f32_fp8(pw, false), hi2 = __builtin_amdgcn_cvt_pk_f32_fp8(pw, true);
                v[j].x += g * lo[0]; v[j].y += g * lo[1]; v[j].z += g * hi2[0]; v[j].w += g * hi2[1]; } }
        float s = 0.f;
#pragma unroll
        for (int j = 0; j < 4; ++j) s += v[j].x * v[j].x + v[j].y * v[j].y + v[j].z * v[j].z + v[j].w * v[j].w;
        const float rstd = rsqrtf(wave_sum(s) * (1.f / D) + RMS_EPS);
#pragma unroll
        for (int j = 0; j < 4; ++j) __builtin_nontemporal_store(v[j] * rstd * gg[j], (f32x4*)(out + (size_t)t * D) + lane + 64 * j);
    }
}

constexpr int N_PHASES = 9;
__global__ void __launch_bounds__(NTHR, 2) fwd(Args a) {
    extern __shared__ __attribute__((aligned(16))) unsigned char lds_raw[];
    Frame F; F.lds = (LAS unsigned char*)lds_raw; F.tid = threadIdx.x; F.lane = F.tid & 63; F.wave = __builtin_amdgcn_readfirstlane(F.tid >> 6); F.G = gridDim.x; F.bx = blockIdx.x;
    F.ws = a.ws; F.ctl = (gu32*)(a.ws + WS_CTL);
    volatile LAS unsigned* MISC = (volatile LAS unsigned*)(F.lds + MISC_OFF);
    if (F.tid < 32) MISC[F.tid] = 0u;
    __syncthreads();
    XcdBarrier bar = xcd_barrier_post((unsigned*)(F.ctl + CW_BAR) + a.li * 4096, MISC + 8);
    unsigned char* const ws = a.ws;
#define WIN ((bf16*)(ws + WS_WIN))
#define WATT ((bf16*)(ws + WS_WATT))
#define WEFF ((bf16*)(ws + WS_WEFF))
#define WOUT ((bf16*)(ws + WS_WOUT))
#define CS ((float*)(ws + WS_CS))
#define WUP ((fp8*)(ws + WS_WUP))
#define WDN ((fp8*)(ws + WS_WDN))
#define H ((bf16*)(ws + WS_H))
#define H2 ((fp8*)(ws + WS_H2))
#define Q ((bf16*)(ws + WS_Q))
#define KB ((bf16*)(ws + WS_KB))
#define VB ((bf16*)(ws + WS_VB))
#define U ((bf16*)(ws + WS_U))
#define PO ((bf16*)(ws + WS_PO))
#define GA ((bf16*)(ws + WS_GA))
#define GP ((bf16*)(ws + WS_GP))
#define AO ((bf16*)(ws + WS_AO))
#define T1 ((bf16*)(ws + WS_T1))
#define MG ((bf16*)(ws + WS_MG))
#define X1 ((bf16*)(ws + WS_X1))
#define STOK ((int*)(ws + WS_STOK))
#define TOKE ((int*)(ws + WS_TOKE))
#define TOKG ((float*)(ws + WS_TOKG))
#define ACT ((fp8*)(ws + WS_ACT))
#define YS ((fp8*)(ws + WS_YS))
    const int lo = a.ph_lo, hi = a.ph_hi;
#define IN(k) (lo <= (k) && (k) < hi)
#define SEAM(k) do { if (IN(k) && IN((k) + 1)) xcd_barrier(bar); } while (0)
#define FRESH() do { int t_ = (int)threadIdx.x; asm volatile("" : "+v"(t_)); F.tid = t_; F.lane = t_ & 63; F.wave = __builtin_amdgcn_readfirstlane(t_ >> 6); } while (0)

    if (IN(0)) { FRESH(); p0b_weights(F, a, F.bx, F.G); p0_prologue(F, a); }
    SEAM(0);
    if (IN(1)) { FRESH();
        pg8::DenseOrder S; S.init(T, INW, F.G, F.bx);
        pg8::EpiInProj E{a.in[4], CS, Q, KB, VB, U, GA, GP};
        pg8::gemm_phase<pg8::EpiInProj, pg8::DenseOrder, 1024, false, false>(F.lds, H, WIN, 0, S, E, nullptr);
        if (F.G == 256 && F.bx >= 192) {
            const int r = UP_DEFER0 + (F.bx - 192) * 8 + F.wave, e = r >> 7, q = r & 127, kb = q >> 4, nb = q & 15;
            conv_item8<2>(a.in[14] + (size_t)e * 1024 * 2048, 2048, (fp8*)(ws + WS_WUP) + (size_t)e * 2048 * 1024, 1024, kb * 128, up_src_col(nb * 128), nb * 128, F.lane, F.lds + F.wave * 16384);
        }
    }
    SEAM(1);
    if (IN(2)) { FRESH();
        for (int u = F.bx; u < 256; u += F.G) attn_unit(F, u, Q, KB, VB, a.in[5], AO, U, PO, u, a.in[16], WDN);
        __syncthreads();
    }
    SEAM(2);
    if (IN(3)) { FRESH();
        pg8::DenseOrder S; S.init(T, 1024, F.G, F.bx);
        { pg8::EpiGateA E{GA, T1}; pg8::gemm_phase<pg8::EpiGateA, pg8::DenseOrder, 1024, false, false>(F.lds, AO, WATT, 0, S, E, nullptr); }
        VM_WAIT(); __syncthreads();
        { pg8::EpiMerge E{GP, T1, MG}; pg8::gemm_phase<pg8::EpiMerge, pg8::DenseOrder, 512, false, false>(F.lds, PO, WEFF, 0, S, E, nullptr); }
    }
    SEAM(3);
    if (IN(4)) { FRESH();
        pg8::DenseOrder S; S.init(T, 1024, F.G, F.bx);
        pg8::EpiX1 E{X1};
        pg8::gemm_phase<pg8::EpiX1, pg8::DenseOrder, 1024, false, false>(F.lds, MG, WOUT, 0, S, E, nullptr);
    }
    SEAM(4);
    if (IN(5)) { FRESH();
        for (int ch = F.bx; ch < T / 64; ch += F.G) router_chunk(F, ch, a.in[0], X1, a.in[11], (const bf16*)(ws + WS_WRH), (const bf16*)(ws + WS_WRL), a.in[13], H2, F.ctl + CW_CNT, STOK, TOKE, TOKG);
        __syncthreads();
    }
    SEAM(5);
    if (IN(6)) { FRESH();
        moe_tables(F);
        const LAS int* tb = (const LAS int*)(F.lds + TBL_OFF);
        pg8::EpiSwiglu E{a.in[15], ACT};
        pg8::MoeOrderX<true> S{tb + 128, tb + 192, 3, F.G, F.bx};
        pg8::gemm_phase<pg8::EpiSwiglu, pg8::MoeOrderX<true>, 1024, true, true>(F.lds, H2, WUP, (size_t)2048 * 1024, S, E, STOK);
        VM_WAIT(); __syncthreads();
        if (F.tid == 0) {
            __builtin_amdgcn_fence(__ATOMIC_RELEASE, "agent"); VM_WAIT();
            for (int v = F.bx; v < 256; v += F.G) { const int e = (v & 7) + 8 * ((v >> 3) >> 3); (void)xb_add((unsigned*)(F.ctl + CW_DONE + 64 * e), 1u); }
        }
    }
    if (IN(7)) { FRESH();
        moe_tables(F);
        const LAS int* tb = (const LAS int*)(F.lds + TBL_OFF);
        const unsigned mx = (unsigned)__builtin_amdgcn_readfirstlane(tb[224]), mh = (unsigned)__builtin_amdgcn_readfirstlane(tb[225]);
        pg8::EpiDown E{a.in[17], YS};
        {   pg8::MoeOrderOwn S{tb + 128, tb + 192, mx, mh, F.G, F.bx};
            if (F.tid == 0) { pg8::GUnit u; unsigned seen = 0u;
                for (int i = 0; S.next(i, u); ++i) { if ((seen >> u.e) & 1u) continue; seen |= 1u << u.e; unsigned* p = (unsigned*)(F.ctl + CW_DONE + 64 * u.e); XB_SPIN(xb_ld(p) < 8u, bar.bar); }
                __builtin_amdgcn_fence(__ATOMIC_ACQUIRE, "agent"); VM_WAIT(); }
            __syncthreads();
            pg8::gemm_phase<pg8::EpiDown, pg8::MoeOrderOwn, 1024, false, true>(F.lds, ACT, WDN, (size_t)1024 * 1024, S, E, nullptr);
        }
        {   pg8::MoeOrderSteal S{tb + 128, tb + 192, mx, mh, F.G, F.bx};
            pg8::GUnit u0;
            if (S.next(0, u0)) {
                VM_WAIT(); __syncthreads();
                if (F.tid == 0) { pg8::GUnit u;
                    for (int i = 0; S.next(i, u); ++i) { unsigned* p = (unsigned*)(F.ctl + CW_DONE + 64 * u.e); XB_SPIN(xb_ld(p) < 8u, bar.bar); }
                    __builtin_amdgcn_fence(__ATOMIC_ACQUIRE, "agent"); VM_WAIT(); }
                __syncthreads();
                pg8::gemm_phase<pg8::EpiDown, pg8::MoeOrderSteal, 1024, false, true>(F.lds, ACT, WDN, (size_t)1024 * 1024, S, E, nullptr);
            }
        }
    }
    SEAM(7);
    if (IN(8)) { FRESH();
        moe_tables(F);
        combine_rows(F, a.in[0], X1, YS, TOKE, TOKG, a.in[18], a.out);
    }
#undef IN
#undef SEAM
#undef WIN
#undef WATT
#undef WEFF
#undef WOUT
#undef CS
#undef WUP
#undef WDN
#undef H
#undef H2
#undef Q
#undef KB
#undef VB
#undef U
#undef PO
#undef GA
#undef GP
#undef AO
#undef T1
#undef MG
#undef X1
#undef STOK
#undef TOKE
#undef TOKG
#undef ACT
#undef YS
}

#ifndef REPEAT_MASK
#define REPEAT_MASK 0
#endif
#ifndef FAST_MASK
#define FAST_MASK 0x1ff
#endif
#ifndef ONE_LAUNCH
#define ONE_LAUNCH 1
#endif
extern "C" void kernel_launch(void* const* d_in, const int* in_sizes, int n_in, void* d_out, int out_size, void* d_ws, size_t ws_size, hipStream_t stream) {
    if (n_in != 19 || out_size != T * D || ws_size < WS_END) { fprintf(stderr, "kernel_launch: unexpected shapes / workspace (n_in %d, out %d, ws %zu)\n", n_in, out_size, ws_size); return; }
    const float* x = (const float*)d_in[0]; const int* positions = (const int*)d_in[1]; const float* norm1_g = (const float*)d_in[2];
    const float* w_in = (const float*)d_in[3]; const float* b_in = (const float*)d_in[4]; const float* sinks = (const float*)d_in[5];
    const float* w_attn = (const float*)d_in[6]; const float* pool_w = (const float*)d_in[7]; const float* pool_scale = (const float*)d_in[8];
    const float* w_pool = (const float*)d_in[9]; const float* w_out = (const float*)d_in[10]; const float* norm2_g = (const float*)d_in[11];
    const float* w_router = (const float*)d_in[12]; const float* b_router = (const float*)d_in[13]; const float* w_up = (const float*)d_in[14];
    const float* b_up = (const float*)d_in[15]; const float* w_down = (const float*)d_in[16]; const float* b_down = (const float*)d_in[17];
    const float* normf_g = (const float*)d_in[18];
    unsigned char* ws = (unsigned char*)d_ws; float* out = (float*)d_out;
    unsigned* ctl = (unsigned*)(ws + WS_CTL);
    bf16* WIN = (bf16*)(ws + WS_WIN); bf16* WATT = (bf16*)(ws + WS_WATT); bf16* WEFF = (bf16*)(ws + WS_WEFF); bf16* WOUT = (bf16*)(ws + WS_WOUT);
    float* CS = (float*)(ws + WS_CS); fp8* WUP = (fp8*)(ws + WS_WUP); fp8* WDN = (fp8*)(ws + WS_WDN);
    bf16* H = (bf16*)(ws + WS_H); bf16* Q = (bf16*)(ws + WS_Q); bf16* KB = (bf16*)(ws + WS_KB); bf16* VB = (bf16*)(ws + WS_VB);
    bf16* U = (bf16*)(ws + WS_U); bf16* PO = (bf16*)(ws + WS_PO); bf16* GA = (bf16*)(ws + WS_GA); bf16* GP = (bf16*)(ws + WS_GP);
    bf16* AO = (bf16*)(ws + WS_AO); bf16* MG = (bf16*)(ws + WS_MG); bf16* X1 = (bf16*)(ws + WS_X1);
    int* STOK = (int*)(ws + WS_STOK); int* TOKE = (int*)(ws + WS_TOKE); float* TOKG = (float*)(ws + WS_TOKG);
    fp8* ACT = (fp8*)(ws + WS_ACT); fp8* YS = (fp8*)(ws + WS_YS); float* TMP = (float*)(ws + WS_TMP); float* TMP2 = TMP + (size_t)T * D;
    unsigned* counts = ctl + CW_CNT;

    static int grid = 0;
    if (grid == 0) {
        int dev = 0, cus = 0;
        if (hipGetDevice(&dev) != hipSuccess || hipDeviceGetAttribute(&cus, hipDeviceAttributeMultiprocessorCount, dev) != hipSuccess) { fprintf(stderr, "kernel_launch: device query failed\n"); grid = -1; return; }
        if (hipFuncSetAttribute((const void*)fwd, hipFuncAttributeMaxDynamicSharedMemorySize, LDS_BYTES) != hipSuccess) { fprintf(stderr, "kernel_launch: hipFuncSetAttribute failed\n"); grid = -1; return; }
        int per_cu = 0;
        if (hipOccupancyMaxActiveBlocksPerMultiprocessor(&per_cu, (const void*)fwd, NTHR, LDS_BYTES) != hipSuccess || per_cu < 1) fprintf(stderr, "kernel_launch: occupancy query says %d blocks per CU\n", per_cu);
        (void)hipGetLastError();
        grid = cus > 256 ? 256 : cus;
    }
    if (grid < 0) return;
    (void)hipMemsetAsync(ws + WS_CTL, 0, CTL_ZERO_BYTES, stream);
    Args a{};
    for (int i = 0; i < 19; ++i) a.in[i] = (const float*)d_in[i];
    a.out = out; a.ws = ws; a.pad = 0;
    int li = 0;
#define RUN_FAST(lo_, hi_) do { a.ph_lo = (lo_); a.ph_hi = (hi_); a.li = li < 3 ? li : 2; ++li; for (int rep_ = 0; rep_ < ((((hi_) - (lo_)) == 1 && ((REPEAT_MASK >> (lo_)) & 1) && (lo_) != 5) ? 2 : 1); ++rep_) hipLaunchKernelGGL(fwd, dim3(grid), dim3(NTHR), LDS_BYTES, stream, a); } while (0)
#if ONE_LAUNCH
    RUN_FAST(0, N_PHASES);
#else
    if (FAST_MASK & 1) RUN_FAST(0, 1); else {
        n_transpose<<<2048, 256, 0, stream>>>(w_in, 1024, INW, WIN, INW, 0);
        n_transpose<<<1024, 256, 0, stream>>>(w_attn, 1024, 1024, WATT, 1024, 0);
        n_transpose<<<1024, 256, 0, stream>>>(w_out, 1024, 1024, WOUT, 1024, 0);
        for (int e = 0; e < NE; ++e) {
            n_transpose8<<<2048, 256, 0, stream>>>(w_up + (size_t)e * 1024 * 2048, 1024, 2048, WUP + (size_t)e * 2048 * 1024, 2048, 1);
            n_transpose8<<<1024, 256, 0, stream>>>(w_down + (size_t)e * 1024 * 1024, 1024, 1024, WDN + (size_t)e * 1024 * 1024, 1024, 0);
        }
        n_weff<<<(1024 * 512) / 256, 256, 0, stream>>>(pool_w, pool_scale, w_pool, WEFF);
        n_rope_table<<<(T * 8) / 256, 256, 0, stream>>>(positions, CS);
        n_wr_split<<<128, 256, 0, stream>>>(w_router, (bf16*)(ws + WS_WRH), (bf16*)(ws + WS_WRL));
        n_rms_bf16<<<T / 4, 256, 0, stream>>>(x, norm1_g, H);
    }
    if (FAST_MASK & 2) RUN_FAST(1, 2); else {
        n_gemm<<<dim3(INW / 64, T / 64), 256, 0, stream>>>(H, WIN, TMP, T, INW, 1024);
        n_post_inproj<<<(unsigned)(((size_t)T * INW + 255) / 256), 256, 0, stream>>>(TMP, b_in, CS, Q, KB, VB, U, GA, GP);
    }
    if (FAST_MASK & 4) RUN_FAST(2, 3); else {
        if (FAST_MASK & 1) for (int e = 0; e < NE; ++e) n_transpose8<<<1024, 256, 0, stream>>>(w_down + (size_t)e * 1024 * 1024, 1024, 1024, WDN + (size_t)e * 1024 * 1024, 1024, 0);
        n_attn<<<(T * NQH) / 256, 256, 0, stream>>>(Q, KB, VB, sinks, AO);
        n_pool<<<(T * PW) / 256, 256, 0, stream>>>(U, PO);
    }
    if (FAST_MASK & 8) RUN_FAST(3, 4); else {
        n_gemm<<<dim3(1024 / 64, T / 64), 256, 0, stream>>>(AO, WATT, TMP, T, 1024, 1024);
        n_gemm<<<dim3(1024 / 64, T / 64), 256, 0, stream>>>(PO, WEFF, TMP2, T, 1024, 512);
        n_merge<<<(T * D) / 256, 256, 0, stream>>>(TMP, TMP2, GA, GP, MG);
    }
    if (FAST_MASK & 16) RUN_FAST(4, 5); else {
        n_gemm<<<dim3(1024 / 64, T / 64), 256, 0, stream>>>(MG, WOUT, TMP, T, 1024, 1024);
        n_x1<<<(T * D) / 256, 256, 0, stream>>>(x, TMP, X1);
    }
    if (FAST_MASK & 32) { if (REPEAT_MASK & 32) { a.ph_lo = 5; a.ph_hi = 6; a.li = 2; hipLaunchKernelGGL(fwd, dim3(grid), dim3(NTHR), LDS_BYTES, stream, a); (void)hipMemsetAsync(counts, 0, 128, stream); } RUN_FAST(5, 6); } else n_router<<<T / 4, 256, 0, stream>>>(x, X1, norm2_g, w_router, b_router, (fp8*)(ws + WS_H2), counts, STOK, TOKE, TOKG);
    if (FAST_MASK & 64) RUN_FAST(6, 7); else { n_moe_up<<<dim3(1024 / 64, T / 64, NE), 256, 0, stream>>>((const fp8*)(ws + WS_H2), STOK, counts, WUP, b_up, ACT); (void)hipMemsetAsync(ctl + CW_DONE, 8, 32 * 256, stream); }
    if (FAST_MASK & 128) RUN_FAST(7, 8); else n_moe_down<<<dim3(1024 / 64, T / 64, NE), 256, 0, stream>>>(ACT, counts, WDN, b_down, YS);
    if (FAST_MASK & 256) RUN_FAST(8, 9); else n_combine<<<T / 4, 256, 0, stream>>>(x, X1, YS, counts, TOKE, TOKG, normf_g, out);
#endif
    (void)in_sizes; (void)sinks; (void)positions; (void)norm1_g; (void)norm2_g; (void)w_router; (void)b_router; (void)b_up; (void)b_down; (void)normf_g; (void)b_in; (void)pool_w; (void)pool_scale; (void)w_pool;
    (void)w_in; (void)w_attn; (void)w_out; (void)w_up; (void)w_down; (void)x; (void)WIN; (void)WATT; (void)WEFF; (void)WOUT; (void)CS; (void)WUP; (void)WDN; (void)H; (void)Q; (void)KB; (void)VB; (void)U; (void)PO; (void)GA; (void)GP;
    (void)AO; (void)MG; (void)X1; (void)STOK; (void)TOKE; (void)TOKG; (void)ACT; (void)YS; (void)TMP; (void)TMP2; (void)counts;
}
```

```cpp
#include <hip/hip_runtime.h>
#include <cstdio>
#include <cstdint>

constexpr int BATCH = 4, SEQ = 4096, T = BATCH * SEQ, D = 1024;
constexpr int NQH = 16, NKVH = 2, HD = 64, WINDOW = 128;
constexpr int INW = 3840, O_K = 1024, O_V = 1152, O_P = 1280, O_GA = 1792, O_GP = 2816, PW = 512;
constexpr int NE = 32, TOPK = 4, DFF = 1024, CAP = T;
constexpr int NSLOT = T * TOPK + NE * 256;
constexpr float RMS_EPS = 1e-5f;

typedef unsigned short bf16;
typedef unsigned char fp8;
constexpr float W8_SCALE = 32.0f, W8_INV = 1.0f / 32.0f;
typedef float f32x4 __attribute__((ext_vector_type(4)));
typedef unsigned u32x4 __attribute__((ext_vector_type(4)));
typedef unsigned u32x2 __attribute__((ext_vector_type(2)));

constexpr size_t MiB = 1u << 20;
constexpr size_t WS_CTL = 0, CTL_ZERO_BYTES = 65536;
constexpr size_t WS_WIN = 2 * MiB;
constexpr size_t WS_WATT = 10 * MiB;
constexpr size_t WS_WEFF = 12 * MiB;
constexpr size_t WS_WOUT = 13 * MiB;
constexpr size_t WS_CS = 15 * MiB;
constexpr size_t WS_WUP = 16 * MiB;
constexpr size_t WS_WDN = 144 * MiB;
constexpr size_t WS_H = 208 * MiB;
constexpr size_t WS_Q = 240 * MiB;
constexpr size_t WS_KB = 272 * MiB;
constexpr size_t WS_VB = 276 * MiB;
constexpr size_t WS_U = 280 * MiB;
constexpr size_t WS_PO = 296 * MiB;
constexpr size_t WS_GA = 312 * MiB;
constexpr size_t WS_GP = 344 * MiB;
constexpr size_t WS_AO = 376 * MiB;
constexpr size_t WS_T1 = 408 * MiB;
constexpr size_t WS_MG = 440 * MiB;
constexpr size_t WS_X1 = 472 * MiB;
constexpr size_t WS_STOK = 536 * MiB;
constexpr size_t WS_TOKE = 538 * MiB;
constexpr size_t WS_TOKG = 539 * MiB;
constexpr size_t WS_WRH = 538 * MiB + 512 * 1024, WS_WRL = WS_WRH + 64 * 1024;
constexpr size_t WS_ACT = 540 * MiB;
constexpr size_t WS_YS = 684 * MiB;
constexpr size_t WS_H2 = 828 * MiB;
constexpr size_t WS_END = 844 * MiB;
constexpr size_t WS_TMP = WS_ACT;
constexpr int CW_TMO = 0, CW_CODE = 1, CW_CNT = 64, CW_DONE = 128  , CW_BAR = 4096;

__device__ __forceinline__ float bf2f(bf16 v) { return __uint_as_float((unsigned)v << 16); }
__device__ __forceinline__ bf16 f2bf(float f) { unsigned u = __float_as_uint(f); return (bf16)((u + 0x7fffu + ((u >> 16) & 1u)) >> 16); }
__device__ __forceinline__ float sigmoidf_(float v) { return 1.0f / (1.0f + __expf(-v)); }
__device__ __forceinline__ float wave_sum(float v) {
#pragma unroll
    for (int o = 1; o < 64; o <<= 1) v += __shfl_xor(v, o);
    return v;
}
__device__ __forceinline__ float fp82f(fp8 v) { return __builtin_amdgcn_cvt_f32_fp8((int)v, 0); }
__device__ __forceinline__ fp8 f2fp8(float f) { return (fp8)(__builtin_amdgcn_cvt_pk_fp8_f32(f, f, 0, false) & 0xff); }
__device__ __forceinline__ int up_src_col(int np) { const int t = np >> 8, c = np & 255; return c < 128 ? 128 * t + c : 1024 + 128 * t + (c - 128); }

__global__ void __launch_bounds__(256) n_transpose(const float* W, int K, int N, bf16* WT, int NT, int upmap) {
    const size_t total = (size_t)NT * K;
    for (size_t idx = (size_t)blockIdx.x * blockDim.x + threadIdx.x; idx < total; idx += (size_t)gridDim.x * blockDim.x) {
        const int n = (int)(idx / K), k = (int)(idx % K); const int sc = upmap ? up_src_col(n) : n;
        WT[idx] = f2bf(W[(size_t)k * N + sc]);
    }
}
__global__ void __launch_bounds__(256) n_transpose8(const float* W, int K, int N, fp8* WT, int NT, int upmap) {
    const size_t total = (size_t)NT * K;
    for (size_t idx = (size_t)blockIdx.x * blockDim.x + threadIdx.x; idx < total; idx += (size_t)gridDim.x * blockDim.x) {
        const int n = (int)(idx / K), k = (int)(idx % K); const int sc = upmap ? up_src_col(n) : n;
        WT[idx] = f2fp8(W[(size_t)k * N + sc] * W8_SCALE);
    }
}
__global__ void __launch_bounds__(256) n_weff(const float* pw, const float* ps, const float* Wpb, bf16* WeffT) {
    const int idx = blockIdx.x * blockDim.x + threadIdx.x; if (idx >= 1024 * 512) return;
    const int n = idx / 512, k = idx % 512, g = k / 128, kk = k % 128; float a = 0.f;
    for (int c = 0; c < 128; ++c) a += pw[(g * 128 + kk) * 128 + c] * ps[g * 128 + c] * Wpb[(size_t)(g * 128 + c) * 1024 + n];
    WeffT[idx] = f2bf(a);
}
__global__ void __launch_bounds__(256) n_wr_split(const float* wr, bf16* WRH, bf16* WRL) {
    const int idx = blockIdx.x * blockDim.x + threadIdx.x; if (idx >= 32 * 1024) return;
    const int e = idx >> 10, k = idx & 1023; const float w = wr[k * 32 + e]; const bf16 h = f2bf(w); WRH[idx] = h; WRL[idx] = f2bf(w - bf2f(h));
}
__global__ void __launch_bounds__(256) n_rope_table(const int* pos, float* cs) {
    const int idx = blockIdx.x * blockDim.x + threadIdx.x; if (idx >= T * 8) return;
    const int t = idx >> 3, i = idx & 7; const float inv = powf(500000.0f, -(float)i * 0.125f); const float a = (float)pos[t] * inv;
    cs[t * 16 + i] = cosf(a); cs[t * 16 + 8 + i] = sinf(a);
}
__global__ void __launch_bounds__(256) n_rms_bf16(const float* x, const float* g, bf16* out) {
    const int row = blockIdx.x * 4 + (threadIdx.x >> 6), lane = threadIdx.x & 63;
    const f32x4* xr = (const f32x4*)(x + (size_t)row * D) + lane; f32x4 v[4]; float s = 0.f;
#pragma unroll
    for (int j = 0; j < 4; ++j) { v[j] = xr[64 * j]; s += v[j].x * v[j].x + v[j].y * v[j].y + v[j].z * v[j].z + v[j].w * v[j].w; }
    const float rstd = rsqrtf(wave_sum(s) * (1.f / D) + RMS_EPS);
#pragma unroll
    for (int j = 0; j < 4; ++j) { const f32x4 gg = ((const f32x4*)g)[lane + 64 * j]; bf16* o = out + (size_t)row * D + 4 * lane + 256 * j;
        o[0] = f2bf(v[j].x * rstd * gg.x); o[1] = f2bf(v[j].y * rstd * gg.y); o[2] = f2bf(v[j].z * rstd * gg.z); o[3] = f2bf(v[j].w * rstd * gg.w); }
}
__global__ void __launch_bounds__(256) n_gemm(const bf16* A, const bf16* Bt, float* C, int M, int N, int K) {
    __shared__ float As[16][65], Bs[16][65];
    const int tx = threadIdx.x & 15, ty = threadIdx.x >> 4, m0 = blockIdx.y * 64, n0 = blockIdx.x * 64;
    float acc[4][4];
#pragma unroll
    for (int i = 0; i < 4; ++i)
#pragma unroll
        for (int j = 0; j < 4; ++j) acc[i][j] = 0.f;
    for (int k0 = 0; k0 < K; k0 += 16) {
        for (int i = threadIdx.x; i < 1024; i += 256) { const int r = i >> 4, c = i & 15;
            As[c][r] = bf2f(A[(size_t)(m0 + r) * K + k0 + c]); Bs[c][r] = bf2f(Bt[(size_t)(n0 + r) * K + k0 + c]); }
        __syncthreads();
#pragma unroll
        for (int kk = 0; kk < 16; ++kk) { float a[4], b[4];
#pragma unroll
            for (int i = 0; i < 4; ++i) { a[i] = As[kk][ty * 4 + i]; b[i] = Bs[kk][tx * 4 + i]; }
#pragma unroll
            for (int i = 0; i < 4; ++i)
#pragma unroll
                for (int j = 0; j < 4; ++j) acc[i][j] += a[i] * b[j]; }
        __syncthreads();
    }
#pragma unroll
    for (int i = 0; i < 4; ++i)
#pragma unroll
        for (int j = 0; j < 4; ++j) C[(size_t)(m0 + ty * 4 + i) * N + n0 + tx * 4 + j] = acc[i][j];
}
__global__ void __launch_bounds__(256) n_post_inproj(const float* P, const float* bias, const float* cs, bf16* Q, bf16* KB, bf16* VB, bf16* U, bf16* GA, bf16* GP) {
    const size_t idx = (size_t)blockIdx.x * blockDim.x + threadIdx.x; if (idx >= (size_t)T * INW) return;
    const int t = (int)(idx / INW), c = (int)(idx % INW); float v = P[idx] + bias[c];
    if (c < O_V) {
        const int d = c & 63;
        if (d < 16) { const int i = d & 7; const int pc = (d < 8) ? c + 8 : c - 8; const float o = P[(size_t)t * INW + pc] + bias[pc];
            const float co = cs[t * 16 + i], si = cs[t * 16 + 8 + i]; v = (d < 8) ? v * co - o * si : v * co + o * si; }
        if (c < O_K) Q[(size_t)t * 1024 + c] = f2bf(v); else KB[(size_t)t * 128 + (c - O_K)] = f2bf(v);
    } else if (c < O_P) VB[(size_t)t * 128 + (c - O_V)] = f2bf(v);
    else if (c < O_GA) U[(size_t)t * 512 + (c - O_P)] = f2bf(v);
    else if (c < O_GP) GA[(size_t)t * 1024 + (c - O_GA)] = f2bf(v);
    else GP[(size_t)t * 1024 + (c - O_GP)] = f2bf(v);
}
__global__ void __launch_bounds__(256) n_attn(const bf16* Q, const bf16* KB, const bf16* VB, const float* sinks, bf16* AO) {
    const int idx = blockIdx.x * blockDim.x + threadIdx.x; if (idx >= T * NQH) return;
    const int t = idx / NQH, hq = idx % NQH, hk = hq / 8, pos = t % SEQ, b0 = t - pos;
    float q[64];
#pragma unroll
    for (int d = 0; d < 64; ++d) q[d] = bf2f(Q[(size_t)t * 1024 + hq * 64 + d]);
    const int lo = pos - (WINDOW - 1) > 0 ? pos - (WINDOW - 1) : 0;
    const float sink = sinks[hq]; float m = sink;
    for (int s = lo; s <= pos; ++s) { float a = 0.f;
#pragma unroll
        for (int d = 0; d < 64; ++d) a += q[d] * bf2f(KB[(size_t)(b0 + s) * 128 + hk * 64 + d]);
        a *= 0.125f; m = fmaxf(m, a); }
    float sum = __expf(sink - m); float o[64];
#pragma unroll
    for (int d = 0; d < 64; ++d) o[d] = 0.f;
    for (int s = lo; s <= pos; ++s) { float a = 0.f;
#pragma unroll
        for (int d = 0; d < 64; ++d) a += q[d] * bf2f(KB[(size_t)(b0 + s) * 128 + hk * 64 + d]);
        const float p = __expf(a * 0.125f - m); sum += p; const float pb = bf2f(f2bf(p));
#pragma unroll
        for (int d = 0; d < 64; ++d) o[d] += pb * bf2f(VB[(size_t)(b0 + s) * 128 + hk * 64 + d]); }
    const float inv = 1.f / sum;
#pragma unroll
    for (int d = 0; d < 64; ++d) AO[(size_t)t * 1024 + hq * 64 + d] = f2bf(o[d] * inv);
}
__global__ void __launch_bounds__(256) n_pool(const bf16* U, bf16* PO) {
    const int idx = blockIdx.x * blockDim.x + threadIdx.x; if (idx >= T * PW) return;
    const int t = idx / PW, c = idx % PW, g = c / 128, w = 2 << g, pos = t % SEQ; const int cnt = pos + 1 < w ? pos + 1 : w; float s = 0.f;
    for (int j = 0; j < cnt; ++j) s += bf2f(U[(size_t)(t - j) * PW + c]);
    PO[idx] = f2bf(s / (float)cnt - bf2f(U[idx]));
}
__global__ void __launch_bounds__(256) n_merge(const float* C1, const float* C2, const bf16* GA, const bf16* GP, bf16* MG) {
    const size_t idx = (size_t)blockIdx.x * blockDim.x + threadIdx.x; if (idx >= (size_t)T * D) return;
    const float t1 = bf2f(f2bf(sigmoidf_(bf2f(GA[idx])) * C1[idx]));
    MG[idx] = f2bf(t1 + sigmoidf_(bf2f(GP[idx])) * C2[idx]);
}
__global__ void __launch_bounds__(256) n_x1(const float* x, const float* C, bf16* X1) {
    const size_t idx = (size_t)blockIdx.x * blockDim.x + threadIdx.x; if (idx >= (size_t)T * D) return;
    X1[idx] = f2bf(C[idx]); (void)x;
}
__global__ void __launch_bounds__(256) n_router(const float* x, const bf16* X1, const float* g2, const float* wr, const float* br, fp8* H2, unsigned* counts, int* stok, int* toke, float* tokg) {
    const int t = blockIdx.x * 4 + (threadIdx.x >> 6), lane = threadIdx.x & 63;
    const f32x4* xr = (const f32x4*)(x + (size_t)t * D) + lane; const bf16* dr = X1 + (size_t)t * D + 4 * lane; f32x4 v[4]; float s = 0.f;
#pragma unroll
    for (int j = 0; j < 4; ++j) { v[j] = xr[64 * j]; v[j].x += bf2f(dr[256 * j]); v[j].y += bf2f(dr[256 * j + 1]); v[j].z += bf2f(dr[256 * j + 2]); v[j].w += bf2f(dr[256 * j + 3]); s += v[j].x * v[j].x + v[j].y * v[j].y + v[j].z * v[j].z + v[j].w * v[j].w; }
    const float rstd = rsqrtf(wave_sum(s) * (1.f / D) + RMS_EPS);
    float h[16];
#pragma unroll
    for (int j = 0; j < 4; ++j) { const f32x4 gg = ((const f32x4*)g2)[lane + 64 * j];
        h[4 * j + 0] = v[j].x * rstd * gg.x; h[4 * j + 1] = v[j].y * rstd * gg.y; h[4 * j + 2] = v[j].z * rstd * gg.z; h[4 * j + 3] = v[j].w * rstd * gg.w;
        fp8* o = H2 + (size_t)t * D + 4 * lane + 256 * j;
#pragma unroll
        for (int q = 0; q < 4; ++q) o[q] = f2fp8(h[4 * j + q]); }
    float lg[32];
#pragma unroll
    for (int e = 0; e < 32; ++e) { float a = 0.f;
#pragma unroll
        for (int j = 0; j < 4; ++j)
#pragma unroll
            for (int q = 0; q < 4; ++q) a += h[4 * j + q] * wr[(size_t)(4 * lane + 256 * j + q) * 32 + e];
        lg[e] = wave_sum(a) + br[e]; }
    int be[4]; float bv[4]; unsigned used = 0u;
#pragma unroll
    for (int k = 0; k < 4; ++k) { float best = -3.0e38f; int bi = 0;
#pragma unroll
        for (int e = 0; e < 32; ++e) { const bool ok = !((used >> e) & 1u) && lg[e] > best; best = ok ? lg[e] : best; bi = ok ? e : bi; }
        be[k] = bi; bv[k] = best; used |= 1u << bi; }
    float ex[4], se = 0.f;
#pragma unroll
    for (int k = 0; k < 4; ++k) { ex[k] = __expf(bv[k] - bv[0]); se += ex[k]; }
    if (lane == 0) {
#pragma unroll
        for (int k = 0; k < 4; ++k) { const unsigned pos = atomicAdd(&counts[be[k]], 1u);
            stok[be[k] * CAP + pos] = t; toke[t * 4 + k] = be[k] | (int)(pos << 8); tokg[t * 4 + k] = ex[k] / se; }
    }
}
__device__ __forceinline__ int moe_rowoff(const unsigned* counts, int e) { int o = 0; for (int i = 0; i < e; ++i) o += (int)((counts[i] + 255u) >> 8) << 8; return o; }
__global__ void __launch_bounds__(256) n_moe_up(const fp8* H2, const int* stok, const unsigned* counts, const fp8* WupT, const float* bup, fp8* ACT) {
    const int e = blockIdx.z, cnt = (int)counts[e], m0 = blockIdx.y * 64, n0 = blockIdx.x * 64; if (m0 >= cnt) return;
    __shared__ float As[16][65], Bg[16][65], Bl[16][65]; __shared__ int rowtok[64];
    const int tx = threadIdx.x & 15, ty = threadIdx.x >> 4; const int roff = moe_rowoff(counts, e);
    if (threadIdx.x < 64) rowtok[threadIdx.x] = (m0 + (int)threadIdx.x < cnt) ? stok[e * CAP + m0 + threadIdx.x] : 0;
    __syncthreads();
    float ag[4][4], al[4][4];
#pragma unroll
    for (int i = 0; i < 4; ++i)
#pragma unroll
        for (int j = 0; j < 4; ++j) { ag[i][j] = 0.f; al[i][j] = 0.f; }
    const fp8* W = WupT + (size_t)e * 2048 * 1024;
    for (int k0 = 0; k0 < 1024; k0 += 16) {
        for (int i = threadIdx.x; i < 1024; i += 256) { const int r = i >> 4, c = i & 15; const int j = n0 + r, ng = (j >> 7) * 256 + (j & 127);
            As[c][r] = fp82f(H2[(size_t)rowtok[r] * 1024 + k0 + c]); Bg[c][r] = fp82f(W[(size_t)ng * 1024 + k0 + c]) * W8_INV; Bl[c][r] = fp82f(W[(size_t)(ng + 128) * 1024 + k0 + c]) * W8_INV; }
        __syncthreads();
#pragma unroll
        for (int kk = 0; kk < 16; ++kk) { float a[4], g[4], l[4];
#pragma unroll
            for (int i = 0; i < 4; ++i) { a[i] = As[kk][ty * 4 + i]; g[i] = Bg[kk][tx * 4 + i]; l[i] = Bl[kk][tx * 4 + i]; }
#pragma unroll
            for (int i = 0; i < 4; ++i)
#pragma unroll
                for (int j = 0; j < 4; ++j) { ag[i][j] += a[i] * g[j]; al[i][j] += a[i] * l[j]; } }
        __syncthreads();
    }
#pragma unroll
    for (int i = 0; i < 4; ++i) { const int m = m0 + ty * 4 + i; if (m >= cnt) continue;
#pragma unroll
        for (int j = 0; j < 4; ++j) { const int c = n0 + tx * 4 + j; float gl = ag[i][j] + bup[e * 2048 + c], li = al[i][j] + bup[e * 2048 + 1024 + c];
            gl = fminf(gl, 7.f); li = fminf(fmaxf(li, -7.f), 7.f);
            ACT[(size_t)(roff + m) * 1024 + c] = f2fp8(gl * sigmoidf_(1.702f * gl) * (li + 1.f)); } }
}
__global__ void __launch_bounds__(256) n_moe_down(const fp8* ACT, const unsigned* counts, const fp8* WdnT, const float* bdn, fp8* YS) {
    const int e = blockIdx.z, cnt = (int)counts[e], m0 = blockIdx.y * 64, n0 = blockIdx.x * 64; if (m0 >= cnt) return;
    __shared__ float As[16][65], Bs[16][65];
    const int tx = threadIdx.x & 15, ty = threadIdx.x >> 4; const int roff = moe_rowoff(counts, e);
    float acc[4][4];
#pragma unroll
    for (int i = 0; i < 4; ++i)
#pragma unroll
        for (int j = 0; j < 4; ++j) acc[i][j] = 0.f;
    const fp8* W = WdnT + (size_t)e * 1024 * 1024;
    for (int k0 = 0; k0 < 1024; k0 += 16) {
        for (int i = threadIdx.x; i < 1024; i += 256) { const int r = i >> 4, c = i & 15; const int m = (m0 + r < cnt) ? m0 + r : m0;
            As[c][r] = fp82f(ACT[(size_t)(roff + m) * 1024 + k0 + c]); Bs[c][r] = fp82f(W[(size_t)(n0 + r) * 1024 + k0 + c]) * W8_INV; }
        __syncthreads();
#pragma unroll
        for (int kk = 0; kk < 16; ++kk) { float a[4], b[4];
#pragma unroll
            for (int i = 0; i < 4; ++i) { a[i] = As[kk][ty * 4 + i]; b[i] = Bs[kk][tx * 4 + i]; }
#pragma unroll
            for (int i = 0; i < 4; ++i)
#pragma unroll
                for (int j = 0; j < 4; ++j) acc[i][j] += a[i] * b[j]; }
        __syncthreads();
    }
#pragma unroll
    for (int i = 0; i < 4; ++i) { const int m = m0 + ty * 4 + i; if (m >= cnt) continue;
#pragma unroll
        for (int j = 0; j < 4; ++j) { const int c = n0 + tx * 4 + j; YS[(size_t)(roff + m) * 1024 + c] = f2fp8(acc[i][j] + bdn[e * 1024 + c]); } }
}
__global__ void __launch_bounds__(256) n_combine(const float* x, const bf16* X1, const fp8* YS, const unsigned* counts, const int* toke, const float* tokg, const float* gf, float* out) {
    const int t = blockIdx.x * 4 + (threadIdx.x >> 6), lane = threadIdx.x & 63;
    f32x4 v[4];
#pragma unroll
    for (int j = 0; j < 4; ++j) { v[j] = ((const f32x4*)(x + (size_t)t * D))[lane + 64 * j]; const bf16* dp = X1 + (size_t)t * D + 4 * lane + 256 * j; v[j].x += bf2f(dp[0]); v[j].y += bf2f(dp[1]); v[j].z += bf2f(dp[2]); v[j].w += bf2f(dp[3]); }
    for (int k = 0; k < 4; ++k) { const int te = toke[t * 4 + k], e = te & 255, pos = te >> 8; const float g = tokg[t * 4 + k];
        const fp8* y = YS + (size_t)(moe_rowoff(counts, e) + pos) * 1024;
#pragma unroll
        for (int j = 0; j < 4; ++j) { const fp8* p = y + 4 * lane + 256 * j; v[j].x += g * fp82f(p[0]); v[j].y += g * fp82f(p[1]); v[j].z += g * fp82f(p[2]); v[j].w += g * fp82f(p[3]); } }
    float s = 0.f;
#pragma unroll
    for (int j = 0; j < 4; ++j) s += v[j].x * v[j].x + v[j].y * v[j].y + v[j].z * v[j].z + v[j].w * v[j].w;
    const float rstd = rsqrtf(wave_sum(s) * (1.f / D) + RMS_EPS);
#pragma unroll
    for (int j = 0; j < 4; ++j) { const f32x4 gg = ((const f32x4*)gf)[lane + 64 * j]; f32x4 o = v[j] * rstd * gg; ((f32x4*)(out + (size_t)t * D))[lane + 64 * j] = o; }
}

#define GAS __attribute__((address_space(1)))
#define LAS __attribute__((address_space(3)))
typedef short bf16x8 __attribute__((ext_vector_type(8)));
typedef float f32x16 __attribute__((ext_vector_type(16)));
typedef short s16x4 __attribute__((ext_vector_type(4)));
typedef float f32x2 __attribute__((ext_vector_type(2)));
typedef GAS unsigned gu32;
#define RLX_AGENT __ATOMIC_RELAXED, __HIP_MEMORY_SCOPE_AGENT
#define LDS_WAIT() asm volatile("s_waitcnt lgkmcnt(0)" ::: "memory")
#define VM_WAIT() asm volatile("s_waitcnt vmcnt(0)" ::: "memory")

constexpr int NWAVES = 8, NTHR = 512;
constexpr int RING_BYTES = 131072;
constexpr int HB_STRIDE = 4112, HB_BYTES = 32 * HB_STRIDE;
constexpr int TBL_OFF = 132096;
constexpr int RT_LOGIT = 133120, RT_TOKE = RT_LOGIT + 8448, RT_TOKR = RT_TOKE + 1024, RT_TOKG = RT_TOKR + 1024, RT_HIST = RT_TOKG + 1024, RT_BASE = RT_HIST + 128;
constexpr int BIAS_OFF = 133120;
constexpr int MISC_OFF = 145408;
constexpr int LDS_BYTES = 147456;
static_assert(RT_BASE + 128 <= MISC_OFF && HB_BYTES <= TBL_OFF && MISC_OFF + 128 <= LDS_BYTES, "LDS map");

__device__ __forceinline__ unsigned cvt_pk_bf16(float lo, float hi) { unsigned r; asm volatile("v_cvt_pk_bf16_f32 %0, %1, %2" : "=v"(r) : "v"(lo), "v"(hi)); return r; }
__device__ __forceinline__ float bflo(unsigned w) { return __uint_as_float(w << 16); }
__device__ __forceinline__ float bfhi(unsigned w) { return __uint_as_float(w & 0xffff0000u); }
__device__ __forceinline__ float fast_sigmoid(float v) { return __builtin_amdgcn_rcpf(1.0f + __builtin_amdgcn_exp2f(-1.44269504089f * v)); }

#define XB_TMO      128
#define XB_XCNT(j)  (256  + 64 * (j))
#define XB_XSUB(j)  (1280 + 64 * (j))
#define XB_XGEN(j)  (2304 + 64 * (j))
#define XB_TOP      3328
#define XB_TOPGEN   3392
#define XCD_BAR_WORDS 3456
#define XB_SPIN_CAP (1u << 18)
__device__ __forceinline__ unsigned xb_ld(unsigned* p)              { return __hip_atomic_load(p, __ATOMIC_RELAXED, __HIP_MEMORY_SCOPE_AGENT); }
__device__ __forceinline__ unsigned xb_add(unsigned* p, unsigned v) { return __hip_atomic_fetch_add(p, v, __ATOMIC_RELAXED, __HIP_MEMORY_SCOPE_AGENT); }
__device__ __forceinline__ unsigned xb_xcc_id() { return (unsigned)__builtin_amdgcn_s_getreg((3 << 11) | 20) & 0xFu; }
#define XB_SPIN(cond, bar) do { unsigned _sp = 0; while (cond) { __builtin_amdgcn_s_sleep(1); \
    if ((++_sp & 255u) == 0u) { if (xb_ld(&(bar)[XB_TMO])) break; if (_sp > XB_SPIN_CAP) { atomicAdd(&(bar)[XB_TMO], 1u); break; } } } } while (0)
struct XcdBarrier { unsigned* bar; unsigned x; volatile LAS unsigned* st; };
__device__ __forceinline__ XcdBarrier xcd_barrier_post(unsigned* bar, volatile LAS unsigned* st) {
    XcdBarrier b; b.bar = bar; b.x = xb_xcc_id(); b.st = st;
    if (threadIdx.x == 0) (void)xb_add(&bar[XB_XCNT(b.x)], 1u);
    return b;
}
__device__ __forceinline__ void xcd_barrier_complete(unsigned* bar, unsigned x, unsigned& nloc, unsigned& nx) {
    const unsigned G = gridDim.x * gridDim.y * gridDim.z;
    unsigned sum, cnt, mine, sp = 0u;
    for (;;) {
        sum = 0u; cnt = 0u; mine = 0u;
#pragma unroll
        for (unsigned j = 0; j < 16; ++j) { const unsigned c = xb_ld(&bar[XB_XCNT(j)]); sum += c; cnt += (c > 0u) ? 1u : 0u; mine = (j == x) ? c : mine; }
        if (sum == G) break;
        __builtin_amdgcn_s_sleep(1);
        if ((++sp & 255u) == 0u) { if (xb_ld(&bar[XB_TMO])) break; if (sp > XB_SPIN_CAP) { atomicAdd(&bar[XB_TMO], 1u); break; } }
    }
    nloc = mine > 0u ? mine : 1u; nx = cnt > 0u ? cnt : 1u;
}
__device__ __forceinline__ void xcd_barrier(const XcdBarrier& b) {
    asm volatile("s_waitcnt vmcnt(0)" ::: "memory");
    __syncthreads();
    if (threadIdx.x == 0) {
        unsigned* bar = b.bar;
        __builtin_amdgcn_s_waitcnt(0);
        unsigned nloc = b.st[0], nx = b.st[1];
        if (nloc == 0u) { xcd_barrier_complete(bar, b.x, nloc, nx); b.st[0] = nloc; b.st[1] = nx; }
        const unsigned old = xb_add(&bar[XB_XSUB(b.x)], 1u);
        const unsigned gen = old / nloc;
        if (old + 1u == (gen + 1u) * nloc) {
            __builtin_amdgcn_fence(__ATOMIC_RELEASE, "agent");
            asm volatile("s_waitcnt vmcnt(0)" ::: "memory");
            const unsigned og = xb_add(&bar[XB_TOP], 1u);
            const unsigned tg = og / nx;
            if (og + 1u == (tg + 1u) * nx) xb_add(&bar[XB_TOPGEN], 1u);
            else XB_SPIN(xb_ld(&bar[XB_TOPGEN]) == tg, bar);
            __builtin_amdgcn_fence(__ATOMIC_ACQUIRE, "agent");
            xb_add(&bar[XB_XGEN(b.x)], 1u);
            asm volatile("s_waitcnt vmcnt(0)" ::: "memory");
        } else {
            XB_SPIN(xb_ld(&bar[XB_XGEN(b.x)]) == gen, bar);
            __builtin_amdgcn_fence(__ATOMIC_ACQUIRE, "agent");
            asm volatile("s_waitcnt vmcnt(0)" ::: "memory");
        }
    }
    __syncthreads();
}

namespace pg8 {
constexpr int BM = 256, BK = 64, HALF = 128, HTB = HALF * BK * 2, STAGE_BYTES = 8 * HTB, NXCD = 8, WGM = 8;
__host__ __device__ __forceinline__ int lds_byte(int r, int c) { const int st = (r >> 4) * 2 + (c >> 5), rr = r & 15, cc = c & 31, ob = rr * 64 + cc * 2; return st * 1024 + (ob ^ (((ob >> 9) & 1) << 5)); }
__host__ __device__ __forceinline__ void stage_rc(int b, int& R, int& C) { const int st = b / 1024, sb = b % 1024, swz = sb ^ (((sb >> 9) & 1) << 5); R = (st >> 1) * 16 + swz / 64; C = (st & 1) * 32 + (swz % 64) / 2; }
__host__ __device__ __forceinline__ int perm32(int rho) { const int n = rho >> 4, i = rho & 15; return 8 * (i >> 2) + 4 * n + (i & 3); }

struct GUnit { int row0, pn, e, grow, nvalid; };

struct DenseOrder {
    int nM, nN, nwg, G, c;
    __device__ void init(int M, int N, int G_, int c_) { nM = M / BM; nN = N / BM; nwg = nM * nN; G = G_; c = c_; }
    __device__ bool next(int i, GUnit& u) const {
        const long L = (long)i * G + c; if (L >= nwg) return false;
        int wgid = (int)L; { const int q = nwg / NXCD, r = nwg % NXCD, xcd = wgid % NXCD, off = wgid / NXCD; wgid = (xcd < r ? xcd * (q + 1) : r * (q + 1) + (xcd - r) * q) + off; }
        const int nig = WGM * nN, gid = wgid / nig, fm = gid * WGM, gsz = (nM - fm) < WGM ? (nM - fm) : WGM;
        u.row0 = (fm + ((wgid % nig) % gsz)) * BM; u.pn = (wgid % nig) / gsz; u.e = 0; u.grow = 0; u.nvalid = BM; return true;
    }
};
struct MoeOrder {
    const LAS int* ust; const LAS int* rowoff; const LAS int* cnt; int lognN, G, c;
    __device__ bool next(int i, GUnit& u) const {
        const int L = i * G + c; const int total = __builtin_amdgcn_readfirstlane(ust[32]); if (L >= total) return false;
        int e = 0;
#pragma unroll
        for (int j = 1; j < 32; ++j) e += (L >= __builtin_amdgcn_readfirstlane(ust[j])) ? 1 : 0;
        const int idx = L - __builtin_amdgcn_readfirstlane(ust[e]); const int r = idx >> lognN, pn = idx & ((1 << lognN) - 1);
        u.row0 = __builtin_amdgcn_readfirstlane(rowoff[e]) + BM * r; u.pn = pn; u.e = e; u.grow = e * CAP + BM * r; u.nvalid = __builtin_amdgcn_readfirstlane(cnt[e]) - BM * r; return true;
    }
};

template <bool VEC> struct MoeOrderX {
    const LAS int* rowoff; const LAS int* cnt; int lognN, G, c;
    __device__ bool next(int i, GUnit& u) const {
        int rem = i;
        for (int v = c; v < 256; v += G) {
            const int x8 = v & 7, j = v >> 3, e = x8 + 8 * (j >> 3), pn = (lognN == 3) ? (j & 7) : ((j & 7) >> 1), r0 = (lognN == 3) ? 0 : (j & 1), rs = (lognN == 3) ? 1 : 2;
            const int ce = __builtin_amdgcn_readfirstlane(cnt[e]), R = (ce + 255) >> 8, n = (R > r0) ? (R - r0 + rs - 1) / rs : 0;
            if (rem < n) { const int r = r0 + rem * rs; u.row0 = __builtin_amdgcn_readfirstlane(rowoff[e]) + BM * r; u.pn = pn; u.e = e; u.grow = e * CAP + BM * r; u.nvalid = ce - BM * r;
                if (VEC) { int ev = e; asm volatile("" : "+v"(ev)); u.e = ev; }
                return true; }
            rem -= n;
        }
        return false;
    }
};
struct MoeOrderOwn {
    const LAS int* rowoff; const LAS int* cnt; unsigned mx, mh; int G, c;
    __device__ bool next(int i, GUnit& u) const {
        int rem = i; const int ns = 8 * __builtin_popcount(mh);
        for (int v = c; v < 256; v += G) {
            const int x8 = v & 7, j = v >> 3, e = x8 + 8 * (j >> 3), jl = j & 7, pn = jl >> 1, rpar = jl & 1;
            const int ce = __builtin_amdgcn_readfirstlane(cnt[e]), R = (ce + 255) >> 8, n2 = R >> 1;
            const bool stolen = ((mx >> e) & 1u) && (4 * __builtin_popcount(mx & ((1u << e) - 1u)) + pn < ns);
            const int n = n2 + (((R & 1) && rpar == 0 && !stolen) ? 1 : 0);
            if (rem < n) { const int r = rem < n2 ? rpar + 2 * rem : R - 1; u.row0 = __builtin_amdgcn_readfirstlane(rowoff[e]) + BM * r; u.pn = pn; u.e = e; u.grow = e * CAP + BM * r; u.nvalid = ce - BM * r; return true; }
            rem -= n;
        }
        return false;
    }
};
struct MoeOrderSteal {
    const LAS int* rowoff; const LAS int* cnt; unsigned mx, mh; int G, c;
    __device__ bool next(int i, GUnit& u) const {
        int rem = i; const int nx = 4 * __builtin_popcount(mx);
        for (int v = c; v < 256; v += G) {
            const int x8 = v & 7, j = v >> 3, e = x8 + 8 * (j >> 3), jl = j & 7;
            if (!((mh >> e) & 1u)) continue;
            const int s = 8 * __builtin_popcount(mh & ((1u << e) - 1u)) + jl;
            if (s >= nx) continue;
            if (rem == 0) { unsigned m = mx; for (int q = 0; q < (s >> 2); ++q) m &= m - 1u;
                const int o = __builtin_ctz(m), pn = s & 3, ce = __builtin_amdgcn_readfirstlane(cnt[o]), r = ((ce + 255) >> 8) - 1;
                u.row0 = __builtin_amdgcn_readfirstlane(rowoff[o]) + BM * r; u.pn = pn; u.e = o; u.grow = o * CAP + BM * r; u.nvalid = ce - BM * r; return true; }
            --rem;
        }
        return false;
    }
};
__host__ __device__ __forceinline__ int sig8(int p) { return (p & 1) | (((p >> 2) & 1) * 6); }
typedef int v8i __attribute__((ext_vector_type(8)));
typedef int i32x4 __attribute__((ext_vector_type(4)));

template <class Epi, class Sched, int K, bool GATHER, bool F8>
__device__ __forceinline__ void gemm_phase(LAS unsigned char* lds, const void* A, const void* Bt, size_t bexp  , const Sched& S, const Epi& E, const int* gidx) {
    const int tid = threadIdx.x, wid = __builtin_amdgcn_readfirstlane(tid >> 6), lane = tid & 63, wr = wid >> 2, wc = wid & 3, fr = lane & 15, fq = lane >> 4;
    constexpr int ES = F8 ? 1 : 2, KB = K * ES, nt = KB / 128;
    static_assert(nt >= 4 && nt % 2 == 0, "K");
    int R0, C0b;
    if constexpr (F8) { R0 = tid >> 3; C0b = ((tid & 7) ^ sig8((R0 >> 1) & 7)) << 4; }
    else { int C0; stage_rc(tid * 16, R0, C0); C0b = C0 * 2; }
    unsigned voffA[2], voffB[2];
#pragma unroll
    for (int i = 0; i < 2; ++i) { const int R = R0 + 64 * i; const int Rb = Epi::PERM ? ((R & ~31) + perm32(R & 31)) : R;
        voffA[i] = (unsigned)(R * KB + C0b); voffB[i] = (unsigned)(Rb * KB + C0b); }
    constexpr size_t kstep = 128, hstep = (size_t)HALF * KB;
    const unsigned ldsw = (unsigned)wid * 1024u;
    int aoff, boff, aoff1 = 0, boff1 = 0;
    if constexpr (F8) { const int sg = sig8((fr >> 1) & 7);
        aoff = (wr * 64 + fr) * 128 + (((2 * fq) ^ sg) << 4); aoff1 = (wr * 64 + fr) * 128 + (((2 * fq + 1) ^ sg) << 4);
        boff = (wc * 32 + fr) * 128 + (((2 * fq) ^ sg) << 4); boff1 = (wc * 32 + fr) * 128 + (((2 * fq + 1) ^ sg) << 4); }
    else { aoff = lds_byte(wr * 64 + fr, fq * 8); boff = lds_byte(wc * 32 + fr, fq * 8); }
    unsigned gcur[2][2], gnxt[2][2];
#define PG8_LOADG(u_, g_) do { _Pragma("unroll") for (int _h = 0; _h < 2; ++_h) _Pragma("unroll") for (int _i = 0; _i < 2; ++_i) { const int _r = _h * HALF + R0 + 64 * _i; int _tok = 0; \
        if (_r < (u_).nvalid) _tok = gidx[(u_).grow + _r]; (g_)[_h][_i] = (unsigned)_tok * (unsigned)KB + (unsigned)C0b; } } while (0)
#define PG8_PING(g_) asm volatile("" : "+v"((g_)[0][0]), "+v"((g_)[0][1]), "+v"((g_)[1][0]), "+v"((g_)[1][1]))
#define PG8_SA(b, h) (((b) * 2 + (h)) * HTB)
#define PG8_SB(b, h) ((4 + (b) * 2 + (h)) * HTB)
#define PG8_STAGE(bufoff, rs, soff, voff) do { _Pragma("unroll") for (int _i = 0; _i < 2; ++_i) \
        __builtin_amdgcn_raw_ptr_buffer_load_lds(rs, (LAS void*)(lds + (bufoff) + ldsw + _i * 8192), 16, (int)(voff)[_i], (int)(soff), 0, 0); } while (0)
#define PG8_STAGE_A(bufoff, h, nx, kb) do { if constexpr (GATHER) { _Pragma("unroll") for (int _i = 0; _i < 2; ++_i) { const unsigned _o = (nx) ? gnxt[h][_i] : gcur[h][_i]; \
            __builtin_amdgcn_raw_ptr_buffer_load_lds(rsA, (LAS void*)(lds + (bufoff) + ldsw + _i * 8192), 16, (int)_o, (int)(kb), 0, 0); } } \
        else { PG8_STAGE(bufoff, rsA, ((nx) ? nA : cA) + (unsigned)((h) * hstep) + (unsigned)(kb), voffA); } } while (0)
#define PG8_LDA(b, h) do { if constexpr (F8) { _Pragma("unroll") for (int m = 0; m < 4; ++m) { const i32x4 _l = *(const LAS i32x4*)(lds + PG8_SA(b, h) + aoff + m * 2048), _h2 = *(const LAS i32x4*)(lds + PG8_SA(b, h) + aoff1 + m * 2048); \
            At8[m] = __builtin_shufflevector(_l, _h2, 0, 1, 2, 3, 4, 5, 6, 7); } } \
        else { _Pragma("unroll") for (int m = 0; m < 4; ++m) _Pragma("unroll") for (int k = 0; k < 2; ++k) At[m][k] = *(const LAS bf16x8*)(lds + PG8_SA(b, h) + aoff + m * 2048 + k * 1024); } } while (0)
#define PG8_LDB(dst, dst8, b, h) do { if constexpr (F8) { _Pragma("unroll") for (int n = 0; n < 2; ++n) { const i32x4 _l = *(const LAS i32x4*)(lds + PG8_SB(b, h) + boff + n * 2048), _h2 = *(const LAS i32x4*)(lds + PG8_SB(b, h) + boff1 + n * 2048); \
            dst8[n] = __builtin_shufflevector(_l, _h2, 0, 1, 2, 3, 4, 5, 6, 7); } } \
        else { _Pragma("unroll") for (int n = 0; n < 2; ++n) _Pragma("unroll") for (int k = 0; k < 2; ++k) dst[n][k] = *(const LAS bf16x8*)(lds + PG8_SB(b, h) + boff + n * 2048 + k * 1024); } } while (0)
#define PG8_MMA(ai, bj, Bt_, Bt8_) do { __builtin_amdgcn_s_setprio(1); if constexpr (F8) { _Pragma("unroll") for (int m = 0; m < 4; ++m) _Pragma("unroll") for (int n = 0; n < 2; ++n) \
            acc[ai][bj][m][n] = __builtin_amdgcn_mfma_scale_f32_16x16x128_f8f6f4(Bt8_[n], At8[m], acc[ai][bj][m][n], 0, 0, 0, 0, 0, 0); } \
        else { _Pragma("unroll") for (int m = 0; m < 4; ++m) _Pragma("unroll") for (int n = 0; n < 2; ++n) _Pragma("unroll") for (int k = 0; k < 2; ++k) \
            acc[ai][bj][m][n] = __builtin_amdgcn_mfma_f32_16x16x32_bf16(Bt_[n][k], At[m][k], acc[ai][bj][m][n], 0, 0, 0); } __builtin_amdgcn_s_setprio(0); } while (0)
#define PG8_WAIT_V(n) asm volatile("s_waitcnt vmcnt(" #n ")" ::: "memory")
#define PG8_WAIT_L(n) asm volatile("s_waitcnt lgkmcnt(" #n ")" ::: "memory")
#define PG8_BAR __builtin_amdgcn_s_barrier()
#define PG8_SCHED __builtin_amdgcn_sched_barrier(0)
    GUnit cur, nxt, nn; int ui = 0;
    if (!S.next(0, cur)) return;
    bool has_next = S.next(1, nxt);
    f32x4 acc[2][2][4][2];
#pragma unroll
    for (int a = 0; a < 2; ++a)
#pragma unroll
        for (int b = 0; b < 2; ++b)
#pragma unroll
            for (int m = 0; m < 4; ++m)
#pragma unroll
                for (int n = 0; n < 2; ++n) acc[a][b][m][n] = (f32x4){0.f, 0.f, 0.f, 0.f};
    bf16x8 At[4][2], B0[2][2], B1[2][2]; v8i At8[4], B08[2], B18[2];
    const __amdgpu_buffer_rsrc_t rsA = __builtin_amdgcn_make_buffer_rsrc((void*)A, 0, 0x7fffffff, 0x00020000), rsB = __builtin_amdgcn_make_buffer_rsrc((void*)Bt, 0, 0x7fffffff, 0x00020000);
    unsigned cA = (unsigned)cur.row0 * (unsigned)KB;
    unsigned cB = (unsigned)(((size_t)cur.e * bexp + (size_t)cur.pn * BM * K) * ES);
    unsigned nA = cA, nB = cB;
    if constexpr (GATHER) {
        PG8_LOADG(cur, gcur);
        if (has_next) PG8_LOADG(nxt, gnxt); else { gnxt[0][0] = gcur[0][0]; gnxt[0][1] = gcur[0][1]; gnxt[1][0] = gcur[1][0]; gnxt[1][1] = gcur[1][1]; }
        PG8_PING(gcur); PG8_PING(gnxt);
    }
    PG8_STAGE(PG8_SB(0, 0), rsB, cB, voffB); PG8_STAGE(PG8_SB(0, 1), rsB, cB + (unsigned)hstep, voffB); PG8_STAGE_A(PG8_SA(0, 0), 0, false, 0u); PG8_STAGE_A(PG8_SA(0, 1), 1, false, 0u);
    if (wr == 1) PG8_BAR;
    PG8_WAIT_V(2); PG8_BAR;
    PG8_STAGE(PG8_SB(1, 0), rsB, cB + (unsigned)kstep, voffB); PG8_STAGE_A(PG8_SA(1, 0), 0, false, (unsigned)kstep); PG8_STAGE(PG8_SB(1, 1), rsB, cB + (unsigned)(hstep + kstep), voffB);
    PG8_WAIT_V(6); PG8_BAR;
    for (;;) {
        if (has_next) { nA = (unsigned)nxt.row0 * (unsigned)KB; nB = (unsigned)(((size_t)nxt.e * bexp + (size_t)nxt.pn * BM * K) * ES); } else { nA = cA; nB = cB; }
#define PG8_KBODY(LAST, T_) do { \
            const unsigned kb1 = (unsigned)((T_) + 1) * (unsigned)kstep, kb2 = (LAST) ? 0u : (unsigned)((T_) + 2) * (unsigned)kstep, kb3 = kb2 + (unsigned)kstep; \
            const unsigned b2 = ((LAST) ? nB : cB) + kb2, b3 = b2 + (unsigned)kstep; \
              \
            PG8_LDB(B0, B08, 0, 0); PG8_LDB(B1, B18, 0, 1); PG8_SCHED; PG8_LDA(0, 0); PG8_STAGE_A(PG8_SA(1, 1), 1, false, kb1); \
            PG8_WAIT_V(8); PG8_WAIT_L(0); PG8_BAR; PG8_MMA(0, 0, B0, B08); PG8_MMA(0, 1, B1, B18); PG8_BAR; PG8_SCHED; \
              \
            PG8_LDA(0, 1); PG8_STAGE(PG8_SB(0, 0), rsB, b2, voffB); PG8_STAGE(PG8_SB(0, 1), rsB, b2 + (unsigned)hstep, voffB); PG8_STAGE_A(PG8_SA(0, 0), 0, LAST, kb2); \
            PG8_WAIT_V(8); PG8_WAIT_L(0); PG8_BAR; PG8_MMA(1, 0, B0, B08); PG8_MMA(1, 1, B1, B18); PG8_BAR; PG8_SCHED; \
              \
            PG8_LDB(B0, B08, 1, 0); PG8_LDB(B1, B18, 1, 1); PG8_SCHED; PG8_LDA(1, 0); PG8_STAGE_A(PG8_SA(0, 1), 1, LAST, kb2); \
            PG8_WAIT_V(8); PG8_WAIT_L(0); PG8_BAR; PG8_MMA(0, 0, B0, B08); PG8_MMA(0, 1, B1, B18); PG8_BAR; PG8_SCHED; \
              \
            PG8_LDA(1, 1); PG8_STAGE(PG8_SB(1, 0), rsB, b3, voffB); PG8_STAGE(PG8_SB(1, 1), rsB, b3 + (unsigned)hstep, voffB); PG8_STAGE_A(PG8_SA(1, 0), 0, LAST, kb3); \
            PG8_WAIT_V(8); PG8_WAIT_L(0); PG8_BAR; PG8_MMA(1, 0, B0, B08); PG8_MMA(1, 1, B1, B18); PG8_BAR; PG8_SCHED; } while (0)
        bool has_nn = false; unsigned gnn[2][2]; int gtok[2][2] = {{0, 0}, {0, 0}};
#pragma unroll 1
        for (int t = 0; t < nt; t += 2) {
            const bool last = (t == nt - 2);
            if (last) {
                has_nn = has_next && S.next(ui + 2, nn);
                if constexpr (GATHER) { if (has_nn) {
#pragma unroll
                    for (int _h = 0; _h < 2; ++_h)
#pragma unroll
                        for (int _i = 0; _i < 2; ++_i) { const int _r = _h * HALF + R0 + 64 * _i; if (_r < nn.nvalid) gtok[_h][_i] = gidx[nn.grow + _r]; } } }
                if (wid == 0) E.stage(cur, lds + BIAS_OFF, lane);
            }
            PG8_KBODY(last, t);
        }
        if constexpr (GATHER) {
#pragma unroll
            for (int _h = 0; _h < 2; ++_h)
#pragma unroll
                for (int _i = 0; _i < 2; ++_i) gnn[_h][_i] = has_nn ? (unsigned)gtok[_h][_i] * (unsigned)KB + (unsigned)C0b : gnxt[_h][_i];
            PG8_PING(gnn);
        }
        if (wr == 0) PG8_BAR;
        E(acc, cur, wr, wc, fr, fq, (const LAS float*)(lds + BIAS_OFF));
        if (!has_next) break;
#pragma unroll
        for (int a = 0; a < 2; ++a)
#pragma unroll
            for (int b = 0; b < 2; ++b)
#pragma unroll
                for (int m = 0; m < 4; ++m)
#pragma unroll
                    for (int n = 0; n < 2; ++n) acc[a][b][m][n] = (f32x4){0.f, 0.f, 0.f, 0.f};
        cur = nxt; nxt = nn; has_next = has_nn; cA = nA; cB = nB; ++ui;
        if constexpr (GATHER) {
#pragma unroll
            for (int h = 0; h < 2; ++h)
#pragma unroll
                for (int i = 0; i < 2; ++i) { gcur[h][i] = gnxt[h][i]; gnxt[h][i] = gnn[h][i]; }
        }
        if (wr == 1) PG8_BAR;
    }
    PG8_WAIT_V(0);
    PG8_BAR;
    (void)At; (void)B0; (void)B1; (void)At8; (void)B08; (void)B18; (void)aoff1; (void)boff1;
#undef PG8_KBODY
#undef PG8_LOADG
#undef PG8_PING
#undef PG8_SA
#undef PG8_SB
#undef PG8_STAGE
#undef PG8_STAGE_A
#undef PG8_LDA
#undef PG8_LDB
#undef PG8_MMA
#undef PG8_WAIT_V
#undef PG8_WAIT_L
#undef PG8_BAR
#undef PG8_SCHED
}

typedef f32x4 Acc[2][2][4][2];
__device__ __forceinline__ u32x4 pack8(const f32x4 v0, const f32x4 v1) { u32x4 w; w.x = cvt_pk_bf16(v0[0], v0[1]); w.y = cvt_pk_bf16(v0[2], v0[3]); w.z = cvt_pk_bf16(v1[0], v1[1]); w.w = cvt_pk_bf16(v1[2], v1[3]); return w; }

struct EpiInProj {
    static constexpr bool PERM = true;
    const float* bias; const float* cs; bf16 *Q, *KB, *VB, *U, *GA, *GP;
    __device__ __forceinline__ void stage(const GUnit& u, LAS unsigned char* slot, int lane) const {
        const __amdgpu_buffer_rsrc_t rs = __builtin_amdgcn_make_buffer_rsrc((void*)bias, 0, 0x7fffffff, 0x00020000);
        __builtin_amdgcn_raw_ptr_buffer_load_lds(rs, (LAS void*)slot, 16, lane * 16, u.pn * 1024, 0, 0); }
    __device__ __forceinline__ void operator()(const Acc& acc, const GUnit& u, int wr, int wc, int fr, int fq, const LAS float* bl) const {
        const int pn = u.pn; const bool rw = (wc & 1) == 0;
        bf16 *d0, *d1; int c0, pitch; bool rp0, rp1, nt;
        if (pn < 4) { d0 = d1 = Q; c0 = pn * 256; pitch = 1024; rp0 = rp1 = rw; nt = false; }
        else if (pn == 4) { d0 = KB; d1 = VB - 128; c0 = 0; pitch = 128; rp0 = rw; rp1 = false; nt = false; }
        else if (pn < 7) { d0 = d1 = U; c0 = (pn - 5) * 256; pitch = 512; rp0 = rp1 = false; nt = false; }
        else if (pn < 11) { d0 = d1 = GA; c0 = (pn - 7) * 256; pitch = 1024; rp0 = rp1 = false; nt = true; }
        else { d0 = d1 = GP; c0 = (pn - 11) * 256; pitch = 1024; rp0 = rp1 = false; nt = true; }
        const int rowl = wr * 64 + fr;
        const __amdgpu_buffer_rsrc_t r0 = __builtin_amdgcn_make_buffer_rsrc((void*)(d0 + (size_t)u.row0 * pitch), 0, 0x7fffffff, 0x00020000);
        const __amdgpu_buffer_rsrc_t r1 = __builtin_amdgcn_make_buffer_rsrc((void*)(d1 + (size_t)u.row0 * pitch), 0, 0x7fffffff, 0x00020000);
        const int vo = (rowl * pitch + c0 + wc * 32 + 8 * fq) * 2;
        f32x4 bb[2][2];
#pragma unroll
        for (int bj = 0; bj < 2; ++bj) { bb[bj][0] = *(const LAS f32x4*)(bl + bj * 128 + wc * 32 + 8 * fq); bb[bj][1] = *(const LAS f32x4*)(bl + bj * 128 + wc * 32 + 8 * fq + 4); }
        const float sg = (fq == 0) ? -1.f : 1.f;
        const int rstep = pitch * 32;
#pragma unroll
        for (int am = 0; am < 8; am += 2) {
            f32x4 csr[2][4];
            if (rp0) {
#pragma unroll
                for (int mm = 0; mm < 2; ++mm)
#pragma unroll
                    for (int q = 0; q < 4; ++q) csr[mm][q] = *(const f32x4*)(cs + (size_t)(u.row0 + rowl + ((am + mm) >> 2) * 128 + ((am + mm) & 3) * 16) * 16 + 4 * q);
            }
#pragma unroll
            for (int mm = 0; mm < 2; ++mm)
#pragma unroll
                for (int bj = 0; bj < 2; ++bj) { const int ai = (am + mm) >> 2, m = (am + mm) & 3;
                    f32x4 v0 = acc[ai][bj][m][0] + bb[bj][0], v1 = acc[ai][bj][m][1] + bb[bj][1];
                    if (bj == 0 ? rp0 : rp1) {
                        f32x4 o0, o1;
#pragma unroll
                        for (int j = 0; j < 4; ++j) { o0[j] = __shfl_xor(v0[j], 16); o1[j] = __shfl_xor(v1[j], 16); }
                        const f32x4 q0 = v0 * csr[mm][0] + (o0 * csr[mm][2]) * sg, q1 = v1 * csr[mm][1] + (o1 * csr[mm][3]) * sg;
                        if (fq < 2) { v0 = q0; v1 = q1; } }
                    const u32x4 w = pack8(v0, v1); const int so = (ai * 8 + m) * rstep;
                    if (nt) __builtin_amdgcn_raw_buffer_store_b128(w, bj == 0 ? r0 : r1, vo + bj * 256, so, 2);
                    else __builtin_amdgcn_raw_buffer_store_b128(w, bj == 0 ? r0 : r1, vo + bj * 256, so, 0);
                }
        }
    }
};
struct EpiGateA {
    static constexpr bool PERM = true;
    const bf16* GA; bf16* T1;
    __device__ __forceinline__ void stage(const GUnit&, LAS unsigned char*, int) const {}
    __device__ __forceinline__ void operator()(const Acc& acc, const GUnit& u, int wr, int wc, int fr, int fq, const LAS float*) const {
        const int row0 = u.row0 + wr * 64 + fr;
        u32x4 gg[16];
#pragma unroll
        for (int ai = 0; ai < 2; ++ai)
#pragma unroll
            for (int m = 0; m < 4; ++m)
#pragma unroll
                for (int bj = 0; bj < 2; ++bj) gg[(ai * 4 + m) * 2 + bj] = *(const u32x4*)(GA + (size_t)(row0 + ai * 128 + m * 16) * 1024 + u.pn * 256 + bj * 128 + wc * 32 + 8 * fq);
#pragma unroll
        for (int ai = 0; ai < 2; ++ai)
#pragma unroll
            for (int m = 0; m < 4; ++m)
#pragma unroll
                for (int bj = 0; bj < 2; ++bj) { const size_t off = (size_t)(row0 + ai * 128 + m * 16) * 1024 + u.pn * 256 + bj * 128 + wc * 32 + 8 * fq;
                    const u32x4 g = gg[(ai * 4 + m) * 2 + bj]; f32x4 v0 = acc[ai][bj][m][0], v1 = acc[ai][bj][m][1];
                    v0[0] *= fast_sigmoid(bflo(g.x)); v0[1] *= fast_sigmoid(bfhi(g.x)); v0[2] *= fast_sigmoid(bflo(g.y)); v0[3] *= fast_sigmoid(bfhi(g.y)); v1[0] *= fast_sigmoid(bflo(g.z)); v1[1] *= fast_sigmoid(bfhi(g.z)); v1[2] *= fast_sigmoid(bflo(g.w)); v1[3] *= fast_sigmoid(bfhi(g.w));
                    *(u32x4*)(T1 + off) = pack8(v0, v1); }
    }
};
struct EpiMerge {
    static constexpr bool PERM = true;
    const bf16* GP; const bf16* T1; bf16* MG;
    __device__ __forceinline__ void stage(const GUnit&, LAS unsigned char*, int) const {}
    __device__ __forceinline__ void operator()(const Acc& acc, const GUnit& u, int wr, int wc, int fr, int fq, const LAS float*) const {
        const int row0 = u.row0 + wr * 64 + fr;
#pragma unroll
        for (int ai = 0; ai < 2; ++ai) {
            u32x4 gg[8], tt[8];
#pragma unroll
            for (int m = 0; m < 4; ++m)
#pragma unroll
                for (int bj = 0; bj < 2; ++bj) { const size_t off = (size_t)(row0 + ai * 128 + m * 16) * 1024 + u.pn * 256 + bj * 128 + wc * 32 + 8 * fq;
                    gg[m * 2 + bj] = *(const u32x4*)(GP + off); tt[m * 2 + bj] = *(const u32x4*)(T1 + off); }
#pragma unroll
            for (int m = 0; m < 4; ++m)
#pragma unroll
                for (int bj = 0; bj < 2; ++bj) { const size_t off = (size_t)(row0 + ai * 128 + m * 16) * 1024 + u.pn * 256 + bj * 128 + wc * 32 + 8 * fq;
                    const u32x4 g = gg[m * 2 + bj]; const u32x4 t = tt[m * 2 + bj]; f32x4 v0 = acc[ai][bj][m][0], v1 = acc[ai][bj][m][1];
                    v0[0] = v0[0] * fast_sigmoid(bflo(g.x)) + bflo(t.x); v0[1] = v0[1] * fast_sigmoid(bfhi(g.x)) + bfhi(t.x); v0[2] = v0[2] * fast_sigmoid(bflo(g.y)) + bflo(t.y); v0[3] = v0[3] * fast_sigmoid(bfhi(g.y)) + bfhi(t.y);
                    v1[0] = v1[0] * fast_sigmoid(bflo(g.z)) + bflo(t.z); v1[1] = v1[1] * fast_sigmoid(bfhi(g.z)) + bfhi(t.z); v1[2] = v1[2] * fast_sigmoid(bflo(g.w)) + bflo(t.w); v1[3] = v1[3] * fast_sigmoid(bfhi(g.w)) + bfhi(t.w);
                    *(u32x4*)(MG + off) = pack8(v0, v1); }
        }
    }
};
struct EpiX1 {
    static constexpr bool PERM = true;
    bf16* X1;
    __device__ __forceinline__ void stage(const GUnit&, LAS unsigned char*, int) const {}
    __device__ __forceinline__ void operator()(const Acc& acc, const GUnit& u, int wr, int wc, int fr, int fq, const LAS float*) const {
        const int row0 = u.row0 + wr * 64 + fr;
#pragma unroll
        for (int ai = 0; ai < 2; ++ai)
#pragma unroll
            for (int m = 0; m < 4; ++m)
#pragma unroll
                for (int bj = 0; bj < 2; ++bj) *(u32x4*)(X1 + (size_t)(row0 + ai * 128 + m * 16) * 1024 + u.pn * 256 + bj * 128 + wc * 32 + 8 * fq) = pack8(acc[ai][bj][m][0], acc[ai][bj][m][1]);
    }
};
struct EpiSwiglu {
    static constexpr bool PERM = true;
    const float* bup; fp8* ACT;
    __device__ __forceinline__ void stage(const GUnit& u, LAS unsigned char* slot, int lane) const {
        const __amdgpu_buffer_rsrc_t rs = __builtin_amdgcn_make_buffer_rsrc((void*)bup, 0, 0x7fffffff, 0x00020000);
        __builtin_amdgcn_raw_ptr_buffer_load_lds(rs, (LAS void*)slot, 16, (lane & 31) * 16 + (lane >> 5) * 4096, (u.e * 2048 + u.pn * 128) * 4, 0, 0); }
    __device__ __forceinline__ void operator()(const Acc& acc, const GUnit& u, int wr, int wc, int fr, int fq, const LAS float* bl) const {
        const int row0 = u.row0 + wr * 64 + fr, col = u.pn * 128 + wc * 32 + 8 * fq;
        const LAS float* bg = bl + wc * 32 + 8 * fq;
        const f32x4 g0 = *(const LAS f32x4*)bg, g1 = *(const LAS f32x4*)(bg + 4), l0 = *(const LAS f32x4*)(bg + 128), l1 = *(const LAS f32x4*)(bg + 132);
#pragma unroll
        for (int ai = 0; ai < 2; ++ai)
#pragma unroll
            for (int m = 0; m < 4; ++m) {
                f32x4 a0 = acc[ai][0][m][0] * W8_INV + g0, a1 = acc[ai][0][m][1] * W8_INV + g1, c0 = acc[ai][1][m][0] * W8_INV + l0, c1 = acc[ai][1][m][1] * W8_INV + l1, r0, r1;
#pragma unroll
                for (int j = 0; j < 4; ++j) {
                    const float ga = fminf(a0[j], 7.f), la = fminf(fmaxf(c0[j], -7.f), 7.f); r0[j] = ga * fast_sigmoid(1.702f * ga) * (la + 1.f);
                    const float gb = fminf(a1[j], 7.f), lb = fminf(fmaxf(c1[j], -7.f), 7.f); r1[j] = gb * fast_sigmoid(1.702f * gb) * (lb + 1.f); }
                int w0 = 0, w1 = 0;
                w0 = __builtin_amdgcn_cvt_pk_fp8_f32(r0[0], r0[1], w0, false); w0 = __builtin_amdgcn_cvt_pk_fp8_f32(r0[2], r0[3], w0, true);
                w1 = __builtin_amdgcn_cvt_pk_fp8_f32(r1[0], r1[1], w1, false); w1 = __builtin_amdgcn_cvt_pk_fp8_f32(r1[2], r1[3], w1, true);
                u32x2 w; w.x = (unsigned)w0; w.y = (unsigned)w1;
                *(u32x2*)(ACT + (size_t)(row0 + ai * 128 + m * 16) * 1024 + col) = w;
            }
    }
};
struct EpiDown {
    static constexpr bool PERM = true;
    const float* bdn; fp8* YS;
    __device__ __forceinline__ void stage(const GUnit& u, LAS unsigned char* slot, int lane) const {
        const __amdgpu_buffer_rsrc_t rs = __builtin_amdgcn_make_buffer_rsrc((void*)bdn, 0, 0x7fffffff, 0x00020000);
        __builtin_amdgcn_raw_ptr_buffer_load_lds(rs, (LAS void*)slot, 16, lane * 16, (u.e * 1024 + u.pn * 256) * 4, 0, 0); }
    __device__ __forceinline__ void operator()(const Acc& acc, const GUnit& u, int wr, int wc, int fr, int fq, const LAS float* bl) const {
        const int row0 = u.row0 + wr * 64 + fr;
#pragma unroll
        for (int bj = 0; bj < 2; ++bj) { const int col = u.pn * 256 + bj * 128 + wc * 32 + 8 * fq;
            const f32x4 b0 = *(const LAS f32x4*)(bl + bj * 128 + wc * 32 + 8 * fq), b1 = *(const LAS f32x4*)(bl + bj * 128 + wc * 32 + 8 * fq + 4);
#pragma unroll
            for (int ai = 0; ai < 2; ++ai)
#pragma unroll
                for (int m = 0; m < 4; ++m) { const f32x4 r0 = acc[ai][bj][m][0] * W8_INV + b0, r1 = acc[ai][bj][m][1] * W8_INV + b1; int w0 = 0, w1 = 0;
                    w0 = __builtin_amdgcn_cvt_pk_fp8_f32(r0[0], r0[1], w0, false); w0 = __builtin_amdgcn_cvt_pk_fp8_f32(r0[2], r0[3], w0, true);
                    w1 = __builtin_amdgcn_cvt_pk_fp8_f32(r1[0], r1[1], w1, false); w1 = __builtin_amdgcn_cvt_pk_fp8_f32(r1[2], r1[3], w1, true);
                    u32x2 w; w.x = (unsigned)w0; w.y = (unsigned)w1; *(u32x2*)(YS + (size_t)(row0 + ai * 128 + m * 16) * 1024 + col) = w; } }
    }
};
}

struct Args { const float* in[19]; float* out; unsigned char* ws; int ph_lo, ph_hi, li, pad; };
struct Frame {
    LAS unsigned char* lds; int tid, lane, wave, G, bx;
    unsigned char* ws; gu32* ctl;
};

__device__ __forceinline__ void conv_item(const float* W, int N, bf16* WT, int K, int k0, int n_src0, int n_dst0, int lane, LAS unsigned char* scr) {
    const int hw = lane >> 5, l5 = lane & 31;
    const float* src = W + (size_t)(k0 + 16 * hw) * N + n_src0 + 4 * l5;
#pragma unroll
    for (int half = 0; half < 2; ++half) {
        f32x4 v[16];
#pragma unroll
        for (int j = 0; j < 16; ++j) v[j] = *(const f32x4*)(src + (size_t)(32 * half + j) * N);
#pragma unroll
        for (int q = 0; q < 4; ++q) { const int row = 4 * l5 + q;
#pragma unroll
            for (int cc = 0; cc < 2; ++cc) { u32x4 w; w.x = cvt_pk_bf16(v[8 * cc + 0][q], v[8 * cc + 1][q]); w.y = cvt_pk_bf16(v[8 * cc + 2][q], v[8 * cc + 3][q]);
                w.z = cvt_pk_bf16(v[8 * cc + 4][q], v[8 * cc + 5][q]); w.w = cvt_pk_bf16(v[8 * cc + 6][q], v[8 * cc + 7][q]);
                const int c = 4 * half + 2 * hw + cc;
                *(LAS u32x4*)(scr + row * 128 + ((c ^ (l5 & 7)) << 4)) = w; } }
    }
    LDS_WAIT(); asm volatile("" ::: "memory");
    bf16* dst = WT + (size_t)(n_dst0 + (lane >> 3)) * K + k0 + 8 * (lane & 7);
#pragma unroll
    for (int i = 0; i < 16; ++i) { const int n = 8 * i + (lane >> 3), c = lane & 7;
        const u32x4 w = *(const LAS u32x4*)(scr + n * 128 + ((c ^ ((n >> 2) & 7)) << 4));
        *(u32x4*)(dst + (size_t)(8 * i) * K) = w; }
    LDS_WAIT(); asm volatile("" ::: "memory");
}
__device__ __forceinline__ int pk4_fp8(float a, float b, float c, float d) { int w = 0; w = __builtin_amdgcn_cvt_pk_fp8_f32(a * W8_SCALE, b * W8_SCALE, w, false); w = __builtin_amdgcn_cvt_pk_fp8_f32(c * W8_SCALE, d * W8_SCALE, w, true); return w; }
template <int UNR> __device__ __forceinline__ void conv_item8(const float* W, int N, fp8* WT, int K, int k0, int n_src0, int n_dst0, int lane, LAS unsigned char* scr) {
    const int hw = lane >> 5, l5 = lane & 31;
    const float* src = W + (size_t)(k0 + 16 * hw) * N + n_src0 + 4 * l5;
#pragma unroll UNR
    for (int qt = 0; qt < 4; ++qt) {
        f32x4 v[16];
#pragma unroll
        for (int j = 0; j < 16; ++j) v[j] = __builtin_nontemporal_load((const f32x4*)(src + (size_t)(32 * qt + j) * N));
#pragma unroll
        for (int q = 0; q < 4; ++q) { const int row = 4 * l5 + q; u32x4 w;
            w.x = (unsigned)pk4_fp8(v[0][q], v[1][q], v[2][q], v[3][q]); w.y = (unsigned)pk4_fp8(v[4][q], v[5][q], v[6][q], v[7][q]);
            w.z = (unsigned)pk4_fp8(v[8][q], v[9][q], v[10][q], v[11][q]); w.w = (unsigned)pk4_fp8(v[12][q], v[13][q], v[14][q], v[15][q]);
            const int c = 2 * qt + hw;
            *(LAS u32x4*)(scr + row * 128 + ((c ^ (l5 & 7)) << 4)) = w; }
    }
    LDS_WAIT(); asm volatile("" ::: "memory");
    fp8* dst = WT + (size_t)(n_dst0 + (lane >> 3)) * K + k0 + 16 * (lane & 7);
#pragma unroll
    for (int i = 0; i < 16; ++i) { const int n = 8 * i + (lane >> 3), c = lane & 7;
        const u32x4 w = *(const LAS u32x4*)(scr + n * 128 + ((c ^ ((n >> 2) & 7)) << 4));
        __builtin_nontemporal_store(w, (u32x4*)(dst + (size_t)(8 * i) * K)); }
    LDS_WAIT(); asm volatile("" ::: "memory");
}
__device__ __forceinline__ void p0b_weights(const Frame& F, const Args& a, int widx, int nw) {
    const int gw = widx * NWAVES + F.wave, NGW = nw * NWAVES, lane = F.lane;
    unsigned char* ws = F.ws;
    bf16* WATT = (bf16*)(ws + WS_WATT); bf16* WEFF = (bf16*)(ws + WS_WEFF); bf16* WOUT = (bf16*)(ws + WS_WOUT);
    LAS unsigned char* scr = F.lds + F.wave * 16384;
    fp8* WUP8 = (fp8*)(ws + WS_WUP);
    constexpr int I_UP = 32 * 8 * 16, I_AT = 16 * 8, I_OUT = 16 * 8;
    for (int it = gw; it < I_UP; it += NGW) {
        int r = it;
        { const int e = r >> 7, q = r & 127, kb = q >> 4, nb = q & 15; conv_item8<2>(a.in[14] + (size_t)e * 1024 * 2048, 2048, WUP8 + (size_t)e * 2048 * 1024, 1024, kb * 128, up_src_col(nb * 128), nb * 128, lane, scr); }
    }
    for (int it = gw; it < I_AT + I_OUT; it += NGW) {
        int r = it;
        if (r < I_AT) { const int kb = r >> 3, nb = r & 7; conv_item(a.in[6], 1024, WATT, 1024, kb * 64, nb * 128, nb * 128, lane, scr); continue; } r -= I_AT;
        { const int kb = r >> 3, nb = r & 7; conv_item(a.in[10], 1024, WOUT, 1024, kb * 64, nb * 128, nb * 128, lane, scr); }
    }
    for (int it = NGW - 1 - gw; it < 64 * 16; it += NGW) {
        const int k0 = (it >> 4) * 8, n0 = (it & 15) * 64, g = k0 >> 7, kk0 = k0 & 127;
        const float* pw = a.in[7] + (size_t)(g * 128 + kk0) * 128; const float* ps = a.in[8] + g * 128; const float* wp = a.in[9] + (size_t)(g * 128) * 1024 + n0 + lane;
        float acc8[8];
#pragma unroll
        for (int q = 0; q < 8; ++q) acc8[q] = 0.f;
#pragma unroll 16
        for (int c = 0; c < 128; ++c) { const float wv = wp[(size_t)c * 1024] * ps[c];
#pragma unroll
            for (int q = 0; q < 8; ++q) acc8[q] += pw[q * 128 + c] * wv; }
        u32x4 w; w.x = cvt_pk_bf16(acc8[0], acc8[1]); w.y = cvt_pk_bf16(acc8[2], acc8[3]); w.z = cvt_pk_bf16(acc8[4], acc8[5]); w.w = cvt_pk_bf16(acc8[6], acc8[7]);
        *(u32x4*)(WEFF + (size_t)(n0 + lane) * 512 + k0) = w;
    }
}
__device__ __forceinline__ void p0_prologue(const Frame& F, const Args& a) {
    const int gw = F.bx * NWAVES + F.wave, NGW = F.G * NWAVES, lane = F.lane;
    unsigned char* ws = F.ws;
    bf16* WIN = (bf16*)(ws + WS_WIN); float* CS = (float*)(ws + WS_CS); bf16* H = (bf16*)(ws + WS_H);
    LAS unsigned char* scr = F.lds + F.wave * 16384;
    for (int it = gw; it < 16 * 30; it += NGW) { const int kb = it / 30, nb = it % 30; conv_item(a.in[3], INW, WIN, 1024, kb * 64, nb * 128, nb * 128, lane, scr); }
    { const float* wr = a.in[12]; bf16* WRH = (bf16*)(ws + WS_WRH); bf16* WRL = (bf16*)(ws + WS_WRL);
      for (int idx = gw * 64 + lane; idx < 32 * 1024; idx += NGW * 64) { const int e = idx >> 10, k = idx & 1023; const float w = wr[k * 32 + e]; const unsigned h = cvt_pk_bf16(w, 0.f) & 0xffffu;
          WRH[idx] = (bf16)h; WRL[idx] = (bf16)(cvt_pk_bf16(w - __uint_as_float(h << 16), 0.f) & 0xffffu); } }
    { const int* pos = (const int*)a.in[1];
      for (int idx = gw * 64 + lane; idx < T * 8; idx += NGW * 64) { const int t = idx >> 3, i = idx & 7; const float inv = powf(500000.0f, -(float)i * 0.125f); const float an = (float)pos[t] * inv;
          CS[t * 16 + i] = cosf(an); CS[t * 16 + 8 + i] = sinf(an); } }
    { const float* x = a.in[0]; const float* g1 = a.in[2];
      f32x4 gg[4];
#pragma unroll
      for (int j = 0; j < 4; ++j) gg[j] = ((const f32x4*)g1)[lane + 64 * j];
      for (int row = gw; row < T; row += 2 * NGW) {
          const int row2 = row + NGW;
          const f32x4* xr = (const f32x4*)(x + (size_t)row * D) + lane; const f32x4* xr2 = (const f32x4*)(x + (size_t)(row2 < T ? row2 : row) * D) + lane; f32x4 v[4], v2[4]; float s = 0.f, s2 = 0.f;
#pragma unroll
          for (int j = 0; j < 4; ++j) { v[j] = __builtin_nontemporal_load(xr + 64 * j); v2[j] = __builtin_nontemporal_load(xr2 + 64 * j); }
#pragma unroll
          for (int j = 0; j < 4; ++j) { s += v[j].x * v[j].x + v[j].y * v[j].y + v[j].z * v[j].z + v[j].w * v[j].w; s2 += v2[j].x * v2[j].x + v2[j].y * v2[j].y + v2[j].z * v2[j].z + v2[j].w * v2[j].w; }
          const float rstd = rsqrtf(wave_sum(s) * (1.f / D) + RMS_EPS), rstd2 = rsqrtf(wave_sum(s2) * (1.f / D) + RMS_EPS);
#pragma unroll
          for (int j = 0; j < 4; ++j) { const f32x4 o = v[j] * rstd * gg[j]; u32x2 w; w.x = cvt_pk_bf16(o[0], o[1]); w.y = cvt_pk_bf16(o[2], o[3]); *(u32x2*)(H + (size_t)row * D + 4 * lane + 256 * j) = w; }
          if (row2 < T) {
#pragma unroll
              for (int j = 0; j < 4; ++j) { const f32x4 o = v2[j] * rstd2 * gg[j]; u32x2 w; w.x = cvt_pk_bf16(o[0], o[1]); w.y = cvt_pk_bf16(o[2], o[3]); *(u32x2*)(H + (size_t)row2 * D + 4 * lane + 256 * j) = w; } }
      } }
}

template <int W> __device__ __forceinline__ void pool_rows(const bf16* U, bf16* PO, int t0, int wave, int lane) {
    const int c4 = 64 * wave + 4 * (lane & 15), r0 = t0 + 16 * (lane >> 4);
    const int pos0 = r0 % SEQ;
    u32x2 v[15 + W];
#pragma unroll
    for (int i = 0; i < 15 + W; ++i) { const int rr = r0 - (W - 1) + i; u32x2 z = {0u, 0u}; if (i >= W - 1 || pos0 != 0) z = *(const u32x2*)(U + (size_t)rr * PW + c4); v[i] = z; }
#pragma unroll
    for (int i = 0; i < 16; ++i) {
        float s0 = 0.f, s1 = 0.f, s2 = 0.f, s3 = 0.f;
#pragma unroll
        for (int jj = 0; jj < W; ++jj) { const u32x2 x = v[i + W - 1 - jj]; s0 += bflo(x.x); s1 += bfhi(x.x); s2 += bflo(x.y); s3 += bfhi(x.y); }
        const int pos = pos0 + i; const float rc = 1.0f / (float)(pos + 1 < W ? pos + 1 : W);
        const u32x2 c = v[i + W - 1]; u32x2 o;
        o.x = cvt_pk_bf16(s0 * rc - bflo(c.x), s1 * rc - bfhi(c.x)); o.y = cvt_pk_bf16(s2 * rc - bflo(c.y), s3 * rc - bfhi(c.y));
        *(u32x2*)(PO + (size_t)(r0 + i) * PW + c4) = o;
    }
}
__device__ __forceinline__ void attn_unit(const Frame& F, int unit, const bf16* Q, const bf16* KB, const bf16* VB, const float* sinks, bf16* AO, const bf16* U, bf16* PO, int pool_chunk, const float* w_down, fp8* WDN8, bool first) {
    const int lane = F.lane, wid = F.wave, r32 = lane & 31, hi = lane >> 5;
    const int b = unit >> 6, n = (unit >> 1) & 31, hkv = unit & 1;
    LAS unsigned char* Kt = F.lds; LAS unsigned char* Vt = F.lds + 32768;
    const int tok0 = b * SEQ + 128 * (n - 1);
    int hq = hkv * 8 + 2 * (wid & 3);
    if (!first) __syncthreads();
    bf16x8 qn[4];
    if (wid >= 4) {
        const int it = unit * 4 + (wid - 4), e = it >> 6, q = it & 63, kb = q >> 3, nb = q & 7;
        conv_item8<1>(w_down + (size_t)e * 1024 * 1024, 1024, WDN8 + (size_t)e * 1024 * 1024, 1024, kb * 128, nb * 128, nb * 128, lane, F.lds + 65536 + (wid - 4) * 16384);
    } else {
        const __amdgpu_buffer_rsrc_t rsK = __builtin_amdgcn_make_buffer_rsrc((void*)KB, 0, 0x7fffffff, 0x00020000), rsV = __builtin_amdgcn_make_buffer_rsrc((void*)VB, 0, 0x7fffffff, 0x00020000);
        int ln = lane; asm volatile("" : "+v"(ln));
#pragma unroll
        for (int i = 0; i < 8; ++i) { const int row = (i * 4 + wid) * 8 + (ln >> 3), pp = ln & 7; int tok = tok0 + row; tok = tok < b * SEQ ? b * SEQ + row : tok;
            const int ck = pp ^ ((row >> 1) & 7), cv = pp ^ (((row >> 1) & 1) << 2);
            __builtin_amdgcn_raw_ptr_buffer_load_lds(rsK, (LAS void*)(Kt + (i * 4 + wid) * 1024), 16, tok * 256 + hkv * 128 + ck * 16, 0, 0, 0);
            __builtin_amdgcn_raw_ptr_buffer_load_lds(rsV, (LAS void*)(Vt + (i * 4 + wid) * 1024), 16, tok * 256 + hkv * 128 + cv * 16, 0, 0, 0); }
        const size_t qrow = (size_t)b * SEQ + 128 * n + r32;
#pragma unroll
        for (int ks = 0; ks < 4; ++ks) qn[ks] = *(const bf16x8*)(Q + qrow * 1024 + hq * 64 + ks * 16 + hi * 8);
    }
    if (pool_chunk >= 0) { const int g = wid >> 1, t0 = pool_chunk * 64;
        if (g == 0) pool_rows<2>(U, PO, t0, wid, lane); else if (g == 1) pool_rows<4>(U, PO, t0, wid, lane); else if (g == 2) pool_rows<8>(U, PO, t0, wid, lane); else pool_rows<16>(U, PO, t0, wid, lane); }
    VM_WAIT();
    __syncthreads();
    if (wid >= 4) {
        const int it = unit * 4 + (wid - 4) + 1024, e = it >> 6, q = it & 63, kb = q >> 3, nb = q & 7;
        conv_item8<1>(w_down + (size_t)e * 1024 * 1024, 1024, WDN8 + (size_t)e * 1024 * 1024, 1024, kb * 128, nb * 128, nb * 128, lane, F.lds + 65536 + (wid - 4) * 16384);
        return;
    }
    constexpr float LOG2E = 1.44269504089f, C2 = 0.125f * LOG2E;
#pragma unroll 1
    for (int hsel = 0; hsel < 2; ++hsel) {
    const float sink = sinks[hq];
    if (hsel == 1) { const size_t qrow = (size_t)b * SEQ + 128 * n + r32;
#pragma unroll
        for (int ks = 0; ks < 4; ++ks) qn[ks] = *(const bf16x8*)(Q + qrow * 1024 + hq * 64 + ks * 16 + hi * 8); }
#pragma unroll 1
    for (int j = 0; j < 4; ++j) {
        const size_t qrow = (size_t)b * SEQ + 128 * n + 32 * j + r32;
        bf16x8 qf[4];
#pragma unroll
        for (int ks = 0; ks < 4; ++ks) qf[ks] = qn[ks];
        if (j < 3) {
#pragma unroll
            for (int ks = 0; ks < 4; ++ks) qn[ks] = *(const bf16x8*)(Q + (qrow + 32) * 1024 + hq * 64 + ks * 16 + hi * 8); }
        int r32v = r32; asm volatile("" : "+v"(r32v));
        f32x16 s[5];
#pragma unroll
        for (int tau = 0; tau < 5; ++tau) {
            const int kt = j + tau; const int krow = 32 * kt + r32;
            f32x16 a = {0.f, 0.f, 0.f, 0.f, 0.f, 0.f, 0.f, 0.f, 0.f, 0.f, 0.f, 0.f, 0.f, 0.f, 0.f, 0.f};
#pragma unroll
            for (int ks = 0; ks < 4; ++ks) { const bf16x8 kf = *(const LAS bf16x8*)(Kt + krow * 128 + (((2 * ks + hi) ^ ((krow >> 1) & 7)) << 4));
                a = __builtin_amdgcn_mfma_f32_32x32x16_bf16(kf, qf[ks], a, 0, 0, 0); }
            s[tau] = a;
        }
        float mx = -1.0e30f;
#pragma unroll
        for (int tau = 0; tau < 5; ++tau) { const bool dead = (n == 0) && (j + tau < 4);
#pragma unroll
            for (int r = 0; r < 16; ++r) { const int kk = (r & 3) + 8 * (r >> 2) + 4 * hi; bool ok = !dead; if (tau == 0) ok = ok && (kk > r32v); if (tau == 4) ok = ok && (kk <= r32v);
                s[tau][r] = ok ? s[tau][r] : -1.0e30f; mx = fmaxf(mx, s[tau][r]); } }
        mx = fmaxf(mx, __shfl_xor(mx, 32));
        const float mm = fmaxf(mx * 0.125f, sink), mml = mm * LOG2E;
        float sum = 0.f;
#pragma unroll
        for (int tau = 0; tau < 5; ++tau)
#pragma unroll
            for (int r = 0; r < 16; ++r) { const float p = (s[tau][r] > -1.0e29f) ? __builtin_amdgcn_exp2f(s[tau][r] * C2 - mml) : 0.f; s[tau][r] = p; sum += p; }
        sum += __shfl_xor(sum, 32);
        sum += __builtin_amdgcn_exp2f((sink - mm) * LOG2E);
        const float inv = 1.0f / sum;
        bf16* orow = AO + qrow * 1024 + hq * 64;
#pragma unroll
        for (int d0 = 0; d0 < 2; ++d0) {
            f32x16 o = {0.f, 0.f, 0.f, 0.f, 0.f, 0.f, 0.f, 0.f, 0.f, 0.f, 0.f, 0.f, 0.f, 0.f, 0.f, 0.f};
#pragma unroll
            for (int tau = 0; tau < 5; ++tau) {
                const int kt = j + tau;
#pragma unroll
                for (int s2 = 0; s2 < 2; ++s2) {
                    bf16x8 pf; { const unsigned w0 = cvt_pk_bf16(s[tau][8 * s2 + 0], s[tau][8 * s2 + 1]), w1 = cvt_pk_bf16(s[tau][8 * s2 + 2], s[tau][8 * s2 + 3]), w2 = cvt_pk_bf16(s[tau][8 * s2 + 4], s[tau][8 * s2 + 5]), w3 = cvt_pk_bf16(s[tau][8 * s2 + 6], s[tau][8 * s2 + 7]);
                        const u32x4 w = {w0, w1, w2, w3}; pf = __builtin_bit_cast(bf16x8, w); }
                    const int vrow = 32 * kt + 16 * s2 + 4 * hi + ((lane & 15) >> 2);
                    const int vcb = 64 * d0 + 32 * ((lane >> 4) & 1) + 8 * (lane & 3);
                    const int vaddr = vrow * 128 + (vcb ^ (((vrow >> 1) & 1) << 6));
                    const s16x4 lo = __builtin_bit_cast(s16x4, __builtin_amdgcn_ds_read_tr16_b64_v4i16((LAS s16x4*)(Vt + vaddr)));
                    const s16x4 hh = __builtin_bit_cast(s16x4, __builtin_amdgcn_ds_read_tr16_b64_v4i16((LAS s16x4*)(Vt + vaddr + 1024)));
                    const bf16x8 vf = {lo[0], lo[1], lo[2], lo[3], hh[0], hh[1], hh[2], hh[3]};
                    o = __builtin_amdgcn_mfma_f32_32x32x16_bf16(vf, pf, o, 0, 0, 0);
                }
            }
#pragma unroll
            for (int rg = 0; rg < 4; ++rg) { u32x2 w; w.x = cvt_pk_bf16(o[4 * rg] * inv, o[4 * rg + 1] * inv); w.y = cvt_pk_bf16(o[4 * rg + 2] * inv, o[4 * rg + 3] * inv);
                *(u32x2*)(orow + 32 * d0 + 8 * rg + 4 * hi) = w; }
        }
    }
    ++hq;
    }
}

__device__ __forceinline__ void moe_tables(const Frame& F) {
    LAS int* tb = (LAS int*)(F.lds + TBL_OFF);
    __syncthreads();
    if (F.tid < 32) tb[192 + F.tid] = (int)__hip_atomic_load(F.ctl + CW_CNT + F.tid, RLX_AGENT);
    __syncthreads();
    if (F.tid == 0) { int u8 = 0, u4 = 0, ro = 0;
        for (int e = 0; e < 32; ++e) { const int c = tb[192 + e], r = (c + 255) >> 8; tb[e] = u8; tb[64 + e] = u4; tb[128 + e] = ro; u8 += r * 8; u4 += r * 4; ro += r * 256; }
        tb[32] = u8; tb[64 + 32] = u4; tb[128 + 32] = ro; }
    if (F.wave == 0) {
        const int e = F.lane & 31, R = (tb[192 + e] + 255) >> 8, L = R + (R >> 1); const bool odd = (R & 1) != 0;
        int lm = odd ? L : 0;
#pragma unroll
        for (int o = 16; o >= 1; o >>= 1) lm = max(lm, __shfl_xor(lm, o));
        const unsigned long long bx = __ballot(odd && L == lm), bh = __ballot(!odd && L + 1 <= lm);
        if (F.lane == 0) { tb[224] = (int)(unsigned)bx; tb[225] = (int)(unsigned)bh; }
    }
    __syncthreads();
}

__device__ __forceinline__ void router_chunk(const Frame& F, int chunk, const float* x, const bf16* X1, const float* g2, const bf16* WRH, const bf16* WRL, const float* br, fp8* H2, gu32* counts, int* stok, int* toke, float* tokg) {
    const int tid = F.tid, lane = F.lane, w = F.wave, i32 = lane & 31, hh = lane >> 5;
    LAS unsigned char* lds = F.lds;
    LAS float* logit = (LAS float*)(lds + RT_LOGIT); LAS int* tokE = (LAS int*)(lds + RT_TOKE); LAS int* tokR = (LAS int*)(lds + RT_TOKR); LAS float* tokG = (LAS float*)(lds + RT_TOKG);
    LAS unsigned* hist = (LAS unsigned*)(lds + RT_HIST); LAS unsigned* base = (LAS unsigned*)(lds + RT_BASE);
    LAS float* g2l = (LAS float*)(lds + RT_LOGIT + 4224);
    const __amdgpu_buffer_rsrc_t rsX = __builtin_amdgcn_make_buffer_rsrc((void*)x, 0, 0x7fffffff, 0x00020000), rsD = __builtin_amdgcn_make_buffer_rsrc((void*)X1, 0, 0x7fffffff, 0x00020000), rsH = __builtin_amdgcn_make_buffer_rsrc((void*)H2, 0, 0x7fffffff, 0x00020000);
    const int vx = lane * 16, vd = lane * 8, vh = lane * 4;
    f32x4 xv[4][4];
#pragma unroll
    for (int q = 0; q < 4; ++q) { const int so = (chunk * 64 + 4 * w + q) * (D * 4);
#pragma unroll
        for (int j = 0; j < 4; ++j) xv[q][j] = __builtin_bit_cast(f32x4, __builtin_amdgcn_raw_buffer_load_b128(rsX, vx + 1024 * j, so, 0)); }
    bf16x8 bh[8], bl[8];
    __syncthreads();
    if (tid < 32) hist[tid] = 0u;
    *(LAS f32x2*)(g2l + 2 * tid) = *(const f32x2*)(g2 + 2 * tid);
    __syncthreads();
#pragma unroll
    for (int p = 0; p < 2; ++p) {
        const int r0 = chunk * 64 + 32 * p;
#pragma unroll
        for (int qh = 0; qh < 2; ++qh) {
            u32x2 dv[2][4];
#pragma unroll
            for (int q2 = 0; q2 < 2; ++q2)
#pragma unroll
                for (int j = 0; j < 4; ++j) dv[q2][j] = __builtin_bit_cast(u32x2, __builtin_amdgcn_raw_buffer_load_b64(rsD, vd + 512 * j, (r0 + 4 * w + 2 * qh + q2) * (D * 2), 0));
#pragma unroll
            for (int q2 = 0; q2 < 2; ++q2) { const int q = 2 * qh + q2, rl = 4 * w + q, row = r0 + rl; float s = 0.f;
#pragma unroll
                for (int j = 0; j < 4; ++j) { const u32x2 dw = dv[q2][j]; const f32x4 t = xv[q][j] + (f32x4){bflo(dw.x), bfhi(dw.x), bflo(dw.y), bfhi(dw.y)}; xv[q][j] = t; s += t.x * t.x + t.y * t.y + t.z * t.z + t.w * t.w; }
                const float rstd = rsqrtf(wave_sum(s) * (1.f / D) + RMS_EPS);
#pragma unroll
                for (int j = 0; j < 4; ++j) { const f32x4 o = xv[q][j] * rstd * *(const LAS f32x4*)(g2l + 4 * lane + 256 * j); int pk = 0; pk = __builtin_amdgcn_cvt_pk_fp8_f32(o[0], o[1], pk, false); pk = __builtin_amdgcn_cvt_pk_fp8_f32(o[2], o[3], pk, true);
                    __builtin_amdgcn_raw_buffer_store_b32((unsigned)pk, rsH, vh + 256 * j, row * D, 0); *(LAS f32x4*)(lds + rl * HB_STRIDE + (4 * lane + 256 * j) * 4) = o; } }
        }
        if (p == 0) {
            { const bf16* ph = WRH + (size_t)i32 * 1024 + 128 * w + 8 * hh; const bf16* pl = WRL + (size_t)i32 * 1024 + 128 * w + 8 * hh;
#pragma unroll
              for (int ks = 0; ks < 8; ++ks) { bh[ks] = *(const bf16x8*)(ph + 16 * ks); bl[ks] = *(const bf16x8*)(pl + 16 * ks); } }
#pragma unroll
            for (int q = 0; q < 4; ++q) { const int so = (chunk * 64 + 32 + 4 * w + q) * (D * 4);
#pragma unroll
                for (int j = 0; j < 4; ++j) xv[q][j] = __builtin_bit_cast(f32x4, __builtin_amdgcn_raw_buffer_load_b128(rsX, vx + 1024 * j, so, 0)); } }
        __syncthreads();
        f32x16 acc = {0.f, 0.f, 0.f, 0.f, 0.f, 0.f, 0.f, 0.f, 0.f, 0.f, 0.f, 0.f, 0.f, 0.f, 0.f, 0.f};
#pragma unroll
        for (int ks = 0; ks < 8; ++ks) {
            const LAS float* hp = (const LAS float*)(lds + i32 * HB_STRIDE + (128 * w + 16 * ks + 8 * hh) * 4);
            const f32x4 a0 = *(const LAS f32x4*)hp, a1 = *(const LAS f32x4*)(hp + 4);
            u32x4 whi, wlo;
            whi.x = cvt_pk_bf16(a0[0], a0[1]); whi.y = cvt_pk_bf16(a0[2], a0[3]); whi.z = cvt_pk_bf16(a1[0], a1[1]); whi.w = cvt_pk_bf16(a1[2], a1[3]);
            wlo.x = cvt_pk_bf16(a0[0] - bflo(whi.x), a0[1] - bfhi(whi.x)); wlo.y = cvt_pk_bf16(a0[2] - bflo(whi.y), a0[3] - bfhi(whi.y));
            wlo.z = cvt_pk_bf16(a1[0] - bflo(whi.z), a1[1] - bfhi(whi.z)); wlo.w = cvt_pk_bf16(a1[2] - bflo(whi.w), a1[3] - bfhi(whi.w));
            const bf16x8 ahi = __builtin_bit_cast(bf16x8, whi), alo = __builtin_bit_cast(bf16x8, wlo);
            acc = __builtin_amdgcn_mfma_f32_32x32x16_bf16(ahi, bh[ks], acc, 0, 0, 0);
            acc = __builtin_amdgcn_mfma_f32_32x32x16_bf16(ahi, bl[ks], acc, 0, 0, 0);
            acc = __builtin_amdgcn_mfma_f32_32x32x16_bf16(alo, bh[ks], acc, 0, 0, 0);
        }
        __syncthreads();
        LAS float* part = (LAS float*)lds;
#pragma unroll
        for (int r = 0; r < 16; ++r) { const int tk = (r & 3) + 8 * (r >> 2) + 4 * hh; part[(w * 32 + tk) * 33 + i32] = acc[r]; }
        __syncthreads();
#pragma unroll
        for (int q = 0; q < 2; ++q) { const int o = tid + 512 * q, tk = o >> 5, e = o & 31; float sacc = br[e];
#pragma unroll
            for (int ww = 0; ww < 8; ++ww) sacc += part[(ww * 32 + tk) * 33 + e];
            logit[(32 * p + tk) * 33 + e] = sacc; }
        __syncthreads();
    }
    if (tid < 64) {
        float lg[32];
#pragma unroll
        for (int e = 0; e < 32; ++e) lg[e] = logit[tid * 33 + e];
        int be[4]; float bv[4]; unsigned used = 0u;
#pragma unroll
        for (int k = 0; k < 4; ++k) { float best = -3.0e38f; int bi = 0;
#pragma unroll
            for (int e = 0; e < 32; ++e) { const bool ok = !((used >> e) & 1u) && lg[e] > best; best = ok ? lg[e] : best; bi = ok ? e : bi; }
            be[k] = bi; bv[k] = best; used |= 1u << bi; }
        float ex[4], se = 0.f;
#pragma unroll
        for (int k = 0; k < 4; ++k) { ex[k] = __expf(bv[k] - bv[0]); se += ex[k]; }
        const float rse = 1.0f / se;
#pragma unroll
        for (int k = 0; k < 4; ++k) { const unsigned rk = __hip_atomic_fetch_add(hist + be[k], 1u, __ATOMIC_RELAXED, __HIP_MEMORY_SCOPE_WORKGROUP);
            tokE[tid * 4 + k] = be[k]; tokR[tid * 4 + k] = (int)rk; tokG[tid * 4 + k] = ex[k] * rse; }
    }
    __syncthreads();
    if (tid < 32) { const unsigned hc = hist[tid]; base[tid] = hc ? __hip_atomic_fetch_add(counts + tid, hc, RLX_AGENT) : 0u; }
    __syncthreads();
    if (tid < 256) { const int tk = tid >> 2, k = tid & 3, e = tokE[tk * 4 + k], pos = (int)base[e] + tokR[tk * 4 + k], t = chunk * 64 + tk;
        stok[e * CAP + pos] = t; toke[t * 4 + k] = e | (pos << 8); tokg[t * 4 + k] = tokG[tk * 4 + k]; }
}

__device__ __forceinline__ void combine_rows(const Frame& F, const float* x, const bf16* X1, const fp8* YS, const int* toke, const float* tokg, const float* gf, float* out) {
    const int lane = F.lane; const LAS int* rowoff = (const LAS int*)(F.lds + TBL_OFF) + 128;
    f32x4 gg[4];
#pragma unroll
    for (int j = 0; j < 4; ++j) gg[j] = ((const f32x4*)gf)[lane + 64 * j];
    for (int t = F.bx * NWAVES + F.wave; t < T; t += F.G * NWAVES) {
        f32x4 v[4];
#pragma unroll
        for (int j = 0; j < 4; ++j) { const u32x2 dw = __builtin_nontemporal_load((const u32x2*)(X1 + (size_t)t * D + 4 * lane + 256 * j)); v[j] = __builtin_nontemporal_load((const f32x4*)(x + (size_t)t * D) + lane + 64 * j) + (f32x4){bflo(dw.x), bfhi(dw.x), bflo(dw.y), bfhi(dw.y)}; }
        const int4 te = *(const int4*)(toke + t * 4); const f32x4 tg = *(const f32x4*)(tokg + t * 4);
        const int tes[4] = {te.x, te.y, te.z, te.w};
#pragma unroll
        for (int k = 0; k < 4; ++k) { const int e = tes[k] & 255, pos = tes[k] >> 8; const float g = tg[k];
            const fp8* y = YS + (size_t)(rowoff[e] + pos) * 1024 + 4 * lane;
#pragma unroll
            for (int j = 0; j < 4; ++j) { const int pw = __builtin_nontemporal_load((const int*)(y + 256 * j)); const f32x2 lo = __builtin_amdgcn_cvt_pk_f32_fp8(pw, false), hi2 = __builtin_amdgcn_cvt_pk_f32_fp8(pw, true);
                v[j].x += g * lo[0]; v[j].y += g * lo[1]; v[j].z += g * hi2[0]; v[j].w += g * hi2[1]; } }
        float s = 0.f;
#pragma unroll
        for (int j = 0; j < 4; ++j) s += v[j].x * v[j].x + v[j].y * v[j].y + v[j].z * v[j].z + v[j].w * v[j].w;
        const float rstd = rsqrtf(wave_sum(s) * (1.f / D) + RMS_EPS);
#pragma unroll
        for (int j = 0; j < 4; ++j) __builtin_nontemporal_store(v[j] * rstd * gg[j], (f32x4*)(out + (size_t)t * D) + lane + 64 * j);
    }
}

constexpr int N_PHASES = 9;
__global__ void __launch_bounds__(NTHR, 2) fwd(Args a) {
    extern __shared__ __attribute__((aligned(16))) unsigned char lds_raw[];
    Frame F; F.lds = (LAS unsigned char*)lds_raw; F.tid = threadIdx.x; F.lane = F.tid & 63; F.wave = __builtin_amdgcn_readfirstlane(F.tid >> 6); F.G = gridDim.x; F.bx = blockIdx.x;
    F.ws = a.ws; F.ctl = (gu32*)(a.ws + WS_CTL);
    volatile LAS unsigned* MISC = (volatile LAS unsigned*)(F.lds + MISC_OFF);
    if (F.tid < 32) MISC[F.tid] = 0u;
    __syncthreads();
    XcdBarrier bar = xcd_barrier_post((unsigned*)(F.ctl + CW_BAR) + a.li * 4096, MISC + 8);
    unsigned char* const ws = a.ws;
#define WIN ((bf16*)(ws + WS_WIN))
#define WATT ((bf16*)(ws + WS_WATT))
#define WEFF ((bf16*)(ws + WS_WEFF))
#define WOUT ((bf16*)(ws + WS_WOUT))
#define CS ((float*)(ws + WS_CS))
#define WUP ((fp8*)(ws + WS_WUP))
#define WDN ((fp8*)(ws + WS_WDN))
#define H ((bf16*)(ws + WS_H))
#define H2 ((fp8*)(ws + WS_H2))
#define Q ((bf16*)(ws + WS_Q))
#define KB ((bf16*)(ws + WS_KB))
#define VB ((bf16*)(ws + WS_VB))
#define U ((bf16*)(ws + WS_U))
#define PO ((bf16*)(ws + WS_PO))
#define GA ((bf16*)(ws + WS_GA))
#define GP ((bf16*)(ws + WS_GP))
#define AO ((bf16*)(ws + WS_AO))
#define T1 ((bf16*)(ws + WS_T1))
#define MG ((bf16*)(ws + WS_MG))
#define X1 ((bf16*)(ws + WS_X1))
#define STOK ((int*)(ws + WS_STOK))
#define TOKE ((int*)(ws + WS_TOKE))
#define TOKG ((float*)(ws + WS_TOKG))
#define ACT ((fp8*)(ws + WS_ACT))
#define YS ((fp8*)(ws + WS_YS))
    const int lo = a.ph_lo, hi = a.ph_hi;
#define IN(k) (lo <= (k) && (k) < hi)
#define SEAM(k) do { if (IN(k) && IN((k) + 1)) xcd_barrier(bar); } while (0)
#define FRESH() do { int t_ = (int)threadIdx.x; asm volatile("" : "+v"(t_)); F.tid = t_; F.lane = t_ & 63; F.wave = __builtin_amdgcn_readfirstlane(t_ >> 6); } while (0)

    if (IN(0)) { FRESH(); p0b_weights(F, a, F.bx, F.G); p0_prologue(F, a); }
    SEAM(0);
    if (IN(1)) { FRESH();
        pg8::DenseOrder S; S.init(T, INW, F.G, F.bx);
        pg8::EpiInProj E{a.in[4], CS, Q, KB, VB, U, GA, GP};
        pg8::gemm_phase<pg8::EpiInProj, pg8::DenseOrder, 1024, false, false>(F.lds, H, WIN, 0, S, E, nullptr);
    }
    SEAM(1);
    if (IN(2)) { FRESH();
        for (int u = F.bx; u < 256; u += F.G) attn_unit(F, u, Q, KB, VB, a.in[5], AO, U, PO, u, a.in[16], WDN, u == F.bx);
        __syncthreads();
    }
    SEAM(2);
    if (IN(3)) { FRESH();
        pg8::DenseOrder S; S.init(T, 1024, F.G, F.bx);
        { pg8::EpiGateA E{GA, T1}; pg8::gemm_phase<pg8::EpiGateA, pg8::DenseOrder, 1024, false, false>(F.lds, AO, WATT, 0, S, E, nullptr); }
        VM_WAIT(); __syncthreads();
        { pg8::EpiMerge E{GP, T1, MG}; pg8::gemm_phase<pg8::EpiMerge, pg8::DenseOrder, 512, false, false>(F.lds, PO, WEFF, 0, S, E, nullptr); }
    }
    SEAM(3);
    if (IN(4)) { FRESH();
        pg8::DenseOrder S; S.init(T, 1024, F.G, F.bx);
        pg8::EpiX1 E{X1};
        pg8::gemm_phase<pg8::EpiX1, pg8::DenseOrder, 1024, false, false>(F.lds, MG, WOUT, 0, S, E, nullptr);
    }
    SEAM(4);
    if (IN(5)) { FRESH();
        for (int ch = F.bx; ch < T / 64; ch += F.G) router_chunk(F, ch, a.in[0], X1, a.in[11], (const bf16*)(ws + WS_WRH), (const bf16*)(ws + WS_WRL), a.in[13], H2, F.ctl + CW_CNT, STOK, TOKE, TOKG);
        __syncthreads();
    }
    SEAM(5);
    if (IN(6)) { FRESH();
        moe_tables(F);
        const LAS int* tb = (const LAS int*)(F.lds + TBL_OFF);
        pg8::EpiSwiglu E{a.in[15], ACT};
        pg8::MoeOrderX<true> S{tb + 128, tb + 192, 3, F.G, F.bx};
        pg8::gemm_phase<pg8::EpiSwiglu, pg8::MoeOrderX<true>, 1024, true, true>(F.lds, H2, WUP, (size_t)2048 * 1024, S, E, STOK);
        VM_WAIT(); __syncthreads();
        if (F.tid == 0) {
            __builtin_amdgcn_fence(__ATOMIC_RELEASE, "agent"); VM_WAIT();
            for (int v = F.bx; v < 256; v += F.G) { const int e = (v & 7) + 8 * ((v >> 3) >> 3); (void)xb_add((unsigned*)(F.ctl + CW_DONE + 64 * e), 1u); }
        }
    }
    if (IN(7)) { FRESH();
        moe_tables(F);
        const LAS int* tb = (const LAS int*)(F.lds + TBL_OFF);
        const unsigned mx = (unsigned)__builtin_amdgcn_readfirstlane(tb[224]), mh = (unsigned)__builtin_amdgcn_readfirstlane(tb[225]);
        pg8::EpiDown E{a.in[17], YS};
        {   pg8::MoeOrderOwn S{tb + 128, tb + 192, mx, mh, F.G, F.bx};
            if (F.tid == 0) { pg8::GUnit u; unsigned seen = 0u;
                for (int i = 0; S.next(i, u); ++i) { if ((seen >> u.e) & 1u) continue; seen |= 1u << u.e; unsigned* p = (unsigned*)(F.ctl + CW_DONE + 64 * u.e); XB_SPIN(xb_ld(p) < 8u, bar.bar); }
                __builtin_amdgcn_fence(__ATOMIC_ACQUIRE, "agent"); VM_WAIT(); }
            __syncthreads();
            pg8::gemm_phase<pg8::EpiDown, pg8::MoeOrderOwn, 1024, false, true>(F.lds, ACT, WDN, (size_t)1024 * 1024, S, E, nullptr);
        }
        {   pg8::MoeOrderSteal S{tb + 128, tb + 192, mx, mh, F.G, F.bx};
            pg8::GUnit u0;
            if (S.next(0, u0)) {
                VM_WAIT(); __syncthreads();
                if (F.tid == 0) { pg8::GUnit u;
                    for (int i = 0; S.next(i, u); ++i) { unsigned* p = (unsigned*)(F.ctl + CW_DONE + 64 * u.e); XB_SPIN(xb_ld(p) < 8u, bar.bar); }
                    __builtin_amdgcn_fence(__ATOMIC_ACQUIRE, "agent"); VM_WAIT(); }
                __syncthreads();
                pg8::gemm_phase<pg8::EpiDown, pg8::MoeOrderSteal, 1024, false, true>(F.lds, ACT, WDN, (size_t)1024 * 1024, S, E, nullptr);
            }
        }
    }
    SEAM(7);
    if (IN(8)) { FRESH();
        moe_tables(F);
        combine_rows(F, a.in[0], X1, YS, TOKE, TOKG, a.in[18], a.out);
    }
#undef IN
#undef SEAM
#undef WIN
#undef WATT
#undef WEFF
#undef WOUT
#undef CS
#undef WUP
#undef WDN
#undef H
#undef H2
#undef Q
#undef KB
#undef VB
#undef U
#undef PO
#undef GA
#undef GP
#undef AO
#undef T1
#undef MG
#undef X1
#undef STOK
#undef TOKE
#undef TOKG
#undef ACT
#undef YS
}

#ifndef REPEAT_MASK
#define REPEAT_MASK 0
#endif
#ifndef FAST_MASK
#define FAST_MASK 0x1ff
#endif
#ifndef ONE_LAUNCH
#define ONE_LAUNCH 1
#endif
extern "C" void kernel_launch(void* const* d_in, const int* in_sizes, int n_in, void* d_out, int out_size, void* d_ws, size_t ws_size, hipStream_t stream) {
    if (n_in != 19 || out_size != T * D || ws_size < WS_END) { fprintf(stderr, "kernel_launch: unexpected shapes / workspace (n_in %d, out %d, ws %zu)\n", n_in, out_size, ws_size); return; }
    const float* x = (const float*)d_in[0]; const int* positions = (const int*)d_in[1]; const float* norm1_g = (const float*)d_in[2];
    const float* w_in = (const float*)d_in[3]; const float* b_in = (const float*)d_in[4]; const float* sinks = (const float*)d_in[5];
    const float* w_attn = (const float*)d_in[6]; const float* pool_w = (const float*)d_in[7]; const float* pool_scale = (const float*)d_in[8];
    const float* w_pool = (const float*)d_in[9]; const float* w_out = (const float*)d_in[10]; const float* norm2_g = (const float*)d_in[11];
    const float* w_router = (const float*)d_in[12]; const float* b_router = (const float*)d_in[13]; const float* w_up = (const float*)d_in[14];
    const float* b_up = (const float*)d_in[15]; const float* w_down = (const float*)d_in[16]; const float* b_down = (const float*)d_in[17];
    const float* normf_g = (const float*)d_in[18];
    unsigned char* ws = (unsigned char*)d_ws; float* out = (float*)d_out;
    unsigned* ctl = (unsigned*)(ws + WS_CTL);
    bf16* WIN = (bf16*)(ws + WS_WIN); bf16* WATT = (bf16*)(ws + WS_WATT); bf16* WEFF = (bf16*)(ws + WS_WEFF); bf16* WOUT = (bf16*)(ws + WS_WOUT);
    float* CS = (float*)(ws + WS_CS); fp8* WUP = (fp8*)(ws + WS_WUP); fp8* WDN = (fp8*)(ws + WS_WDN);
    bf16* H = (bf16*)(ws + WS_H); bf16* Q = (bf16*)(ws + WS_Q); bf16* KB = (bf16*)(ws + WS_KB); bf16* VB = (bf16*)(ws + WS_VB);
    bf16* U = (bf16*)(ws + WS_U); bf16* PO = (bf16*)(ws + WS_PO); bf16* GA = (bf16*)(ws + WS_GA); bf16* GP = (bf16*)(ws + WS_GP);
    bf16* AO = (bf16*)(ws + WS_AO); bf16* MG = (bf16*)(ws + WS_MG); bf16* X1 = (bf16*)(ws + WS_X1);
    int* STOK = (int*)(ws + WS_STOK); int* TOKE = (int*)(ws + WS_TOKE); float* TOKG = (float*)(ws + WS_TOKG);
    fp8* ACT = (fp8*)(ws + WS_ACT); fp8* YS = (fp8*)(ws + WS_YS); float* TMP = (float*)(ws + WS_TMP); float* TMP2 = TMP + (size_t)T * D;
    unsigned* counts = ctl + CW_CNT;

    static int grid = 0;
    if (grid == 0) {
        int dev = 0, cus = 0;
        if (hipGetDevice(&dev) != hipSuccess || hipDeviceGetAttribute(&cus, hipDeviceAttributeMultiprocessorCount, dev) != hipSuccess) { fprintf(stderr, "kernel_launch: device query failed\n"); grid = -1; return; }
        if (hipFuncSetAttribute((const void*)fwd, hipFuncAttributeMaxDynamicSharedMemorySize, LDS_BYTES) != hipSuccess) { fprintf(stderr, "kernel_launch: hipFuncSetAttribute failed\n"); grid = -1; return; }
        int per_cu = 0;
        if (hipOccupancyMaxActiveBlocksPerMultiprocessor(&per_cu, (const void*)fwd, NTHR, LDS_BYTES) != hipSuccess || per_cu < 1) fprintf(stderr, "kernel_launch: occupancy query says %d blocks per CU\n", per_cu);
        (void)hipGetLastError();
        grid = cus > 256 ? 256 : cus;
    }
    if (grid < 0) return;
    (void)hipMemsetAsync(ws + WS_CTL, 0, CTL_ZERO_BYTES, stream);
    Args a{};
    for (int i = 0; i < 19; ++i) a.in[i] = (const float*)d_in[i];
    a.out = out; a.ws = ws; a.pad = 0;
    int li = 0;
#define RUN_FAST(lo_, hi_) do { a.ph_lo = (lo_); a.ph_hi = (hi_); a.li = li < 3 ? li : 2; ++li; for (int rep_ = 0; rep_ < ((((hi_) - (lo_)) == 1 && ((REPEAT_MASK >> (lo_)) & 1) && (lo_) != 5) ? 2 : 1); ++rep_) hipLaunchKernelGGL(fwd, dim3(grid), dim3(NTHR), LDS_BYTES, stream, a); } while (0)
#if ONE_LAUNCH
    RUN_FAST(0, N_PHASES);
#else
    if (FAST_MASK & 1) RUN_FAST(0, 1); else {
        n_transpose<<<2048, 256, 0, stream>>>(w_in, 1024, INW, WIN, INW, 0);
        n_transpose<<<1024, 256, 0, stream>>>(w_attn, 1024, 1024, WATT, 1024, 0);
        n_transpose<<<1024, 256, 0, stream>>>(w_out, 1024, 1024, WOUT, 1024, 0);
        for (int e = 0; e < NE; ++e) {
            n_transpose8<<<2048, 256, 0, stream>>>(w_up + (size_t)e * 1024 * 2048, 1024, 2048, WUP + (size_t)e * 2048 * 1024, 2048, 1);
            n_transpose8<<<1024, 256, 0, stream>>>(w_down + (size_t)e * 1024 * 1024, 1024, 1024, WDN + (size_t)e * 1024 * 1024, 1024, 0);
        }
        n_weff<<<(1024 * 512) / 256, 256, 0, stream>>>(pool_w, pool_scale, w_pool, WEFF);
        n_rope_table<<<(T * 8) / 256, 256, 0, stream>>>(positions, CS);
        n_wr_split<<<128, 256, 0, stream>>>(w_router, (bf16*)(ws + WS_WRH), (bf16*)(ws + WS_WRL));
        n_rms_bf16<<<T / 4, 256, 0, stream>>>(x, norm1_g, H);
    }
    if (FAST_MASK & 2) RUN_FAST(1, 2); else {
        n_gemm<<<dim3(INW / 64, T / 64), 256, 0, stream>>>(H, WIN, TMP, T, INW, 1024);
        n_post_inproj<<<(unsigned)(((size_t)T * INW + 255) / 256), 256, 0, stream>>>(TMP, b_in, CS, Q, KB, VB, U, GA, GP);
    }
    if (FAST_MASK & 4) RUN_FAST(2, 3); else {
        if (FAST_MASK & 1) for (int e = 0; e < NE; ++e) n_transpose8<<<1024, 256, 0, stream>>>(w_down + (size_t)e * 1024 * 1024, 1024, 1024, WDN + (size_t)e * 1024 * 1024, 1024, 0);
        n_attn<<<(T * NQH) / 256, 256, 0, stream>>>(Q, KB, VB, sinks, AO);
        n_pool<<<(T * PW) / 256, 256, 0, stream>>>(U, PO);
    }
    if (FAST_MASK & 8) RUN_FAST(3, 4); else {
        n_gemm<<<dim3(1024 / 64, T / 64), 256, 0, stream>>>(AO, WATT, TMP, T, 1024, 1024);
        n_gemm<<<dim3(1024 / 64, T / 64), 256, 0, stream>>>(PO, WEFF, TMP2, T, 1024, 512);
        n_merge<<<(T * D) / 256, 256, 0, stream>>>(TMP, TMP2, GA, GP, MG);
    }
    if (FAST_MASK & 16) RUN_FAST(4, 5); else {
        n_gemm<<<dim3(1024 / 64, T / 64), 256, 0, stream>>>(MG, WOUT, TMP, T, 1024, 1024);
        n_x1<<<(T * D) / 256, 256, 0, stream>>>(x, TMP, X1);
    }
    if (FAST_MASK & 32) { if (REPEAT_MASK & 32) { a.ph_lo = 5; a.ph_hi = 6; a.li = 2; hipLaunchKernelGGL(fwd, dim3(grid), dim3(NTHR), LDS_BYTES, stream, a); (void)hipMemsetAsync(counts, 0, 128, stream); } RUN_FAST(5, 6); } else n_router<<<T / 4, 256, 0, stream>>>(x, X1, norm2_g, w_router, b_router, (fp8*)(ws + WS_H2), counts, STOK, TOKE, TOKG);
    if (FAST_MASK & 64) RUN_FAST(6, 7); else { n_moe_up<<<dim3(1024 / 64, T / 64, NE), 256, 0, stream>>>((const fp8*)(ws + WS_H2), STOK, counts, WUP, b_up, ACT); (void)hipMemsetAsync(ctl + CW_DONE, 8, 32 * 256, stream); }
    if (FAST_MASK & 128) RUN_FAST(7, 8); else n_moe_down<<<dim3(1024 / 64, T / 64, NE), 256, 0, stream>>>(ACT, counts, WDN, b_down, YS);
    if (FAST_MASK & 256) RUN_FAST(8, 9); else n_combine<<<T / 4, 256, 0, stream>>>(x, X1, YS, counts, TOKE, TOKG, normf_g, out);
#endif
    (void)in_sizes; (void)sinks; (void)positions; (void)norm1_g; (void)norm2_g; (void)w_router; (void)b_router; (void)b_up; (void)b_down; (void)normf_g; (void)b_in; (void)pool_w; (void)pool_scale; (void)w_pool;
    (void)w_in; (void)w_attn; (void)w_out; (void)w_up; (void)w_down; (void)x; (void)WIN; (void)WATT; (void)WEFF; (void)WOUT; (void)CS; (void)WUP; (void)WDN; (void)H; (void)Q; (void)KB; (void)VB; (void)U; (void)PO; (void)GA; (void)GP;
    (void)AO; (void)MG; (void)X1; (void)STOK; (void)TOKE; (void)TOKG; (void)ACT; (void)YS; (void)TMP; (void)TMP2; (void)counts;
}
```

```cpp
#include <hip/hip_runtime.h>
#include <cstdio>
#include <cstdint>

constexpr int BATCH = 4, SEQ = 4096, T = BATCH * SEQ, D = 1024;
constexpr int NQH = 16, NKVH = 2, HD = 64, WINDOW = 128;
constexpr int INW = 3840, O_K = 1024, O_V = 1152, O_P = 1280, O_GA = 1792, O_GP = 2816, PW = 512;
constexpr int NE = 32, TOPK = 4, DFF = 1024, CAP = T;
constexpr int NSLOT = T * TOPK + NE * 256;
constexpr float RMS_EPS = 1e-5f;

typedef unsigned short bf16;
typedef unsigned char fp8;
constexpr float W8_SCALE = 32.0f, W8_INV = 1.0f / 32.0f;
typedef float f32x4 __attribute__((ext_vector_type(4)));
typedef unsigned u32x4 __attribute__((ext_vector_type(4)));
typedef unsigned u32x2 __attribute__((ext_vector_type(2)));

constexpr size_t MiB = 1u << 20;
constexpr size_t WS_CTL = 0, CTL_ZERO_BYTES = 65536;
constexpr size_t WS_WIN = 2 * MiB;
constexpr size_t WS_WATT = 10 * MiB;
constexpr size_t WS_WEFF = 12 * MiB;
constexpr size_t WS_WOUT = 13 * MiB;
constexpr size_t WS_CS = 15 * MiB;
constexpr size_t WS_WUP = 16 * MiB;
constexpr size_t WS_WDN = 144 * MiB;
constexpr size_t WS_H = 208 * MiB;
constexpr size_t WS_Q = 240 * MiB;
constexpr size_t WS_KB = 272 * MiB;
constexpr size_t WS_VB = 276 * MiB;
constexpr size_t WS_U = 280 * MiB;
constexpr size_t WS_PO = 296 * MiB;
constexpr size_t WS_GA = 312 * MiB;
constexpr size_t WS_GP = 344 * MiB;
constexpr size_t WS_AO = 376 * MiB;
constexpr size_t WS_T1 = 408 * MiB;
constexpr size_t WS_MG = 440 * MiB;
constexpr size_t WS_X1 = 472 * MiB;
constexpr size_t WS_STOK = 536 * MiB;
constexpr size_t WS_TOKE = 538 * MiB;
constexpr size_t WS_TOKG = 539 * MiB;
constexpr size_t WS_WRH = 538 * MiB + 512 * 1024, WS_WRL = WS_WRH + 64 * 1024;
constexpr size_t WS_ACT = 540 * MiB;
constexpr size_t WS_YS = 684 * MiB;
constexpr size_t WS_H2 = 828 * MiB;
constexpr size_t WS_X1B = 844 * MiB;
constexpr size_t WS_END = 876 * MiB;
constexpr size_t WS_TMP = WS_ACT;
constexpr int CW_TMO = 0, CW_CODE = 1, CW_CNT = 64, CW_DONE = 128  , CW_BAR = 4096;

__device__ __forceinline__ float bf2f(bf16 v) { return __uint_as_float((unsigned)v << 16); }
__device__ __forceinline__ bf16 f2bf(float f) { unsigned u = __float_as_uint(f); return (bf16)((u + 0x7fffu + ((u >> 16) & 1u)) >> 16); }
__device__ __forceinline__ float sigmoidf_(float v) { return 1.0f / (1.0f + __expf(-v)); }
__device__ __forceinline__ float wave_sum(float v) {
#pragma unroll
    for (int o = 1; o < 64; o <<= 1) v += __shfl_xor(v, o);
    return v;
}
__device__ __forceinline__ float fp82f(fp8 v) { return __builtin_amdgcn_cvt_f32_fp8((int)v, 0); }
__device__ __forceinline__ fp8 f2fp8(float f) { return (fp8)(__builtin_amdgcn_cvt_pk_fp8_f32(f, f, 0, false) & 0xff); }
__device__ __forceinline__ int up_src_col(int np) { const int t = np >> 8, c = np & 255; return c < 128 ? 128 * t + c : 1024 + 128 * t + (c - 128); }

__global__ void __launch_bounds__(256) n_transpose(const float* W, int K, int N, bf16* WT, int NT, int upmap) {
    const size_t total = (size_t)NT * K;
    for (size_t idx = (size_t)blockIdx.x * blockDim.x + threadIdx.x; idx < total; idx += (size_t)gridDim.x * blockDim.x) {
        const int n = (int)(idx / K), k = (int)(idx % K); const int sc = upmap ? up_src_col(n) : n;
        WT[idx] = f2bf(W[(size_t)k * N + sc]);
    }
}
__global__ void __launch_bounds__(256) n_transpose8(const float* W, int K, int N, fp8* WT, int NT, int upmap) {
    const size_t total = (size_t)NT * K;
    for (size_t idx = (size_t)blockIdx.x * blockDim.x + threadIdx.x; idx < total; idx += (size_t)gridDim.x * blockDim.x) {
        const int n = (int)(idx / K), k = (int)(idx % K); const int sc = upmap ? up_src_col(n) : n;
        WT[idx] = f2fp8(W[(size_t)k * N + sc] * W8_SCALE);
    }
}
__global__ void __launch_bounds__(256) n_weff(const float* pw, const float* ps, const float* Wpb, bf16* WeffT) {
    const int idx = blockIdx.x * blockDim.x + threadIdx.x; if (idx >= 1024 * 512) return;
    const int n = idx / 512, k = idx % 512, g = k / 128, kk = k % 128; float a = 0.f;
    for (int c = 0; c < 128; ++c) a += pw[(g * 128 + kk) * 128 + c] * ps[g * 128 + c] * Wpb[(size_t)(g * 128 + c) * 1024 + n];
    WeffT[idx] = f2bf(a);
}
__global__ void __launch_bounds__(256) n_wr_split(const float* wr, bf16* WRH, bf16* WRL) {
    const int idx = blockIdx.x * blockDim.x + threadIdx.x; if (idx >= 32 * 1024) return;
    const int e = idx >> 10, k = idx & 1023; const float w = wr[k * 32 + e]; const bf16 h = f2bf(w); WRH[idx] = h; WRL[idx] = f2bf(w - bf2f(h));
}
__global__ void __launch_bounds__(256) n_rope_table(const int* pos, float* cs) {
    const int idx = blockIdx.x * blockDim.x + threadIdx.x; if (idx >= T * 8) return;
    const int t = idx >> 3, i = idx & 7; const float inv = powf(500000.0f, -(float)i * 0.125f); const float a = (float)pos[t] * inv;
    cs[t * 16 + i] = cosf(a); cs[t * 16 + 8 + i] = sinf(a);
}
__global__ void __launch_bounds__(256) n_rms_bf16(const float* x, const float* g, bf16* out) {
    const int row = blockIdx.x * 4 + (threadIdx.x >> 6), lane = threadIdx.x & 63;
    const f32x4* xr = (const f32x4*)(x + (size_t)row * D) + lane; f32x4 v[4]; float s = 0.f;
#pragma unroll
    for (int j = 0; j < 4; ++j) { v[j] = xr[64 * j]; s += v[j].x * v[j].x + v[j].y * v[j].y + v[j].z * v[j].z + v[j].w * v[j].w; }
    const float rstd = rsqrtf(wave_sum(s) * (1.f / D) + RMS_EPS);
#pragma unroll
    for (int j = 0; j < 4; ++j) { const f32x4 gg = ((const f32x4*)g)[lane + 64 * j]; bf16* o = out + (size_t)row * D + 4 * lane + 256 * j;
        o[0] = f2bf(v[j].x * rstd * gg.x); o[1] = f2bf(v[j].y * rstd * gg.y); o[2] = f2bf(v[j].z * rstd * gg.z); o[3] = f2bf(v[j].w * rstd * gg.w); }
}
__global__ void __launch_bounds__(256) n_gemm(const bf16* A, const bf16* Bt, float* C, int M, int N, int K) {
    __shared__ float As[16][65], Bs[16][65];
    const int tx = threadIdx.x & 15, ty = threadIdx.x >> 4, m0 = blockIdx.y * 64, n0 = blockIdx.x * 64;
    float acc[4][4];
#pragma unroll
    for (int i = 0; i < 4; ++i)
#pragma unroll
        for (int j = 0; j < 4; ++j) acc[i][j] = 0.f;
    for (int k0 = 0; k0 < K; k0 += 16) {
        for (int i = threadIdx.x; i < 1024; i += 256) { const int r = i >> 4, c = i & 15;
            As[c][r] = bf2f(A[(size_t)(m0 + r) * K + k0 + c]); Bs[c][r] = bf2f(Bt[(size_t)(n0 + r) * K + k0 + c]); }
        __syncthreads();
#pragma unroll
        for (int kk = 0; kk < 16; ++kk) { float a[4], b[4];
#pragma unroll
            for (int i = 0; i < 4; ++i) { a[i] = As[kk][ty * 4 + i]; b[i] = Bs[kk][tx * 4 + i]; }
#pragma unroll
            for (int i = 0; i < 4; ++i)
#pragma unroll
                for (int j = 0; j < 4; ++j) acc[i][j] += a[i] * b[j]; }
        __syncthreads();
    }
#pragma unroll
    for (int i = 0; i < 4; ++i)
#pragma unroll
        for (int j = 0; j < 4; ++j) C[(size_t)(m0 + ty * 4 + i) * N + n0 + tx * 4 + j] = acc[i][j];
}
__global__ void __launch_bounds__(256) n_post_inproj(const float* P, const float* bias, const float* cs, bf16* Q, bf16* KB, bf16* VB, bf16* U, bf16* GA, bf16* GP) {
    const size_t idx = (size_t)blockIdx.x * blockDim.x + threadIdx.x; if (idx >= (size_t)T * INW) return;
    const int t = (int)(idx / INW), c = (int)(idx % INW); float v = P[idx] + bias[c];
    if (c < O_V) {
        const int d = c & 63;
        if (d < 16) { const int i = d & 7; const int pc = (d < 8) ? c + 8 : c - 8; const float o = P[(size_t)t * INW + pc] + bias[pc];
            const float co = cs[t * 16 + i], si = cs[t * 16 + 8 + i]; v = (d < 8) ? v * co - o * si : v * co + o * si; }
        if (c < O_K) Q[(size_t)t * 1024 + c] = f2bf(v); else KB[(size_t)t * 128 + (c - O_K)] = f2bf(v);
    } else if (c < O_P) VB[(size_t)t * 128 + (c - O_V)] = f2bf(v);
    else if (c < O_GA) U[(size_t)t * 512 + (c - O_P)] = f2bf(v);
    else if (c < O_GP) GA[(size_t)t * 1024 + (c - O_GA)] = f2bf(v);
    else GP[(size_t)t * 1024 + (c - O_GP)] = f2bf(v);
}
__global__ void __launch_bounds__(256) n_attn(const bf16* Q, const bf16* KB, const bf16* VB, const float* sinks, bf16* AO) {
    const int idx = blockIdx.x * blockDim.x + threadIdx.x; if (idx >= T * NQH) return;
    const int t = idx / NQH, hq = idx % NQH, hk = hq / 8, pos = t % SEQ, b0 = t - pos;
    float q[64];
#pragma unroll
    for (int d = 0; d < 64; ++d) q[d] = bf2f(Q[(size_t)t * 1024 + hq * 64 + d]);
    const int lo = pos - (WINDOW - 1) > 0 ? pos - (WINDOW - 1) : 0;
    const float sink = sinks[hq]; float m = sink;
    for (int s = lo; s <= pos; ++s) { float a = 0.f;
#pragma unroll
        for (int d = 0; d < 64; ++d) a += q[d] * bf2f(KB[(size_t)(b0 + s) * 128 + hk * 64 + d]);
        a *= 0.125f; m = fmaxf(m, a); }
    float sum = __expf(sink - m); float o[64];
#pragma unroll
    for (int d = 0; d < 64; ++d) o[d] = 0.f;
    for (int s = lo; s <= pos; ++s) { float a = 0.f;
#pragma unroll
        for (int d = 0; d < 64; ++d) a += q[d] * bf2f(KB[(size_t)(b0 + s) * 128 + hk * 64 + d]);
        const float p = __expf(a * 0.125f - m); sum += p; const float pb = bf2f(f2bf(p));
#pragma unroll
        for (int d = 0; d < 64; ++d) o[d] += pb * bf2f(VB[(size_t)(b0 + s) * 128 + hk * 64 + d]); }
    const float inv = 1.f / sum;
#pragma unroll
    for (int d = 0; d < 64; ++d) AO[(size_t)t * 1024 + hq * 64 + d] = f2bf(o[d] * inv);
}
__global__ void __launch_bounds__(256) n_pool(const bf16* U, bf16* PO) {
    const int idx = blockIdx.x * blockDim.x + threadIdx.x; if (idx >= T * PW) return;
    const int t = idx / PW, c = idx % PW, g = c / 128, w = 2 << g, pos = t % SEQ; const int cnt = pos + 1 < w ? pos + 1 : w; float s = 0.f;
    for (int j = 0; j < cnt; ++j) s += bf2f(U[(size_t)(t - j) * PW + c]);
    PO[idx] = f2bf(s / (float)cnt - bf2f(U[idx]));
}
__global__ void __launch_bounds__(256) n_merge(const float* C1, const float* C2, const bf16* GA, const bf16* GP, bf16* MG) {
    const size_t idx = (size_t)blockIdx.x * blockDim.x + threadIdx.x; if (idx >= (size_t)T * D) return;
    const float t1 = bf2f(f2bf(sigmoidf_(bf2f(GA[idx])) * C1[idx]));
    MG[idx] = f2bf(t1 + sigmoidf_(bf2f(GP[idx])) * C2[idx]);
}
__global__ void __launch_bounds__(256) n_x1(const float* x, const float* C, bf16* X1) {
    const size_t idx = (size_t)blockIdx.x * blockDim.x + threadIdx.x; if (idx >= (size_t)T * D) return;
    X1[idx] = f2bf(C[idx]); (void)x;
}
__global__ void __launch_bounds__(256) n_router(const float* x, const bf16* X1, const float* g2, const float* wr, const float* br, fp8* H2, unsigned* counts, int* stok, int* toke, float* tokg) {
    const int t = blockIdx.x * 4 + (threadIdx.x >> 6), lane = threadIdx.x & 63;
    const f32x4* xr = (const f32x4*)(x + (size_t)t * D) + lane; const bf16* dr = X1 + (size_t)t * D + 4 * lane; f32x4 v[4]; float s = 0.f;
#pragma unroll
    for (int j = 0; j < 4; ++j) { v[j] = xr[64 * j]; v[j].x += bf2f(dr[256 * j]); v[j].y += bf2f(dr[256 * j + 1]); v[j].z += bf2f(dr[256 * j + 2]); v[j].w += bf2f(dr[256 * j + 3]); s += v[j].x * v[j].x + v[j].y * v[j].y + v[j].z * v[j].z + v[j].w * v[j].w; }
    const float rstd = rsqrtf(wave_sum(s) * (1.f / D) + RMS_EPS);
    float h[16];
#pragma unroll
    for (int j = 0; j < 4; ++j) { const f32x4 gg = ((const f32x4*)g2)[lane + 64 * j];
        h[4 * j + 0] = v[j].x * rstd * gg.x; h[4 * j + 1] = v[j].y * rstd * gg.y; h[4 * j + 2] = v[j].z * rstd * gg.z; h[4 * j + 3] = v[j].w * rstd * gg.w;
        fp8* o = H2 + (size_t)t * D + 4 * lane + 256 * j;
#pragma unroll
        for (int q = 0; q < 4; ++q) o[q] = f2fp8(h[4 * j + q]); }
    float lg[32];
#pragma unroll
    for (int e = 0; e < 32; ++e) { float a = 0.f;
#pragma unroll
        for (int j = 0; j < 4; ++j)
#pragma unroll
            for (int q = 0; q < 4; ++q) a += h[4 * j + q] * wr[(size_t)(4 * lane + 256 * j + q) * 32 + e];
        lg[e] = wave_sum(a) + br[e]; }
    int be[4]; float bv[4]; unsigned used = 0u;
#pragma unroll
    for (int k = 0; k < 4; ++k) { float best = -3.0e38f; int bi = 0;
#pragma unroll
        for (int e = 0; e < 32; ++e) { const bool ok = !((used >> e) & 1u) && lg[e] > best; best = ok ? lg[e] : best; bi = ok ? e : bi; }
        be[k] = bi; bv[k] = best; used |= 1u << bi; }
    float ex[4], se = 0.f;
#pragma unroll
    for (int k = 0; k < 4; ++k) { ex[k] = __expf(bv[k] - bv[0]); se += ex[k]; }
    if (lane == 0) {
#pragma unroll
        for (int k = 0; k < 4; ++k) { const unsigned pos = atomicAdd(&counts[be[k]], 1u);
            stok[be[k] * CAP + pos] = t; toke[t * 4 + k] = be[k] | (int)(pos << 8); tokg[t * 4 + k] = ex[k] / se; }
    }
}
__device__ __forceinline__ int moe_rowoff(const unsigned* counts, int e) { int o = 0; for (int i = 0; i < e; ++i) o += (int)((counts[i] + 255u) >> 8) << 8; return o; }
__global__ void __launch_bounds__(256) n_moe_up(const fp8* H2, const int* stok, const unsigned* counts, const fp8* WupT, const float* bup, fp8* ACT) {
    const int e = blockIdx.z, cnt = (int)counts[e], m0 = blockIdx.y * 64, n0 = blockIdx.x * 64; if (m0 >= cnt) return;
    __shared__ float As[16][65], Bg[16][65], Bl[16][65]; __shared__ int rowtok[64];
    const int tx = threadIdx.x & 15, ty = threadIdx.x >> 4; const int roff = moe_rowoff(counts, e);
    if (threadIdx.x < 64) rowtok[threadIdx.x] = (m0 + (int)threadIdx.x < cnt) ? stok[e * CAP + m0 + threadIdx.x] : 0;
    __syncthreads();
    float ag[4][4], al[4][4];
#pragma unroll
    for (int i = 0; i < 4; ++i)
#pragma unroll
        for (int j = 0; j < 4; ++j) { ag[i][j] = 0.f; al[i][j] = 0.f; }
    const fp8* W = WupT + (size_t)e * 2048 * 1024;
    for (int k0 = 0; k0 < 1024; k0 += 16) {
        for (int i = threadIdx.x; i < 1024; i += 256) { const int r = i >> 4, c = i & 15; const int j = n0 + r, ng = (j >> 7) * 256 + (j & 127);
            As[c][r] = fp82f(H2[(size_t)rowtok[r] * 1024 + k0 + c]); Bg[c][r] = fp82f(W[(size_t)ng * 1024 + k0 + c]) * W8_INV; Bl[c][r] = fp82f(W[(size_t)(ng + 128) * 1024 + k0 + c]) * W8_INV; }
        __syncthreads();
#pragma unroll
        for (int kk = 0; kk < 16; ++kk) { float a[4], g[4], l[4];
#pragma unroll
            for (int i = 0; i < 4; ++i) { a[i] = As[kk][ty * 4 + i]; g[i] = Bg[kk][tx * 4 + i]; l[i] = Bl[kk][tx * 4 + i]; }
#pragma unroll
            for (int i = 0; i < 4; ++i)
#pragma unroll
                for (int j = 0; j < 4; ++j) { ag[i][j] += a[i] * g[j]; al[i][j] += a[i] * l[j]; } }
        __syncthreads();
    }
#pragma unroll
    for (int i = 0; i < 4; ++i) { const int m = m0 + ty * 4 + i; if (m >= cnt) continue;
#pragma unroll
        for (int j = 0; j < 4; ++j) { const int c = n0 + tx * 4 + j; float gl = ag[i][j] + bup[e * 2048 + c], li = al[i][j] + bup[e * 2048 + 1024 + c];
            gl = fminf(gl, 7.f); li = fminf(fmaxf(li, -7.f), 7.f);
            ACT[(size_t)(roff + m) * 1024 + c] = f2fp8(gl * sigmoidf_(1.702f * gl) * (li + 1.f)); } }
}
__global__ void __launch_bounds__(256) n_moe_down(const fp8* ACT, const unsigned* counts, const fp8* WdnT, const float* bdn, fp8* YS) {
    const int e = blockIdx.z, cnt = (int)counts[e], m0 = blockIdx.y * 64, n0 = blockIdx.x * 64; if (m0 >= cnt) return;
    __shared__ float As[16][65], Bs[16][65];
    const int tx = threadIdx.x & 15, ty = threadIdx.x >> 4; const int roff = moe_rowoff(counts, e);
    float acc[4][4];
#pragma unroll
    for (int i = 0; i < 4; ++i)
#pragma unroll
        for (int j = 0; j < 4; ++j) acc[i][j] = 0.f;
    const fp8* W = WdnT + (size_t)e * 1024 * 1024;
    for (int k0 = 0; k0 < 1024; k0 += 16) {
        for (int i = threadIdx.x; i < 1024; i += 256) { const int r = i >> 4, c = i & 15; const int m = (m0 + r < cnt) ? m0 + r : m0;
            As[c][r] = fp82f(ACT[(size_t)(roff + m) * 1024 + k0 + c]); Bs[c][r] = fp82f(W[(size_t)(n0 + r) * 1024 + k0 + c]) * W8_INV; }
        __syncthreads();
#pragma unroll
        for (int kk = 0; kk < 16; ++kk) { float a[4], b[4];
#pragma unroll
            for (int i = 0; i < 4; ++i) { a[i] = As[kk][ty * 4 + i]; b[i] = Bs[kk][tx * 4 + i]; }
#pragma unroll
            for (int i = 0; i < 4; ++i)
#pragma unroll
                for (int j = 0; j < 4; ++j) acc[i][j] += a[i] * b[j]; }
        __syncthreads();
    }
#pragma unroll
    for (int i = 0; i < 4; ++i) { const int m = m0 + ty * 4 + i; if (m >= cnt) continue;
#pragma unroll
        for (int j = 0; j < 4; ++j) { const int c = n0 + tx * 4 + j; YS[(size_t)(roff + m) * 1024 + c] = f2fp8(acc[i][j] + bdn[e * 1024 + c]); } }
}
__global__ void __launch_bounds__(256) n_combine(const float* x, const bf16* X1, const fp8* YS, const unsigned* counts, const int* toke, const float* tokg, const float* gf, float* out) {
    const int t = blockIdx.x * 4 + (threadIdx.x >> 6), lane = threadIdx.x & 63;
    f32x4 v[4];
#pragma unroll
    for (int j = 0; j < 4; ++j) { v[j] = ((const f32x4*)(x + (size_t)t * D))[lane + 64 * j]; const bf16* dp = X1 + (size_t)t * D + 4 * lane + 256 * j; v[j].x += bf2f(dp[0]); v[j].y += bf2f(dp[1]); v[j].z += bf2f(dp[2]); v[j].w += bf2f(dp[3]); }
    for (int k = 0; k < 4; ++k) { const int te = toke[t * 4 + k], e = te & 255, pos = te >> 8; const float g = tokg[t * 4 + k];
        const fp8* y = YS + (size_t)(moe_rowoff(counts, e) + pos) * 1024;
#pragma unroll
        for (int j = 0; j < 4; ++j) { const fp8* p = y + 4 * lane + 256 * j; v[j].x += g * fp82f(p[0]); v[j].y += g * fp82f(p[1]); v[j].z += g * fp82f(p[2]); v[j].w += g * fp82f(p[3]); } }
    float s = 0.f;
#pragma unroll
    for (int j = 0; j < 4; ++j) s += v[j].x * v[j].x + v[j].y * v[j].y + v[j].z * v[j].z + v[j].w * v[j].w;
    const float rstd = rsqrtf(wave_sum(s) * (1.f / D) + RMS_EPS);
#pragma unroll
    for (int j = 0; j < 4; ++j) { const f32x4 gg = ((const f32x4*)gf)[lane + 64 * j]; f32x4 o = v[j] * rstd * gg; ((f32x4*)(out + (size_t)t * D))[lane + 64 * j] = o; }
}

#define GAS __attribute__((address_space(1)))
#define LAS __attribute__((address_space(3)))
typedef short bf16x8 __attribute__((ext_vector_type(8)));
typedef float f32x16 __attribute__((ext_vector_type(16)));
typedef short s16x4 __attribute__((ext_vector_type(4)));
typedef float f32x2 __attribute__((ext_vector_type(2)));
typedef GAS unsigned gu32;
#define RLX_AGENT __ATOMIC_RELAXED, __HIP_MEMORY_SCOPE_AGENT
#define LDS_WAIT() asm volatile("s_waitcnt lgkmcnt(0)" ::: "memory")
#define VM_WAIT() asm volatile("s_waitcnt vmcnt(0)" ::: "memory")

constexpr int NWAVES = 8, NTHR = 512;
constexpr int RING_BYTES = 131072;
constexpr int HB_STRIDE = 4112, HB_BYTES = 32 * HB_STRIDE;
constexpr int TBL_OFF = 132096;
constexpr int RT_LOGIT = 133120, RT_TOKE = RT_LOGIT + 8448, RT_TOKR = RT_TOKE + 1024, RT_TOKG = RT_TOKR + 1024, RT_HIST = RT_TOKG + 1024, RT_BASE = RT_HIST + 128;
constexpr int BIAS_OFF = 133120;
constexpr int MISC_OFF = 145408;
constexpr int LDS_BYTES = 147456;
static_assert(RT_BASE + 128 <= MISC_OFF && HB_BYTES <= TBL_OFF && MISC_OFF + 128 <= LDS_BYTES, "LDS map");

__device__ __forceinline__ unsigned cvt_pk_bf16(float lo, float hi) { unsigned r; asm volatile("v_cvt_pk_bf16_f32 %0, %1, %2" : "=v"(r) : "v"(lo), "v"(hi)); return r; }
__device__ __forceinline__ float bflo(unsigned w) { return __uint_as_float(w << 16); }
__device__ __forceinline__ float bfhi(unsigned w) { return __uint_as_float(w & 0xffff0000u); }
__device__ __forceinline__ float fast_sigmoid(float v) { return __builtin_amdgcn_rcpf(1.0f + __builtin_amdgcn_exp2f(-1.44269504089f * v)); }

#define XB_TMO      128
#define XB_XCNT(j)  (256  + 64 * (j))
#define XB_XSUB(j)  (1280 + 64 * (j))
#define XB_XGEN(j)  (2304 + 64 * (j))
#define XB_TOP      3328
#define XB_TOPGEN   3392
#define XCD_BAR_WORDS 3456
#define XB_SPIN_CAP (1u << 18)
__device__ __forceinline__ unsigned xb_ld(unsigned* p)              { return __hip_atomic_load(p, __ATOMIC_RELAXED, __HIP_MEMORY_SCOPE_AGENT); }
__device__ __forceinline__ unsigned xb_add(unsigned* p, unsigned v) { return __hip_atomic_fetch_add(p, v, __ATOMIC_RELAXED, __HIP_MEMORY_SCOPE_AGENT); }
__device__ __forceinline__ unsigned xb_xcc_id() { return (unsigned)__builtin_amdgcn_s_getreg((3 << 11) | 20) & 0xFu; }
#define XB_SPIN(cond, bar) do { unsigned _sp = 0; while (cond) { __builtin_amdgcn_s_sleep(1); \
    if ((++_sp & 255u) == 0u) { if (xb_ld(&(bar)[XB_TMO])) break; if (_sp > XB_SPIN_CAP) { atomicAdd(&(bar)[XB_TMO], 1u); break; } } } } while (0)
struct XcdBarrier { unsigned* bar; unsigned x; volatile LAS unsigned* st; };
__device__ __forceinline__ XcdBarrier xcd_barrier_post(unsigned* bar, volatile LAS unsigned* st) {
    XcdBarrier b; b.bar = bar; b.x = xb_xcc_id(); b.st = st;
    if (threadIdx.x == 0) (void)xb_add(&bar[XB_XCNT(b.x)], 1u);
    return b;
}
__device__ __forceinline__ void xcd_barrier_complete(unsigned* bar, unsigned x, unsigned& nloc, unsigned& nx) {
    const unsigned G = gridDim.x * gridDim.y * gridDim.z;
    unsigned sum, cnt, mine, sp = 0u;
    for (;;) {
        sum = 0u; cnt = 0u; mine = 0u;
#pragma unroll
        for (unsigned j = 0; j < 16; ++j) { const unsigned c = xb_ld(&bar[XB_XCNT(j)]); sum += c; cnt += (c > 0u) ? 1u : 0u; mine = (j == x) ? c : mine; }
        if (sum == G) break;
        __builtin_amdgcn_s_sleep(1);
        if ((++sp & 255u) == 0u) { if (xb_ld(&bar[XB_TMO])) break; if (sp > XB_SPIN_CAP) { atomicAdd(&bar[XB_TMO], 1u); break; } }
    }
    nloc = mine > 0u ? mine : 1u; nx = cnt > 0u ? cnt : 1u;
}
__device__ __forceinline__ void xcd_barrier(const XcdBarrier& b) {
    asm volatile("s_waitcnt vmcnt(0)" ::: "memory");
    __syncthreads();
    if (threadIdx.x == 0) {
        unsigned* bar = b.bar;
        __builtin_amdgcn_s_waitcnt(0);
        unsigned nloc = b.st[0], nx = b.st[1];
        if (nloc == 0u) { xcd_barrier_complete(bar, b.x, nloc, nx); b.st[0] = nloc; b.st[1] = nx; }
        const unsigned old = xb_add(&bar[XB_XSUB(b.x)], 1u);
        const unsigned gen = old / nloc;
        if (old + 1u == (gen + 1u) * nloc) {
            __builtin_amdgcn_fence(__ATOMIC_RELEASE, "agent");
            asm volatile("s_waitcnt vmcnt(0)" ::: "memory");
            const unsigned og = xb_add(&bar[XB_TOP], 1u);
            const unsigned tg = og / nx;
            if (og + 1u == (tg + 1u) * nx) xb_add(&bar[XB_TOPGEN], 1u);
            else XB_SPIN(xb_ld(&bar[XB_TOPGEN]) == tg, bar);
            __builtin_amdgcn_fence(__ATOMIC_ACQUIRE, "agent");
            xb_add(&bar[XB_XGEN(b.x)], 1u);
            asm volatile("s_waitcnt vmcnt(0)" ::: "memory");
        } else {
            XB_SPIN(xb_ld(&bar[XB_XGEN(b.x)]) == gen, bar);
            __builtin_amdgcn_fence(__ATOMIC_ACQUIRE, "agent");
            asm volatile("s_waitcnt vmcnt(0)" ::: "memory");
        }
    }
    __syncthreads();
}

namespace pg8 {
constexpr int BM = 256, BK = 64, HALF = 128, HTB = HALF * BK * 2, STAGE_BYTES = 8 * HTB, NXCD = 8, WGM = 8;
__host__ __device__ __forceinline__ int lds_byte(int r, int c) { const int st = (r >> 4) * 2 + (c >> 5), rr = r & 15, cc = c & 31, ob = rr * 64 + cc * 2; return st * 1024 + (ob ^ (((ob >> 9) & 1) << 5)); }
__host__ __device__ __forceinline__ void stage_rc(int b, int& R, int& C) { const int st = b / 1024, sb = b % 1024, swz = sb ^ (((sb >> 9) & 1) << 5); R = (st >> 1) * 16 + swz / 64; C = (st & 1) * 32 + (swz % 64) / 2; }
__host__ __device__ __forceinline__ int perm32(int rho) { const int n = rho >> 4, i = rho & 15; return 8 * (i >> 2) + 4 * n + (i & 3); }

struct GUnit { int row0, pn, e, grow, nvalid; };

struct DenseOrder {
    int nM, nN, nwg, G, c;
    __device__ void init(int M, int N, int G_, int c_) { nM = M / BM; nN = N / BM; nwg = nM * nN; G = G_; c = c_; }
    __device__ bool next(int i, GUnit& u) const {
        const long L = (long)i * G + c; if (L >= nwg) return false;
        int wgid = (int)L; { const int q = nwg / NXCD, r = nwg % NXCD, xcd = wgid % NXCD, off = wgid / NXCD; wgid = (xcd < r ? xcd * (q + 1) : r * (q + 1) + (xcd - r) * q) + off; }
        const int nig = WGM * nN, gid = wgid / nig, fm = gid * WGM, gsz = (nM - fm) < WGM ? (nM - fm) : WGM;
        u.row0 = (fm + ((wgid % nig) % gsz)) * BM; u.pn = (wgid % nig) / gsz; u.e = 0; u.grow = 0; u.nvalid = BM; return true;
    }
};
struct MoeOrder {
    const LAS int* ust; const LAS int* rowoff; const LAS int* cnt; int lognN, G, c;
    __device__ bool next(int i, GUnit& u) const {
        const int L = i * G + c; const int total = __builtin_amdgcn_readfirstlane(ust[32]); if (L >= total) return false;
        int e = 0;
#pragma unroll
        for (int j = 1; j < 32; ++j) e += (L >= __builtin_amdgcn_readfirstlane(ust[j])) ? 1 : 0;
        const int idx = L - __builtin_amdgcn_readfirstlane(ust[e]); const int r = idx >> lognN, pn = idx & ((1 << lognN) - 1);
        u.row0 = __builtin_amdgcn_readfirstlane(rowoff[e]) + BM * r; u.pn = pn; u.e = e; u.grow = e * CAP + BM * r; u.nvalid = __builtin_amdgcn_readfirstlane(cnt[e]) - BM * r; return true;
    }
};

template <bool VEC> struct MoeOrderX {
    const LAS int* rowoff; const LAS int* cnt; int lognN, G, c;
    __device__ bool next(int i, GUnit& u) const {
        int rem = i;
        for (int v = c; v < 256; v += G) {
            const int x8 = v & 7, j = v >> 3, e = x8 + 8 * (j >> 3), pn = (lognN == 3) ? (j & 7) : ((j & 7) >> 1), r0 = (lognN == 3) ? 0 : (j & 1), rs = (lognN == 3) ? 1 : 2;
            const int ce = __builtin_amdgcn_readfirstlane(cnt[e]), R = (ce + 255) >> 8, n = (R > r0) ? (R - r0 + rs - 1) / rs : 0;
            if (rem < n) { const int r = r0 + rem * rs; u.row0 = __builtin_amdgcn_readfirstlane(rowoff[e]) + BM * r; u.pn = pn; u.e = e; u.grow = e * CAP + BM * r; u.nvalid = ce - BM * r;
                if (VEC) { int ev = e; asm volatile("" : "+v"(ev)); u.e = ev; }
                return true; }
            rem -= n;
        }
        return false;
    }
};
struct MoeOrderOwn {
    const LAS int* rowoff; const LAS int* cnt; unsigned mx, mh; int G, c;
    __device__ bool next(int i, GUnit& u) const {
        int rem = i; const int ns = 8 * __builtin_popcount(mh);
        for (int v = c; v < 256; v += G) {
            const int x8 = v & 7, j = v >> 3, e = x8 + 8 * (j >> 3), jl = j & 7, pn = jl >> 1, rpar = jl & 1;
            const int ce = __builtin_amdgcn_readfirstlane(cnt[e]), R = (ce + 255) >> 8, n2 = R >> 1;
            const bool stolen = ((mx >> e) & 1u) && (4 * __builtin_popcount(mx & ((1u << e) - 1u)) + pn < ns);
            const int n = n2 + (((R & 1) && rpar == 0 && !stolen) ? 1 : 0);
            if (rem < n) { const int r = rem < n2 ? rpar + 2 * rem : R - 1; u.row0 = __builtin_amdgcn_readfirstlane(rowoff[e]) + BM * r; u.pn = pn; u.e = e; u.grow = e * CAP + BM * r; u.nvalid = ce - BM * r; return true; }
            rem -= n;
        }
        return false;
    }
};
struct MoeOrderSteal {
    const LAS int* rowoff; const LAS int* cnt; unsigned mx, mh; int G, c;
    __device__ bool next(int i, GUnit& u) const {
        int rem = i; const int nx = 4 * __builtin_popcount(mx);
        for (int v = c; v < 256; v += G) {
            const int x8 = v & 7, j = v >> 3, e = x8 + 8 * (j >> 3), jl = j & 7;
            if (!((mh >> e) & 1u)) continue;
            const int s = 8 * __builtin_popcount(mh & ((1u << e) - 1u)) + jl;
            if (s >= nx) continue;
            if (rem == 0) { unsigned m = mx; for (int q = 0; q < (s >> 2); ++q) m &= m - 1u;
                const int o = __builtin_ctz(m), pn = s & 3, ce = __builtin_amdgcn_readfirstlane(cnt[o]), r = ((ce + 255) >> 8) - 1;
                u.row0 = __builtin_amdgcn_readfirstlane(rowoff[o]) + BM * r; u.pn = pn; u.e = o; u.grow = o * CAP + BM * r; u.nvalid = ce - BM * r; return true; }
            --rem;
        }
        return false;
    }
};
__host__ __device__ __forceinline__ int sig8(int p) { return (p & 1) | (((p >> 2) & 1) * 6); }
typedef int v8i __attribute__((ext_vector_type(8)));
typedef int i32x4 __attribute__((ext_vector_type(4)));

template <class Epi, class Sched, int K, bool GATHER, bool F8>
__device__ __forceinline__ void gemm_phase(LAS unsigned char* lds, const void* A, const void* Bt, size_t bexp  , const Sched& S, const Epi& E, const int* gidx) {
    const int tid = threadIdx.x, wid = __builtin_amdgcn_readfirstlane(tid >> 6), lane = tid & 63, wr = wid >> 2, wc = wid & 3, fr = lane & 15, fq = lane >> 4;
    constexpr int ES = F8 ? 1 : 2, KB = K * ES, nt = KB / 128;
    static_assert(nt >= 4 && nt % 2 == 0, "K");
    int R0, C0b;
    if constexpr (F8) { R0 = tid >> 3; C0b = ((tid & 7) ^ sig8((R0 >> 1) & 7)) << 4; }
    else { int C0; stage_rc(tid * 16, R0, C0); C0b = C0 * 2; }
    unsigned voffA[2], voffB[2];
#pragma unroll
    for (int i = 0; i < 2; ++i) { const int R = R0 + 64 * i; const int Rb = Epi::PERM ? ((R & ~31) + perm32(R & 31)) : R;
        voffA[i] = (unsigned)(R * KB + C0b); voffB[i] = (unsigned)(Rb * KB + C0b); }
    constexpr size_t kstep = 128, hstep = (size_t)HALF * KB;
    const unsigned ldsw = (unsigned)wid * 1024u;
    int aoff, boff, aoff1 = 0, boff1 = 0;
    if constexpr (F8) { const int sg = sig8((fr >> 1) & 7);
        aoff = (wr * 64 + fr) * 128 + (((2 * fq) ^ sg) << 4); aoff1 = (wr * 64 + fr) * 128 + (((2 * fq + 1) ^ sg) << 4);
        boff = (wc * 32 + fr) * 128 + (((2 * fq) ^ sg) << 4); boff1 = (wc * 32 + fr) * 128 + (((2 * fq + 1) ^ sg) << 4); }
    else { aoff = lds_byte(wr * 64 + fr, fq * 8); boff = lds_byte(wc * 32 + fr, fq * 8); }
    unsigned gcur[2][2], gnxt[2][2];
#define PG8_LOADG(u_, g_) do { _Pragma("unroll") for (int _h = 0; _h < 2; ++_h) _Pragma("unroll") for (int _i = 0; _i < 2; ++_i) { const int _r = _h * HALF + R0 + 64 * _i; int _tok = 0; \
        if (_r < (u_).nvalid) _tok = gidx[(u_).grow + _r]; (g_)[_h][_i] = (unsigned)_tok * (unsigned)KB + (unsigned)C0b; } } while (0)
#define PG8_PING(g_) asm volatile("" : "+v"((g_)[0][0]), "+v"((g_)[0][1]), "+v"((g_)[1][0]), "+v"((g_)[1][1]))
#define PG8_SA(b, h) (((b) * 2 + (h)) * HTB)
#define PG8_SB(b, h) ((4 + (b) * 2 + (h)) * HTB)
#define PG8_STAGE(bufoff, rs, soff, voff) do { _Pragma("unroll") for (int _i = 0; _i < 2; ++_i) \
        __builtin_amdgcn_raw_ptr_buffer_load_lds(rs, (LAS void*)(lds + (bufoff) + ldsw + _i * 8192), 16, (int)(voff)[_i], (int)(soff), 0, 0); } while (0)
#define PG8_STAGE_A(bufoff, h, nx, kb) do { if constexpr (GATHER) { _Pragma("unroll") for (int _i = 0; _i < 2; ++_i) { const unsigned _o = (nx) ? gnxt[h][_i] : gcur[h][_i]; \
            __builtin_amdgcn_raw_ptr_buffer_load_lds(rsA, (LAS void*)(lds + (bufoff) + ldsw + _i * 8192), 16, (int)_o, (int)(kb), 0, 0); } } \
        else { PG8_STAGE(bufoff, rsA, ((nx) ? nA : cA) + (unsigned)((h) * hstep) + (unsigned)(kb), voffA); } } while (0)
#define PG8_LDA(b, h) do { if constexpr (F8) { _Pragma("unroll") for (int m = 0; m < 4; ++m) { const i32x4 _l = *(const LAS i32x4*)(lds + PG8_SA(b, h) + aoff + m * 2048), _h2 = *(const LAS i32x4*)(lds + PG8_SA(b, h) + aoff1 + m * 2048); \
            At8[m] = __builtin_shufflevector(_l, _h2, 0, 1, 2, 3, 4, 5, 6, 7); } } \
        else { _Pragma("unroll") for (int m = 0; m < 4; ++m) _Pragma("unroll") for (int k = 0; k < 2; ++k) At[m][k] = *(const LAS bf16x8*)(lds + PG8_SA(b, h) + aoff + m * 2048 + k * 1024); } } while (0)
#define PG8_LDB(dst, dst8, b, h) do { if constexpr (F8) { _Pragma("unroll") for (int n = 0; n < 2; ++n) { const i32x4 _l = *(const LAS i32x4*)(lds + PG8_SB(b, h) + boff + n * 2048), _h2 = *(const LAS i32x4*)(lds + PG8_SB(b, h) + boff1 + n * 2048); \
            dst8[n] = __builtin_shufflevector(_l, _h2, 0, 1, 2, 3, 4, 5, 6, 7); } } \
        else { _Pragma("unroll") for (int n = 0; n < 2; ++n) _Pragma("unroll") for (int k = 0; k < 2; ++k) dst[n][k] = *(const LAS bf16x8*)(lds + PG8_SB(b, h) + boff + n * 2048 + k * 1024); } } while (0)
#define PG8_MMA(ai, bj, Bt_, Bt8_) do { __builtin_amdgcn_s_setprio(1); if constexpr (F8) { _Pragma("unroll") for (int m = 0; m < 4; ++m) _Pragma("unroll") for (int n = 0; n < 2; ++n) \
            acc[ai][bj][m][n] = __builtin_amdgcn_mfma_scale_f32_16x16x128_f8f6f4(Bt8_[n], At8[m], acc[ai][bj][m][n], 0, 0, 0, 0, 0, 0); } \
        else { _Pragma("unroll") for (int m = 0; m < 4; ++m) _Pragma("unroll") for (int n = 0; n < 2; ++n) _Pragma("unroll") for (int k = 0; k < 2; ++k) \
            acc[ai][bj][m][n] = __builtin_amdgcn_mfma_f32_16x16x32_bf16(Bt_[n][k], At[m][k], acc[ai][bj][m][n], 0, 0, 0); } __builtin_amdgcn_s_setprio(0); } while (0)
#define PG8_WAIT_V(n) asm volatile("s_waitcnt vmcnt(" #n ")" ::: "memory")
#define PG8_WAIT_L(n) asm volatile("s_waitcnt lgkmcnt(" #n ")" ::: "memory")
#define PG8_BAR __builtin_amdgcn_s_barrier()
#define PG8_SCHED __builtin_amdgcn_sched_barrier(0)
    GUnit cur, nxt, nn; int ui = 0;
    if (!S.next(0, cur)) return;
    bool has_next = S.next(1, nxt);
    f32x4 acc[2][2][4][2];
#pragma unroll
    for (int a = 0; a < 2; ++a)
#pragma unroll
        for (int b = 0; b < 2; ++b)
#pragma unroll
            for (int m = 0; m < 4; ++m)
#pragma unroll
                for (int n = 0; n < 2; ++n) acc[a][b][m][n] = (f32x4){0.f, 0.f, 0.f, 0.f};
    bf16x8 At[4][2], B0[2][2], B1[2][2]; v8i At8[4], B08[2], B18[2];
    const __amdgpu_buffer_rsrc_t rsA = __builtin_amdgcn_make_buffer_rsrc((void*)A, 0, 0x7fffffff, 0x00020000), rsB = __builtin_amdgcn_make_buffer_rsrc((void*)Bt, 0, 0x7fffffff, 0x00020000);
    unsigned cA = (unsigned)cur.row0 * (unsigned)KB;
    unsigned cB = (unsigned)(((size_t)cur.e * bexp + (size_t)cur.pn * BM * K) * ES);
    unsigned nA = cA, nB = cB;
    if constexpr (GATHER) {
        PG8_LOADG(cur, gcur);
        if (has_next) PG8_LOADG(nxt, gnxt); else { gnxt[0][0] = gcur[0][0]; gnxt[0][1] = gcur[0][1]; gnxt[1][0] = gcur[1][0]; gnxt[1][1] = gcur[1][1]; }
        PG8_PING(gcur); PG8_PING(gnxt);
    }
    PG8_STAGE(PG8_SB(0, 0), rsB, cB, voffB); PG8_STAGE(PG8_SB(0, 1), rsB, cB + (unsigned)hstep, voffB); PG8_STAGE_A(PG8_SA(0, 0), 0, false, 0u); PG8_STAGE_A(PG8_SA(0, 1), 1, false, 0u);
    if (wr == 1) PG8_BAR;
    PG8_WAIT_V(2); PG8_BAR;
    PG8_STAGE(PG8_SB(1, 0), rsB, cB + (unsigned)kstep, voffB); PG8_STAGE_A(PG8_SA(1, 0), 0, false, (unsigned)kstep); PG8_STAGE(PG8_SB(1, 1), rsB, cB + (unsigned)(hstep + kstep), voffB);
    PG8_WAIT_V(6); PG8_BAR;
    for (;;) {
        if (has_next) { nA = (unsigned)nxt.row0 * (unsigned)KB; nB = (unsigned)(((size_t)nxt.e * bexp + (size_t)nxt.pn * BM * K) * ES); } else { nA = cA; nB = cB; }
#define PG8_KBODY(LAST, T_) do { \
            const unsigned kb1 = (unsigned)((T_) + 1) * (unsigned)kstep, kb2 = (LAST) ? 0u : (unsigned)((T_) + 2) * (unsigned)kstep, kb3 = kb2 + (unsigned)kstep; \
            const unsigned b2 = ((LAST) ? nB : cB) + kb2, b3 = b2 + (unsigned)kstep; \
              \
            PG8_LDB(B0, B08, 0, 0); PG8_LDB(B1, B18, 0, 1); PG8_SCHED; PG8_LDA(0, 0); PG8_STAGE_A(PG8_SA(1, 1), 1, false, kb1); \
            PG8_WAIT_V(8); PG8_WAIT_L(0); PG8_BAR; PG8_MMA(0, 0, B0, B08); PG8_MMA(0, 1, B1, B18); PG8_BAR; PG8_SCHED; \
              \
            PG8_LDA(0, 1); PG8_STAGE(PG8_SB(0, 0), rsB, b2, voffB); PG8_STAGE(PG8_SB(0, 1), rsB, b2 + (unsigned)hstep, voffB); PG8_STAGE_A(PG8_SA(0, 0), 0, LAST, kb2); \
            PG8_WAIT_V(8); PG8_WAIT_L(0); PG8_BAR; PG8_MMA(1, 0, B0, B08); PG8_MMA(1, 1, B1, B18); PG8_BAR; PG8_SCHED; \
              \
            PG8_LDB(B0, B08, 1, 0); PG8_LDB(B1, B18, 1, 1); PG8_SCHED; PG8_LDA(1, 0); PG8_STAGE_A(PG8_SA(0, 1), 1, LAST, kb2); \
            PG8_WAIT_V(8); PG8_WAIT_L(0); PG8_BAR; PG8_MMA(0, 0, B0, B08); PG8_MMA(0, 1, B1, B18); PG8_BAR; PG8_SCHED; \
              \
            PG8_LDA(1, 1); PG8_STAGE(PG8_SB(1, 0), rsB, b3, voffB); PG8_STAGE(PG8_SB(1, 1), rsB, b3 + (unsigned)hstep, voffB); PG8_STAGE_A(PG8_SA(1, 0), 0, LAST, kb3); \
            PG8_WAIT_V(8); PG8_WAIT_L(0); PG8_BAR; PG8_MMA(1, 0, B0, B08); PG8_MMA(1, 1, B1, B18); PG8_BAR; PG8_SCHED; } while (0)
        bool has_nn = false; unsigned gnn[2][2]; int gtok[2][2] = {{0, 0}, {0, 0}};
#pragma unroll 1
        for (int t = 0; t < nt; t += 2) {
            const bool last = (t == nt - 2);
            if (last) {
                has_nn = has_next && S.next(ui + 2, nn);
                if constexpr (GATHER) { if (has_nn) {
#pragma unroll
                    for (int _h = 0; _h < 2; ++_h)
#pragma unroll
                        for (int _i = 0; _i < 2; ++_i) { const int _r = _h * HALF + R0 + 64 * _i; if (_r < nn.nvalid) gtok[_h][_i] = gidx[nn.grow + _r]; } } }
                if (wid == 0) E.stage(cur, lds + BIAS_OFF, lane);
            }
            PG8_KBODY(last, t);
        }
        if constexpr (GATHER) {
#pragma unroll
            for (int _h = 0; _h < 2; ++_h)
#pragma unroll
                for (int _i = 0; _i < 2; ++_i) gnn[_h][_i] = has_nn ? (unsigned)gtok[_h][_i] * (unsigned)KB + (unsigned)C0b : gnxt[_h][_i];
            PG8_PING(gnn);
        }
        if (wr == 0) PG8_BAR;
        E(acc, cur, wr, wc, fr, fq, (const LAS float*)(lds + BIAS_OFF));
        if (!has_next) break;
#pragma unroll
        for (int a = 0; a < 2; ++a)
#pragma unroll
            for (int b = 0; b < 2; ++b)
#pragma unroll
                for (int m = 0; m < 4; ++m)
#pragma unroll
                    for (int n = 0; n < 2; ++n) acc[a][b][m][n] = (f32x4){0.f, 0.f, 0.f, 0.f};
        cur = nxt; nxt = nn; has_next = has_nn; cA = nA; cB = nB; ++ui;
        if constexpr (GATHER) {
#pragma unroll
            for (int h = 0; h < 2; ++h)
#pragma unroll
                for (int i = 0; i < 2; ++i) { gcur[h][i] = gnxt[h][i]; gnxt[h][i] = gnn[h][i]; }
        }
        if (wr == 1) PG8_BAR;
    }
    PG8_WAIT_V(0);
    PG8_BAR;
    (void)At; (void)B0; (void)B1; (void)At8; (void)B08; (void)B18; (void)aoff1; (void)boff1;
#undef PG8_KBODY
#undef PG8_LOADG
#undef PG8_PING
#undef PG8_SA
#undef PG8_SB
#undef PG8_STAGE
#undef PG8_STAGE_A
#undef PG8_LDA
#undef PG8_LDB
#undef PG8_MMA
#undef PG8_WAIT_V
#undef PG8_WAIT_L
#undef PG8_BAR
#undef PG8_SCHED
}

typedef f32x4 Acc[2][2][4][2];
__device__ __forceinline__ u32x4 pack8(const f32x4 v0, const f32x4 v1) { u32x4 w; w.x = cvt_pk_bf16(v0[0], v0[1]); w.y = cvt_pk_bf16(v0[2], v0[3]); w.z = cvt_pk_bf16(v1[0], v1[1]); w.w = cvt_pk_bf16(v1[2], v1[3]); return w; }

struct EpiInProj {
    static constexpr bool PERM = true;
    const float* bias; const float* cs; bf16 *Q, *KB, *VB, *U, *GA, *GP;
    __device__ __forceinline__ void stage(const GUnit& u, LAS unsigned char* slot, int lane) const {
        const __amdgpu_buffer_rsrc_t rs = __builtin_amdgcn_make_buffer_rsrc((void*)bias, 0, 0x7fffffff, 0x00020000);
        __builtin_amdgcn_raw_ptr_buffer_load_lds(rs, (LAS void*)slot, 16, lane * 16, u.pn * 1024, 0, 0); }
    __device__ __forceinline__ void operator()(const Acc& acc, const GUnit& u, int wr, int wc, int fr, int fq, const LAS float* bl) const {
        const int pn = u.pn; const bool rw = (wc & 1) == 0;
        bf16 *d0, *d1; int c0, pitch; bool rp0, rp1, nt;
        if (pn < 4) { d0 = d1 = Q; c0 = pn * 256; pitch = 1024; rp0 = rp1 = rw; nt = false; }
        else if (pn == 4) { d0 = KB; d1 = VB - 128; c0 = 0; pitch = 128; rp0 = rw; rp1 = false; nt = false; }
        else if (pn < 7) { d0 = d1 = U; c0 = (pn - 5) * 256; pitch = 512; rp0 = rp1 = false; nt = false; }
        else if (pn < 11) { d0 = d1 = GA; c0 = (pn - 7) * 256; pitch = 1024; rp0 = rp1 = false; nt = true; }
        else { d0 = d1 = GP; c0 = (pn - 11) * 256; pitch = 1024; rp0 = rp1 = false; nt = true; }
        const int rowl = wr * 64 + fr;
        const __amdgpu_buffer_rsrc_t r0 = __builtin_amdgcn_make_buffer_rsrc((void*)(d0 + (size_t)u.row0 * pitch), 0, 0x7fffffff, 0x00020000);
        const __amdgpu_buffer_rsrc_t r1 = __builtin_amdgcn_make_buffer_rsrc((void*)(d1 + (size_t)u.row0 * pitch), 0, 0x7fffffff, 0x00020000);
        const int vo = (rowl * pitch + c0 + wc * 32 + 8 * fq) * 2;
        f32x4 bb[2][2];
#pragma unroll
        for (int bj = 0; bj < 2; ++bj) { bb[bj][0] = *(const LAS f32x4*)(bl + bj * 128 + wc * 32 + 8 * fq); bb[bj][1] = *(const LAS f32x4*)(bl + bj * 128 + wc * 32 + 8 * fq + 4); }
        const float sg = (fq == 0) ? -1.f : 1.f;
        const int rstep = pitch * 32;
#pragma unroll
        for (int am = 0; am < 8; am += 2) {
            f32x4 csr[2][4];
            if (rp0) {
#pragma unroll
                for (int mm = 0; mm < 2; ++mm)
#pragma unroll
                    for (int q = 0; q < 4; ++q) csr[mm][q] = *(const f32x4*)(cs + (size_t)(u.row0 + rowl + ((am + mm) >> 2) * 128 + ((am + mm) & 3) * 16) * 16 + 4 * q);
            }
#pragma unroll
            for (int mm = 0; mm < 2; ++mm)
#pragma unroll
                for (int bj = 0; bj < 2; ++bj) { const int ai = (am + mm) >> 2, m = (am + mm) & 3;
                    f32x4 v0 = acc[ai][bj][m][0] + bb[bj][0], v1 = acc[ai][bj][m][1] + bb[bj][1];
                    if (bj == 0 ? rp0 : rp1) {
                        f32x4 o0, o1;
#pragma unroll
                        for (int j = 0; j < 4; ++j) { o0[j] = __shfl_xor(v0[j], 16); o1[j] = __shfl_xor(v1[j], 16); }
                        const f32x4 q0 = v0 * csr[mm][0] + (o0 * csr[mm][2]) * sg, q1 = v1 * csr[mm][1] + (o1 * csr[mm][3]) * sg;
                        if (fq < 2) { v0 = q0; v1 = q1; } }
                    const u32x4 w = pack8(v0, v1); const int so = (ai * 8 + m) * rstep;
                    if (nt) __builtin_amdgcn_raw_buffer_store_b128(w, bj == 0 ? r0 : r1, vo + bj * 256, so, 2);
                    else __builtin_amdgcn_raw_buffer_store_b128(w, bj == 0 ? r0 : r1, vo + bj * 256, so, 0);
                }
        }
    }
};
struct EpiGateA {
    static constexpr bool PERM = true;
    const bf16* GA; bf16* T1;
    __device__ __forceinline__ void stage(const GUnit&, LAS unsigned char*, int) const {}
    __device__ __forceinline__ void operator()(const Acc& acc, const GUnit& u, int wr, int wc, int fr, int fq, const LAS float*) const {
        const int row0 = u.row0 + wr * 64 + fr;
        u32x4 gg[16];
#pragma unroll
        for (int ai = 0; ai < 2; ++ai)
#pragma unroll
            for (int m = 0; m < 4; ++m)
#pragma unroll
                for (int bj = 0; bj < 2; ++bj) gg[(ai * 4 + m) * 2 + bj] = *(const u32x4*)(GA + (size_t)(row0 + ai * 128 + m * 16) * 1024 + u.pn * 256 + bj * 128 + wc * 32 + 8 * fq);
#pragma unroll
        for (int ai = 0; ai < 2; ++ai)
#pragma unroll
            for (int m = 0; m < 4; ++m)
#pragma unroll
                for (int bj = 0; bj < 2; ++bj) { const size_t off = (size_t)(row0 + ai * 128 + m * 16) * 1024 + u.pn * 256 + bj * 128 + wc * 32 + 8 * fq;
                    const u32x4 g = gg[(ai * 4 + m) * 2 + bj]; f32x4 v0 = acc[ai][bj][m][0], v1 = acc[ai][bj][m][1];
                    v0[0] *= fast_sigmoid(bflo(g.x)); v0[1] *= fast_sigmoid(bfhi(g.x)); v0[2] *= fast_sigmoid(bflo(g.y)); v0[3] *= fast_sigmoid(bfhi(g.y)); v1[0] *= fast_sigmoid(bflo(g.z)); v1[1] *= fast_sigmoid(bfhi(g.z)); v1[2] *= fast_sigmoid(bflo(g.w)); v1[3] *= fast_sigmoid(bfhi(g.w));
                    *(u32x4*)(T1 + off) = pack8(v0, v1); }
    }
};
struct EpiMerge {
    static constexpr bool PERM = true;
    const bf16* GP; const bf16* T1; bf16* MG;
    __device__ __forceinline__ void stage(const GUnit&, LAS unsigned char*, int) const {}
    __device__ __forceinline__ void operator()(const Acc& acc, const GUnit& u, int wr, int wc, int fr, int fq, const LAS float*) const {
        const int row0 = u.row0 + wr * 64 + fr;
#pragma unroll
        for (int ai = 0; ai < 2; ++ai) {
            u32x4 gg[8], tt[8];
#pragma unroll
            for (int m = 0; m < 4; ++m)
#pragma unroll
                for (int bj = 0; bj < 2; ++bj) { const size_t off = (size_t)(row0 + ai * 128 + m * 16) * 1024 + u.pn * 256 + bj * 128 + wc * 32 + 8 * fq;
                    gg[m * 2 + bj] = *(const u32x4*)(GP + off); tt[m * 2 + bj] = *(const u32x4*)(T1 + off); }
#pragma unroll
            for (int m = 0; m < 4; ++m)
#pragma unroll
                for (int bj = 0; bj < 2; ++bj) { const size_t off = (size_t)(row0 + ai * 128 + m * 16) * 1024 + u.pn * 256 + bj * 128 + wc * 32 + 8 * fq;
                    const u32x4 g = gg[m * 2 + bj]; const u32x4 t = tt[m * 2 + bj]; f32x4 v0 = acc[ai][bj][m][0], v1 = acc[ai][bj][m][1];
                    v0[0] = v0[0] * fast_sigmoid(bflo(g.x)) + bflo(t.x); v0[1] = v0[1] * fast_sigmoid(bfhi(g.x)) + bfhi(t.x); v0[2] = v0[2] * fast_sigmoid(bflo(g.y)) + bflo(t.y); v0[3] = v0[3] * fast_sigmoid(bfhi(g.y)) + bfhi(t.y);
                    v1[0] = v1[0] * fast_sigmoid(bflo(g.z)) + bflo(t.z); v1[1] = v1[1] * fast_sigmoid(bfhi(g.z)) + bfhi(t.z); v1[2] = v1[2] * fast_sigmoid(bflo(g.w)) + bflo(t.w); v1[3] = v1[3] * fast_sigmoid(bfhi(g.w)) + bfhi(t.w);
                    *(u32x4*)(MG + off) = pack8(v0, v1); }
        }
    }
};
struct EpiX1 {
    static constexpr bool PERM = true;
    bf16* X1;
    __device__ __forceinline__ void stage(const GUnit&, LAS unsigned char*, int) const {}
    __device__ __forceinline__ void operator()(const Acc& acc, const GUnit& u, int wr, int wc, int fr, int fq, const LAS float*) const {
        const int row0 = u.row0 + wr * 64 + fr;
#pragma unroll
        for (int ai = 0; ai < 2; ++ai)
#pragma unroll
            for (int m = 0; m < 4; ++m)
#pragma unroll
                for (int bj = 0; bj < 2; ++bj) *(u32x4*)(X1 + (size_t)(row0 + ai * 128 + m * 16) * 1024 + u.pn * 256 + bj * 128 + wc * 32 + 8 * fq) = pack8(acc[ai][bj][m][0], acc[ai][bj][m][1]);
    }
};
struct EpiSwiglu {
    static constexpr bool PERM = true;
    const float* bup; fp8* ACT;
    __device__ __forceinline__ void stage(const GUnit& u, LAS unsigned char* slot, int lane) const {
        const __amdgpu_buffer_rsrc_t rs = __builtin_amdgcn_make_buffer_rsrc((void*)bup, 0, 0x7fffffff, 0x00020000);
        __builtin_amdgcn_raw_ptr_buffer_load_lds(rs, (LAS void*)slot, 16, (lane & 31) * 16 + (lane >> 5) * 4096, (u.e * 2048 + u.pn * 128) * 4, 0, 0); }
    __device__ __forceinline__ void operator()(const Acc& acc, const GUnit& u, int wr, int wc, int fr, int fq, const LAS float* bl) const {
        const int row0 = u.row0 + wr * 64 + fr, col = u.pn * 128 + wc * 32 + 8 * fq;
        const LAS float* bg = bl + wc * 32 + 8 * fq;
        const f32x4 g0 = *(const LAS f32x4*)bg, g1 = *(const LAS f32x4*)(bg + 4), l0 = *(const LAS f32x4*)(bg + 128), l1 = *(const LAS f32x4*)(bg + 132);
#pragma unroll
        for (int ai = 0; ai < 2; ++ai)
#pragma unroll
            for (int m = 0; m < 4; ++m) {
                f32x4 a0 = acc[ai][0][m][0] * W8_INV + g0, a1 = acc[ai][0][m][1] * W8_INV + g1, c0 = acc[ai][1][m][0] * W8_INV + l0, c1 = acc[ai][1][m][1] * W8_INV + l1, r0, r1;
#pragma unroll
                for (int j = 0; j < 4; ++j) {
                    const float ga = fminf(a0[j], 7.f), la = fminf(fmaxf(c0[j], -7.f), 7.f); r0[j] = ga * fast_sigmoid(1.702f * ga) * (la + 1.f);
                    const float gb = fminf(a1[j], 7.f), lb = fminf(fmaxf(c1[j], -7.f), 7.f); r1[j] = gb * fast_sigmoid(1.702f * gb) * (lb + 1.f); }
                int w0 = 0, w1 = 0;
                w0 = __builtin_amdgcn_cvt_pk_fp8_f32(r0[0], r0[1], w0, false); w0 = __builtin_amdgcn_cvt_pk_fp8_f32(r0[2], r0[3], w0, true);
                w1 = __builtin_amdgcn_cvt_pk_fp8_f32(r1[0], r1[1], w1, false); w1 = __builtin_amdgcn_cvt_pk_fp8_f32(r1[2], r1[3], w1, true);
                u32x2 w; w.x = (unsigned)w0; w.y = (unsigned)w1;
                *(u32x2*)(ACT + (size_t)(row0 + ai * 128 + m * 16) * 1024 + col) = w;
            }
    }
};
struct EpiDown {
    static constexpr bool PERM = true;
    const float* bdn; fp8* YS;
    __device__ __forceinline__ void stage(const GUnit& u, LAS unsigned char* slot, int lane) const {
        const __amdgpu_buffer_rsrc_t rs = __builtin_amdgcn_make_buffer_rsrc((void*)bdn, 0, 0x7fffffff, 0x00020000);
        __builtin_amdgcn_raw_ptr_buffer_load_lds(rs, (LAS void*)slot, 16, lane * 16, (u.e * 1024 + u.pn * 256) * 4, 0, 0); }
    __device__ __forceinline__ void operator()(const Acc& acc, const GUnit& u, int wr, int wc, int fr, int fq, const LAS float* bl) const {
        const int row0 = u.row0 + wr * 64 + fr;
#pragma unroll
        for (int bj = 0; bj < 2; ++bj) { const int col = u.pn * 256 + bj * 128 + wc * 32 + 8 * fq;
            const f32x4 b0 = *(const LAS f32x4*)(bl + bj * 128 + wc * 32 + 8 * fq), b1 = *(const LAS f32x4*)(bl + bj * 128 + wc * 32 + 8 * fq + 4);
#pragma unroll
            for (int ai = 0; ai < 2; ++ai)
#pragma unroll
                for (int m = 0; m < 4; ++m) { const f32x4 r0 = acc[ai][bj][m][0] * W8_INV + b0, r1 = acc[ai][bj][m][1] * W8_INV + b1; int w0 = 0, w1 = 0;
                    w0 = __builtin_amdgcn_cvt_pk_fp8_f32(r0[0], r0[1], w0, false); w0 = __builtin_amdgcn_cvt_pk_fp8_f32(r0[2], r0[3], w0, true);
                    w1 = __builtin_amdgcn_cvt_pk_fp8_f32(r1[0], r1[1], w1, false); w1 = __builtin_amdgcn_cvt_pk_fp8_f32(r1[2], r1[3], w1, true);
                    u32x2 w; w.x = (unsigned)w0; w.y = (unsigned)w1; *(u32x2*)(YS + (size_t)(row0 + ai * 128 + m * 16) * 1024 + col) = w; } }
    }
};
}

struct Args { const float* in[19]; float* out; unsigned char* ws; int ph_lo, ph_hi, li, pad; };
struct Frame {
    LAS unsigned char* lds; int tid, lane, wave, G, bx;
    unsigned char* ws; gu32* ctl;
};

__device__ __forceinline__ void conv_item(const float* W, int N, bf16* WT, int K, int k0, int n_src0, int n_dst0, int lane, LAS unsigned char* scr) {
    const int hw = lane >> 5, l5 = lane & 31;
    const float* src = W + (size_t)(k0 + 16 * hw) * N + n_src0 + 4 * l5;
#pragma unroll
    for (int half = 0; half < 2; ++half) {
        f32x4 v[16];
#pragma unroll
        for (int j = 0; j < 16; ++j) v[j] = *(const f32x4*)(src + (size_t)(32 * half + j) * N);
#pragma unroll
        for (int q = 0; q < 4; ++q) { const int row = 4 * l5 + q;
#pragma unroll
            for (int cc = 0; cc < 2; ++cc) { u32x4 w; w.x = cvt_pk_bf16(v[8 * cc + 0][q], v[8 * cc + 1][q]); w.y = cvt_pk_bf16(v[8 * cc + 2][q], v[8 * cc + 3][q]);
                w.z = cvt_pk_bf16(v[8 * cc + 4][q], v[8 * cc + 5][q]); w.w = cvt_pk_bf16(v[8 * cc + 6][q], v[8 * cc + 7][q]);
                const int c = 4 * half + 2 * hw + cc;
                *(LAS u32x4*)(scr + row * 128 + ((c ^ (l5 & 7)) << 4)) = w; } }
    }
    LDS_WAIT(); asm volatile("" ::: "memory");
    bf16* dst = WT + (size_t)(n_dst0 + (lane >> 3)) * K + k0 + 8 * (lane & 7);
#pragma unroll
    for (int i = 0; i < 16; ++i) { const int n = 8 * i + (lane >> 3), c = lane & 7;
        const u32x4 w = *(const LAS u32x4*)(scr + n * 128 + ((c ^ ((n >> 2) & 7)) << 4));
        *(u32x4*)(dst + (size_t)(8 * i) * K) = w; }
    LDS_WAIT(); asm volatile("" ::: "memory");
}
__device__ __forceinline__ int pk4_fp8(float a, float b, float c, float d) { int w = 0; w = __builtin_amdgcn_cvt_pk_fp8_f32(a * W8_SCALE, b * W8_SCALE, w, false); w = __builtin_amdgcn_cvt_pk_fp8_f32(c * W8_SCALE, d * W8_SCALE, w, true); return w; }
template <int UNR> __device__ __forceinline__ void conv_item8(const float* W, int N, fp8* WT, int K, int k0, int n_src0, int n_dst0, int lane, LAS unsigned char* scr) {
    const int hw = lane >> 5, l5 = lane & 31;
    const float* src = W + (size_t)(k0 + 16 * hw) * N + n_src0 + 4 * l5;
#pragma unroll UNR
    for (int qt = 0; qt < 4; ++qt) {
        f32x4 v[16];
#pragma unroll
        for (int j = 0; j < 16; ++j) v[j] = __builtin_nontemporal_load((const f32x4*)(src + (size_t)(32 * qt + j) * N));
#pragma unroll
        for (int q = 0; q < 4; ++q) { const int row = 4 * l5 + q; u32x4 w;
            w.x = (unsigned)pk4_fp8(v[0][q], v[1][q], v[2][q], v[3][q]); w.y = (unsigned)pk4_fp8(v[4][q], v[5][q], v[6][q], v[7][q]);
            w.z = (unsigned)pk4_fp8(v[8][q], v[9][q], v[10][q], v[11][q]); w.w = (unsigned)pk4_fp8(v[12][q], v[13][q], v[14][q], v[15][q]);
            const int c = 2 * qt + hw;
            *(LAS u32x4*)(scr + row * 128 + ((c ^ (l5 & 7)) << 4)) = w; }
    }
    LDS_WAIT(); asm volatile("" ::: "memory");
    fp8* dst = WT + (size_t)(n_dst0 + (lane >> 3)) * K + k0 + 16 * (lane & 7);
#pragma unroll
    for (int i = 0; i < 16; ++i) { const int n = 8 * i + (lane >> 3), c = lane & 7;
        const u32x4 w = *(const LAS u32x4*)(scr + n * 128 + ((c ^ ((n >> 2) & 7)) << 4));
        __builtin_nontemporal_store(w, (u32x4*)(dst + (size_t)(8 * i) * K)); }
    LDS_WAIT(); asm volatile("" ::: "memory");
}
__device__ __forceinline__ void p0b_weights(const Frame& F, const Args& a, int widx, int nw) {
    const int gw = widx * NWAVES + F.wave, NGW = nw * NWAVES, lane = F.lane;
    unsigned char* ws = F.ws;
    bf16* WATT = (bf16*)(ws + WS_WATT); bf16* WEFF = (bf16*)(ws + WS_WEFF); bf16* WOUT = (bf16*)(ws + WS_WOUT);
    LAS unsigned char* scr = F.lds + F.wave * 16384;
    fp8* WUP8 = (fp8*)(ws + WS_WUP);
    constexpr int I_UP = 32 * 8 * 16, I_AT = 16 * 8, I_OUT = 16 * 8;
    for (int it = gw; it < I_UP; it += NGW) {
        int r = it;
        { const int e = r >> 7, q = r & 127, kb = q >> 4, nb = q & 15; conv_item8<2>(a.in[14] + (size_t)e * 1024 * 2048, 2048, WUP8 + (size_t)e * 2048 * 1024, 1024, kb * 128, up_src_col(nb * 128), nb * 128, lane, scr); }
    }
    for (int it = gw; it < I_AT + I_OUT; it += NGW) {
        int r = it;
        if (r < I_AT) { const int kb = r >> 3, nb = r & 7; conv_item(a.in[6], 1024, WATT, 1024, kb * 64, nb * 128, nb * 128, lane, scr); continue; } r -= I_AT;
        { const int kb = r >> 3, nb = r & 7; conv_item(a.in[10], 1024, WOUT, 1024, kb * 64, nb * 128, nb * 128, lane, scr); }
    }
    for (int it = NGW - 1 - gw; it < 64 * 16; it += NGW) {
        const int k0 = (it >> 4) * 8, n0 = (it & 15) * 64, g = k0 >> 7, kk0 = k0 & 127;
        const float* pw = a.in[7] + (size_t)(g * 128 + kk0) * 128; const float* ps = a.in[8] + g * 128; const float* wp = a.in[9] + (size_t)(g * 128) * 1024 + n0 + lane;
        float acc8[8];
#pragma unroll
        for (int q = 0; q < 8; ++q) acc8[q] = 0.f;
#pragma unroll 16
        for (int c = 0; c < 128; ++c) { const float wv = wp[(size_t)c * 1024] * ps[c];
#pragma unroll
            for (int q = 0; q < 8; ++q) acc8[q] += pw[q * 128 + c] * wv; }
        u32x4 w; w.x = cvt_pk_bf16(acc8[0], acc8[1]); w.y = cvt_pk_bf16(acc8[2], acc8[3]); w.z = cvt_pk_bf16(acc8[4], acc8[5]); w.w = cvt_pk_bf16(acc8[6], acc8[7]);
        *(u32x4*)(WEFF + (size_t)(n0 + lane) * 512 + k0) = w;
    }
}
__device__ __forceinline__ void p0_prologue(const Frame& F, const Args& a) {
    const int gw = F.bx * NWAVES + F.wave, NGW = F.G * NWAVES, lane = F.lane;
    unsigned char* ws = F.ws;
    bf16* WIN = (bf16*)(ws + WS_WIN); float* CS = (float*)(ws + WS_CS); bf16* H = (bf16*)(ws + WS_H);
    LAS unsigned char* scr = F.lds + F.wave * 16384;
    for (int it = gw; it < 16 * 30; it += NGW) { const int kb = it / 30, nb = it % 30; conv_item(a.in[3], INW, WIN, 1024, kb * 64, nb * 128, nb * 128, lane, scr); }
    { const float* wr = a.in[12]; bf16* WRH = (bf16*)(ws + WS_WRH); bf16* WRL = (bf16*)(ws + WS_WRL);
      for (int idx = gw * 64 + lane; idx < 32 * 1024; idx += NGW * 64) { const int e = idx >> 10, k = idx & 1023; const float w = wr[k * 32 + e]; const unsigned h = cvt_pk_bf16(w, 0.f) & 0xffffu;
          WRH[idx] = (bf16)h; WRL[idx] = (bf16)(cvt_pk_bf16(w - __uint_as_float(h << 16), 0.f) & 0xffffu); } }
    { const int* pos = (const int*)a.in[1];
      for (int idx = gw * 64 + lane; idx < T * 8; idx += NGW * 64) { const int t = idx >> 3, i = idx & 7; const float inv = powf(500000.0f, -(float)i * 0.125f); const float an = (float)pos[t] * inv;
          CS[t * 16 + i] = cosf(an); CS[t * 16 + 8 + i] = sinf(an); } }
    { const float* x = a.in[0]; const float* g1 = a.in[2];
      f32x4 gg[4];
#pragma unroll
      for (int j = 0; j < 4; ++j) gg[j] = ((const f32x4*)g1)[lane + 64 * j];
      for (int row = gw; row < T; row += 2 * NGW) {
          const int row2 = row + NGW;
          const f32x4* xr = (const f32x4*)(x + (size_t)row * D) + lane; const f32x4* xr2 = (const f32x4*)(x + (size_t)(row2 < T ? row2 : row) * D) + lane; f32x4 v[4], v2[4]; float s = 0.f, s2 = 0.f;
#pragma unroll
          for (int j = 0; j < 4; ++j) { v[j] = __builtin_nontemporal_load(xr + 64 * j); v2[j] = __builtin_nontemporal_load(xr2 + 64 * j); }
#pragma unroll
          for (int j = 0; j < 4; ++j) { s += v[j].x * v[j].x + v[j].y * v[j].y + v[j].z * v[j].z + v[j].w * v[j].w; s2 += v2[j].x * v2[j].x + v2[j].y * v2[j].y + v2[j].z * v2[j].z + v2[j].w * v2[j].w; }
          const float rstd = rsqrtf(wave_sum(s) * (1.f / D) + RMS_EPS), rstd2 = rsqrtf(wave_sum(s2) * (1.f / D) + RMS_EPS);
#pragma unroll
          for (int j = 0; j < 4; ++j) { const f32x4 o = v[j] * rstd * gg[j]; u32x2 w; w.x = cvt_pk_bf16(o[0], o[1]); w.y = cvt_pk_bf16(o[2], o[3]); *(u32x2*)(H + (size_t)row * D + 4 * lane + 256 * j) = w; }
          if (row2 < T) {
#pragma unroll
              for (int j = 0; j < 4; ++j) { const f32x4 o = v2[j] * rstd2 * gg[j]; u32x2 w; w.x = cvt_pk_bf16(o[0], o[1]); w.y = cvt_pk_bf16(o[2], o[3]); *(u32x2*)(H + (size_t)row2 * D + 4 * lane + 256 * j) = w; } }
      } }
}

template <int W> __device__ __forceinline__ void pool_rows(const bf16* U, bf16* PO, int t0, int wave, int lane) {
    const int c4 = 64 * wave + 4 * (lane & 15), r0 = t0 + 16 * (lane >> 4);
    const int pos0 = r0 % SEQ;
    u32x2 v[15 + W];
#pragma unroll
    for (int i = 0; i < 15 + W; ++i) { const int rr = r0 - (W - 1) + i; u32x2 z = {0u, 0u}; if (i >= W - 1 || pos0 != 0) z = *(const u32x2*)(U + (size_t)rr * PW + c4); v[i] = z; }
#pragma unroll
    for (int i = 0; i < 16; ++i) {
        float s0 = 0.f, s1 = 0.f, s2 = 0.f, s3 = 0.f;
#pragma unroll
        for (int jj = 0; jj < W; ++jj) { const u32x2 x = v[i + W - 1 - jj]; s0 += bflo(x.x); s1 += bfhi(x.x); s2 += bflo(x.y); s3 += bfhi(x.y); }
        const int pos = pos0 + i; const float rc = 1.0f / (float)(pos + 1 < W ? pos + 1 : W);
        const u32x2 c = v[i + W - 1]; u32x2 o;
        o.x = cvt_pk_bf16(s0 * rc - bflo(c.x), s1 * rc - bfhi(c.x)); o.y = cvt_pk_bf16(s2 * rc - bflo(c.y), s3 * rc - bfhi(c.y));
        *(u32x2*)(PO + (size_t)(r0 + i) * PW + c4) = o;
    }
}
__device__ __forceinline__ void attn_unit(const Frame& F, int unit, const bf16* Q, const bf16* KB, const bf16* VB, const float* sinks, bf16* AO, const bf16* U, bf16* PO, int pool_chunk, const float* w_down, fp8* WDN8, bool first) {
    const int lane = F.lane, wid = F.wave, r32 = lane & 31, hi = lane >> 5;
    const int b = unit >> 6, n = (unit >> 1) & 31, hkv = unit & 1;
    LAS unsigned char* Kt = F.lds; LAS unsigned char* Vt = F.lds + 32768;
    const int tok0 = b * SEQ + 128 * (n - 1);
    int hq = hkv * 8 + 2 * (wid & 3);
    if (!first) __syncthreads();
    bf16x8 qn[4];
    if (wid >= 4) {
        const int it = unit * 4 + (wid - 4), e = it >> 6, q = it & 63, kb = q >> 3, nb = q & 7;
        conv_item8<1>(w_down + (size_t)e * 1024 * 1024, 1024, WDN8 + (size_t)e * 1024 * 1024, 1024, kb * 128, nb * 128, nb * 128, lane, F.lds + 65536 + (wid - 4) * 16384);
    } else {
        const __amdgpu_buffer_rsrc_t rsK = __builtin_amdgcn_make_buffer_rsrc((void*)KB, 0, 0x7fffffff, 0x00020000), rsV = __builtin_amdgcn_make_buffer_rsrc((void*)VB, 0, 0x7fffffff, 0x00020000);
        int ln = lane; asm volatile("" : "+v"(ln));
#pragma unroll
        for (int i = 0; i < 8; ++i) { const int row = (i * 4 + wid) * 8 + (ln >> 3), pp = ln & 7; int tok = tok0 + row; tok = tok < b * SEQ ? b * SEQ + row : tok;
            const int ck = pp ^ ((row >> 1) & 7), cv = pp ^ (((row >> 1) & 1) << 2);
            __builtin_amdgcn_raw_ptr_buffer_load_lds(rsK, (LAS void*)(Kt + (i * 4 + wid) * 1024), 16, tok * 256 + hkv * 128 + ck * 16, 0, 0, 0);
            __builtin_amdgcn_raw_ptr_buffer_load_lds(rsV, (LAS void*)(Vt + (i * 4 + wid) * 1024), 16, tok * 256 + hkv * 128 + cv * 16, 0, 0, 0); }
        const size_t qrow = (size_t)b * SEQ + 128 * n + r32;
#pragma unroll
        for (int ks = 0; ks < 4; ++ks) qn[ks] = *(const bf16x8*)(Q + qrow * 1024 + hq * 64 + ks * 16 + hi * 8);
    }
    if (pool_chunk >= 0) { const int g = wid >> 1, t0 = pool_chunk * 64;
        if (g == 0) pool_rows<2>(U, PO, t0, wid, lane); else if (g == 1) pool_rows<4>(U, PO, t0, wid, lane); else if (g == 2) pool_rows<8>(U, PO, t0, wid, lane); else pool_rows<16>(U, PO, t0, wid, lane); }
    VM_WAIT();
    __syncthreads();
    if (wid >= 4) {
        const int it = unit * 4 + (wid - 4) + 1024, e = it >> 6, q = it & 63, kb = q >> 3, nb = q & 7;
        conv_item8<1>(w_down + (size_t)e * 1024 * 1024, 1024, WDN8 + (size_t)e * 1024 * 1024, 1024, kb * 128, nb * 128, nb * 128, lane, F.lds + 65536 + (wid - 4) * 16384);
        return;
    }
    constexpr float LOG2E = 1.44269504089f, C2 = 0.125f * LOG2E;
#pragma unroll 1
    for (int hsel = 0; hsel < 2; ++hsel) {
    const float sink = sinks[hq];
    if (hsel == 1) { const size_t qrow = (size_t)b * SEQ + 128 * n + r32;
#pragma unroll
        for (int ks = 0; ks < 4; ++ks) qn[ks] = *(const bf16x8*)(Q + qrow * 1024 + hq * 64 + ks * 16 + hi * 8); }
#pragma unroll 1
    for (int j = 0; j < 4; ++j) {
        const size_t qrow = (size_t)b * SEQ + 128 * n + 32 * j + r32;
        bf16x8 qf[4];
#pragma unroll
        for (int ks = 0; ks < 4; ++ks) qf[ks] = qn[ks];
        if (j < 3) {
#pragma unroll
            for (int ks = 0; ks < 4; ++ks) qn[ks] = *(const bf16x8*)(Q + (qrow + 32) * 1024 + hq * 64 + ks * 16 + hi * 8); }
        int r32v = r32; asm volatile("" : "+v"(r32v));
        f32x16 s[5];
#pragma unroll
        for (int tau = 0; tau < 5; ++tau) {
            const int kt = j + tau; const int krow = 32 * kt + r32;
            f32x16 a = {0.f, 0.f, 0.f, 0.f, 0.f, 0.f, 0.f, 0.f, 0.f, 0.f, 0.f, 0.f, 0.f, 0.f, 0.f, 0.f};
#pragma unroll
            for (int ks = 0; ks < 4; ++ks) { const bf16x8 kf = *(const LAS bf16x8*)(Kt + krow * 128 + (((2 * ks + hi) ^ ((krow >> 1) & 7)) << 4));
                a = __builtin_amdgcn_mfma_f32_32x32x16_bf16(kf, qf[ks], a, 0, 0, 0); }
            s[tau] = a;
        }
        float mx = -1.0e30f;
#pragma unroll
        for (int tau = 0; tau < 5; ++tau) { const bool dead = (n == 0) && (j + tau < 4);
#pragma unroll
            for (int r = 0; r < 16; ++r) { const int kk = (r & 3) + 8 * (r >> 2) + 4 * hi; bool ok = !dead; if (tau == 0) ok = ok && (kk > r32v); if (tau == 4) ok = ok && (kk <= r32v);
                s[tau][r] = ok ? s[tau][r] : -1.0e30f; mx = fmaxf(mx, s[tau][r]); } }
        mx = fmaxf(mx, __shfl_xor(mx, 32));
        const float mm = fmaxf(mx * 0.125f, sink), mml = mm * LOG2E;
        float sum = 0.f;
#pragma unroll
        for (int tau = 0; tau < 5; ++tau)
#pragma unroll
            for (int r = 0; r < 16; ++r) { const float p = (s[tau][r] > -1.0e29f) ? __builtin_amdgcn_exp2f(s[tau][r] * C2 - mml) : 0.f; s[tau][r] = p; sum += p; }
        sum += __shfl_xor(sum, 32);
        sum += __builtin_amdgcn_exp2f((sink - mm) * LOG2E);
        const float inv = 1.0f / sum;
        bf16* orow = AO + qrow * 1024 + hq * 64;
#pragma unroll
        for (int d0 = 0; d0 < 2; ++d0) {
            f32x16 o = {0.f, 0.f, 0.f, 0.f, 0.f, 0.f, 0.f, 0.f, 0.f, 0.f, 0.f, 0.f, 0.f, 0.f, 0.f, 0.f};
#pragma unroll
            for (int tau = 0; tau < 5; ++tau) {
                const int kt = j + tau;
#pragma unroll
                for (int s2 = 0; s2 < 2; ++s2) {
                    bf16x8 pf; { const unsigned w0 = cvt_pk_bf16(s[tau][8 * s2 + 0], s[tau][8 * s2 + 1]), w1 = cvt_pk_bf16(s[tau][8 * s2 + 2], s[tau][8 * s2 + 3]), w2 = cvt_pk_bf16(s[tau][8 * s2 + 4], s[tau][8 * s2 + 5]), w3 = cvt_pk_bf16(s[tau][8 * s2 + 6], s[tau][8 * s2 + 7]);
                        const u32x4 w = {w0, w1, w2, w3}; pf = __builtin_bit_cast(bf16x8, w); }
                    const int vrow = 32 * kt + 16 * s2 + 4 * hi + ((lane & 15) >> 2);
                    const int vcb = 64 * d0 + 32 * ((lane >> 4) & 1) + 8 * (lane & 3);
                    const int vaddr = vrow * 128 + (vcb ^ (((vrow >> 1) & 1) << 6));
                    const s16x4 lo = __builtin_bit_cast(s16x4, __builtin_amdgcn_ds_read_tr16_b64_v4i16((LAS s16x4*)(Vt + vaddr)));
                    const s16x4 hh = __builtin_bit_cast(s16x4, __builtin_amdgcn_ds_read_tr16_b64_v4i16((LAS s16x4*)(Vt + vaddr + 1024)));
                    const bf16x8 vf = {lo[0], lo[1], lo[2], lo[3], hh[0], hh[1], hh[2], hh[3]};
                    o = __builtin_amdgcn_mfma_f32_32x32x16_bf16(vf, pf, o, 0, 0, 0);
                }
            }
#pragma unroll
            for (int rg = 0; rg < 4; ++rg) { u32x2 w; w.x = cvt_pk_bf16(o[4 * rg] * inv, o[4 * rg + 1] * inv); w.y = cvt_pk_bf16(o[4 * rg + 2] * inv, o[4 * rg + 3] * inv);
                *(u32x2*)(orow + 32 * d0 + 8 * rg + 4 * hi) = w; }
        }
    }
    ++hq;
    }
}

__device__ __forceinline__ void moe_tables(const Frame& F) {
    LAS int* tb = (LAS int*)(F.lds + TBL_OFF);
    __syncthreads();
    if (F.tid < 32) tb[192 + F.tid] = (int)__hip_atomic_load(F.ctl + CW_CNT + F.tid, RLX_AGENT);
    __syncthreads();
    if (F.tid == 0) { int u8 = 0, u4 = 0, ro = 0;
        for (int e = 0; e < 32; ++e) { const int c = tb[192 + e], r = (c + 255) >> 8; tb[e] = u8; tb[64 + e] = u4; tb[128 + e] = ro; u8 += r * 8; u4 += r * 4; ro += r * 256; }
        tb[32] = u8; tb[64 + 32] = u4; tb[128 + 32] = ro; }
    if (F.wave == 0) {
        const int e = F.lane & 31, R = (tb[192 + e] + 255) >> 8, L = R + (R >> 1); const bool odd = (R & 1) != 0;
        int lm = odd ? L : 0;
#pragma unroll
        for (int o = 16; o >= 1; o >>= 1) lm = max(lm, __shfl_xor(lm, o));
        const unsigned long long bx = __ballot(odd && L == lm), bh = __ballot(!odd && L + 1 <= lm);
        if (F.lane == 0) { tb[224] = (int)(unsigned)bx; tb[225] = (int)(unsigned)bh; }
    }
    __syncthreads();
}

__device__ __forceinline__ void router_chunk(const Frame& F, int chunk, const float* x, const bf16* X1, const float* g2, const bf16* WRH, const bf16* WRL, const float* br, fp8* H2, gu32* counts, int* stok, int* toke, float* tokg, bf16* X1B) {
    const int tid = F.tid, lane = F.lane, w = F.wave, i32 = lane & 31, hh = lane >> 5;
    LAS unsigned char* lds = F.lds;
    LAS float* logit = (LAS float*)(lds + RT_LOGIT); LAS int* tokE = (LAS int*)(lds + RT_TOKE); LAS int* tokR = (LAS int*)(lds + RT_TOKR); LAS float* tokG = (LAS float*)(lds + RT_TOKG);
    LAS unsigned* hist = (LAS unsigned*)(lds + RT_HIST); LAS unsigned* base = (LAS unsigned*)(lds + RT_BASE);
    LAS float* g2l = (LAS float*)(lds + RT_LOGIT + 4224);
    const __amdgpu_buffer_rsrc_t rsX = __builtin_amdgcn_make_buffer_rsrc((void*)x, 0, 0x7fffffff, 0x00020000), rsD = __builtin_amdgcn_make_buffer_rsrc((void*)X1, 0, 0x7fffffff, 0x00020000), rsH = __builtin_amdgcn_make_buffer_rsrc((void*)H2, 0, 0x7fffffff, 0x00020000), rsB = __builtin_amdgcn_make_buffer_rsrc((void*)X1B, 0, 0x7fffffff, 0x00020000);
    const int vx = lane * 16, vd = lane * 8, vh = lane * 4;
    f32x4 xv[4][4];
#pragma unroll
    for (int q = 0; q < 4; ++q) { const int so = (chunk * 64 + 4 * w + q) * (D * 4);
#pragma unroll
        for (int j = 0; j < 4; ++j) xv[q][j] = __builtin_bit_cast(f32x4, __builtin_amdgcn_raw_buffer_load_b128(rsX, vx + 1024 * j, so, 0)); }
    bf16x8 bh[8], bl[8];
    __syncthreads();
    if (tid < 32) hist[tid] = 0u;
    *(LAS f32x2*)(g2l + 2 * tid) = *(const f32x2*)(g2 + 2 * tid);
    __syncthreads();
#pragma unroll
    for (int p = 0; p < 2; ++p) {
        const int r0 = chunk * 64 + 32 * p;
#pragma unroll
        for (int qh = 0; qh < 2; ++qh) {
            u32x2 dv[2][4];
#pragma unroll
            for (int q2 = 0; q2 < 2; ++q2)
#pragma unroll
                for (int j = 0; j < 4; ++j) dv[q2][j] = __builtin_bit_cast(u32x2, __builtin_amdgcn_raw_buffer_load_b64(rsD, vd + 512 * j, (r0 + 4 * w + 2 * qh + q2) * (D * 2), 0));
#pragma unroll
            for (int q2 = 0; q2 < 2; ++q2) { const int q = 2 * qh + q2, rl = 4 * w + q, row = r0 + rl; float s = 0.f;
#pragma unroll
                for (int j = 0; j < 4; ++j) { const u32x2 dw = dv[q2][j]; const f32x4 t = xv[q][j] + (f32x4){bflo(dw.x), bfhi(dw.x), bflo(dw.y), bfhi(dw.y)}; xv[q][j] = t; s += t.x * t.x + t.y * t.y + t.z * t.z + t.w * t.w;
                    u32x2 xb; xb.x = cvt_pk_bf16(t.x, t.y); xb.y = cvt_pk_bf16(t.z, t.w); __builtin_amdgcn_raw_buffer_store_b64(xb, rsB, vd + 512 * j, row * (D * 2), 0); }
                const float rstd = rsqrtf(wave_sum(s) * (1.f / D) + RMS_EPS);
#pragma unroll
                for (int j = 0; j < 4; ++j) { const f32x4 o = xv[q][j] * rstd * *(const LAS f32x4*)(g2l + 4 * lane + 256 * j); int pk = 0; pk = __builtin_amdgcn_cvt_pk_fp8_f32(o[0], o[1], pk, false); pk = __builtin_amdgcn_cvt_pk_fp8_f32(o[2], o[3], pk, true);
                    __builtin_amdgcn_raw_buffer_store_b32((unsigned)pk, rsH, vh + 256 * j, row * D, 0); *(LAS f32x4*)(lds + rl * HB_STRIDE + (4 * lane + 256 * j) * 4) = o; } }
        }
        if (p == 0) {
            { const bf16* ph = WRH + (size_t)i32 * 1024 + 128 * w + 8 * hh; const bf16* pl = WRL + (size_t)i32 * 1024 + 128 * w + 8 * hh;
#pragma unroll
              for (int ks = 0; ks < 8; ++ks) { bh[ks] = *(const bf16x8*)(ph + 16 * ks); bl[ks] = *(const bf16x8*)(pl + 16 * ks); } }
#pragma unroll
            for (int q = 0; q < 4; ++q) { const int so = (chunk * 64 + 32 + 4 * w + q) * (D * 4);
#pragma unroll
                for (int j = 0; j < 4; ++j) xv[q][j] = __builtin_bit_cast(f32x4, __builtin_amdgcn_raw_buffer_load_b128(rsX, vx + 1024 * j, so, 0)); } }
        __syncthreads();
        f32x16 acc = {0.f, 0.f, 0.f, 0.f, 0.f, 0.f, 0.f, 0.f, 0.f, 0.f, 0.f, 0.f, 0.f, 0.f, 0.f, 0.f};
#pragma unroll
        for (int ks = 0; ks < 8; ++ks) {
            const LAS float* hp = (const LAS float*)(lds + i32 * HB_STRIDE + (128 * w + 16 * ks + 8 * hh) * 4);
            const f32x4 a0 = *(const LAS f32x4*)hp, a1 = *(const LAS f32x4*)(hp + 4);
            u32x4 whi, wlo;
            whi.x = cvt_pk_bf16(a0[0], a0[1]); whi.y = cvt_pk_bf16(a0[2], a0[3]); whi.z = cvt_pk_bf16(a1[0], a1[1]); whi.w = cvt_pk_bf16(a1[2], a1[3]);
            wlo.x = cvt_pk_bf16(a0[0] - bflo(whi.x), a0[1] - bfhi(whi.x)); wlo.y = cvt_pk_bf16(a0[2] - bflo(whi.y), a0[3] - bfhi(whi.y));
            wlo.z = cvt_pk_bf16(a1[0] - bflo(whi.z), a1[1] - bfhi(whi.z)); wlo.w = cvt_pk_bf16(a1[2] - bflo(whi.w), a1[3] - bfhi(whi.w));
            const bf16x8 ahi = __builtin_bit_cast(bf16x8, whi), alo = __builtin_bit_cast(bf16x8, wlo);
            acc = __builtin_amdgcn_mfma_f32_32x32x16_bf16(ahi, bh[ks], acc, 0, 0, 0);
            acc = __builtin_amdgcn_mfma_f32_32x32x16_bf16(ahi, bl[ks], acc, 0, 0, 0);
            acc = __builtin_amdgcn_mfma_f32_32x32x16_bf16(alo, bh[ks], acc, 0, 0, 0);
        }
        __syncthreads();
        LAS float* part = (LAS float*)lds;
#pragma unroll
        for (int r = 0; r < 16; ++r) { const int tk = (r & 3) + 8 * (r >> 2) + 4 * hh; part[(w * 32 + tk) * 33 + i32] = acc[r]; }
        __syncthreads();
#pragma unroll
        for (int q = 0; q < 2; ++q) { const int o = tid + 512 * q, tk = o >> 5, e = o & 31; float sacc = br[e];
#pragma unroll
            for (int ww = 0; ww < 8; ++ww) sacc += part[(ww * 32 + tk) * 33 + e];
            logit[(32 * p + tk) * 33 + e] = sacc; }
        __syncthreads();
    }
    if (tid < 64) {
        float lg[32];
#pragma unroll
        for (int e = 0; e < 32; ++e) lg[e] = logit[tid * 33 + e];
        int be[4]; float bv[4]; unsigned used = 0u;
#pragma unroll
        for (int k = 0; k < 4; ++k) { float best = -3.0e38f; int bi = 0;
#pragma unroll
            for (int e = 0; e < 32; ++e) { const bool ok = !((used >> e) & 1u) && lg[e] > best; best = ok ? lg[e] : best; bi = ok ? e : bi; }
            be[k] = bi; bv[k] = best; used |= 1u << bi; }
        float ex[4], se = 0.f;
#pragma unroll
        for (int k = 0; k < 4; ++k) { ex[k] = __expf(bv[k] - bv[0]); se += ex[k]; }
        const float rse = 1.0f / se;
#pragma unroll
        for (int k = 0; k < 4; ++k) { const unsigned rk = __hip_atomic_fetch_add(hist + be[k], 1u, __ATOMIC_RELAXED, __HIP_MEMORY_SCOPE_WORKGROUP);
            tokE[tid * 4 + k] = be[k]; tokR[tid * 4 + k] = (int)rk; tokG[tid * 4 + k] = ex[k] * rse; }
    }
    __syncthreads();
    if (tid < 32) { const unsigned hc = hist[tid]; base[tid] = hc ? __hip_atomic_fetch_add(counts + tid, hc, RLX_AGENT) : 0u; }
    __syncthreads();
    if (tid < 256) { const int tk = tid >> 2, k = tid & 3, e = tokE[tk * 4 + k], pos = (int)base[e] + tokR[tk * 4 + k], t = chunk * 64 + tk;
        stok[e * CAP + pos] = t; toke[t * 4 + k] = e | (pos << 8); tokg[t * 4 + k] = tokG[tk * 4 + k]; }
}

__device__ __forceinline__ void combine_rows(const Frame& F, const float* x, const bf16* X1, const fp8* YS, const int* toke, const float* tokg, const float* gf, float* out) {
    const int lane = F.lane; const LAS int* rowoff = (const LAS int*)(F.lds + TBL_OFF) + 128;
    f32x4 gg[4];
#pragma unroll
    for (int j = 0; j < 4; ++j) gg[j] = ((const f32x4*)gf)[lane + 64 * j];
    for (int t = F.bx * NWAVES + F.wave; t < T; t += F.G * NWAVES) {
        f32x4 v[4];
#pragma unroll
        for (int j = 0; j < 4; ++j) { const u32x2 dw = __builtin_nontemporal_load((const u32x2*)(X1 + (size_t)t * D + 4 * lane + 256 * j)); v[j] = (f32x4){bflo(dw.x), bfhi(dw.x), bflo(dw.y), bfhi(dw.y)}; }
        const int4 te = *(const int4*)(toke + t * 4); const f32x4 tg = *(const f32x4*)(tokg + t * 4);
        const int tes[4] = {te.x, te.y, te.z, te.w};
#pragma unroll
        for (int k = 0; k < 4; ++k) { const int e = tes[k] & 255, pos = tes[k] >> 8; const float g = tg[k];
            const fp8* y = YS + (size_t)(rowoff[e] + pos) * 1024 + 4 * lane;
#pragma unroll
            for (int j = 0; j < 4; ++j) { const int pw = __builtin_nontemporal_load((const int*)(y + 256 * j)); const f32x2 lo = __builtin_amdgcn_cvt_pk_f32_fp8(pw, false), hi2 = __builtin_amdgcn_cvt_pk_f32_fp8(pw, true);
                v[j].x += g * lo[0]; v[j].y += g * lo[1]; v[j].z += g * hi2[0]; v[j].w += g * hi2[1]; } }
        float s = 0.f;
#pragma unroll
        for (int j = 0; j < 4; ++j) s += v[j].x * v[j].x + v[j].y * v[j].y + v[j].z * v[j].z + v[j].w * v[j].w;
        const float rstd = rsqrtf(wave_sum(s) * (1.f / D) + RMS_EPS);
#pragma unroll
        for (int j = 0; j < 4; ++j) __builtin_nontemporal_store(v[j] * rstd * gg[j], (f32x4*)(out + (size_t)t * D) + lane + 64 * j);
    }
}

constexpr int N_PHASES = 9;
__global__ void __launch_bounds__(NTHR, 2) fwd(Args a) {
    extern __shared__ __attribute__((aligned(16))) unsigned char lds_raw[];
    Frame F; F.lds = (LAS unsigned char*)lds_raw; F.tid = threadIdx.x; F.lane = F.tid & 63; F.wave = __builtin_amdgcn_readfirstlane(F.tid >> 6); F.G = gridDim.x; F.bx = blockIdx.x;
    F.ws = a.ws; F.ctl = (gu32*)(a.ws + WS_CTL);
    volatile LAS unsigned* MISC = (volatile LAS unsigned*)(F.lds + MISC_OFF);
    if (F.tid < 32) MISC[F.tid] = 0u;
    __syncthreads();
    XcdBarrier bar = xcd_barrier_post((unsigned*)(F.ctl + CW_BAR) + a.li * 4096, MISC + 8);
    unsigned char* const ws = a.ws;
#define WIN ((bf16*)(ws + WS_WIN))
#define WATT ((bf16*)(ws + WS_WATT))
#define WEFF ((bf16*)(ws + WS_WEFF))
#define WOUT ((bf16*)(ws + WS_WOUT))
#define CS ((float*)(ws + WS_CS))
#define WUP ((fp8*)(ws + WS_WUP))
#define WDN ((fp8*)(ws + WS_WDN))
#define H ((bf16*)(ws + WS_H))
#define H2 ((fp8*)(ws + WS_H2))
#define Q ((bf16*)(ws + WS_Q))
#define KB ((bf16*)(ws + WS_KB))
#define VB ((bf16*)(ws + WS_VB))
#define U ((bf16*)(ws + WS_U))
#define PO ((bf16*)(ws + WS_PO))
#define GA ((bf16*)(ws + WS_GA))
#define GP ((bf16*)(ws + WS_GP))
#define AO ((bf16*)(ws + WS_AO))
#define T1 ((bf16*)(ws + WS_T1))
#define MG ((bf16*)(ws + WS_MG))
#define X1 ((bf16*)(ws + WS_X1))
#define STOK ((int*)(ws + WS_STOK))
#define TOKE ((int*)(ws + WS_TOKE))
#define TOKG ((float*)(ws + WS_TOKG))
#define ACT ((fp8*)(ws + WS_ACT))
#define YS ((fp8*)(ws + WS_YS))
    const int lo = a.ph_lo, hi = a.ph_hi;
#define IN(k) (lo <= (k) && (k) < hi)
#define SEAM(k) do { if (IN(k) && IN((k) + 1)) xcd_barrier(bar); } while (0)
#define FRESH() do { int t_ = (int)threadIdx.x; asm volatile("" : "+v"(t_)); F.tid = t_; F.lane = t_ & 63; F.wave = __builtin_amdgcn_readfirstlane(t_ >> 6); } while (0)

    if (IN(0)) { FRESH(); p0b_weights(F, a, F.bx, F.G); p0_prologue(F, a); }
    SEAM(0);
    if (IN(1)) { FRESH();
        pg8::DenseOrder S; S.init(T, INW, F.G, F.bx);
        pg8::EpiInProj E{a.in[4], CS, Q, KB, VB, U, GA, GP};
        pg8::gemm_phase<pg8::EpiInProj, pg8::DenseOrder, 1024, false, false>(F.lds, H, WIN, 0, S, E, nullptr);
    }
    SEAM(1);
    if (IN(2)) { FRESH();
        for (int u = F.bx; u < 256; u += F.G) attn_unit(F, u, Q, KB, VB, a.in[5], AO, U, PO, u, a.in[16], WDN, u == F.bx);
        __syncthreads();
    }
    SEAM(2);
    if (IN(3)) { FRESH();
        pg8::DenseOrder S; S.init(T, 1024, F.G, F.bx);
        { pg8::EpiGateA E{GA, T1}; pg8::gemm_phase<pg8::EpiGateA, pg8::DenseOrder, 1024, false, false>(F.lds, AO, WATT, 0, S, E, nullptr); }
        VM_WAIT(); __syncthreads();
        { pg8::EpiMerge E{GP, T1, MG}; pg8::gemm_phase<pg8::EpiMerge, pg8::DenseOrder, 512, false, false>(F.lds, PO, WEFF, 0, S, E, nullptr); }
    }
    SEAM(3);
    if (IN(4)) { FRESH();
        pg8::DenseOrder S; S.init(T, 1024, F.G, F.bx);
        pg8::EpiX1 E{X1};
        pg8::gemm_phase<pg8::EpiX1, pg8::DenseOrder, 1024, false, false>(F.lds, MG, WOUT, 0, S, E, nullptr);
    }
    SEAM(4);
    if (IN(5)) { FRESH();
        for (int ch = F.bx; ch < T / 64; ch += F.G) router_chunk(F, ch, a.in[0], X1, a.in[11], (const bf16*)(ws + WS_WRH), (const bf16*)(ws + WS_WRL), a.in[13], H2, F.ctl + CW_CNT, STOK, TOKE, TOKG, (bf16*)(ws + WS_X1B));
        __syncthreads();
    }
    SEAM(5);
    if (IN(6)) { FRESH();
        moe_tables(F);
        const LAS int* tb = (const LAS int*)(F.lds + TBL_OFF);
        pg8::EpiSwiglu E{a.in[15], ACT};
        pg8::MoeOrderX<true> S{tb + 128, tb + 192, 3, F.G, F.bx};
        pg8::gemm_phase<pg8::EpiSwiglu, pg8::MoeOrderX<true>, 1024, true, true>(F.lds, H2, WUP, (size_t)2048 * 1024, S, E, STOK);
        VM_WAIT(); __syncthreads();
        if (F.tid == 0) {
            __builtin_amdgcn_fence(__ATOMIC_RELEASE, "agent"); VM_WAIT();
            for (int v = F.bx; v < 256; v += F.G) { const int e = (v & 7) + 8 * ((v >> 3) >> 3); (void)xb_add((unsigned*)(F.ctl + CW_DONE + 64 * e), 1u); }
        }
    }
    if (IN(7)) { FRESH();
        moe_tables(F);
        const LAS int* tb = (const LAS int*)(F.lds + TBL_OFF);
        const unsigned mx = (unsigned)__builtin_amdgcn_readfirstlane(tb[224]), mh = (unsigned)__builtin_amdgcn_readfirstlane(tb[225]);
        pg8::EpiDown E{a.in[17], YS};
        {   pg8::MoeOrderOwn S{tb + 128, tb + 192, mx, mh, F.G, F.bx};
            if (F.tid == 0) { pg8::GUnit u; unsigned seen = 0u;
                for (int i = 0; S.next(i, u); ++i) { if ((seen >> u.e) & 1u) continue; seen |= 1u << u.e; unsigned* p = (unsigned*)(F.ctl + CW_DONE + 64 * u.e); XB_SPIN(xb_ld(p) < 8u, bar.bar); }
                __builtin_amdgcn_fence(__ATOMIC_ACQUIRE, "agent"); VM_WAIT(); }
            __syncthreads();
            pg8::gemm_phase<pg8::EpiDown, pg8::MoeOrderOwn, 1024, false, true>(F.lds, ACT, WDN, (size_t)1024 * 1024, S, E, nullptr);
        }
        {   pg8::MoeOrderSteal S{tb + 128, tb + 192, mx, mh, F.G, F.bx};
            pg8::GUnit u0;
            if (S.next(0, u0)) {
                VM_WAIT(); __syncthreads();
                if (F.tid == 0) { pg8::GUnit u;
                    for (int i = 0; S.next(i, u); ++i) { unsigned* p = (unsigned*)(F.ctl + CW_DONE + 64 * u.e); XB_SPIN(xb_ld(p) < 8u, bar.bar); }
                    __builtin_amdgcn_fence(__ATOMIC_ACQUIRE, "agent"); VM_WAIT(); }
                __syncthreads();
                pg8::gemm_phase<pg8::EpiDown, pg8::MoeOrderSteal, 1024, false, true>(F.lds, ACT, WDN, (size_t)1024 * 1024, S, E, nullptr);
            }
        }
    }
    SEAM(7);
    if (IN(8)) { FRESH();
        moe_tables(F);
        combine_rows(F, a.in[0], (const bf16*)(ws + WS_X1B), YS, TOKE, TOKG, a.in[18], a.out);
    }
#undef IN
#undef SEAM
#undef WIN
#undef WATT
#undef WEFF
#undef WOUT
#undef CS
#undef WUP
#undef WDN
#undef H
#undef H2
#undef Q
#undef KB
#undef VB
#undef U
#undef PO
#undef GA
#undef GP
#undef AO
#undef T1
#undef MG
#undef X1
#undef STOK
#undef TOKE
#undef TOKG
#undef ACT
#undef YS
}

#ifndef REPEAT_MASK
#define REPEAT_MASK 0
#endif
#ifndef FAST_MASK
#define FAST_MASK 0x1ff
#endif
#ifndef ONE_LAUNCH
#define ONE_LAUNCH 1
#endif
extern "C" void kernel_launch(void* const* d_in, const int* in_sizes, int n_in, void* d_out, int out_size, void* d_ws, size_t ws_size, hipStream_t stream) {
    if (n_in != 19 || out_size != T * D || ws_size < WS_END) { fprintf(stderr, "kernel_launch: unexpected shapes / workspace (n_in %d, out %d, ws %zu)\n", n_in, out_size, ws_size); return; }
    const float* x = (const float*)d_in[0]; const int* positions = (const int*)d_in[1]; const float* norm1_g = (const float*)d_in[2];
    const float* w_in = (const float*)d_in[3]; const float* b_in = (const float*)d_in[4]; const float* sinks = (const float*)d_in[5];
    const float* w_attn = (const float*)d_in[6]; const float* pool_w = (const float*)d_in[7]; const float* pool_scale = (const float*)d_in[8];
    const float* w_pool = (const float*)d_in[9]; const float* w_out = (const float*)d_in[10]; const float* norm2_g = (const float*)d_in[11];
    const float* w_router = (const float*)d_in[12]; const float* b_router = (const float*)d_in[13]; const float* w_up = (const float*)d_in[14];
    const float* b_up = (const float*)d_in[15]; const float* w_down = (const float*)d_in[16]; const float* b_down = (const float*)d_in[17];
    const float* normf_g = (const float*)d_in[18];
    unsigned char* ws = (unsigned char*)d_ws; float* out = (float*)d_out;
    unsigned* ctl = (unsigned*)(ws + WS_CTL);
    bf16* WIN = (bf16*)(ws + WS_WIN); bf16* WATT = (bf16*)(ws + WS_WATT); bf16* WEFF = (bf16*)(ws + WS_WEFF); bf16* WOUT = (bf16*)(ws + WS_WOUT);
    float* CS = (float*)(ws + WS_CS); fp8* WUP = (fp8*)(ws + WS_WUP); fp8* WDN = (fp8*)(ws + WS_WDN);
    bf16* H = (bf16*)(ws + WS_H); bf16* Q = (bf16*)(ws + WS_Q); bf16* KB = (bf16*)(ws + WS_KB); bf16* VB = (bf16*)(ws + WS_VB);
    bf16* U = (bf16*)(ws + WS_U); bf16* PO = (bf16*)(ws + WS_PO); bf16* GA = (bf16*)(ws + WS_GA); bf16* GP = (bf16*)(ws + WS_GP);
    bf16* AO = (bf16*)(ws + WS_AO); bf16* MG = (bf16*)(ws + WS_MG); bf16* X1 = (bf16*)(ws + WS_X1);
    int* STOK = (int*)(ws + WS_STOK); int* TOKE = (int*)(ws + WS_TOKE); float* TOKG = (float*)(ws + WS_TOKG);
    fp8* ACT = (fp8*)(ws + WS_ACT); fp8* YS = (fp8*)(ws + WS_YS); float* TMP = (float*)(ws + WS_TMP); float* TMP2 = TMP + (size_t)T * D;
    unsigned* counts = ctl + CW_CNT;

    static int grid = 0;
    if (grid == 0) {
        int dev = 0, cus = 0;
        if (hipGetDevice(&dev) != hipSuccess || hipDeviceGetAttribute(&cus, hipDeviceAttributeMultiprocessorCount, dev) != hipSuccess) { fprintf(stderr, "kernel_launch: device query failed\n"); grid = -1; return; }
        if (hipFuncSetAttribute((const void*)fwd, hipFuncAttributeMaxDynamicSharedMemorySize, LDS_BYTES) != hipSuccess) { fprintf(stderr, "kernel_launch: hipFuncSetAttribute failed\n"); grid = -1; return; }
        int per_cu = 0;
        if (hipOccupancyMaxActiveBlocksPerMultiprocessor(&per_cu, (const void*)fwd, NTHR, LDS_BYTES) != hipSuccess || per_cu < 1) fprintf(stderr, "kernel_launch: occupancy query says %d blocks per CU\n", per_cu);
        (void)hipGetLastError();
        grid = cus > 256 ? 256 : cus;
    }
    if (grid < 0) return;
    (void)hipMemsetAsync(ws + WS_CTL, 0, CTL_ZERO_BYTES, stream);
    Args a{};
    for (int i = 0; i < 19; ++i) a.in[i] = (const float*)d_in[i];
    a.out = out; a.ws = ws; a.pad = 0;
    int li = 0;
#define RUN_FAST(lo_, hi_) do { a.ph_lo = (lo_); a.ph_hi = (hi_); a.li = li < 3 ? li : 2; ++li; for (int rep_ = 0; rep_ < ((((hi_) - (lo_)) == 1 && ((REPEAT_MASK >> (lo_)) & 1) && (lo_) != 5) ? 2 : 1); ++rep_) hipLaunchKernelGGL(fwd, dim3(grid), dim3(NTHR), LDS_BYTES, stream, a); } while (0)
#if ONE_LAUNCH
    RUN_FAST(0, N_PHASES);
#else
    if (FAST_MASK & 1) RUN_FAST(0, 1); else {
        n_transpose<<<2048, 256, 0, stream>>>(w_in, 1024, INW, WIN, INW, 0);
        n_transpose<<<1024, 256, 0, stream>>>(w_attn, 1024, 1024, WATT, 1024, 0);
        n_transpose<<<1024, 256, 0, stream>>>(w_out, 1024, 1024, WOUT, 1024, 0);
        for (int e = 0; e < NE; ++e) {
            n_transpose8<<<2048, 256, 0, stream>>>(w_up + (size_t)e * 1024 * 2048, 1024, 2048, WUP + (size_t)e * 2048 * 1024, 2048, 1);
            n_transpose8<<<1024, 256, 0, stream>>>(w_down + (size_t)e * 1024 * 1024, 1024, 1024, WDN + (size_t)e * 1024 * 1024, 1024, 0);
        }
        n_weff<<<(1024 * 512) / 256, 256, 0, stream>>>(pool_w, pool_scale, w_pool, WEFF);
        n_rope_table<<<(T * 8) / 256, 256, 0, stream>>>(positions, CS);
        n_wr_split<<<128, 256, 0, stream>>>(w_router, (bf16*)(ws + WS_WRH), (bf16*)(ws + WS_WRL));
        n_rms_bf16<<<T / 4, 256, 0, stream>>>(x, norm1_g, H);
    }
    if (FAST_MASK & 2) RUN_FAST(1, 2); else {
        n_gemm<<<dim3(INW / 64, T / 64), 256, 0, stream>>>(H, WIN, TMP, T, INW, 1024);
        n_post_inproj<<<(unsigned)(((size_t)T * INW + 255) / 256), 256, 0, stream>>>(TMP, b_in, CS, Q, KB, VB, U, GA, GP);
    }
    if (FAST_MASK & 4) RUN_FAST(2, 3); else {
        if (FAST_MASK & 1) for (int e = 0; e < NE; ++e) n_transpose8<<<1024, 256, 0, stream>>>(w_down + (size_t)e * 1024 * 1024, 1024, 1024, WDN + (size_t)e * 1024 * 1024, 1024, 0);
        n_attn<<<(T * NQH) / 256, 256, 0, stream>>>(Q, KB, VB, sinks, AO);
        n_pool<<<(T * PW) / 256, 256, 0, stream>>>(U, PO);
    }
    if (FAST_MASK & 8) RUN_FAST(3, 4); else {
        n_gemm<<<dim3(1024 / 64, T / 64), 256, 0, stream>>>(AO, WATT, TMP, T, 1024, 1024);
        n_gemm<<<dim3(1024 / 64, T / 64), 256, 0, stream>>>(PO, WEFF, TMP2, T, 1024, 512);
        n_merge<<<(T * D) / 256, 256, 0, stream>>>(TMP, TMP2, GA, GP, MG);
    }
    if (FAST_MASK & 16) RUN_FAST(4, 5); else {
        n_gemm<<<dim3(1024 / 64, T / 64), 256, 0, stream>>>(MG, WOUT, TMP, T, 1024, 1024);
        n_x1<<<(T * D) / 256, 256, 0, stream>>>(x, TMP, X1);
    }
    if (FAST_MASK & 32) { if (REPEAT_MASK & 32) { a.ph_lo = 5; a.ph_hi = 6; a.li = 2; hipLaunchKernelGGL(fwd, dim3(grid), dim3(NTHR), LDS_BYTES, stream, a); (void)hipMemsetAsync(counts, 0, 128, stream); } RUN_FAST(5, 6); } else n_router<<<T / 4, 256, 0, stream>>>(x, X1, norm2_g, w_router, b_router, (fp8*)(ws + WS_H2), counts, STOK, TOKE, TOKG);
    if (FAST_MASK & 64) RUN_FAST(6, 7); else { n_moe_up<<<dim3(1024 / 64, T / 64, NE), 256, 0, stream>>>((const fp8*)(ws + WS_H2), STOK, counts, WUP, b_up, ACT); (void)hipMemsetAsync(ctl + CW_DONE, 8, 32 * 256, stream); }
    if (FAST_MASK & 128) RUN_FAST(7, 8); else n_moe_down<<<dim3(1024 / 64, T / 64, NE), 256, 0, stream>>>(ACT, counts, WDN, b_down, YS);
    if (FAST_MASK & 256) RUN_FAST(8, 9); else n_combine<<<T / 4, 256, 0, stream>>>(x, X1, YS, counts, TOKE, TOKG, normf_g, out);
#endif
    (void)in_sizes; (void)sinks; (void)positions; (void)norm1_g; (void)norm2_g; (void)w_router; (void)b_router; (void)b_up; (void)b_down; (void)normf_g; (void)b_in; (void)pool_w; (void)pool_scale; (void)w_pool;
    (void)w_in; (void)w_attn; (void)w_out; (void)w_up; (void)w_down; (void)x; (void)WIN; (void)WATT; (void)WEFF; (void)WOUT; (void)CS; (void)WUP; (void)WDN; (void)H; (void)Q; (void)KB; (void)VB; (void)U; (void)PO; (void)GA; (void)GP;
    (void)AO; (void)MG; (void)X1; (void)STOK; (void)TOKE; (void)TOKG; (void)ACT; (void)YS; (void)TMP; (void)TMP2; (void)counts;
}
```

```cpp
#include <hip/hip_runtime.h>
#include <cstdio>
#include <cstdint>

constexpr int BATCH = 4, SEQ = 4096, T = BATCH * SEQ, D = 1024;
constexpr int NQH = 16, NKVH = 2, HD = 64, WINDOW = 128;
constexpr int INW = 3840, O_K = 1024, O_V = 1152, O_P = 1280, O_GA = 1792, O_GP = 2816, PW = 512;
constexpr int NE = 32, TOPK = 4, DFF = 1024, CAP = T;
constexpr int NSLOT = T * TOPK + NE * 256;
constexpr float RMS_EPS = 1e-5f;

typedef unsigned short bf16;
typedef unsigned char fp8;
constexpr float W8_SCALE = 32.0f, W8_INV = 1.0f / 32.0f;
typedef float f32x4 __attribute__((ext_vector_type(4)));
typedef unsigned u32x4 __attribute__((ext_vector_type(4)));
typedef unsigned u32x2 __attribute__((ext_vector_type(2)));

constexpr size_t MiB = 1u << 20;
constexpr size_t WS_CTL = 0, CTL_ZERO_BYTES = 65536;
constexpr size_t WS_WIN = 2 * MiB;
constexpr size_t WS_WATT = 10 * MiB;
constexpr size_t WS_WEFF = 12 * MiB;
constexpr size_t WS_WOUT = 13 * MiB;
constexpr size_t WS_CS = 15 * MiB;
constexpr size_t WS_WUP = 16 * MiB;
constexpr size_t WS_WDN = 144 * MiB;
constexpr size_t WS_H = 208 * MiB;
constexpr size_t WS_Q = 240 * MiB;
constexpr size_t WS_KB = 272 * MiB;
constexpr size_t WS_VB = 276 * MiB;
constexpr size_t WS_U = 280 * MiB;
constexpr size_t WS_PO = 296 * MiB;
constexpr size_t WS_GA = 312 * MiB;
constexpr size_t WS_GP = 344 * MiB;
constexpr size_t WS_AO = 376 * MiB;
constexpr size_t WS_T1 = 408 * MiB;
constexpr size_t WS_MG = 440 * MiB;
constexpr size_t WS_X1 = 472 * MiB;
constexpr size_t WS_STOK = 536 * MiB;
constexpr size_t WS_TOKE = 538 * MiB;
constexpr size_t WS_TOKG = 539 * MiB;
constexpr size_t WS_WRH = 538 * MiB + 512 * 1024, WS_WRL = WS_WRH + 64 * 1024;
constexpr size_t WS_ACT = 540 * MiB;
constexpr size_t WS_YS = 684 * MiB;
constexpr size_t WS_H2 = 828 * MiB;
constexpr size_t WS_X1B = 844 * MiB;
constexpr size_t WS_END = 876 * MiB;
constexpr size_t WS_TMP = WS_ACT;
constexpr int CW_TMO = 0, CW_CODE = 1, CW_CNT = 64, CW_DONE = 128  , CW_BAR = 4096;

__device__ __forceinline__ float bf2f(bf16 v) { return __uint_as_float((unsigned)v << 16); }
__device__ __forceinline__ bf16 f2bf(float f) { unsigned u = __float_as_uint(f); return (bf16)((u + 0x7fffu + ((u >> 16) & 1u)) >> 16); }
__device__ __forceinline__ float sigmoidf_(float v) { return 1.0f / (1.0f + __expf(-v)); }
__device__ __forceinline__ float wave_sum(float v) {
#pragma unroll
    for (int o = 1; o < 64; o <<= 1) v += __shfl_xor(v, o);
    return v;
}
__device__ __forceinline__ float fp82f(fp8 v) { return __builtin_amdgcn_cvt_f32_fp8((int)v, 0); }
__device__ __forceinline__ fp8 f2fp8(float f) { return (fp8)(__builtin_amdgcn_cvt_pk_fp8_f32(f, f, 0, false) & 0xff); }
__device__ __forceinline__ int up_src_col(int np) { const int t = np >> 8, c = np & 255; return c < 128 ? 128 * t + c : 1024 + 128 * t + (c - 128); }

__global__ void __launch_bounds__(256) n_transpose(const float* W, int K, int N, bf16* WT, int NT, int upmap) {
    const size_t total = (size_t)NT * K;
    for (size_t idx = (size_t)blockIdx.x * blockDim.x + threadIdx.x; idx < total; idx += (size_t)gridDim.x * blockDim.x) {
        const int n = (int)(idx / K), k = (int)(idx % K); const int sc = upmap ? up_src_col(n) : n;
        WT[idx] = f2bf(W[(size_t)k * N + sc]);
    }
}
__global__ void __launch_bounds__(256) n_transpose8(const float* W, int K, int N, fp8* WT, int NT, int upmap) {
    const size_t total = (size_t)NT * K;
    for (size_t idx = (size_t)blockIdx.x * blockDim.x + threadIdx.x; idx < total; idx += (size_t)gridDim.x * blockDim.x) {
        const int n = (int)(idx / K), k = (int)(idx % K); const int sc = upmap ? up_src_col(n) : n;
        WT[idx] = f2fp8(W[(size_t)k * N + sc] * W8_SCALE);
    }
}
__global__ void __launch_bounds__(256) n_weff(const float* pw, const float* ps, const float* Wpb, bf16* WeffT) {
    const int idx = blockIdx.x * blockDim.x + threadIdx.x; if (idx >= 1024 * 512) return;
    const int n = idx / 512, k = idx % 512, g = k / 128, kk = k % 128; float a = 0.f;
    for (int c = 0; c < 128; ++c) a += pw[(g * 128 + kk) * 128 + c] * ps[g * 128 + c] * Wpb[(size_t)(g * 128 + c) * 1024 + n];
    WeffT[idx] = f2bf(a);
}
__global__ void __launch_bounds__(256) n_wr_split(const float* wr, bf16* WRH, bf16* WRL) {
    const int idx = blockIdx.x * blockDim.x + threadIdx.x; if (idx >= 32 * 1024) return;
    const int e = idx >> 10, k = idx & 1023; const float w = wr[k * 32 + e]; const bf16 h = f2bf(w); WRH[idx] = h; WRL[idx] = f2bf(w - bf2f(h));
}
__global__ void __launch_bounds__(256) n_rope_table(const int* pos, float* cs) {
    const int idx = blockIdx.x * blockDim.x + threadIdx.x; if (idx >= T * 8) return;
    const int t = idx >> 3, i = idx & 7; const float inv = powf(500000.0f, -(float)i * 0.125f); const float a = (float)pos[t] * inv;
    cs[t * 16 + i] = cosf(a); cs[t * 16 + 8 + i] = sinf(a);
}
__global__ void __launch_bounds__(256) n_rms_bf16(const float* x, const float* g, bf16* out) {
    const int row = blockIdx.x * 4 + (threadIdx.x >> 6), lane = threadIdx.x & 63;
    const f32x4* xr = (const f32x4*)(x + (size_t)row * D) + lane; f32x4 v[4]; float s = 0.f;
#pragma unroll
    for (int j = 0; j < 4; ++j) { v[j] = xr[64 * j]; s += v[j].x * v[j].x + v[j].y * v[j].y + v[j].z * v[j].z + v[j].w * v[j].w; }
    const float rstd = rsqrtf(wave_sum(s) * (1.f / D) + RMS_EPS);
#pragma unroll
    for (int j = 0; j < 4; ++j) { const f32x4 gg = ((const f32x4*)g)[lane + 64 * j]; bf16* o = out + (size_t)row * D + 4 * lane + 256 * j;
        o[0] = f2bf(v[j].x * rstd * gg.x); o[1] = f2bf(v[j].y * rstd * gg.y); o[2] = f2bf(v[j].z * rstd * gg.z); o[3] = f2bf(v[j].w * rstd * gg.w); }
}
__global__ void __launch_bounds__(256) n_gemm(const bf16* A, const bf16* Bt, float* C, int M, int N, int K) {
    __shared__ float As[16][65], Bs[16][65];
    const int tx = threadIdx.x & 15, ty = threadIdx.x >> 4, m0 = blockIdx.y * 64, n0 = blockIdx.x * 64;
    float acc[4][4];
#pragma unroll
    for (int i = 0; i < 4; ++i)
#pragma unroll
        for (int j = 0; j < 4; ++j) acc[i][j] = 0.f;
    for (int k0 = 0; k0 < K; k0 += 16) {
        for (int i = threadIdx.x; i < 1024; i += 256) { const int r = i >> 4, c = i & 15;
            As[c][r] = bf2f(A[(size_t)(m0 + r) * K + k0 + c]); Bs[c][r] = bf2f(Bt[(size_t)(n0 + r) * K + k0 + c]); }
        __syncthreads();
#pragma unroll
        for (int kk = 0; kk < 16; ++kk) { float a[4], b[4];
#pragma unroll
            for (int i = 0; i < 4; ++i) { a[i] = As[kk][ty * 4 + i]; b[i] = Bs[kk][tx * 4 + i]; }
#pragma unroll
            for (int i = 0; i < 4; ++i)
#pragma unroll
                for (int j = 0; j < 4; ++j) acc[i][j] += a[i] * b[j]; }
        __syncthreads();
    }
#pragma unroll
    for (int i = 0; i < 4; ++i)
#pragma unroll
        for (int j = 0; j < 4; ++j) C[(size_t)(m0 + ty * 4 + i) * N + n0 + tx * 4 + j] = acc[i][j];
}
__global__ void __launch_bounds__(256) n_post_inproj(const float* P, const float* bias, const float* cs, bf16* Q, bf16* KB, bf16* VB, bf16* U, bf16* GA, bf16* GP) {
    const size_t idx = (size_t)blockIdx.x * blockDim.x + threadIdx.x; if (idx >= (size_t)T * INW) return;
    const int t = (int)(idx / INW), c = (int)(idx % INW); float v = P[idx] + bias[c];
    if (c < O_V) {
        const int d = c & 63;
        if (d < 16) { const int i = d & 7; const int pc = (d < 8) ? c + 8 : c - 8; const float o = P[(size_t)t * INW + pc] + bias[pc];
            const float co = cs[t * 16 + i], si = cs[t * 16 + 8 + i]; v = (d < 8) ? v * co - o * si : v * co + o * si; }
        if (c < O_K) Q[(size_t)t * 1024 + c] = f2bf(v); else KB[(size_t)t * 128 + (c - O_K)] = f2bf(v);
    } else if (c < O_P) VB[(size_t)t * 128 + (c - O_V)] = f2bf(v);
    else if (c < O_GA) U[(size_t)t * 512 + (c - O_P)] = f2bf(v);
    else if (c < O_GP) GA[(size_t)t * 1024 + (c - O_GA)] = f2bf(v);
    else GP[(size_t)t * 1024 + (c - O_GP)] = f2bf(v);
}
__global__ void __launch_bounds__(256) n_attn(const bf16* Q, const bf16* KB, const bf16* VB, const float* sinks, bf16* AO) {
    const int idx = blockIdx.x * blockDim.x + threadIdx.x; if (idx >= T * NQH) return;
    const int t = idx / NQH, hq = idx % NQH, hk = hq / 8, pos = t % SEQ, b0 = t - pos;
    float q[64];
#pragma unroll
    for (int d = 0; d < 64; ++d) q[d] = bf2f(Q[(size_t)t * 1024 + hq * 64 + d]);
    const int lo = pos - (WINDOW - 1) > 0 ? pos - (WINDOW - 1) : 0;
    const float sink = sinks[hq]; float m = sink;
    for (int s = lo; s <= pos; ++s) { float a = 0.f;
#pragma unroll
        for (int d = 0; d < 64; ++d) a += q[d] * bf2f(KB[(size_t)(b0 + s) * 128 + hk * 64 + d]);
        a *= 0.125f; m = fmaxf(m, a); }
    float sum = __expf(sink - m); float o[64];
#pragma unroll
    for (int d = 0; d < 64; ++d) o[d] = 0.f;
    for (int s = lo; s <= pos; ++s) { float a = 0.f;
#pragma unroll
        for (int d = 0; d < 64; ++d) a += q[d] * bf2f(KB[(size_t)(b0 + s) * 128 + hk * 64 + d]);
        const float p = __expf(a * 0.125f - m); sum += p; const float pb = bf2f(f2bf(p));
#pragma unroll
        for (int d = 0; d < 64; ++d) o[d] += pb * bf2f(VB[(size_t)(b0 + s) * 128 + hk * 64 + d]); }
    const float inv = 1.f / sum;
#pragma unroll
    for (int d = 0; d < 64; ++d) AO[(size_t)t * 1024 + hq * 64 + d] = f2bf(o[d] * inv);
}
__global__ void __launch_bounds__(256) n_pool(const bf16* U, bf16* PO) {
    const int idx = blockIdx.x * blockDim.x + threadIdx.x; if (idx >= T * PW) return;
    const int t = idx / PW, c = idx % PW, g = c / 128, w = 2 << g, pos = t % SEQ; const int cnt = pos + 1 < w ? pos + 1 : w; float s = 0.f;
    for (int j = 0; j < cnt; ++j) s += bf2f(U[(size_t)(t - j) * PW + c]);
    PO[idx] = f2bf(s / (float)cnt - bf2f(U[idx]));
}
__global__ void __launch_bounds__(256) n_merge(const float* C1, const float* C2, const bf16* GA, const bf16* GP, bf16* MG) {
    const size_t idx = (size_t)blockIdx.x * blockDim.x + threadIdx.x; if (idx >= (size_t)T * D) return;
    const float t1 = bf2f(f2bf(sigmoidf_(bf2f(GA[idx])) * C1[idx]));
    MG[idx] = f2bf(t1 + sigmoidf_(bf2f(GP[idx])) * C2[idx]);
}
__global__ void __launch_bounds__(256) n_x1(const float* x, const float* C, bf16* X1) {
    const size_t idx = (size_t)blockIdx.x * blockDim.x + threadIdx.x; if (idx >= (size_t)T * D) return;
    X1[idx] = f2bf(C[idx]); (void)x;
}
__global__ void __launch_bounds__(256) n_router(const float* x, const bf16* X1, const float* g2, const float* wr, const float* br, fp8* H2, unsigned* counts, int* stok, int* toke, float* tokg) {
    const int t = blockIdx.x * 4 + (threadIdx.x >> 6), lane = threadIdx.x & 63;
    const f32x4* xr = (const f32x4*)(x + (size_t)t * D) + lane; const bf16* dr = X1 + (size_t)t * D + 4 * lane; f32x4 v[4]; float s = 0.f;
#pragma unroll
    for (int j = 0; j < 4; ++j) { v[j] = xr[64 * j]; v[j].x += bf2f(dr[256 * j]); v[j].y += bf2f(dr[256 * j + 1]); v[j].z += bf2f(dr[256 * j + 2]); v[j].w += bf2f(dr[256 * j + 3]); s += v[j].x * v[j].x + v[j].y * v[j].y + v[j].z * v[j].z + v[j].w * v[j].w; }
    const float rstd = rsqrtf(wave_sum(s) * (1.f / D) + RMS_EPS);
    float h[16];
#pragma unroll
    for (int j = 0; j < 4; ++j) { const f32x4 gg = ((const f32x4*)g2)[lane + 64 * j];
        h[4 * j + 0] = v[j].x * rstd * gg.x; h[4 * j + 1] = v[j].y * rstd * gg.y; h[4 * j + 2] = v[j].z * rstd * gg.z; h[4 * j + 3] = v[j].w * rstd * gg.w;
        fp8* o = H2 + (size_t)t * D + 4 * lane + 256 * j;
#pragma unroll
        for (int q = 0; q < 4; ++q) o[q] = f2fp8(h[4 * j + q]); }
    float lg[32];
#pragma unroll
    for (int e = 0; e < 32; ++e) { float a = 0.f;
#pragma unroll
        for (int j = 0; j < 4; ++j)
#pragma unroll
            for (int q = 0; q < 4; ++q) a += h[4 * j + q] * wr[(size_t)(4 * lane + 256 * j + q) * 32 + e];
        lg[e] = wave_sum(a) + br[e]; }
    int be[4]; float bv[4]; unsigned used = 0u;
#pragma unroll
    for (int k = 0; k < 4; ++k) { float best = -3.0e38f; int bi = 0;
#pragma unroll
        for (int e = 0; e < 32; ++e) { const bool ok = !((used >> e) & 1u) && lg[e] > best; best = ok ? lg[e] : best; bi = ok ? e : bi; }
        be[k] = bi; bv[k] = best; used |= 1u << bi; }
    float ex[4], se = 0.f;
#pragma unroll
    for (int k = 0; k < 4; ++k) { ex[k] = __expf(bv[k] - bv[0]); se += ex[k]; }
    if (lane == 0) {
#pragma unroll
        for (int k = 0; k < 4; ++k) { const unsigned pos = atomicAdd(&counts[be[k]], 1u);
            stok[be[k] * CAP + pos] = t; toke[t * 4 + k] = be[k] | (int)(pos << 8); tokg[t * 4 + k] = ex[k] / se; }
    }
}
__device__ __forceinline__ int moe_rowoff(const unsigned* counts, int e) { int o = 0; for (int i = 0; i < e; ++i) o += (int)((counts[i] + 255u) >> 8) << 8; return o; }
__global__ void __launch_bounds__(256) n_moe_up(const fp8* H2, const int* stok, const unsigned* counts, const fp8* WupT, const float* bup, fp8* ACT) {
    const int e = blockIdx.z, cnt = (int)counts[e], m0 = blockIdx.y * 64, n0 = blockIdx.x * 64; if (m0 >= cnt) return;
    __shared__ float As[16][65], Bg[16][65], Bl[16][65]; __shared__ int rowtok[64];
    const int tx = threadIdx.x & 15, ty = threadIdx.x >> 4; const int roff = moe_rowoff(counts, e);
    if (threadIdx.x < 64) rowtok[threadIdx.x] = (m0 + (int)threadIdx.x < cnt) ? stok[e * CAP + m0 + threadIdx.x] : 0;
    __syncthreads();
    float ag[4][4], al[4][4];
#pragma unroll
    for (int i = 0; i < 4; ++i)
#pragma unroll
        for (int j = 0; j < 4; ++j) { ag[i][j] = 0.f; al[i][j] = 0.f; }
    const fp8* W = WupT + (size_t)e * 2048 * 1024;
    for (int k0 = 0; k0 < 1024; k0 += 16) {
        for (int i = threadIdx.x; i < 1024; i += 256) { const int r = i >> 4, c = i & 15; const int j = n0 + r, ng = (j >> 7) * 256 + (j & 127);
            As[c][r] = fp82f(H2[(size_t)rowtok[r] * 1024 + k0 + c]); Bg[c][r] = fp82f(W[(size_t)ng * 1024 + k0 + c]) * W8_INV; Bl[c][r] = fp82f(W[(size_t)(ng + 128) * 1024 + k0 + c]) * W8_INV; }
        __syncthreads();
#pragma unroll
        for (int kk = 0; kk < 16; ++kk) { float a[4], g[4], l[4];
#pragma unroll
            for (int i = 0; i < 4; ++i) { a[i] = As[kk][ty * 4 + i]; g[i] = Bg[kk][tx * 4 + i]; l[i] = Bl[kk][tx * 4 + i]; }
#pragma unroll
            for (int i = 0; i < 4; ++i)
#pragma unroll
                for (int j = 0; j < 4; ++j) { ag[i][j] += a[i] * g[j]; al[i][j] += a[i] * l[j]; } }
        __syncthreads();
    }
#pragma unroll
    for (int i = 0; i < 4; ++i) { const int m = m0 + ty * 4 + i; if (m >= cnt) continue;
#pragma unroll
        for (int j = 0; j < 4; ++j) { const int c = n0 + tx * 4 + j; float gl = ag[i][j] + bup[e * 2048 + c], li = al[i][j] + bup[e * 2048 + 1024 + c];
            gl = fminf(gl, 7.f); li = fminf(fmaxf(li, -7.f), 7.f);
            ACT[(size_t)(roff + m) * 1024 + c] = f2fp8(gl * sigmoidf_(1.702f * gl) * (li + 1.f)); } }
}
__global__ void __launch_bounds__(256) n_moe_down(const fp8* ACT, const unsigned* counts, const fp8* WdnT, const float* bdn, fp8* YS) {
    const int e = blockIdx.z, cnt = (int)counts[e], m0 = blockIdx.y * 64, n0 = blockIdx.x * 64; if (m0 >= cnt) return;
    __shared__ float As[16][65], Bs[16][65];
    const int tx = threadIdx.x & 15, ty = threadIdx.x >> 4; const int roff = moe_rowoff(counts, e);
    float acc[4][4];
#pragma unroll
    for (int i = 0; i < 4; ++i)
#pragma unroll
        for (int j = 0; j < 4; ++j) acc[i][j] = 0.f;
    const fp8* W = WdnT + (size_t)e * 1024 * 1024;
    for (int k0 = 0; k0 < 1024; k0 += 16) {
        for (int i = threadIdx.x; i < 1024; i += 256) { const int r = i >> 4, c = i & 15; const int m = (m0 + r < cnt) ? m0 + r : m0;
            As[c][r] = fp82f(ACT[(size_t)(roff + m) * 1024 + k0 + c]); Bs[c][r] = fp82f(W[(size_t)(n0 + r) * 1024 + k0 + c]) * W8_INV; }
        __syncthreads();
#pragma unroll
        for (int kk = 0; kk < 16; ++kk) { float a[4], b[4];
#pragma unroll
            for (int i = 0; i < 4; ++i) { a[i] = As[kk][ty * 4 + i]; b[i] = Bs[kk][tx * 4 + i]; }
#pragma unroll
            for (int i = 0; i < 4; ++i)
#pragma unroll
                for (int j = 0; j < 4; ++j) acc[i][j] += a[i] * b[j]; }
        __syncthreads();
    }
#pragma unroll
    for (int i = 0; i < 4; ++i) { const int m = m0 + ty * 4 + i; if (m >= cnt) continue;
#pragma unroll
        for (int j = 0; j < 4; ++j) { const int c = n0 + tx * 4 + j; YS[(size_t)(roff + m) * 1024 + c] = f2fp8(acc[i][j] + bdn[e * 1024 + c]); } }
}
__global__ void __launch_bounds__(256) n_combine(const float* x, const bf16* X1, const fp8* YS, const unsigned* counts, const int* toke, const float* tokg, const float* gf, float* out) {
    const int t = blockIdx.x * 4 + (threadIdx.x >> 6), lane = threadIdx.x & 63;
    f32x4 v[4];
#pragma unroll
    for (int j = 0; j < 4; ++j) { v[j] = ((const f32x4*)(x + (size_t)t * D))[lane + 64 * j]; const bf16* dp = X1 + (size_t)t * D + 4 * lane + 256 * j; v[j].x += bf2f(dp[0]); v[j].y += bf2f(dp[1]); v[j].z += bf2f(dp[2]); v[j].w += bf2f(dp[3]); }
    for (int k = 0; k < 4; ++k) { const int te = toke[t * 4 + k], e = te & 255, pos = te >> 8; const float g = tokg[t * 4 + k];
        const fp8* y = YS + (size_t)(moe_rowoff(counts, e) + pos) * 1024;
#pragma unroll
        for (int j = 0; j < 4; ++j) { const fp8* p = y + 4 * lane + 256 * j; v[j].x += g * fp82f(p[0]); v[j].y += g * fp82f(p[1]); v[j].z += g * fp82f(p[2]); v[j].w += g * fp82f(p[3]); } }
    float s = 0.f;
#pragma unroll
    for (int j = 0; j < 4; ++j) s += v[j].x * v[j].x + v[j].y * v[j].y + v[j].z * v[j].z + v[j].w * v[j].w;
    const float rstd = rsqrtf(wave_sum(s) * (1.f / D) + RMS_EPS);
#pragma unroll
    for (int j = 0; j < 4; ++j) { const f32x4 gg = ((const f32x4*)gf)[lane + 64 * j]; f32x4 o = v[j] * rstd * gg; ((f32x4*)(out + (size_t)t * D))[lane + 64 * j] = o; }
}

#define GAS __attribute__((address_space(1)))
#define LAS __attribute__((address_space(3)))
typedef short bf16x8 __attribute__((ext_vector_type(8)));
typedef float f32x16 __attribute__((ext_vector_type(16)));
typedef short s16x4 __attribute__((ext_vector_type(4)));
typedef float f32x2 __attribute__((ext_vector_type(2)));
typedef GAS unsigned gu32;
#define RLX_AGENT __ATOMIC_RELAXED, __HIP_MEMORY_SCOPE_AGENT
#define LDS_WAIT() asm volatile("s_waitcnt lgkmcnt(0)" ::: "memory")
#define VM_WAIT() asm volatile("s_waitcnt vmcnt(0)" ::: "memory")

constexpr int NWAVES = 8, NTHR = 512;
constexpr int RING_BYTES = 131072;
constexpr int HB_STRIDE = 4112, HB_BYTES = 32 * HB_STRIDE;
constexpr int TBL_OFF = 132096;
constexpr int RT_LOGIT = 133120, RT_TOKE = RT_LOGIT + 8448, RT_TOKR = RT_TOKE + 1024, RT_TOKG = RT_TOKR + 1024, RT_HIST = RT_TOKG + 1024, RT_BASE = RT_HIST + 128;
constexpr int BIAS_OFF = 133120;
constexpr int MISC_OFF = 145408;
constexpr int LDS_BYTES = 147456;
static_assert(RT_BASE + 128 <= MISC_OFF && HB_BYTES <= TBL_OFF && MISC_OFF + 128 <= LDS_BYTES, "LDS map");

__device__ __forceinline__ unsigned cvt_pk_bf16(float lo, float hi) { unsigned r; asm volatile("v_cvt_pk_bf16_f32 %0, %1, %2" : "=v"(r) : "v"(lo), "v"(hi)); return r; }
__device__ __forceinline__ float bflo(unsigned w) { return __uint_as_float(w << 16); }
__device__ __forceinline__ float bfhi(unsigned w) { return __uint_as_float(w & 0xffff0000u); }
__device__ __forceinline__ float ub8(unsigned w, int n) { return (float)((w >> (8 * n)) & 255u); }
__device__ __forceinline__ float fast_sigmoid(float v) { return __builtin_amdgcn_rcpf(1.0f + __builtin_amdgcn_exp2f(-1.44269504089f * v)); }

#define XB_TMO      128
#define XB_XCNT(j)  (256  + 64 * (j))
#define XB_XSUB(j)  (1280 + 64 * (j))
#define XB_XGEN(j)  (2304 + 64 * (j))
#define XB_TOP      3328
#define XB_TOPGEN   3392
#define XCD_BAR_WORDS 3456
#define XB_SPIN_CAP (1u << 18)
__device__ __forceinline__ unsigned xb_ld(unsigned* p)              { return __hip_atomic_load(p, __ATOMIC_RELAXED, __HIP_MEMORY_SCOPE_AGENT); }
__device__ __forceinline__ unsigned xb_add(unsigned* p, unsigned v) { return __hip_atomic_fetch_add(p, v, __ATOMIC_RELAXED, __HIP_MEMORY_SCOPE_AGENT); }
__device__ __forceinline__ unsigned xb_xcc_id() { return (unsigned)__builtin_amdgcn_s_getreg((3 << 11) | 20) & 0xFu; }
#define XB_SPIN(cond, bar) do { unsigned _sp = 0; while (cond) { __builtin_amdgcn_s_sleep(1); \
    if ((++_sp & 255u) == 0u) { if (xb_ld(&(bar)[XB_TMO])) break; if (_sp > XB_SPIN_CAP) { atomicAdd(&(bar)[XB_TMO], 1u); break; } } } } while (0)
struct XcdBarrier { unsigned* bar; unsigned x; volatile LAS unsigned* st; };
__device__ __forceinline__ XcdBarrier xcd_barrier_post(unsigned* bar, volatile LAS unsigned* st) {
    XcdBarrier b; b.bar = bar; b.x = xb_xcc_id(); b.st = st;
    if (threadIdx.x == 0) (void)xb_add(&bar[XB_XCNT(b.x)], 1u);
    return b;
}
__device__ __forceinline__ void xcd_barrier_complete(unsigned* bar, unsigned x, unsigned& nloc, unsigned& nx) {
    const unsigned G = gridDim.x * gridDim.y * gridDim.z;
    unsigned sum, cnt, mine, sp = 0u;
    for (;;) {
        sum = 0u; cnt = 0u; mine = 0u;
#pragma unroll
        for (unsigned j = 0; j < 16; ++j) { const unsigned c = xb_ld(&bar[XB_XCNT(j)]); sum += c; cnt += (c > 0u) ? 1u : 0u; mine = (j == x) ? c : mine; }
        if (sum == G) break;
        __builtin_amdgcn_s_sleep(1);
        if ((++sp & 255u) == 0u) { if (xb_ld(&bar[XB_TMO])) break; if (sp > XB_SPIN_CAP) { atomicAdd(&bar[XB_TMO], 1u); break; } }
    }
    nloc = mine > 0u ? mine : 1u; nx = cnt > 0u ? cnt : 1u;
}
__device__ __forceinline__ void xcd_barrier(const XcdBarrier& b) {
    asm volatile("s_waitcnt vmcnt(0)" ::: "memory");
    __syncthreads();
    if (threadIdx.x == 0) {
        unsigned* bar = b.bar;
        __builtin_amdgcn_s_waitcnt(0);
        unsigned nloc = b.st[0], nx = b.st[1];
        if (nloc == 0u) { xcd_barrier_complete(bar, b.x, nloc, nx); b.st[0] = nloc; b.st[1] = nx; }
        const unsigned old = xb_add(&bar[XB_XSUB(b.x)], 1u);
        const unsigned gen = old / nloc;
        if (old + 1u == (gen + 1u) * nloc) {
            __builtin_amdgcn_fence(__ATOMIC_RELEASE, "agent");
            asm volatile("s_waitcnt vmcnt(0)" ::: "memory");
            const unsigned og = xb_add(&bar[XB_TOP], 1u);
            const unsigned tg = og / nx;
            if (og + 1u == (tg + 1u) * nx) xb_add(&bar[XB_TOPGEN], 1u);
            else XB_SPIN(xb_ld(&bar[XB_TOPGEN]) == tg, bar);
            __builtin_amdgcn_fence(__ATOMIC_ACQUIRE, "agent");
            xb_add(&bar[XB_XGEN(b.x)], 1u);
            asm volatile("s_waitcnt vmcnt(0)" ::: "memory");
        } else {
            XB_SPIN(xb_ld(&bar[XB_XGEN(b.x)]) == gen, bar);
            __builtin_amdgcn_fence(__ATOMIC_ACQUIRE, "agent");
            asm volatile("s_waitcnt vmcnt(0)" ::: "memory");
        }
    }
    __syncthreads();
}

namespace pg8 {
constexpr int BM = 256, BK = 64, HALF = 128, HTB = HALF * BK * 2, STAGE_BYTES = 8 * HTB, NXCD = 8, WGM = 8;
__host__ __device__ __forceinline__ int lds_byte(int r, int c) { const int st = (r >> 4) * 2 + (c >> 5), rr = r & 15, cc = c & 31, ob = rr * 64 + cc * 2; return st * 1024 + (ob ^ (((ob >> 9) & 1) << 5)); }
__host__ __device__ __forceinline__ void stage_rc(int b, int& R, int& C) { const int st = b / 1024, sb = b % 1024, swz = sb ^ (((sb >> 9) & 1) << 5); R = (st >> 1) * 16 + swz / 64; C = (st & 1) * 32 + (swz % 64) / 2; }
__host__ __device__ __forceinline__ int perm32(int rho) { const int n = rho >> 4, i = rho & 15; return 8 * (i >> 2) + 4 * n + (i & 3); }

struct GUnit { int row0, pn, e, grow, nvalid; };

struct DenseOrder {
    int nM, nN, nwg, G, c;
    __device__ void init(int M, int N, int G_, int c_) { nM = M / BM; nN = N / BM; nwg = nM * nN; G = G_; c = c_; }
    __device__ bool next(int i, GUnit& u) const {
        const long L = (long)i * G + c; if (L >= nwg) return false;
        int wgid = (int)L; { const int q = nwg / NXCD, r = nwg % NXCD, xcd = wgid % NXCD, off = wgid / NXCD; wgid = (xcd < r ? xcd * (q + 1) : r * (q + 1) + (xcd - r) * q) + off; }
        const int nig = WGM * nN, gid = wgid / nig, fm = gid * WGM, gsz = (nM - fm) < WGM ? (nM - fm) : WGM;
        u.row0 = (fm + ((wgid % nig) % gsz)) * BM; u.pn = (wgid % nig) / gsz; u.e = 0; u.grow = 0; u.nvalid = BM; return true;
    }
};
struct MoeOrder {
    const LAS int* ust; const LAS int* rowoff; const LAS int* cnt; int lognN, G, c;
    __device__ bool next(int i, GUnit& u) const {
        const int L = i * G + c; const int total = __builtin_amdgcn_readfirstlane(ust[32]); if (L >= total) return false;
        int e = 0;
#pragma unroll
        for (int j = 1; j < 32; ++j) e += (L >= __builtin_amdgcn_readfirstlane(ust[j])) ? 1 : 0;
        const int idx = L - __builtin_amdgcn_readfirstlane(ust[e]); const int r = idx >> lognN, pn = idx & ((1 << lognN) - 1);
        u.row0 = __builtin_amdgcn_readfirstlane(rowoff[e]) + BM * r; u.pn = pn; u.e = e; u.grow = e * CAP + BM * r; u.nvalid = __builtin_amdgcn_readfirstlane(cnt[e]) - BM * r; return true;
    }
};

template <bool VEC> struct MoeOrderX {
    const LAS int* rowoff; const LAS int* cnt; int lognN, G, c;
    __device__ bool next(int i, GUnit& u) const {
        int rem = i;
        for (int v = c; v < 256; v += G) {
            const int x8 = v & 7, j = v >> 3, e = x8 + 8 * (j >> 3), pn = (lognN == 3) ? (j & 7) : ((j & 7) >> 1), r0 = (lognN == 3) ? 0 : (j & 1), rs = (lognN == 3) ? 1 : 2;
            const int ce = __builtin_amdgcn_readfirstlane(cnt[e]), R = (ce + 255) >> 8, n = (R > r0) ? (R - r0 + rs - 1) / rs : 0;
            if (rem < n) { const int r = r0 + rem * rs; u.row0 = __builtin_amdgcn_readfirstlane(rowoff[e]) + BM * r; u.pn = pn; u.e = e; u.grow = e * CAP + BM * r; u.nvalid = ce - BM * r;
                if (VEC) { int ev = e; asm volatile("" : "+v"(ev)); u.e = ev; }
                return true; }
            rem -= n;
        }
        return false;
    }
};
struct MoeOrderOwn {
    const LAS int* rowoff; const LAS int* cnt; unsigned mx, mh; int G, c;
    __device__ bool next(int i, GUnit& u) const {
        int rem = i; const int ns = 8 * __builtin_popcount(mh);
        for (int v = c; v < 256; v += G) {
            const int x8 = v & 7, j = v >> 3, e = x8 + 8 * (j >> 3), jl = j & 7, pn = jl >> 1, rpar = jl & 1;
            const int ce = __builtin_amdgcn_readfirstlane(cnt[e]), R = (ce + 255) >> 8, n2 = R >> 1;
            const bool stolen = ((mx >> e) & 1u) && (4 * __builtin_popcount(mx & ((1u << e) - 1u)) + pn < ns);
            const int n = n2 + (((R & 1) && rpar == 0 && !stolen) ? 1 : 0);
            if (rem < n) { const int r = rem < n2 ? rpar + 2 * rem : R - 1; u.row0 = __builtin_amdgcn_readfirstlane(rowoff[e]) + BM * r; u.pn = pn; u.e = e; u.grow = e * CAP + BM * r; u.nvalid = ce - BM * r; return true; }
            rem -= n;
        }
        return false;
    }
};
struct MoeOrderSteal {
    const LAS int* rowoff; const LAS int* cnt; unsigned mx, mh; int G, c;
    __device__ bool next(int i, GUnit& u) const {
        int rem = i; const int nx = 4 * __builtin_popcount(mx);
        for (int v = c; v < 256; v += G) {
            const int x8 = v & 7, j = v >> 3, e = x8 + 8 * (j >> 3), jl = j & 7;
            if (!((mh >> e) & 1u)) continue;
            const int s = 8 * __builtin_popcount(mh & ((1u << e) - 1u)) + jl;
            if (s >= nx) continue;
            if (rem == 0) { unsigned m = mx; for (int q = 0; q < (s >> 2); ++q) m &= m - 1u;
                const int o = __builtin_ctz(m), pn = s & 3, ce = __builtin_amdgcn_readfirstlane(cnt[o]), r = ((ce + 255) >> 8) - 1;
                u.row0 = __builtin_amdgcn_readfirstlane(rowoff[o]) + BM * r; u.pn = pn; u.e = o; u.grow = o * CAP + BM * r; u.nvalid = ce - BM * r; return true; }
            --rem;
        }
        return false;
    }
};
__host__ __device__ __forceinline__ int sig8(int p) { return (p & 1) | (((p >> 2) & 1) * 6); }
typedef int v8i __attribute__((ext_vector_type(8)));
typedef int i32x4 __attribute__((ext_vector_type(4)));

template <class Epi, class Sched, int K, bool GATHER, bool F8>
__device__ __forceinline__ void gemm_phase(LAS unsigned char* lds, const void* A, const void* Bt, size_t bexp  , const Sched& S, const Epi& E, const int* gidx) {
    const int tid = threadIdx.x, wid = __builtin_amdgcn_readfirstlane(tid >> 6), lane = tid & 63, wr = wid >> 2, wc = wid & 3, fr = lane & 15, fq = lane >> 4;
    constexpr int ES = F8 ? 1 : 2, KB = K * ES, nt = KB / 128;
    static_assert(nt >= 4 && nt % 2 == 0, "K");
    int R0, C0b;
    if constexpr (F8) { R0 = tid >> 3; C0b = ((tid & 7) ^ sig8((R0 >> 1) & 7)) << 4; }
    else { int C0; stage_rc(tid * 16, R0, C0); C0b = C0 * 2; }
    unsigned voffA[2], voffB[2];
#pragma unroll
    for (int i = 0; i < 2; ++i) { const int R = R0 + 64 * i; const int Rb = Epi::PERM ? ((R & ~31) + perm32(R & 31)) : R;
        voffA[i] = (unsigned)(R * KB + C0b); voffB[i] = (unsigned)(Rb * KB + C0b); }
    constexpr size_t kstep = 128, hstep = (size_t)HALF * KB;
    const unsigned ldsw = (unsigned)wid * 1024u;
    int aoff, boff, aoff1 = 0, boff1 = 0;
    if constexpr (F8) { const int sg = sig8((fr >> 1) & 7);
        aoff = (wr * 64 + fr) * 128 + (((2 * fq) ^ sg) << 4); aoff1 = (wr * 64 + fr) * 128 + (((2 * fq + 1) ^ sg) << 4);
        boff = (wc * 32 + fr) * 128 + (((2 * fq) ^ sg) << 4); boff1 = (wc * 32 + fr) * 128 + (((2 * fq + 1) ^ sg) << 4); }
    else { aoff = lds_byte(wr * 64 + fr, fq * 8); boff = lds_byte(wc * 32 + fr, fq * 8); }
    unsigned gcur[2][2], gnxt[2][2];
#define PG8_LOADG(u_, g_) do { _Pragma("unroll") for (int _h = 0; _h < 2; ++_h) _Pragma("unroll") for (int _i = 0; _i < 2; ++_i) { const int _r = _h * HALF + R0 + 64 * _i; int _tok = 0; \
        if (_r < (u_).nvalid) _tok = gidx[(u_).grow + _r]; (g_)[_h][_i] = (unsigned)_tok * (unsigned)KB + (unsigned)C0b; } } while (0)
#define PG8_PING(g_) asm volatile("" : "+v"((g_)[0][0]), "+v"((g_)[0][1]), "+v"((g_)[1][0]), "+v"((g_)[1][1]))
#define PG8_SA(b, h) (((b) * 2 + (h)) * HTB)
#define PG8_SB(b, h) ((4 + (b) * 2 + (h)) * HTB)
#define PG8_STAGE(bufoff, rs, soff, voff) do { _Pragma("unroll") for (int _i = 0; _i < 2; ++_i) \
        __builtin_amdgcn_raw_ptr_buffer_load_lds(rs, (LAS void*)(lds + (bufoff) + ldsw + _i * 8192), 16, (int)(voff)[_i], (int)(soff), 0, 0); } while (0)
#define PG8_STAGE_A(bufoff, h, nx, kb) do { if constexpr (GATHER) { _Pragma("unroll") for (int _i = 0; _i < 2; ++_i) { const unsigned _o = (nx) ? gnxt[h][_i] : gcur[h][_i]; \
            __builtin_amdgcn_raw_ptr_buffer_load_lds(rsA, (LAS void*)(lds + (bufoff) + ldsw + _i * 8192), 16, (int)_o, (int)(kb), 0, 0); } } \
        else { PG8_STAGE(bufoff, rsA, ((nx) ? nA : cA) + (unsigned)((h) * hstep) + (unsigned)(kb), voffA); } } while (0)
#define PG8_LDA(b, h) do { if constexpr (F8) { _Pragma("unroll") for (int m = 0; m < 4; ++m) { const i32x4 _l = *(const LAS i32x4*)(lds + PG8_SA(b, h) + aoff + m * 2048), _h2 = *(const LAS i32x4*)(lds + PG8_SA(b, h) + aoff1 + m * 2048); \
            At8[m] = __builtin_shufflevector(_l, _h2, 0, 1, 2, 3, 4, 5, 6, 7); } } \
        else { _Pragma("unroll") for (int m = 0; m < 4; ++m) _Pragma("unroll") for (int k = 0; k < 2; ++k) At[m][k] = *(const LAS bf16x8*)(lds + PG8_SA(b, h) + aoff + m * 2048 + k * 1024); } } while (0)
#define PG8_LDB(dst, dst8, b, h) do { if constexpr (F8) { _Pragma("unroll") for (int n = 0; n < 2; ++n) { const i32x4 _l = *(const LAS i32x4*)(lds + PG8_SB(b, h) + boff + n * 2048), _h2 = *(const LAS i32x4*)(lds + PG8_SB(b, h) + boff1 + n * 2048); \
            dst8[n] = __builtin_shufflevector(_l, _h2, 0, 1, 2, 3, 4, 5, 6, 7); } } \
        else { _Pragma("unroll") for (int n = 0; n < 2; ++n) _Pragma("unroll") for (int k = 0; k < 2; ++k) dst[n][k] = *(const LAS bf16x8*)(lds + PG8_SB(b, h) + boff + n * 2048 + k * 1024); } } while (0)
#define PG8_MMA(ai, bj, Bt_, Bt8_) do { __builtin_amdgcn_s_setprio(1); if constexpr (F8) { _Pragma("unroll") for (int m = 0; m < 4; ++m) _Pragma("unroll") for (int n = 0; n < 2; ++n) \
            acc[ai][bj][m][n] = __builtin_amdgcn_mfma_scale_f32_16x16x128_f8f6f4(Bt8_[n], At8[m], acc[ai][bj][m][n], 0, 0, 0, 0, 0, 0); } \
        else { _Pragma("unroll") for (int m = 0; m < 4; ++m) _Pragma("unroll") for (int n = 0; n < 2; ++n) _Pragma("unroll") for (int k = 0; k < 2; ++k) \
            acc[ai][bj][m][n] = __builtin_amdgcn_mfma_f32_16x16x32_bf16(Bt_[n][k], At[m][k], acc[ai][bj][m][n], 0, 0, 0); } __builtin_amdgcn_s_setprio(0); } while (0)
#define PG8_WAIT_V(n) asm volatile("s_waitcnt vmcnt(" #n ")" ::: "memory")
#define PG8_WAIT_L(n) asm volatile("s_waitcnt lgkmcnt(" #n ")" ::: "memory")
#define PG8_BAR __builtin_amdgcn_s_barrier()
#define PG8_SCHED __builtin_amdgcn_sched_barrier(0)
    GUnit cur, nxt, nn; int ui = 0;
    if (!S.next(0, cur)) return;
    bool has_next = S.next(1, nxt);
    f32x4 acc[2][2][4][2];
#pragma unroll
    for (int a = 0; a < 2; ++a)
#pragma unroll
        for (int b = 0; b < 2; ++b)
#pragma unroll
            for (int m = 0; m < 4; ++m)
#pragma unroll
                for (int n = 0; n < 2; ++n) acc[a][b][m][n] = (f32x4){0.f, 0.f, 0.f, 0.f};
    bf16x8 At[4][2], B0[2][2], B1[2][2]; v8i At8[4], B08[2], B18[2];
    const __amdgpu_buffer_rsrc_t rsA = __builtin_amdgcn_make_buffer_rsrc((void*)A, 0, 0x7fffffff, 0x00020000), rsB = __builtin_amdgcn_make_buffer_rsrc((void*)Bt, 0, 0x7fffffff, 0x00020000);
    unsigned cA = (unsigned)cur.row0 * (unsigned)KB;
    unsigned cB = (unsigned)(((size_t)cur.e * bexp + (size_t)cur.pn * BM * K) * ES);
    unsigned nA = cA, nB = cB;
    if constexpr (GATHER) {
        PG8_LOADG(cur, gcur);
        if (has_next) PG8_LOADG(nxt, gnxt); else { gnxt[0][0] = gcur[0][0]; gnxt[0][1] = gcur[0][1]; gnxt[1][0] = gcur[1][0]; gnxt[1][1] = gcur[1][1]; }
        PG8_PING(gcur); PG8_PING(gnxt);
    }
    PG8_STAGE(PG8_SB(0, 0), rsB, cB, voffB); PG8_STAGE(PG8_SB(0, 1), rsB, cB + (unsigned)hstep, voffB); PG8_STAGE_A(PG8_SA(0, 0), 0, false, 0u); PG8_STAGE_A(PG8_SA(0, 1), 1, false, 0u);
    if (wr == 1) PG8_BAR;
    PG8_WAIT_V(2); PG8_BAR;
    PG8_STAGE(PG8_SB(1, 0), rsB, cB + (unsigned)kstep, voffB); PG8_STAGE_A(PG8_SA(1, 0), 0, false, (unsigned)kstep); PG8_STAGE(PG8_SB(1, 1), rsB, cB + (unsigned)(hstep + kstep), voffB);
    PG8_WAIT_V(6); PG8_BAR;
    for (;;) {
        if (has_next) { nA = (unsigned)nxt.row0 * (unsigned)KB; nB = (unsigned)(((size_t)nxt.e * bexp + (size_t)nxt.pn * BM * K) * ES); } else { nA = cA; nB = cB; }
#define PG8_KBODY(LAST, T_) do { \
            const unsigned kb1 = (unsigned)((T_) + 1) * (unsigned)kstep, kb2 = (LAST) ? 0u : (unsigned)((T_) + 2) * (unsigned)kstep, kb3 = kb2 + (unsigned)kstep; \
            const unsigned b2 = ((LAST) ? nB : cB) + kb2, b3 = b2 + (unsigned)kstep; \
              \
            PG8_LDB(B0, B08, 0, 0); PG8_LDB(B1, B18, 0, 1); PG8_SCHED; PG8_LDA(0, 0); PG8_STAGE_A(PG8_SA(1, 1), 1, false, kb1); \
            PG8_WAIT_V(8); PG8_WAIT_L(0); PG8_BAR; PG8_MMA(0, 0, B0, B08); PG8_MMA(0, 1, B1, B18); PG8_BAR; PG8_SCHED; \
              \
            PG8_LDA(0, 1); PG8_STAGE(PG8_SB(0, 0), rsB, b2, voffB); PG8_STAGE(PG8_SB(0, 1), rsB, b2 + (unsigned)hstep, voffB); PG8_STAGE_A(PG8_SA(0, 0), 0, LAST, kb2); \
            PG8_WAIT_V(8); PG8_WAIT_L(0); PG8_BAR; PG8_MMA(1, 0, B0, B08); PG8_MMA(1, 1, B1, B18); PG8_BAR; PG8_SCHED; \
              \
            PG8_LDB(B0, B08, 1, 0); PG8_LDB(B1, B18, 1, 1); PG8_SCHED; PG8_LDA(1, 0); PG8_STAGE_A(PG8_SA(0, 1), 1, LAST, kb2); \
            PG8_WAIT_V(8); PG8_WAIT_L(0); PG8_BAR; PG8_MMA(0, 0, B0, B08); PG8_MMA(0, 1, B1, B18); PG8_BAR; PG8_SCHED; \
              \
            PG8_LDA(1, 1); PG8_STAGE(PG8_SB(1, 0), rsB, b3, voffB); PG8_STAGE(PG8_SB(1, 1), rsB, b3 + (unsigned)hstep, voffB); PG8_STAGE_A(PG8_SA(1, 0), 0, LAST, kb3); \
            PG8_WAIT_V(8); PG8_WAIT_L(0); PG8_BAR; PG8_MMA(1, 0, B0, B08); PG8_MMA(1, 1, B1, B18); PG8_BAR; PG8_SCHED; } while (0)
        bool has_nn = false; unsigned gnn[2][2]; int gtok[2][2] = {{0, 0}, {0, 0}};
#pragma unroll 1
        for (int t = 0; t < nt; t += 2) {
            const bool last = (t == nt - 2);
            if (last) {
                has_nn = has_next && S.next(ui + 2, nn);
                if constexpr (GATHER) { if (has_nn) {
#pragma unroll
                    for (int _h = 0; _h < 2; ++_h)
#pragma unroll
                        for (int _i = 0; _i < 2; ++_i) { const int _r = _h * HALF + R0 + 64 * _i; if (_r < nn.nvalid) gtok[_h][_i] = gidx[nn.grow + _r]; } } }
                if (wid == 0) E.stage(cur, lds + BIAS_OFF, lane);
            }
            PG8_KBODY(last, t);
        }
        if constexpr (GATHER) {
#pragma unroll
            for (int _h = 0; _h < 2; ++_h)
#pragma unroll
                for (int _i = 0; _i < 2; ++_i) gnn[_h][_i] = has_nn ? (unsigned)gtok[_h][_i] * (unsigned)KB + (unsigned)C0b : gnxt[_h][_i];
            PG8_PING(gnn);
        }
        if (wr == 0) PG8_BAR;
        E(acc, cur, wr, wc, fr, fq, (const LAS float*)(lds + BIAS_OFF));
        if (!has_next) break;
#pragma unroll
        for (int a = 0; a < 2; ++a)
#pragma unroll
            for (int b = 0; b < 2; ++b)
#pragma unroll
                for (int m = 0; m < 4; ++m)
#pragma unroll
                    for (int n = 0; n < 2; ++n) acc[a][b][m][n] = (f32x4){0.f, 0.f, 0.f, 0.f};
        cur = nxt; nxt = nn; has_next = has_nn; cA = nA; cB = nB; ++ui;
        if constexpr (GATHER) {
#pragma unroll
            for (int h = 0; h < 2; ++h)
#pragma unroll
                for (int i = 0; i < 2; ++i) { gcur[h][i] = gnxt[h][i]; gnxt[h][i] = gnn[h][i]; }
        }
        if (wr == 1) PG8_BAR;
    }
    PG8_WAIT_V(0);
    PG8_BAR;
    (void)At; (void)B0; (void)B1; (void)At8; (void)B08; (void)B18; (void)aoff1; (void)boff1;
#undef PG8_KBODY
#undef PG8_LOADG
#undef PG8_PING
#undef PG8_SA
#undef PG8_SB
#undef PG8_STAGE
#undef PG8_STAGE_A
#undef PG8_LDA
#undef PG8_LDB
#undef PG8_MMA
#undef PG8_WAIT_V
#undef PG8_WAIT_L
#undef PG8_BAR
#undef PG8_SCHED
}

typedef f32x4 Acc[2][2][4][2];
__device__ __forceinline__ u32x4 pack8(const f32x4 v0, const f32x4 v1) { u32x4 w; w.x = cvt_pk_bf16(v0[0], v0[1]); w.y = cvt_pk_bf16(v0[2], v0[3]); w.z = cvt_pk_bf16(v1[0], v1[1]); w.w = cvt_pk_bf16(v1[2], v1[3]); return w; }

struct EpiInProj {
    static constexpr bool PERM = true;
    const float* bias; const float* cs; bf16 *Q, *KB, *VB, *U, *GA, *GP;
    __device__ __forceinline__ void stage(const GUnit& u, LAS unsigned char* slot, int lane) const {
        const __amdgpu_buffer_rsrc_t rs = __builtin_amdgcn_make_buffer_rsrc((void*)bias, 0, 0x7fffffff, 0x00020000);
        __builtin_amdgcn_raw_ptr_buffer_load_lds(rs, (LAS void*)slot, 16, lane * 16, u.pn * 1024, 0, 0); }
    __device__ __forceinline__ void operator()(const Acc& acc, const GUnit& u, int wr, int wc, int fr, int fq, const LAS float* bl) const {
        const int pn = u.pn; const bool rw = (wc & 1) == 0;
        bf16 *d0, *d1; int c0, pitch; bool rp0, rp1, nt;
        if (pn < 4) { d0 = d1 = Q; c0 = pn * 256; pitch = 1024; rp0 = rp1 = rw; nt = false; }
        else if (pn == 4) { d0 = KB; d1 = VB - 128; c0 = 0; pitch = 128; rp0 = rw; rp1 = false; nt = false; }
        else if (pn < 7) { d0 = d1 = U; c0 = (pn - 5) * 256; pitch = 512; rp0 = rp1 = false; nt = false; }
        else if (pn < 11) { d0 = d1 = GA; c0 = (pn - 7) * 256; pitch = 1024; rp0 = rp1 = false; nt = true; }
        else { d0 = d1 = GP; c0 = (pn - 11) * 256; pitch = 1024; rp0 = rp1 = false; nt = true; }
        const int rowl = wr * 64 + fr;
        const __amdgpu_buffer_rsrc_t r0 = __builtin_amdgcn_make_buffer_rsrc((void*)(d0 + (size_t)u.row0 * (nt ? pitch / 2 : pitch)), 0, 0x7fffffff, 0x00020000);
        const __amdgpu_buffer_rsrc_t r1 = __builtin_amdgcn_make_buffer_rsrc((void*)(d1 + (size_t)u.row0 * pitch), 0, 0x7fffffff, 0x00020000);
        const int vo = (rowl * pitch + c0 + wc * 32 + 8 * fq) * 2;
        f32x4 bb[2][2];
#pragma unroll
        for (int bj = 0; bj < 2; ++bj) { bb[bj][0] = *(const LAS f32x4*)(bl + bj * 128 + wc * 32 + 8 * fq); bb[bj][1] = *(const LAS f32x4*)(bl + bj * 128 + wc * 32 + 8 * fq + 4); }
        const float sg = (fq == 0) ? -1.f : 1.f;
        const int rstep = pitch * 32;
#pragma unroll
        for (int am = 0; am < 8; am += 2) {
            f32x4 csr[2][4];
            if (rp0) {
#pragma unroll
                for (int mm = 0; mm < 2; ++mm)
#pragma unroll
                    for (int q = 0; q < 4; ++q) csr[mm][q] = *(const f32x4*)(cs + (size_t)(u.row0 + rowl + ((am + mm) >> 2) * 128 + ((am + mm) & 3) * 16) * 16 + 4 * q);
            }
#pragma unroll
            for (int mm = 0; mm < 2; ++mm)
#pragma unroll
                for (int bj = 0; bj < 2; ++bj) { const int ai = (am + mm) >> 2, m = (am + mm) & 3;
                    f32x4 v0 = acc[ai][bj][m][0] + bb[bj][0], v1 = acc[ai][bj][m][1] + bb[bj][1];
                    if (bj == 0 ? rp0 : rp1) {
                        f32x4 o0, o1;
#pragma unroll
                        for (int j = 0; j < 4; ++j) { o0[j] = __shfl_xor(v0[j], 16); o1[j] = __shfl_xor(v1[j], 16); }
                        const f32x4 q0 = v0 * csr[mm][0] + (o0 * csr[mm][2]) * sg, q1 = v1 * csr[mm][1] + (o1 * csr[mm][3]) * sg;
                        if (fq < 2) { v0 = q0; v1 = q1; } }
                    const int so = (ai * 8 + m) * rstep;
                    if (nt) {
                        unsigned lo, hi2;
#define Q8(x_) ((unsigned)(fast_sigmoid(x_) * 255.f + 0.5f))
                        lo = Q8(v0[0]) | (Q8(v0[1]) << 8) | (Q8(v0[2]) << 16) | (Q8(v0[3]) << 24);
                        hi2 = Q8(v1[0]) | (Q8(v1[1]) << 8) | (Q8(v1[2]) << 16) | (Q8(v1[3]) << 24);
#undef Q8
                        const u32x2 w8 = {lo, hi2};
                        __builtin_amdgcn_raw_buffer_store_b64(w8, r0, (vo >> 1) + bj * 128, so >> 1, 2);
                    } else { const u32x4 w = pack8(v0, v1); __builtin_amdgcn_raw_buffer_store_b128(w, bj == 0 ? r0 : r1, vo + bj * 256, so, 0); }
                }
        }
    }
};
struct EpiGateA {
    static constexpr bool PERM = true;
    const bf16* GA; bf16* T1;
    __device__ __forceinline__ void stage(const GUnit&, LAS unsigned char*, int) const {}
    __device__ __forceinline__ void operator()(const Acc& acc, const GUnit& u, int wr, int wc, int fr, int fq, const LAS float*) const {
        const int row0 = u.row0 + wr * 64 + fr;
        u32x2 gg[16];
        const unsigned char* G8 = (const unsigned char*)GA;
#pragma unroll
        for (int ai = 0; ai < 2; ++ai)
#pragma unroll
            for (int m = 0; m < 4; ++m)
#pragma unroll
                for (int bj = 0; bj < 2; ++bj) gg[(ai * 4 + m) * 2 + bj] = *(const u32x2*)(G8 + (size_t)(row0 + ai * 128 + m * 16) * 1024 + u.pn * 256 + bj * 128 + wc * 32 + 8 * fq);
#pragma unroll
        for (int ai = 0; ai < 2; ++ai)
#pragma unroll
            for (int m = 0; m < 4; ++m)
#pragma unroll
                for (int bj = 0; bj < 2; ++bj) { const size_t off = (size_t)(row0 + ai * 128 + m * 16) * 1024 + u.pn * 256 + bj * 128 + wc * 32 + 8 * fq;
                    const u32x2 g = gg[(ai * 4 + m) * 2 + bj]; f32x4 v0 = acc[ai][bj][m][0], v1 = acc[ai][bj][m][1]; constexpr float K8 = 1.0f / 255.0f;
                    v0[0] *= ub8(g.x, 0) * K8; v0[1] *= ub8(g.x, 1) * K8; v0[2] *= ub8(g.x, 2) * K8; v0[3] *= ub8(g.x, 3) * K8;
                    v1[0] *= ub8(g.y, 0) * K8; v1[1] *= ub8(g.y, 1) * K8; v1[2] *= ub8(g.y, 2) * K8; v1[3] *= ub8(g.y, 3) * K8;
                    *(u32x4*)(T1 + off) = pack8(v0, v1); }
    }
};
struct EpiMerge {
    static constexpr bool PERM = true;
    const bf16* GP; const bf16* T1; bf16* MG;
    __device__ __forceinline__ void stage(const GUnit&, LAS unsigned char*, int) const {}
    __device__ __forceinline__ void operator()(const Acc& acc, const GUnit& u, int wr, int wc, int fr, int fq, const LAS float*) const {
        const int row0 = u.row0 + wr * 64 + fr;
#pragma unroll
        for (int ai = 0; ai < 2; ++ai) {
            u32x2 gg[8]; u32x4 tt[8];
            const unsigned char* G8 = (const unsigned char*)GP;
#pragma unroll
            for (int m = 0; m < 4; ++m)
#pragma unroll
                for (int bj = 0; bj < 2; ++bj) { const size_t off = (size_t)(row0 + ai * 128 + m * 16) * 1024 + u.pn * 256 + bj * 128 + wc * 32 + 8 * fq;
                    gg[m * 2 + bj] = *(const u32x2*)(G8 + off); tt[m * 2 + bj] = *(const u32x4*)(T1 + off); }
#pragma unroll
            for (int m = 0; m < 4; ++m)
#pragma unroll
                for (int bj = 0; bj < 2; ++bj) { const size_t off = (size_t)(row0 + ai * 128 + m * 16) * 1024 + u.pn * 256 + bj * 128 + wc * 32 + 8 * fq;
                    const u32x2 g = gg[m * 2 + bj]; const u32x4 t = tt[m * 2 + bj]; f32x4 v0 = acc[ai][bj][m][0], v1 = acc[ai][bj][m][1]; constexpr float K8 = 1.0f / 255.0f;
                    v0[0] = v0[0] * (ub8(g.x, 0) * K8) + bflo(t.x); v0[1] = v0[1] * (ub8(g.x, 1) * K8) + bfhi(t.x); v0[2] = v0[2] * (ub8(g.x, 2) * K8) + bflo(t.y); v0[3] = v0[3] * (ub8(g.x, 3) * K8) + bfhi(t.y);
                    v1[0] = v1[0] * (ub8(g.y, 0) * K8) + bflo(t.z); v1[1] = v1[1] * (ub8(g.y, 1) * K8) + bfhi(t.z); v1[2] = v1[2] * (ub8(g.y, 2) * K8) + bflo(t.w); v1[3] = v1[3] * (ub8(g.y, 3) * K8) + bfhi(t.w);
                    *(u32x4*)(MG + off) = pack8(v0, v1); }
        }
    }
};
struct EpiX1 {
    static constexpr bool PERM = true;
    bf16* X1;
    __device__ __forceinline__ void stage(const GUnit&, LAS unsigned char*, int) const {}
    __device__ __forceinline__ void operator()(const Acc& acc, const GUnit& u, int wr, int wc, int fr, int fq, const LAS float*) const {
        const int row0 = u.row0 + wr * 64 + fr;
#pragma unroll
        for (int ai = 0; ai < 2; ++ai)
#pragma unroll
            for (int m = 0; m < 4; ++m)
#pragma unroll
                for (int bj = 0; bj < 2; ++bj) *(u32x4*)(X1 + (size_t)(row0 + ai * 128 + m * 16) * 1024 + u.pn * 256 + bj * 128 + wc * 32 + 8 * fq) = pack8(acc[ai][bj][m][0], acc[ai][bj][m][1]);
    }
};
struct EpiSwiglu {
    static constexpr bool PERM = true;
    const float* bup; fp8* ACT;
    __device__ __forceinline__ void stage(const GUnit& u, LAS unsigned char* slot, int lane) const {
        const __amdgpu_buffer_rsrc_t rs = __builtin_amdgcn_make_buffer_rsrc((void*)bup, 0, 0x7fffffff, 0x00020000);
        __builtin_amdgcn_raw_ptr_buffer_load_lds(rs, (LAS void*)slot, 16, (lane & 31) * 16 + (lane >> 5) * 4096, (u.e * 2048 + u.pn * 128) * 4, 0, 0); }
    __device__ __forceinline__ void operator()(const Acc& acc, const GUnit& u, int wr, int wc, int fr, int fq, const LAS float* bl) const {
        const int row0 = u.row0 + wr * 64 + fr, col = u.pn * 128 + wc * 32 + 8 * fq;
        const LAS float* bg = bl + wc * 32 + 8 * fq;
        const f32x4 g0 = *(const LAS f32x4*)bg, g1 = *(const LAS f32x4*)(bg + 4), l0 = *(const LAS f32x4*)(bg + 128), l1 = *(const LAS f32x4*)(bg + 132);
#pragma unroll
        for (int ai = 0; ai < 2; ++ai)
#pragma unroll
            for (int m = 0; m < 4; ++m) {
                f32x4 a0 = acc[ai][0][m][0] * W8_INV + g0, a1 = acc[ai][0][m][1] * W8_INV + g1, c0 = acc[ai][1][m][0] * W8_INV + l0, c1 = acc[ai][1][m][1] * W8_INV + l1, r0, r1;
#pragma unroll
                for (int j = 0; j < 4; ++j) {
                    const float ga = fminf(a0[j], 7.f), la = fminf(fmaxf(c0[j], -7.f), 7.f); r0[j] = ga * fast_sigmoid(1.702f * ga) * (la + 1.f);
                    const float gb = fminf(a1[j], 7.f), lb = fminf(fmaxf(c1[j], -7.f), 7.f); r1[j] = gb * fast_sigmoid(1.702f * gb) * (lb + 1.f); }
                int w0 = 0, w1 = 0;
                w0 = __builtin_amdgcn_cvt_pk_fp8_f32(r0[0], r0[1], w0, false); w0 = __builtin_amdgcn_cvt_pk_fp8_f32(r0[2], r0[3], w0, true);
                w1 = __builtin_amdgcn_cvt_pk_fp8_f32(r1[0], r1[1], w1, false); w1 = __builtin_amdgcn_cvt_pk_fp8_f32(r1[2], r1[3], w1, true);
                u32x2 w; w.x = (unsigned)w0; w.y = (unsigned)w1;
                *(u32x2*)(ACT + (size_t)(row0 + ai * 128 + m * 16) * 1024 + col) = w;
            }
    }
};
struct EpiDown {
    static constexpr bool PERM = true;
    const float* bdn; fp8* YS;
    __device__ __forceinline__ void stage(const GUnit& u, LAS unsigned char* slot, int lane) const {
        const __amdgpu_buffer_rsrc_t rs = __builtin_amdgcn_make_buffer_rsrc((void*)bdn, 0, 0x7fffffff, 0x00020000);
        __builtin_amdgcn_raw_ptr_buffer_load_lds(rs, (LAS void*)slot, 16, lane * 16, (u.e * 1024 + u.pn * 256) * 4, 0, 0); }
    __device__ __forceinline__ void operator()(const Acc& acc, const GUnit& u, int wr, int wc, int fr, int fq, const LAS float* bl) const {
        const int row0 = u.row0 + wr * 64 + fr;
#pragma unroll
        for (int bj = 0; bj < 2; ++bj) { const int col = u.pn * 256 + bj * 128 + wc * 32 + 8 * fq;
            const f32x4 b0 = *(const LAS f32x4*)(bl + bj * 128 + wc * 32 + 8 * fq), b1 = *(const LAS f32x4*)(bl + bj * 128 + wc * 32 + 8 * fq + 4);
#pragma unroll
            for (int ai = 0; ai < 2; ++ai)
#pragma unroll
                for (int m = 0; m < 4; ++m) { const f32x4 r0 = acc[ai][bj][m][0] * W8_INV + b0, r1 = acc[ai][bj][m][1] * W8_INV + b1; int w0 = 0, w1 = 0;
                    w0 = __builtin_amdgcn_cvt_pk_fp8_f32(r0[0], r0[1], w0, false); w0 = __builtin_amdgcn_cvt_pk_fp8_f32(r0[2], r0[3], w0, true);
                    w1 = __builtin_amdgcn_cvt_pk_fp8_f32(r1[0], r1[1], w1, false); w1 = __builtin_amdgcn_cvt_pk_fp8_f32(r1[2], r1[3], w1, true);
                    u32x2 w; w.x = (unsigned)w0; w.y = (unsigned)w1; *(u32x2*)(YS + (size_t)(row0 + ai * 128 + m * 16) * 1024 + col) = w; } }
    }
};
}

struct Args { const float* in[19]; float* out; unsigned char* ws; int ph_lo, ph_hi, li, pad; };
struct Frame {
    LAS unsigned char* lds; int tid, lane, wave, G, bx;
    unsigned char* ws; gu32* ctl;
};

__device__ __forceinline__ void conv_item(const float* W, int N, bf16* WT, int K, int k0, int n_src0, int n_dst0, int lane, LAS unsigned char* scr) {
    const int hw = lane >> 5, l5 = lane & 31;
    const float* src = W + (size_t)(k0 + 16 * hw) * N + n_src0 + 4 * l5;
#pragma unroll
    for (int half = 0; half < 2; ++half) {
        f32x4 v[16];
#pragma unroll
        for (int j = 0; j < 16; ++j) v[j] = *(const f32x4*)(src + (size_t)(32 * half + j) * N);
#pragma unroll
        for (int q = 0; q < 4; ++q) { const int row = 4 * l5 + q;
#pragma unroll
            for (int cc = 0; cc < 2; ++cc) { u32x4 w; w.x = cvt_pk_bf16(v[8 * cc + 0][q], v[8 * cc + 1][q]); w.y = cvt_pk_bf16(v[8 * cc + 2][q], v[8 * cc + 3][q]);
                w.z = cvt_pk_bf16(v[8 * cc + 4][q], v[8 * cc + 5][q]); w.w = cvt_pk_bf16(v[8 * cc + 6][q], v[8 * cc + 7][q]);
                const int c = 4 * half + 2 * hw + cc;
                *(LAS u32x4*)(scr + row * 128 + ((c ^ (l5 & 7)) << 4)) = w; } }
    }
    LDS_WAIT(); asm volatile("" ::: "memory");
    bf16* dst = WT + (size_t)(n_dst0 + (lane >> 3)) * K + k0 + 8 * (lane & 7);
#pragma unroll
    for (int i = 0; i < 16; ++i) { const int n = 8 * i + (lane >> 3), c = lane & 7;
        const u32x4 w = *(const LAS u32x4*)(scr + n * 128 + ((c ^ ((n >> 2) & 7)) << 4));
        *(u32x4*)(dst + (size_t)(8 * i) * K) = w; }
    LDS_WAIT(); asm volatile("" ::: "memory");
}
__device__ __forceinline__ int pk4_fp8(float a, float b, float c, float d) { int w = 0; w = __builtin_amdgcn_cvt_pk_fp8_f32(a * W8_SCALE, b * W8_SCALE, w, false); w = __builtin_amdgcn_cvt_pk_fp8_f32(c * W8_SCALE, d * W8_SCALE, w, true); return w; }
template <int UNR> __device__ __forceinline__ void conv_item8(const float* W, int N, fp8* WT, int K, int k0, int n_src0, int n_dst0, int lane, LAS unsigned char* scr) {
    const int hw = lane >> 5, l5 = lane & 31;
    const float* src = W + (size_t)(k0 + 16 * hw) * N + n_src0 + 4 * l5;
#pragma unroll UNR
    for (int qt = 0; qt < 4; ++qt) {
        f32x4 v[16];
#pragma unroll
        for (int j = 0; j < 16; ++j) v[j] = __builtin_nontemporal_load((const f32x4*)(src + (size_t)(32 * qt + j) * N));
#pragma unroll
        for (int q = 0; q < 4; ++q) { const int row = 4 * l5 + q; u32x4 w;
            w.x = (unsigned)pk4_fp8(v[0][q], v[1][q], v[2][q], v[3][q]); w.y = (unsigned)pk4_fp8(v[4][q], v[5][q], v[6][q], v[7][q]);
            w.z = (unsigned)pk4_fp8(v[8][q], v[9][q], v[10][q], v[11][q]); w.w = (unsigned)pk4_fp8(v[12][q], v[13][q], v[14][q], v[15][q]);
            const int c = 2 * qt + hw;
            *(LAS u32x4*)(scr + row * 128 + ((c ^ (l5 & 7)) << 4)) = w; }
    }
    LDS_WAIT(); asm volatile("" ::: "memory");
    fp8* dst = WT + (size_t)(n_dst0 + (lane >> 3)) * K + k0 + 16 * (lane & 7);
#pragma unroll
    for (int i = 0; i < 16; ++i) { const int n = 8 * i + (lane >> 3), c = lane & 7;
        const u32x4 w = *(const LAS u32x4*)(scr + n * 128 + ((c ^ ((n >> 2) & 7)) << 4));
        __builtin_nontemporal_store(w, (u32x4*)(dst + (size_t)(8 * i) * K)); }
    LDS_WAIT(); asm volatile("" ::: "memory");
}
__device__ __forceinline__ void p0b_weights(const Frame& F, const Args& a, int widx, int nw) {
    const int gw = widx * NWAVES + F.wave, NGW = nw * NWAVES, lane = F.lane;
    unsigned char* ws = F.ws;
    bf16* WATT = (bf16*)(ws + WS_WATT); bf16* WEFF = (bf16*)(ws + WS_WEFF); bf16* WOUT = (bf16*)(ws + WS_WOUT);
    LAS unsigned char* scr = F.lds + F.wave * 16384;
    fp8* WUP8 = (fp8*)(ws + WS_WUP);
    constexpr int I_UP = 32 * 8 * 16, I_AT = 16 * 8, I_OUT = 16 * 8;
    for (int it = gw; it < I_UP; it += NGW) {
        int r = it;
        { const int e = r >> 7, q = r & 127, kb = q >> 4, nb = q & 15; conv_item8<2>(a.in[14] + (size_t)e * 1024 * 2048, 2048, WUP8 + (size_t)e * 2048 * 1024, 1024, kb * 128, up_src_col(nb * 128), nb * 128, lane, scr); }
    }
    for (int it = gw; it < I_AT + I_OUT; it += NGW) {
        int r = it;
        if (r < I_AT) { const int kb = r >> 3, nb = r & 7; conv_item(a.in[6], 1024, WATT, 1024, kb * 64, nb * 128, nb * 128, lane, scr); continue; } r -= I_AT;
        { const int kb = r >> 3, nb = r & 7; conv_item(a.in[10], 1024, WOUT, 1024, kb * 64, nb * 128, nb * 128, lane, scr); }
    }
    for (int it = NGW - 1 - gw; it < 64 * 16; it += NGW) {
        const int k0 = (it >> 4) * 8, n0 = (it & 15) * 64, g = k0 >> 7, kk0 = k0 & 127;
        const float* pw = a.in[7] + (size_t)(g * 128 + kk0) * 128; const float* ps = a.in[8] + g * 128; const float* wp = a.in[9] + (size_t)(g * 128) * 1024 + n0 + lane;
        float acc8[8];
#pragma unroll
        for (int q = 0; q < 8; ++q) acc8[q] = 0.f;
#pragma unroll 16
        for (int c = 0; c < 128; ++c) { const float wv = wp[(size_t)c * 1024] * ps[c];
#pragma unroll
            for (int q = 0; q < 8; ++q) acc8[q] += pw[q * 128 + c] * wv; }
        u32x4 w; w.x = cvt_pk_bf16(acc8[0], acc8[1]); w.y = cvt_pk_bf16(acc8[2], acc8[3]); w.z = cvt_pk_bf16(acc8[4], acc8[5]); w.w = cvt_pk_bf16(acc8[6], acc8[7]);
        *(u32x4*)(WEFF + (size_t)(n0 + lane) * 512 + k0) = w;
    }
}
__device__ __forceinline__ void p0_prologue(const Frame& F, const Args& a) {
    const int gw = F.bx * NWAVES + F.wave, NGW = F.G * NWAVES, lane = F.lane;
    unsigned char* ws = F.ws;
    bf16* WIN = (bf16*)(ws + WS_WIN); float* CS = (float*)(ws + WS_CS); bf16* H = (bf16*)(ws + WS_H);
    LAS unsigned char* scr = F.lds + F.wave * 16384;
    for (int it = gw; it < 16 * 30; it += NGW) { const int kb = it / 30, nb = it % 30; conv_item(a.in[3], INW, WIN, 1024, kb * 64, nb * 128, nb * 128, lane, scr); }
    { const float* wr = a.in[12]; bf16* WRH = (bf16*)(ws + WS_WRH); bf16* WRL = (bf16*)(ws + WS_WRL);
      for (int idx = gw * 64 + lane; idx < 32 * 1024; idx += NGW * 64) { const int e = idx >> 10, k = idx & 1023; const float w = wr[k * 32 + e]; const unsigned h = cvt_pk_bf16(w, 0.f) & 0xffffu;
          WRH[idx] = (bf16)h; WRL[idx] = (bf16)(cvt_pk_bf16(w - __uint_as_float(h << 16), 0.f) & 0xffffu); } }
    { const int* pos = (const int*)a.in[1];
      for (int idx = gw * 64 + lane; idx < T * 8; idx += NGW * 64) { const int t = idx >> 3, i = idx & 7; const float inv = powf(500000.0f, -(float)i * 0.125f); const float an = (float)pos[t] * inv;
          CS[t * 16 + i] = cosf(an); CS[t * 16 + 8 + i] = sinf(an); } }
    { const float* x = a.in[0]; const float* g1 = a.in[2];
      f32x4 gg[4];
#pragma unroll
      for (int j = 0; j < 4; ++j) gg[j] = ((const f32x4*)g1)[lane + 64 * j];
      for (int row = gw; row < T; row += 2 * NGW) {
          const int row2 = row + NGW;
          const f32x4* xr = (const f32x4*)(x + (size_t)row * D) + lane; const f32x4* xr2 = (const f32x4*)(x + (size_t)(row2 < T ? row2 : row) * D) + lane; f32x4 v[4], v2[4]; float s = 0.f, s2 = 0.f;
#pragma unroll
          for (int j = 0; j < 4; ++j) { v[j] = __builtin_nontemporal_load(xr + 64 * j); v2[j] = __builtin_nontemporal_load(xr2 + 64 * j); }
#pragma unroll
          for (int j = 0; j < 4; ++j) { s += v[j].x * v[j].x + v[j].y * v[j].y + v[j].z * v[j].z + v[j].w * v[j].w; s2 += v2[j].x * v2[j].x + v2[j].y * v2[j].y + v2[j].z * v2[j].z + v2[j].w * v2[j].w; }
          const float rstd = rsqrtf(wave_sum(s) * (1.f / D) + RMS_EPS), rstd2 = rsqrtf(wave_sum(s2) * (1.f / D) + RMS_EPS);
#pragma unroll
          for (int j = 0; j < 4; ++j) { const f32x4 o = v[j] * rstd * gg[j]; u32x2 w; w.x = cvt_pk_bf16(o[0], o[1]); w.y = cvt_pk_bf16(o[2], o[3]); *(u32x2*)(H + (size_t)row * D + 4 * lane + 256 * j) = w; }
          if (row2 < T) {
#pragma unroll
              for (int j = 0; j < 4; ++j) { const f32x4 o = v2[j] * rstd2 * gg[j]; u32x2 w; w.x = cvt_pk_bf16(o[0], o[1]); w.y = cvt_pk_bf16(o[2], o[3]); *(u32x2*)(H + (size_t)row2 * D + 4 * lane + 256 * j) = w; } }
      } }
}

template <int W> __device__ __forceinline__ void pool_rows(const bf16* U, bf16* PO, int t0, int wave, int lane) {
    const int c4 = 64 * wave + 4 * (lane & 15), r0 = t0 + 16 * (lane >> 4);
    const int pos0 = r0 % SEQ;
    u32x2 v[15 + W];
#pragma unroll
    for (int i = 0; i < 15 + W; ++i) { const int rr = r0 - (W - 1) + i; u32x2 z = {0u, 0u}; if (i >= W - 1 || pos0 != 0) z = *(const u32x2*)(U + (size_t)rr * PW + c4); v[i] = z; }
#pragma unroll
    for (int i = 0; i < 16; ++i) {
        float s0 = 0.f, s1 = 0.f, s2 = 0.f, s3 = 0.f;
#pragma unroll
        for (int jj = 0; jj < W; ++jj) { const u32x2 x = v[i + W - 1 - jj]; s0 += bflo(x.x); s1 += bfhi(x.x); s2 += bflo(x.y); s3 += bfhi(x.y); }
        const int pos = pos0 + i; const float rc = 1.0f / (float)(pos + 1 < W ? pos + 1 : W);
        const u32x2 c = v[i + W - 1]; u32x2 o;
        o.x = cvt_pk_bf16(s0 * rc - bflo(c.x), s1 * rc - bfhi(c.x)); o.y = cvt_pk_bf16(s2 * rc - bflo(c.y), s3 * rc - bfhi(c.y));
        *(u32x2*)(PO + (size_t)(r0 + i) * PW + c4) = o;
    }
}
__device__ __forceinline__ void attn_unit(const Frame& F, int unit, const bf16* Q, const bf16* KB, const bf16* VB, const float* sinks, bf16* AO, const bf16* U, bf16* PO, int pool_chunk, const float* w_down, fp8* WDN8, bool first) {
    const int lane = F.lane, wid = F.wave, r32 = lane & 31, hi = lane >> 5;
    const int b = unit >> 6, n = (unit >> 1) & 31, hkv = unit & 1;
    LAS unsigned char* Kt = F.lds; LAS unsigned char* Vt = F.lds + 32768;
    const int tok0 = b * SEQ + 128 * (n - 1);
    int hq = hkv * 8 + 2 * (wid & 3);
    if (!first) __syncthreads();
    bf16x8 qn[4];
    if (wid >= 4) {
        const int it = unit * 4 + (wid - 4), e = it >> 6, q = it & 63, kb = q >> 3, nb = q & 7;
        conv_item8<1>(w_down + (size_t)e * 1024 * 1024, 1024, WDN8 + (size_t)e * 1024 * 1024, 1024, kb * 128, nb * 128, nb * 128, lane, F.lds + 65536 + (wid - 4) * 16384);
    } else {
        const __amdgpu_buffer_rsrc_t rsK = __builtin_amdgcn_make_buffer_rsrc((void*)KB, 0, 0x7fffffff, 0x00020000), rsV = __builtin_amdgcn_make_buffer_rsrc((void*)VB, 0, 0x7fffffff, 0x00020000);
        int ln = lane; asm volatile("" : "+v"(ln));
#pragma unroll
        for (int i = 0; i < 8; ++i) { const int row = (i * 4 + wid) * 8 + (ln >> 3), pp = ln & 7; int tok = tok0 + row; tok = tok < b * SEQ ? b * SEQ + row : tok;
            const int ck = pp ^ ((row >> 1) & 7), cv = pp ^ (((row >> 1) & 1) << 2);
            __builtin_amdgcn_raw_ptr_buffer_load_lds(rsK, (LAS void*)(Kt + (i * 4 + wid) * 1024), 16, tok * 256 + hkv * 128 + ck * 16, 0, 0, 0);
            __builtin_amdgcn_raw_ptr_buffer_load_lds(rsV, (LAS void*)(Vt + (i * 4 + wid) * 1024), 16, tok * 256 + hkv * 128 + cv * 16, 0, 0, 0); }
        const size_t qrow = (size_t)b * SEQ + 128 * n + r32;
#pragma unroll
        for (int ks = 0; ks < 4; ++ks) qn[ks] = *(const bf16x8*)(Q + qrow * 1024 + hq * 64 + ks * 16 + hi * 8);
    }
    if (pool_chunk >= 0) { const int g = wid >> 1, t0 = pool_chunk * 64;
        if (g == 0) pool_rows<2>(U, PO, t0, wid, lane); else if (g == 1) pool_rows<4>(U, PO, t0, wid, lane); else if (g == 2) pool_rows<8>(U, PO, t0, wid, lane); else pool_rows<16>(U, PO, t0, wid, lane); }
    VM_WAIT();
    __syncthreads();
    if (wid >= 4) {
        const int it = unit * 4 + (wid - 4) + 1024, e = it >> 6, q = it & 63, kb = q >> 3, nb = q & 7;
        conv_item8<1>(w_down + (size_t)e * 1024 * 1024, 1024, WDN8 + (size_t)e * 1024 * 1024, 1024, kb * 128, nb * 128, nb * 128, lane, F.lds + 65536 + (wid - 4) * 16384);
        return;
    }
    constexpr float LOG2E = 1.44269504089f, C2 = 0.125f * LOG2E;
#pragma unroll 1
    for (int hsel = 0; hsel < 2; ++hsel) {
    const float sink = sinks[hq];
    if (hsel == 1) { const size_t qrow = (size_t)b * SEQ + 128 * n + r32;
#pragma unroll
        for (int ks = 0; ks < 4; ++ks) qn[ks] = *(const bf16x8*)(Q + qrow * 1024 + hq * 64 + ks * 16 + hi * 8); }
#pragma unroll 1
    for (int j = 0; j < 4; ++j) {
        const size_t qrow = (size_t)b * SEQ + 128 * n + 32 * j + r32;
        bf16x8 qf[4];
#pragma unroll
        for (int ks = 0; ks < 4; ++ks) qf[ks] = qn[ks];
        if (j < 3) {
#pragma unroll
            for (int ks = 0; ks < 4; ++ks) qn[ks] = *(const bf16x8*)(Q + (qrow + 32) * 1024 + hq * 64 + ks * 16 + hi * 8); }
        int r32v = r32; asm volatile("" : "+v"(r32v));
        f32x16 s[5];
#pragma unroll
        for (int tau = 0; tau < 5; ++tau) {
            const int kt = j + tau; const int krow = 32 * kt + r32;
            f32x16 a = {0.f, 0.f, 0.f, 0.f, 0.f, 0.f, 0.f, 0.f, 0.f, 0.f, 0.f, 0.f, 0.f, 0.f, 0.f, 0.f};
#pragma unroll
            for (int ks = 0; ks < 4; ++ks) { const bf16x8 kf = *(const LAS bf16x8*)(Kt + krow * 128 + (((2 * ks + hi) ^ ((krow >> 1) & 7)) << 4));
                a = __builtin_amdgcn_mfma_f32_32x32x16_bf16(kf, qf[ks], a, 0, 0, 0); }
            s[tau] = a;
        }
        float mx = -1.0e30f;
#pragma unroll
        for (int tau = 0; tau < 5; ++tau) { const bool dead = (n == 0) && (j + tau < 4);
#pragma unroll
            for (int r = 0; r < 16; ++r) { const int kk = (r & 3) + 8 * (r >> 2) + 4 * hi; bool ok = !dead; if (tau == 0) ok = ok && (kk > r32v); if (tau == 4) ok = ok && (kk <= r32v);
                s[tau][r] = ok ? s[tau][r] : -1.0e30f; mx = fmaxf(mx, s[tau][r]); } }
        mx = fmaxf(mx, __shfl_xor(mx, 32));
        const float mm = fmaxf(mx * 0.125f, sink), mml = mm * LOG2E;
        float sum = 0.f;
#pragma unroll
        for (int tau = 0; tau < 5; ++tau)
#pragma unroll
            for (int r = 0; r < 16; ++r) { const float p = (s[tau][r] > -1.0e29f) ? __builtin_amdgcn_exp2f(s[tau][r] * C2 - mml) : 0.f; s[tau][r] = p; sum += p; }
        sum += __shfl_xor(sum, 32);
        sum += __builtin_amdgcn_exp2f((sink - mm) * LOG2E);
        const float inv = 1.0f / sum;
        bf16* orow = AO + qrow * 1024 + hq * 64;
#pragma unroll
        for (int d0 = 0; d0 < 2; ++d0) {
            f32x16 o = {0.f, 0.f, 0.f, 0.f, 0.f, 0.f, 0.f, 0.f, 0.f, 0.f, 0.f, 0.f, 0.f, 0.f, 0.f, 0.f};
#pragma unroll
            for (int tau = 0; tau < 5; ++tau) {
                const int kt = j + tau;
#pragma unroll
                for (int s2 = 0; s2 < 2; ++s2) {
                    bf16x8 pf; { const unsigned w0 = cvt_pk_bf16(s[tau][8 * s2 + 0], s[tau][8 * s2 + 1]), w1 = cvt_pk_bf16(s[tau][8 * s2 + 2], s[tau][8 * s2 + 3]), w2 = cvt_pk_bf16(s[tau][8 * s2 + 4], s[tau][8 * s2 + 5]), w3 = cvt_pk_bf16(s[tau][8 * s2 + 6], s[tau][8 * s2 + 7]);
                        const u32x4 w = {w0, w1, w2, w3}; pf = __builtin_bit_cast(bf16x8, w); }
                    const int vrow = 32 * kt + 16 * s2 + 4 * hi + ((lane & 15) >> 2);
                    const int vcb = 64 * d0 + 32 * ((lane >> 4) & 1) + 8 * (lane & 3);
                    const int vaddr = vrow * 128 + (vcb ^ (((vrow >> 1) & 1) << 6));
                    const s16x4 lo = __builtin_bit_cast(s16x4, __builtin_amdgcn_ds_read_tr16_b64_v4i16((LAS s16x4*)(Vt + vaddr)));
                    const s16x4 hh = __builtin_bit_cast(s16x4, __builtin_amdgcn_ds_read_tr16_b64_v4i16((LAS s16x4*)(Vt + vaddr + 1024)));
                    const bf16x8 vf = {lo[0], lo[1], lo[2], lo[3], hh[0], hh[1], hh[2], hh[3]};
                    o = __builtin_amdgcn_mfma_f32_32x32x16_bf16(vf, pf, o, 0, 0, 0);
                }
            }
#pragma unroll
            for (int rg = 0; rg < 4; ++rg) { u32x2 w; w.x = cvt_pk_bf16(o[4 * rg] * inv, o[4 * rg + 1] * inv); w.y = cvt_pk_bf16(o[4 * rg + 2] * inv, o[4 * rg + 3] * inv);
                *(u32x2*)(orow + 32 * d0 + 8 * rg + 4 * hi) = w; }
        }
    }
    ++hq;
    }
}

__device__ __forceinline__ void moe_tables(const Frame& F) {
    LAS int* tb = (LAS int*)(F.lds + TBL_OFF);
    __syncthreads();
    if (F.tid < 32) tb[192 + F.tid] = (int)__hip_atomic_load(F.ctl + CW_CNT + F.tid, RLX_AGENT);
    __syncthreads();
    if (F.tid == 0) { int u8 = 0, u4 = 0, ro = 0;
        for (int e = 0; e < 32; ++e) { const int c = tb[192 + e], r = (c + 255) >> 8; tb[e] = u8; tb[64 + e] = u4; tb[128 + e] = ro; u8 += r * 8; u4 += r * 4; ro += r * 256; }
        tb[32] = u8; tb[64 + 32] = u4; tb[128 + 32] = ro; }
    if (F.wave == 0) {
        const int e = F.lane & 31, R = (tb[192 + e] + 255) >> 8, L = R + (R >> 1); const bool odd = (R & 1) != 0;
        int lm = odd ? L : 0;
#pragma unroll
        for (int o = 16; o >= 1; o >>= 1) lm = max(lm, __shfl_xor(lm, o));
        const unsigned long long bx = __ballot(odd && L == lm), bh = __ballot(!odd && L + 1 <= lm);
        if (F.lane == 0) { tb[224] = (int)(unsigned)bx; tb[225] = (int)(unsigned)bh; }
    }
    __syncthreads();
}

__device__ __forceinline__ void router_chunk(const Frame& F, int chunk, const float* x, const bf16* X1, const float* g2, const bf16* WRH, const bf16* WRL, const float* br, fp8* H2, gu32* counts, int* stok, int* toke, float* tokg, bf16* X1B) {
    const int tid = F.tid, lane = F.lane, w = F.wave, i32 = lane & 31, hh = lane >> 5;
    LAS unsigned char* lds = F.lds;
    LAS float* logit = (LAS float*)(lds + RT_LOGIT); LAS int* tokE = (LAS int*)(lds + RT_TOKE); LAS int* tokR = (LAS int*)(lds + RT_TOKR); LAS float* tokG = (LAS float*)(lds + RT_TOKG);
    LAS unsigned* hist = (LAS unsigned*)(lds + RT_HIST); LAS unsigned* base = (LAS unsigned*)(lds + RT_BASE);
    LAS float* g2l = (LAS float*)(lds + RT_LOGIT + 4224);
    const __amdgpu_buffer_rsrc_t rsX = __builtin_amdgcn_make_buffer_rsrc((void*)x, 0, 0x7fffffff, 0x00020000), rsD = __builtin_amdgcn_make_buffer_rsrc((void*)X1, 0, 0x7fffffff, 0x00020000), rsH = __builtin_amdgcn_make_buffer_rsrc((void*)H2, 0, 0x7fffffff, 0x00020000), rsB = __builtin_amdgcn_make_buffer_rsrc((void*)X1B, 0, 0x7fffffff, 0x00020000);
    const int vx = lane * 16, vd = lane * 8, vh = lane * 4;
    f32x4 xv[4][4];
#pragma unroll
    for (int q = 0; q < 4; ++q) { const int so = (chunk * 64 + 4 * w + q) * (D * 4);
#pragma unroll
        for (int j = 0; j < 4; ++j) xv[q][j] = __builtin_bit_cast(f32x4, __builtin_amdgcn_raw_buffer_load_b128(rsX, vx + 1024 * j, so, 0)); }
    bf16x8 bh[8], bl[8];
    __syncthreads();
    if (tid < 32) hist[tid] = 0u;
    *(LAS f32x2*)(g2l + 2 * tid) = *(const f32x2*)(g2 + 2 * tid);
    __syncthreads();
#pragma unroll
    for (int p = 0; p < 2; ++p) {
        const int r0 = chunk * 64 + 32 * p;
#pragma unroll
        for (int qh = 0; qh < 2; ++qh) {
            u32x2 dv[2][4];
#pragma unroll
            for (int q2 = 0; q2 < 2; ++q2)
#pragma unroll
                for (int j = 0; j < 4; ++j) dv[q2][j] = __builtin_bit_cast(u32x2, __builtin_amdgcn_raw_buffer_load_b64(rsD, vd + 512 * j, (r0 + 4 * w + 2 * qh + q2) * (D * 2), 0));
#pragma unroll
            for (int q2 = 0; q2 < 2; ++q2) { const int q = 2 * qh + q2, rl = 4 * w + q, row = r0 + rl; float s = 0.f;
#pragma unroll
                for (int j = 0; j < 4; ++j) { const u32x2 dw = dv[q2][j]; const f32x4 t = xv[q][j] + (f32x4){bflo(dw.x), bfhi(dw.x), bflo(dw.y), bfhi(dw.y)}; xv[q][j] = t; s += t.x * t.x + t.y * t.y + t.z * t.z + t.w * t.w;
                    u32x2 xb; xb.x = cvt_pk_bf16(t.x, t.y); xb.y = cvt_pk_bf16(t.z, t.w); __builtin_amdgcn_raw_buffer_store_b64(xb, rsB, vd + 512 * j, row * (D * 2), 0); }
                const float rstd = rsqrtf(wave_sum(s) * (1.f / D) + RMS_EPS);
#pragma unroll
                for (int j = 0; j < 4; ++j) { const f32x4 o = xv[q][j] * rstd * *(const LAS f32x4*)(g2l + 4 * lane + 256 * j); int pk = 0; pk = __builtin_amdgcn_cvt_pk_fp8_f32(o[0], o[1], pk, false); pk = __builtin_amdgcn_cvt_pk_fp8_f32(o[2], o[3], pk, true);
                    __builtin_amdgcn_raw_buffer_store_b32((unsigned)pk, rsH, vh + 256 * j, row * D, 0); *(LAS f32x4*)(lds + rl * HB_STRIDE + (4 * lane + 256 * j) * 4) = o; } }
        }
        if (p == 0) {
            { const bf16* ph = WRH + (size_t)i32 * 1024 + 128 * w + 8 * hh; const bf16* pl = WRL + (size_t)i32 * 1024 + 128 * w + 8 * hh;
#pragma unroll
              for (int ks = 0; ks < 8; ++ks) { bh[ks] = *(const bf16x8*)(ph + 16 * ks); bl[ks] = *(const bf16x8*)(pl + 16 * ks); } }
#pragma unroll
            for (int q = 0; q < 4; ++q) { const int so = (chunk * 64 + 32 + 4 * w + q) * (D * 4);
#pragma unroll
                for (int j = 0; j < 4; ++j) xv[q][j] = __builtin_bit_cast(f32x4, __builtin_amdgcn_raw_buffer_load_b128(rsX, vx + 1024 * j, so, 0)); } }
        __syncthreads();
        f32x16 acc = {0.f, 0.f, 0.f, 0.f, 0.f, 0.f, 0.f, 0.f, 0.f, 0.f, 0.f, 0.f, 0.f, 0.f, 0.f, 0.f};
#pragma unroll
        for (int ks = 0; ks < 8; ++ks) {
            const LAS float* hp = (const LAS float*)(lds + i32 * HB_STRIDE + (128 * w + 16 * ks + 8 * hh) * 4);
            const f32x4 a0 = *(const LAS f32x4*)hp, a1 = *(const LAS f32x4*)(hp + 4);
            u32x4 whi, wlo;
            whi.x = cvt_pk_bf16(a0[0], a0[1]); whi.y = cvt_pk_bf16(a0[2], a0[3]); whi.z = cvt_pk_bf16(a1[0], a1[1]); whi.w = cvt_pk_bf16(a1[2], a1[3]);
            wlo.x = cvt_pk_bf16(a0[0] - bflo(whi.x), a0[1] - bfhi(whi.x)); wlo.y = cvt_pk_bf16(a0[2] - bflo(whi.y), a0[3] - bfhi(whi.y));
            wlo.z = cvt_pk_bf16(a1[0] - bflo(whi.z), a1[1] - bfhi(whi.z)); wlo.w = cvt_pk_bf16(a1[2] - bflo(whi.w), a1[3] - bfhi(whi.w));
            const bf16x8 ahi = __builtin_bit_cast(bf16x8, whi), alo = __builtin_bit_cast(bf16x8, wlo);
            acc = __builtin_amdgcn_mfma_f32_32x32x16_bf16(ahi, bh[ks], acc, 0, 0, 0);
            acc = __builtin_amdgcn_mfma_f32_32x32x16_bf16(ahi, bl[ks], acc, 0, 0, 0);
            acc = __builtin_amdgcn_mfma_f32_32x32x16_bf16(alo, bh[ks], acc, 0, 0, 0);
        }
        __syncthreads();
        LAS float* part = (LAS float*)lds;
#pragma unroll
        for (int r = 0; r < 16; ++r) { const int tk = (r & 3) + 8 * (r >> 2) + 4 * hh; part[(w * 32 + tk) * 33 + i32] = acc[r]; }
        __syncthreads();
#pragma unroll
        for (int q = 0; q < 2; ++q) { const int o = tid + 512 * q, tk = o >> 5, e = o & 31; float sacc = br[e];
#pragma unroll
            for (int ww = 0; ww < 8; ++ww) sacc += part[(ww * 32 + tk) * 33 + e];
            logit[(32 * p + tk) * 33 + e] = sacc; }
        __syncthreads();
    }
    if (tid < 64) {
        float lg[32];
#pragma unroll
        for (int e = 0; e < 32; ++e) lg[e] = logit[tid * 33 + e];
        int be[4]; float bv[4]; unsigned used = 0u;
#pragma unroll
        for (int k = 0; k < 4; ++k) { float best = -3.0e38f; int bi = 0;
#pragma unroll
            for (int e = 0; e < 32; ++e) { const bool ok = !((used >> e) & 1u) && lg[e] > best; best = ok ? lg[e] : best; bi = ok ? e : bi; }
            be[k] = bi; bv[k] = best; used |= 1u << bi; }
        float ex[4], se = 0.f;
#pragma unroll
        for (int k = 0; k < 4; ++k) { ex[k] = __expf(bv[k] - bv[0]); se += ex[k]; }
        const float rse = 1.0f / se;
#pragma unroll
        for (int k = 0; k < 4; ++k) { const unsigned rk = __hip_atomic_fetch_add(hist + be[k], 1u, __ATOMIC_RELAXED, __HIP_MEMORY_SCOPE_WORKGROUP);
            tokE[tid * 4 + k] = be[k]; tokR[tid * 4 + k] = (int)rk; tokG[tid * 4 + k] = ex[k] * rse; }
    }
    __syncthreads();
    if (tid < 32) { const unsigned hc = hist[tid]; base[tid] = hc ? __hip_atomic_fetch_add(counts + tid, hc, RLX_AGENT) : 0u; }
    __syncthreads();
    if (tid < 256) { const int tk = tid >> 2, k = tid & 3, e = tokE[tk * 4 + k], pos = (int)base[e] + tokR[tk * 4 + k], t = chunk * 64 + tk;
        stok[e * CAP + pos] = t; toke[t * 4 + k] = e | (pos << 8); tokg[t * 4 + k] = tokG[tk * 4 + k]; }
}

__device__ __forceinline__ void combine_rows(const Frame& F, const float* x, const bf16* X1, const fp8* YS, const int* toke, const float* tokg, const float* gf, float* out) {
    const int lane = F.lane; const LAS int* rowoff = (const LAS int*)(F.lds + TBL_OFF) + 128;
    f32x4 gg[4];
#pragma unroll
    for (int j = 0; j < 4; ++j) gg[j] = ((const f32x4*)gf)[lane + 64 * j];
    for (int t = F.bx * NWAVES + F.wave; t < T; t += F.G * NWAVES) {
        f32x4 v[4];
#pragma unroll
        for (int j = 0; j < 4; ++j) { const u32x2 dw = __builtin_nontemporal_load((const u32x2*)(X1 + (size_t)t * D + 4 * lane + 256 * j)); v[j] = (f32x4){bflo(dw.x), bfhi(dw.x), bflo(dw.y), bfhi(dw.y)}; }
        const int4 te = *(const int4*)(toke + t * 4); const f32x4 tg = *(const f32x4*)(tokg + t * 4);
        const int tes[4] = {te.x, te.y, te.z, te.w};
#pragma unroll
        for (int k = 0; k < 4; ++k) { const int e = tes[k] & 255, pos = tes[k] >> 8; const float g = tg[k];
            const fp8* y = YS + (size_t)(rowoff[e] + pos) * 1024 + 4 * lane;
#pragma unroll
            for (int j = 0; j < 4; ++j) { const int pw = __builtin_nontemporal_load((const int*)(y + 256 * j)); const f32x2 lo = __builtin_amdgcn_cvt_pk_f32_fp8(pw, false), hi2 = __builtin_amdgcn_cvt_pk_f32_fp8(pw, true);
                v[j].x += g * lo[0]; v[j].y += g * lo[1]; v[j].z += g * hi2[0]; v[j].w += g * hi2[1]; } }
        float s = 0.f;
#pragma unroll
        for (int j = 0; j < 4; ++j) s += v[j].x * v[j].x + v[j].y * v[j].y + v[j].z * v[j].z + v[j].w * v[j].w;
        const float rstd = rsqrtf(wave_sum(s) * (1.f / D) + RMS_EPS);
#pragma unroll
        for (int j = 0; j < 4; ++j) __builtin_nontemporal_store(v[j] * rstd * gg[j], (f32x4*)(out + (size_t)t * D) + lane + 64 * j);
    }
}

constexpr int N_PHASES = 9;
__global__ void __launch_bounds__(NTHR, 2) fwd(Args a) {
    extern __shared__ __attribute__((aligned(16))) unsigned char lds_raw[];
    Frame F; F.lds = (LAS unsigned char*)lds_raw; F.tid = threadIdx.x; F.lane = F.tid & 63; F.wave = __builtin_amdgcn_readfirstlane(F.tid >> 6); F.G = gridDim.x; F.bx = blockIdx.x;
    F.ws = a.ws; F.ctl = (gu32*)(a.ws + WS_CTL);
    volatile LAS unsigned* MISC = (volatile LAS unsigned*)(F.lds + MISC_OFF);
    if (F.tid < 32) MISC[F.tid] = 0u;
    __syncthreads();
    XcdBarrier bar = xcd_barrier_post((unsigned*)(F.ctl + CW_BAR) + a.li * 4096, MISC + 8);
    unsigned char* const ws = a.ws;
#define WIN ((bf16*)(ws + WS_WIN))
#define WATT ((bf16*)(ws + WS_WATT))
#define WEFF ((bf16*)(ws + WS_WEFF))
#define WOUT ((bf16*)(ws + WS_WOUT))
#define CS ((float*)(ws + WS_CS))
#define WUP ((fp8*)(ws + WS_WUP))
#define WDN ((fp8*)(ws + WS_WDN))
#define H ((bf16*)(ws + WS_H))
#define H2 ((fp8*)(ws + WS_H2))
#define Q ((bf16*)(ws + WS_Q))
#define KB ((bf16*)(ws + WS_KB))
#define VB ((bf16*)(ws + WS_VB))
#define U ((bf16*)(ws + WS_U))
#define PO ((bf16*)(ws + WS_PO))
#define GA ((bf16*)(ws + WS_GA))
#define GP ((bf16*)(ws + WS_GP))
#define AO ((bf16*)(ws + WS_AO))
#define T1 ((bf16*)(ws + WS_T1))
#define MG ((bf16*)(ws + WS_MG))
#define X1 ((bf16*)(ws + WS_X1))
#define STOK ((int*)(ws + WS_STOK))
#define TOKE ((int*)(ws + WS_TOKE))
#define TOKG ((float*)(ws + WS_TOKG))
#define ACT ((fp8*)(ws + WS_ACT))
#define YS ((fp8*)(ws + WS_YS))
    const int lo = a.ph_lo, hi = a.ph_hi;
#define IN(k) (lo <= (k) && (k) < hi)
#define SEAM(k) do { if (IN(k) && IN((k) + 1)) xcd_barrier(bar); } while (0)
#define FRESH() do { int t_ = (int)threadIdx.x; asm volatile("" : "+v"(t_)); F.tid = t_; F.lane = t_ & 63; F.wave = __builtin_amdgcn_readfirstlane(t_ >> 6); } while (0)

    if (IN(0)) { FRESH(); p0b_weights(F, a, F.bx, F.G); p0_prologue(F, a); }
    SEAM(0);
    if (IN(1)) { FRESH();
        pg8::DenseOrder S; S.init(T, INW, F.G, F.bx);
        pg8::EpiInProj E{a.in[4], CS, Q, KB, VB, U, GA, GP};
        pg8::gemm_phase<pg8::EpiInProj, pg8::DenseOrder, 1024, false, false>(F.lds, H, WIN, 0, S, E, nullptr);
    }
    SEAM(1);
    if (IN(2)) { FRESH();
        for (int u = F.bx; u < 256; u += F.G) attn_unit(F, u, Q, KB, VB, a.in[5], AO, U, PO, u, a.in[16], WDN, u == F.bx);
        __syncthreads();
    }
    SEAM(2);
    if (IN(3)) { FRESH();
        pg8::DenseOrder S; S.init(T, 1024, F.G, F.bx);
        { pg8::EpiGateA E{GA, T1}; pg8::gemm_phase<pg8::EpiGateA, pg8::DenseOrder, 1024, false, false>(F.lds, AO, WATT, 0, S, E, nullptr); }
        VM_WAIT(); __syncthreads();
        { pg8::EpiMerge E{GP, T1, MG}; pg8::gemm_phase<pg8::EpiMerge, pg8::DenseOrder, 512, false, false>(F.lds, PO, WEFF, 0, S, E, nullptr); }
    }
    SEAM(3);
    if (IN(4)) { FRESH();
        pg8::DenseOrder S; S.init(T, 1024, F.G, F.bx);
        pg8::EpiX1 E{X1};
        pg8::gemm_phase<pg8::EpiX1, pg8::DenseOrder, 1024, false, false>(F.lds, MG, WOUT, 0, S, E, nullptr);
    }
    SEAM(4);
    if (IN(5)) { FRESH();
        for (int ch = F.bx; ch < T / 64; ch += F.G) router_chunk(F, ch, a.in[0], X1, a.in[11], (const bf16*)(ws + WS_WRH), (const bf16*)(ws + WS_WRL), a.in[13], H2, F.ctl + CW_CNT, STOK, TOKE, TOKG, (bf16*)(ws + WS_X1B));
        __syncthreads();
    }
    SEAM(5);
    if (IN(6)) { FRESH();
        moe_tables(F);
        const LAS int* tb = (const LAS int*)(F.lds + TBL_OFF);
        pg8::EpiSwiglu E{a.in[15], ACT};
        pg8::MoeOrderX<true> S{tb + 128, tb + 192, 3, F.G, F.bx};
        pg8::gemm_phase<pg8::EpiSwiglu, pg8::MoeOrderX<true>, 1024, true, true>(F.lds, H2, WUP, (size_t)2048 * 1024, S, E, STOK);
        VM_WAIT(); __syncthreads();
        if (F.tid == 0) {
            __builtin_amdgcn_fence(__ATOMIC_RELEASE, "agent"); VM_WAIT();
            for (int v = F.bx; v < 256; v += F.G) { const int e = (v & 7) + 8 * ((v >> 3) >> 3); (void)xb_add((unsigned*)(F.ctl + CW_DONE + 64 * e), 1u); }
        }
    }
    if (IN(7)) { FRESH();
        moe_tables(F);
        const LAS int* tb = (const LAS int*)(F.lds + TBL_OFF);
        const unsigned mx = (unsigned)__builtin_amdgcn_readfirstlane(tb[224]), mh = (unsigned)__builtin_amdgcn_readfirstlane(tb[225]);
        pg8::EpiDown E{a.in[17], YS};
        {   pg8::MoeOrderOwn S{tb + 128, tb + 192, mx, mh, F.G, F.bx};
            if (F.tid == 0) { pg8::GUnit u; unsigned seen = 0u;
                for (int i = 0; S.next(i, u); ++i) { if ((seen >> u.e) & 1u) continue; seen |= 1u << u.e; unsigned* p = (unsigned*)(F.ctl + CW_DONE + 64 * u.e); XB_SPIN(xb_ld(p) < 8u, bar.bar); }
                __builtin_amdgcn_fence(__ATOMIC_ACQUIRE, "agent"); VM_WAIT(); }
            __syncthreads();
            pg8::gemm_phase<pg8::EpiDown, pg8::MoeOrderOwn, 1024, false, true>(F.lds, ACT, WDN, (size_t)1024 * 1024, S, E, nullptr);
        }
        {   pg8::MoeOrderSteal S{tb + 128, tb + 192, mx, mh, F.G, F.bx};
            pg8::GUnit u0;
            if (S.next(0, u0)) {
                VM_WAIT(); __syncthreads();
                if (F.tid == 0) { pg8::GUnit u;
                    for (int i = 0; S.next(i, u); ++i) { unsigned* p = (unsigned*)(F.ctl + CW_DONE + 64 * u.e); XB_SPIN(xb_ld(p) < 8u, bar.bar); }
                    __builtin_amdgcn_fence(__ATOMIC_ACQUIRE, "agent"); VM_WAIT(); }
                __syncthreads();
                pg8::gemm_phase<pg8::EpiDown, pg8::MoeOrderSteal, 1024, false, true>(F.lds, ACT, WDN, (size_t)1024 * 1024, S, E, nullptr);
            }
        }
    }
    SEAM(7);
    if (IN(8)) { FRESH();
        moe_tables(F);
        combine_rows(F, a.in[0], (const bf16*)(ws + WS_X1B), YS, TOKE, TOKG, a.in[18], a.out);
    }
#undef IN
#undef SEAM
#undef WIN
#undef WATT
#undef WEFF
#undef WOUT
#undef CS
#undef WUP
#undef WDN
#undef H
#undef H2
#undef Q
#undef KB
#undef VB
#undef U
#undef PO
#undef GA
#undef GP
#undef AO
#undef T1
#undef MG
#undef X1
#undef STOK
#undef TOKE
#undef TOKG
#undef ACT
#undef YS
}

#ifndef REPEAT_MASK
#define REPEAT_MASK 0
#endif
#ifndef FAST_MASK
#define FAST_MASK 0x1ff
#endif
#ifndef ONE_LAUNCH
#define ONE_LAUNCH 1
#endif
extern "C" void kernel_launch(void* const* d_in, const int* in_sizes, int n_in, void* d_out, int out_size, void* d_ws, size_t ws_size, hipStream_t stream) {
    if (n_in != 19 || out_size != T * D || ws_size < WS_END) { fprintf(stderr, "kernel_launch: unexpected shapes / workspace (n_in %d, out %d, ws %zu)\n", n_in, out_size, ws_size); return; }
    const float* x = (const float*)d_in[0]; const int* positions = (const int*)d_in[1]; const float* norm1_g = (const float*)d_in[2];
    const float* w_in = (const float*)d_in[3]; const float* b_in = (const float*)d_in[4]; const float* sinks = (const float*)d_in[5];
    const float* w_attn = (const float*)d_in[6]; const float* pool_w = (const float*)d_in[7]; const float* pool_scale = (const float*)d_in[8];
    const float* w_pool = (const float*)d_in[9]; const float* w_out = (const float*)d_in[10]; const float* norm2_g = (const float*)d_in[11];
    const float* w_router = (const float*)d_in[12]; const float* b_router = (const float*)d_in[13]; const float* w_up = (const float*)d_in[14];
    const float* b_up = (const float*)d_in[15]; const float* w_down = (const float*)d_in[16]; const float* b_down = (const float*)d_in[17];
    const float* normf_g = (const float*)d_in[18];
    unsigned char* ws = (unsigned char*)d_ws; float* out = (float*)d_out;
    unsigned* ctl = (unsigned*)(ws + WS_CTL);
    bf16* WIN = (bf16*)(ws + WS_WIN); bf16* WATT = (bf16*)(ws + WS_WATT); bf16* WEFF = (bf16*)(ws + WS_WEFF); bf16* WOUT = (bf16*)(ws + WS_WOUT);
    float* CS = (float*)(ws + WS_CS); fp8* WUP = (fp8*)(ws + WS_WUP); fp8* WDN = (fp8*)(ws + WS_WDN);
    bf16* H = (bf16*)(ws + WS_H); bf16* Q = (bf16*)(ws + WS_Q); bf16* KB = (bf16*)(ws + WS_KB); bf16* VB = (bf16*)(ws + WS_VB);
    bf16* U = (bf16*)(ws + WS_U); bf16* PO = (bf16*)(ws + WS_PO); bf16* GA = (bf16*)(ws + WS_GA); bf16* GP = (bf16*)(ws + WS_GP);
    bf16* AO = (bf16*)(ws + WS_AO); bf16* MG = (bf16*)(ws + WS_MG); bf16* X1 = (bf16*)(ws + WS_X1);
    int* STOK = (int*)(ws + WS_STOK); int* TOKE = (int*)(ws + WS_TOKE); float* TOKG = (float*)(ws + WS_TOKG);
    fp8* ACT = (fp8*)(ws + WS_ACT); fp8* YS = (fp8*)(ws + WS_YS); float* TMP = (float*)(ws + WS_TMP); float* TMP2 = TMP + (size_t)T * D;
    unsigned* counts = ctl + CW_CNT;

    static int grid = 0;
    if (grid == 0) {
        int dev = 0, cus = 0;
        if (hipGetDevice(&dev) != hipSuccess || hipDeviceGetAttribute(&cus, hipDeviceAttributeMultiprocessorCount, dev) != hipSuccess) { fprintf(stderr, "kernel_launch: device query failed\n"); grid = -1; return; }
        if (hipFuncSetAttribute((const void*)fwd, hipFuncAttributeMaxDynamicSharedMemorySize, LDS_BYTES) != hipSuccess) { fprintf(stderr, "kernel_launch: hipFuncSetAttribute failed\n"); grid = -1; return; }
        int per_cu = 0;
        if (hipOccupancyMaxActiveBlocksPerMultiprocessor(&per_cu, (const void*)fwd, NTHR, LDS_BYTES) != hipSuccess || per_cu < 1) fprintf(stderr, "kernel_launch: occupancy query says %d blocks per CU\n", per_cu);
        (void)hipGetLastError();
        grid = cus > 256 ? 256 : cus;
    }
    if (grid < 0) return;
    (void)hipMemsetAsync(ws + WS_CTL, 0, CTL_ZERO_BYTES, stream);
    Args a{};
    for (int i = 0; i < 19; ++i) a.in[i] = (const float*)d_in[i];
    a.out = out; a.ws = ws; a.pad = 0;
    int li = 0;
#define RUN_FAST(lo_, hi_) do { a.ph_lo = (lo_); a.ph_hi = (hi_); a.li = li < 3 ? li : 2; ++li; for (int rep_ = 0; rep_ < ((((hi_) - (lo_)) == 1 && ((REPEAT_MASK >> (lo_)) & 1) && (lo_) != 5) ? 2 : 1); ++rep_) hipLaunchKernelGGL(fwd, dim3(grid), dim3(NTHR), LDS_BYTES, stream, a); } while (0)
#if ONE_LAUNCH
    RUN_FAST(0, N_PHASES);
#else
    if (FAST_MASK & 1) RUN_FAST(0, 1); else {
        n_transpose<<<2048, 256, 0, stream>>>(w_in, 1024, INW, WIN, INW, 0);
        n_transpose<<<1024, 256, 0, stream>>>(w_attn, 1024, 1024, WATT, 1024, 0);
        n_transpose<<<1024, 256, 0, stream>>>(w_out, 1024, 1024, WOUT, 1024, 0);
        for (int e = 0; e < NE; ++e) {
            n_transpose8<<<2048, 256, 0, stream>>>(w_up + (size_t)e * 1024 * 2048, 1024, 2048, WUP + (size_t)e * 2048 * 1024, 2048, 1);
            n_transpose8<<<1024, 256, 0, stream>>>(w_down + (size_t)e * 1024 * 1024, 1024, 1024, WDN + (size_t)e * 1024 * 1024, 1024, 0);
        }
        n_weff<<<(1024 * 512) / 256, 256, 0, stream>>>(pool_w, pool_scale, w_pool, WEFF);
        n_rope_table<<<(T * 8) / 256, 256, 0, stream>>>(positions, CS);
        n_wr_split<<<128, 256, 0, stream>>>(w_router, (bf16*)(ws + WS_WRH), (bf16*)(ws + WS_WRL));
        n_rms_bf16<<<T / 4, 256, 0, stream>>>(x, norm1_g, H);
    }
    if (FAST_MASK & 2) RUN_FAST(1, 2); else {
        n_gemm<<<dim3(INW / 64, T / 64), 256, 0, stream>>>(H, WIN, TMP, T, INW, 1024);
        n_post_inproj<<<(unsigned)(((size_t)T * INW + 255) / 256), 256, 0, stream>>>(TMP, b_in, CS, Q, KB, VB, U, GA, GP);
    }
    if (FAST_MASK & 4) RUN_FAST(2, 3); else {
        if (FAST_MASK & 1) for (int e = 0; e < NE; ++e) n_transpose8<<<1024, 256, 0, stream>>>(w_down + (size_t)e * 1024 * 1024, 1024, 1024, WDN + (size_t)e * 1024 * 1024, 1024, 0);
        n_attn<<<(T * NQH) / 256, 256, 0, stream>>>(Q, KB, VB, sinks, AO);
        n_pool<<<(T * PW) / 256, 256, 0, stream>>>(U, PO);
    }
    if (FAST_MASK & 8) RUN_FAST(3, 4); else {
        n_gemm<<<dim3(1024 / 64, T / 64), 256, 0, stream>>>(AO, WATT, TMP, T, 1024, 1024);
        n_gemm<<<dim3(1024 / 64, T / 64), 256, 0, stream>>>(PO, WEFF, TMP2, T, 1024, 512);
        n_merge<<<(T * D) / 256, 256, 0, stream>>>(TMP, TMP2, GA, GP, MG);
    }
    if (FAST_MASK & 16) RUN_FAST(4, 5); else {
        n_gemm<<<dim3(1024 / 64, T / 64), 256, 0, stream>>>(MG, WOUT, TMP, T, 1024, 1024);
        n_x1<<<(T * D) / 256, 256, 0, stream>>>(x, TMP, X1);
    }
    if (FAST_MASK & 32) { if (REPEAT_MASK & 32) { a.ph_lo = 5; a.ph_hi = 6; a.li = 2; hipLaunchKernelGGL(fwd, dim3(grid), dim3(NTHR), LDS_BYTES, stream, a); (void)hipMemsetAsync(counts, 0, 128, stream); } RUN_FAST(5, 6); } else n_router<<<T / 4, 256, 0, stream>>>(x, X1, norm2_g, w_router, b_router, (fp8*)(ws + WS_H2), counts, STOK, TOKE, TOKG);
    if (FAST_MASK & 64) RUN_FAST(6, 7); else { n_moe_up<<<dim3(1024 / 64, T / 64, NE), 256, 0, stream>>>((const fp8*)(ws + WS_H2), STOK, counts, WUP, b_up, ACT); (void)hipMemsetAsync(ctl + CW_DONE, 8, 32 * 256, stream); }
    if (FAST_MASK & 128) RUN_FAST(7, 8); else n_moe_down<<<dim3(1024 / 64, T / 64, NE), 256, 0, stream>>>(ACT, counts, WDN, b_down, YS);
    if (FAST_MASK & 256) RUN_FAST(8, 9); else n_combine<<<T / 4, 256, 0, stream>>>(x, X1, YS, counts, TOKE, TOKG, normf_g, out);
#endif
    (void)in_sizes; (void)sinks; (void)positions; (void)norm1_g; (void)norm2_g; (void)w_router; (void)b_router; (void)b_up; (void)b_down; (void)normf_g; (void)b_in; (void)pool_w; (void)pool_scale; (void)w_pool;
    (void)w_in; (void)w_attn; (void)w_out; (void)w_up; (void)w_down; (void)x; (void)WIN; (void)WATT; (void)WEFF; (void)WOUT; (void)CS; (void)WUP; (void)WDN; (void)H; (void)Q; (void)KB; (void)VB; (void)U; (void)PO; (void)GA; (void)GP;
    (void)AO; (void)MG; (void)X1; (void)STOK; (void)TOKE; (void)TOKG; (void)ACT; (void)YS; (void)TMP; (void)TMP2; (void)counts;
}
```

```cpp
#include <hip/hip_runtime.h>
#include <cstdio>
#include <cstdint>

constexpr int BATCH = 4, SEQ = 4096, T = BATCH * SEQ, D = 1024;
constexpr int NQH = 16, NKVH = 2, HD = 64, WINDOW = 128;
constexpr int INW = 3840, O_K = 1024, O_V = 1152, O_P = 1280, O_GA = 1792, O_GP = 2816, PW = 512;
constexpr int NE = 32, TOPK = 4, DFF = 1024, CAP = T;
constexpr int NSLOT = T * TOPK + NE * 256;
constexpr float RMS_EPS = 1e-5f;

typedef unsigned short bf16;
typedef unsigned char fp8;
constexpr float W8_SCALE = 32.0f, W8_INV = 1.0f / 32.0f;
typedef float f32x4 __attribute__((ext_vector_type(4)));
typedef unsigned u32x4 __attribute__((ext_vector_type(4)));
typedef unsigned u32x2 __attribute__((ext_vector_type(2)));

constexpr size_t MiB = 1u << 20;
constexpr size_t WS_CTL = 0, CTL_ZERO_BYTES = 131072;
constexpr size_t WS_WIN = 2 * MiB;
constexpr size_t WS_WATT = 10 * MiB;
constexpr size_t WS_WEFF = 12 * MiB;
constexpr size_t WS_WOUT = 13 * MiB;
constexpr size_t WS_CS = 15 * MiB;
constexpr size_t WS_WUP = 16 * MiB;
constexpr size_t WS_WDN = 144 * MiB;
constexpr size_t WS_H = 208 * MiB;
constexpr size_t WS_Q = 240 * MiB;
constexpr size_t WS_KB = 272 * MiB;
constexpr size_t WS_VB = 276 * MiB;
constexpr size_t WS_U = 280 * MiB;
constexpr size_t WS_PO = 296 * MiB;
constexpr size_t WS_GA = 312 * MiB;
constexpr size_t WS_GP = 344 * MiB;
constexpr size_t WS_AO = 376 * MiB;
constexpr size_t WS_T1 = 408 * MiB;
constexpr size_t WS_MG = WS_T1;
constexpr size_t WS_X1 = 472 * MiB;
constexpr size_t WS_STOK = 536 * MiB;
constexpr size_t WS_TOKE = 538 * MiB;
constexpr size_t WS_TOKG = 539 * MiB;
constexpr size_t WS_WRH = 538 * MiB + 512 * 1024, WS_WRL = WS_WRH + 64 * 1024;
constexpr size_t WS_ACT = 540 * MiB;
constexpr size_t WS_YS = 684 * MiB;
constexpr size_t WS_H2 = 828 * MiB;
constexpr size_t WS_X1B = 844 * MiB;
constexpr size_t WS_END = 876 * MiB;
constexpr size_t WS_TMP = WS_ACT;
constexpr int CW_PG0 = 24576;
constexpr int CW_TMO = 0, CW_CODE = 1, CW_CNT = 64, CW_DONE = 128  , CW_GRPX = 2240  , CW_TK = 2304  , CW_BAR = 4096,
              CW_PGX = 16384  , CW_BAD = 16512  , CW_PGC = 16640  , CW_PGF = 20800  ;

__device__ __forceinline__ float bf2f(bf16 v) { return __uint_as_float((unsigned)v << 16); }
__device__ __forceinline__ bf16 f2bf(float f) { unsigned u = __float_as_uint(f); return (bf16)((u + 0x7fffu + ((u >> 16) & 1u)) >> 16); }
__device__ __forceinline__ float sigmoidf_(float v) { return 1.0f / (1.0f + __expf(-v)); }
__device__ __forceinline__ float wave_sum(float v) {
#pragma unroll
    for (int o = 1; o < 64; o <<= 1) v += __shfl_xor(v, o);
    return v;
}
__device__ __forceinline__ float fp82f(fp8 v) { return __builtin_amdgcn_cvt_f32_fp8((int)v, 0); }
__device__ __forceinline__ fp8 f2fp8(float f) { return (fp8)(__builtin_amdgcn_cvt_pk_fp8_f32(f, f, 0, false) & 0xff); }
__device__ __forceinline__ int up_src_col(int np) { const int t = np >> 8, c = np & 255; return c < 128 ? 128 * t + c : 1024 + 128 * t + (c - 128); }

__global__ void __launch_bounds__(256) n_transpose(const float* W, int K, int N, bf16* WT, int NT, int upmap) {
    const size_t total = (size_t)NT * K;
    for (size_t idx = (size_t)blockIdx.x * blockDim.x + threadIdx.x; idx < total; idx += (size_t)gridDim.x * blockDim.x) {
        const int n = (int)(idx / K), k = (int)(idx % K); const int sc = upmap ? up_src_col(n) : n;
        WT[idx] = f2bf(W[(size_t)k * N + sc]);
    }
}
__global__ void __launch_bounds__(256) n_transpose8(const float* W, int K, int N, fp8* WT, int NT, int upmap) {
    const size_t total = (size_t)NT * K;
    for (size_t idx = (size_t)blockIdx.x * blockDim.x + threadIdx.x; idx < total; idx += (size_t)gridDim.x * blockDim.x) {
        const int n = (int)(idx / K), k = (int)(idx % K); const int sc = upmap ? up_src_col(n) : n;
        WT[idx] = f2fp8(W[(size_t)k * N + sc] * W8_SCALE);
    }
}
__global__ void __launch_bounds__(256) n_weff(const float* pw, const float* ps, const float* Wpb, bf16* WeffT) {
    const int idx = blockIdx.x * blockDim.x + threadIdx.x; if (idx >= 1024 * 512) return;
    const int n = idx / 512, k = idx % 512, g = k / 128, kk = k % 128; float a = 0.f;
    for (int c = 0; c < 128; ++c) a += pw[(g * 128 + kk) * 128 + c] * ps[g * 128 + c] * Wpb[(size_t)(g * 128 + c) * 1024 + n];
    WeffT[idx] = f2bf(a);
}
__global__ void __launch_bounds__(256) n_wr_split(const float* wr, bf16* WRH, bf16* WRL) {
    const int idx = blockIdx.x * blockDim.x + threadIdx.x; if (idx >= 32 * 1024) return;
    const int e = idx >> 10, k = idx & 1023; const float w = wr[k * 32 + e]; const bf16 h = f2bf(w); WRH[idx] = h; WRL[idx] = f2bf(w - bf2f(h));
}
__global__ void __launch_bounds__(256) n_rope_table(const int* pos, float* cs) {
    const int idx = blockIdx.x * blockDim.x + threadIdx.x; if (idx >= T * 8) return;
    const int t = idx >> 3, i = idx & 7; const float inv = powf(500000.0f, -(float)i * 0.125f); const float a = (float)pos[t] * inv;
    cs[t * 16 + i] = cosf(a); cs[t * 16 + 8 + i] = sinf(a);
}
__global__ void __launch_bounds__(256) n_rms_bf16(const float* x, const float* g, bf16* out) {
    const int row = blockIdx.x * 4 + (threadIdx.x >> 6), lane = threadIdx.x & 63;
    const f32x4* xr = (const f32x4*)(x + (size_t)row * D) + lane; f32x4 v[4]; float s = 0.f;
#pragma unroll
    for (int j = 0; j < 4; ++j) { v[j] = xr[64 * j]; s += v[j].x * v[j].x + v[j].y * v[j].y + v[j].z * v[j].z + v[j].w * v[j].w; }
    const float rstd = rsqrtf(wave_sum(s) * (1.f / D) + RMS_EPS);
#pragma unroll
    for (int j = 0; j < 4; ++j) { const f32x4 gg = ((const f32x4*)g)[lane + 64 * j]; bf16* o = out + (size_t)row * D + 4 * lane + 256 * j;
        o[0] = f2bf(v[j].x * rstd * gg.x); o[1] = f2bf(v[j].y * rstd * gg.y); o[2] = f2bf(v[j].z * rstd * gg.z); o[3] = f2bf(v[j].w * rstd * gg.w); }
}
__global__ void __launch_bounds__(256) n_gemm(const bf16* A, const bf16* Bt, float* C, int M, int N, int K) {
    __shared__ float As[16][65], Bs[16][65];
    const int tx = threadIdx.x & 15, ty = threadIdx.x >> 4, m0 = blockIdx.y * 64, n0 = blockIdx.x * 64;
    float acc[4][4];
#pragma unroll
    for (int i = 0; i < 4; ++i)
#pragma unroll
        for (int j = 0; j < 4; ++j) acc[i][j] = 0.f;
    for (int k0 = 0; k0 < K; k0 += 16) {
        for (int i = threadIdx.x; i < 1024; i += 256) { const int r = i >> 4, c = i & 15;
            As[c][r] = bf2f(A[(size_t)(m0 + r) * K + k0 + c]); Bs[c][r] = bf2f(Bt[(size_t)(n0 + r) * K + k0 + c]); }
        __syncthreads();
#pragma unroll
        for (int kk = 0; kk < 16; ++kk) { float a[4], b[4];
#pragma unroll
            for (int i = 0; i < 4; ++i) { a[i] = As[kk][ty * 4 + i]; b[i] = Bs[kk][tx * 4 + i]; }
#pragma unroll
            for (int i = 0; i < 4; ++i)
#pragma unroll
                for (int j = 0; j < 4; ++j) acc[i][j] += a[i] * b[j]; }
        __syncthreads();
    }
#pragma unroll
    for (int i = 0; i < 4; ++i)
#pragma unroll
        for (int j = 0; j < 4; ++j) C[(size_t)(m0 + ty * 4 + i) * N + n0 + tx * 4 + j] = acc[i][j];
}
__global__ void __launch_bounds__(256) n_post_inproj(const float* P, const float* bias, const float* cs, bf16* Q, bf16* KB, bf16* VB, bf16* U, bf16* GA, bf16* GP) {
    const size_t idx = (size_t)blockIdx.x * blockDim.x + threadIdx.x; if (idx >= (size_t)T * INW) return;
    const int t = (int)(idx / INW), c = (int)(idx % INW); float v = P[idx] + bias[c];
    if (c < O_V) {
        const int d = c & 63;
        if (d < 16) { const int i = d & 7; const int pc = (d < 8) ? c + 8 : c - 8; const float o = P[(size_t)t * INW + pc] + bias[pc];
            const float co = cs[t * 16 + i], si = cs[t * 16 + 8 + i]; v = (d < 8) ? v * co - o * si : v * co + o * si; }
        if (c < O_K) Q[(size_t)t * 1024 + c] = f2bf(v); else KB[(size_t)t * 128 + (c - O_K)] = f2bf(v);
    } else if (c < O_P) VB[(size_t)t * 128 + (c - O_V)] = f2bf(v);
    else if (c < O_GA) U[(size_t)t * 512 + (c - O_P)] = f2bf(v);
    else if (c < O_GP) GA[(size_t)t * 1024 + (c - O_GA)] = f2bf(v);
    else GP[(size_t)t * 1024 + (c - O_GP)] = f2bf(v);
}
__global__ void __launch_bounds__(256) n_attn(const bf16* Q, const bf16* KB, const bf16* VB, const float* sinks, bf16* AO) {
    const int idx = blockIdx.x * blockDim.x + threadIdx.x; if (idx >= T * NQH) return;
    const int t = idx / NQH, hq = idx % NQH, hk = hq / 8, pos = t % SEQ, b0 = t - pos;
    float q[64];
#pragma unroll
    for (int d = 0; d < 64; ++d) q[d] = bf2f(Q[(size_t)t * 1024 + hq * 64 + d]);
    const int lo = pos - (WINDOW - 1) > 0 ? pos - (WINDOW - 1) : 0;
    const float sink = sinks[hq]; float m = sink;
    for (int s = lo; s <= pos; ++s) { float a = 0.f;
#pragma unroll
        for (int d = 0; d < 64; ++d) a += q[d] * bf2f(KB[(size_t)(b0 + s) * 128 + hk * 64 + d]);
        a *= 0.125f; m = fmaxf(m, a); }
    float sum = __expf(sink - m); float o[64];
#pragma unroll
    for (int d = 0; d < 64; ++d) o[d] = 0.f;
    for (int s = lo; s <= pos; ++s) { float a = 0.f;
#pragma unroll
        for (int d = 0; d < 64; ++d) a += q[d] * bf2f(KB[(size_t)(b0 + s) * 128 + hk * 64 + d]);
        const float p = __expf(a * 0.125f - m); sum += p; const float pb = bf2f(f2bf(p));
#pragma unroll
        for (int d = 0; d < 64; ++d) o[d] += pb * bf2f(VB[(size_t)(b0 + s) * 128 + hk * 64 + d]); }
    const float inv = 1.f / sum;
#pragma unroll
    for (int d = 0; d < 64; ++d) AO[(size_t)t * 1024 + hq * 64 + d] = f2bf(o[d] * inv);
}
__global__ void __launch_bounds__(256) n_pool(const bf16* U, bf16* PO) {
    const int idx = blockIdx.x * blockDim.x + threadIdx.x; if (idx >= T * PW) return;
    const int t = idx / PW, c = idx % PW, g = c / 128, w = 2 << g, pos = t % SEQ; const int cnt = pos + 1 < w ? pos + 1 : w; float s = 0.f;
    for (int j = 0; j < cnt; ++j) s += bf2f(U[(size_t)(t - j) * PW + c]);
    PO[idx] = f2bf(s / (float)cnt - bf2f(U[idx]));
}
__global__ void __launch_bounds__(256) n_merge(const float* C1, const float* C2, const bf16* GA, const bf16* GP, bf16* MG) {
    const size_t idx = (size_t)blockIdx.x * blockDim.x + threadIdx.x; if (idx >= (size_t)T * D) return;
    const float t1 = bf2f(f2bf(sigmoidf_(bf2f(GA[idx])) * C1[idx]));
    MG[idx] = f2bf(t1 + sigmoidf_(bf2f(GP[idx])) * C2[idx]);
}
__global__ void __launch_bounds__(256) n_x1(const float* x, const float* C, bf16* X1) {
    const size_t idx = (size_t)blockIdx.x * blockDim.x + threadIdx.x; if (idx >= (size_t)T * D) return;
    X1[idx] = f2bf(C[idx]); (void)x;
}
__global__ void __launch_bounds__(256) n_router(const float* x, const bf16* X1, const float* g2, const float* wr, const float* br, fp8* H2, unsigned* counts, int* stok, int* toke, float* tokg) {
    const int t = blockIdx.x * 4 + (threadIdx.x >> 6), lane = threadIdx.x & 63;
    const f32x4* xr = (const f32x4*)(x + (size_t)t * D) + lane; const bf16* dr = X1 + (size_t)t * D + 4 * lane; f32x4 v[4]; float s = 0.f;
#pragma unroll
    for (int j = 0; j < 4; ++j) { v[j] = xr[64 * j]; v[j].x += bf2f(dr[256 * j]); v[j].y += bf2f(dr[256 * j + 1]); v[j].z += bf2f(dr[256 * j + 2]); v[j].w += bf2f(dr[256 * j + 3]); s += v[j].x * v[j].x + v[j].y * v[j].y + v[j].z * v[j].z + v[j].w * v[j].w; }
    const float rstd = rsqrtf(wave_sum(s) * (1.f / D) + RMS_EPS);
    float h[16];
#pragma unroll
    for (int j = 0; j < 4; ++j) { const f32x4 gg = ((const f32x4*)g2)[lane + 64 * j];
        h[4 * j + 0] = v[j].x * rstd * gg.x; h[4 * j + 1] = v[j].y * rstd * gg.y; h[4 * j + 2] = v[j].z * rstd * gg.z; h[4 * j + 3] = v[j].w * rstd * gg.w;
        fp8* o = H2 + (size_t)t * D + 4 * lane + 256 * j;
#pragma unroll
        for (int q = 0; q < 4; ++q) o[q] = f2fp8(h[4 * j + q]); }
    float lg[32];
#pragma unroll
    for (int e = 0; e < 32; ++e) { float a = 0.f;
#pragma unroll
        for (int j = 0; j < 4; ++j)
#pragma unroll
            for (int q = 0; q < 4; ++q) a += h[4 * j + q] * wr[(size_t)(4 * lane + 256 * j + q) * 32 + e];
        lg[e] = wave_sum(a) + br[e]; }
    int be[4]; float bv[4]; unsigned used = 0u;
#pragma unroll
    for (int k = 0; k < 4; ++k) { float best = -3.0e38f; int bi = 0;
#pragma unroll
        for (int e = 0; e < 32; ++e) { const bool ok = !((used >> e) & 1u) && lg[e] > best; best = ok ? lg[e] : best; bi = ok ? e : bi; }
        be[k] = bi; bv[k] = best; used |= 1u << bi; }
    float ex[4], se = 0.f;
#pragma unroll
    for (int k = 0; k < 4; ++k) { ex[k] = __expf(bv[k] - bv[0]); se += ex[k]; }
    if (lane == 0) {
#pragma unroll
        for (int k = 0; k < 4; ++k) { const unsigned pos = atomicAdd(&counts[be[k]], 1u);
            stok[be[k] * CAP + pos] = t; toke[t * 4 + k] = be[k] | (int)(pos << 8); tokg[t * 4 + k] = ex[k] / se; }
    }
}
__device__ __forceinline__ int moe_rowoff(const unsigned* counts, int e) { int o = 0; for (int i = 0; i < e; ++i) o += (int)((counts[i] + 255u) >> 8) << 8; return o; }
__global__ void __launch_bounds__(256) n_moe_up(const fp8* H2, const int* stok, const unsigned* counts, const fp8* WupT, const float* bup, fp8* ACT) {
    const int e = blockIdx.z, cnt = (int)counts[e], m0 = blockIdx.y * 64, n0 = blockIdx.x * 64; if (m0 >= cnt) return;
    __shared__ float As[16][65], Bg[16][65], Bl[16][65]; __shared__ int rowtok[64];
    const int tx = threadIdx.x & 15, ty = threadIdx.x >> 4; const int roff = moe_rowoff(counts, e);
    if (threadIdx.x < 64) rowtok[threadIdx.x] = (m0 + (int)threadIdx.x < cnt) ? stok[e * CAP + m0 + threadIdx.x] : 0;
    __syncthreads();
    float ag[4][4], al[4][4];
#pragma unroll
    for (int i = 0; i < 4; ++i)
#pragma unroll
        for (int j = 0; j < 4; ++j) { ag[i][j] = 0.f; al[i][j] = 0.f; }
    const fp8* W = WupT + (size_t)e * 2048 * 1024;
    for (int k0 = 0; k0 < 1024; k0 += 16) {
        for (int i = threadIdx.x; i < 1024; i += 256) { const int r = i >> 4, c = i & 15; const int j = n0 + r, ng = (j >> 7) * 256 + (j & 127);
            As[c][r] = fp82f(H2[(size_t)rowtok[r] * 1024 + k0 + c]); Bg[c][r] = fp82f(W[(size_t)ng * 1024 + k0 + c]) * W8_INV; Bl[c][r] = fp82f(W[(size_t)(ng + 128) * 1024 + k0 + c]) * W8_INV; }
        __syncthreads();
#pragma unroll
        for (int kk = 0; kk < 16; ++kk) { float a[4], g[4], l[4];
#pragma unroll
            for (int i = 0; i < 4; ++i) { a[i] = As[kk][ty * 4 + i]; g[i] = Bg[kk][tx * 4 + i]; l[i] = Bl[kk][tx * 4 + i]; }
#pragma unroll
            for (int i = 0; i < 4; ++i)
#pragma unroll
                for (int j = 0; j < 4; ++j) { ag[i][j] += a[i] * g[j]; al[i][j] += a[i] * l[j]; } }
        __syncthreads();
    }
#pragma unroll
    for (int i = 0; i < 4; ++i) { const int m = m0 + ty * 4 + i; if (m >= cnt) continue;
#pragma unroll
        for (int j = 0; j < 4; ++j) { const int c = n0 + tx * 4 + j; float gl = ag[i][j] + bup[e * 2048 + c], li = al[i][j] + bup[e * 2048 + 1024 + c];
            gl = fminf(gl, 7.f); li = fminf(fmaxf(li, -7.f), 7.f);
            ACT[(size_t)(roff + m) * 1024 + c] = f2fp8(gl * sigmoidf_(1.702f * gl) * (li + 1.f)); } }
}
__global__ void __launch_bounds__(256) n_moe_down(const fp8* ACT, const unsigned* counts, const fp8* WdnT, const float* bdn, fp8* YS) {
    const int e = blockIdx.z, cnt = (int)counts[e], m0 = blockIdx.y * 64, n0 = blockIdx.x * 64; if (m0 >= cnt) return;
    __shared__ float As[16][65], Bs[16][65];
    const int tx = threadIdx.x & 15, ty = threadIdx.x >> 4; const int roff = moe_rowoff(counts, e);
    float acc[4][4];
#pragma unroll
    for (int i = 0; i < 4; ++i)
#pragma unroll
        for (int j = 0; j < 4; ++j) acc[i][j] = 0.f;
    const fp8* W = WdnT + (size_t)e * 1024 * 1024;
    for (int k0 = 0; k0 < 1024; k0 += 16) {
        for (int i = threadIdx.x; i < 1024; i += 256) { const int r = i >> 4, c = i & 15; const int m = (m0 + r < cnt) ? m0 + r : m0;
            As[c][r] = fp82f(ACT[(size_t)(roff + m) * 1024 + k0 + c]); Bs[c][r] = fp82f(W[(size_t)(n0 + r) * 1024 + k0 + c]) * W8_INV; }
        __syncthreads();
#pragma unroll
        for (int kk = 0; kk < 16; ++kk) { float a[4], b[4];
#pragma unroll
            for (int i = 0; i < 4; ++i) { a[i] = As[kk][ty * 4 + i]; b[i] = Bs[kk][tx * 4 + i]; }
#pragma unroll
            for (int i = 0; i < 4; ++i)
#pragma unroll
                for (int j = 0; j < 4; ++j) acc[i][j] += a[i] * b[j]; }
        __syncthreads();
    }
#pragma unroll
    for (int i = 0; i < 4; ++i) { const int m = m0 + ty * 4 + i; if (m >= cnt) continue;
#pragma unroll
        for (int j = 0; j < 4; ++j) { const int c = n0 + tx * 4 + j; YS[(size_t)(roff + m) * 1024 + c] = f2fp8(acc[i][j] + bdn[e * 1024 + c]); } }
}
__global__ void __launch_bounds__(256) n_combine(const float* x, const bf16* X1, const fp8* YS, const unsigned* counts, const int* toke, const float* tokg, const float* gf, float* out) {
    const int t = blockIdx.x * 4 + (threadIdx.x >> 6), lane = threadIdx.x & 63;
    f32x4 v[4];
#pragma unroll
    for (int j = 0; j < 4; ++j) { v[j] = ((const f32x4*)(x + (size_t)t * D))[lane + 64 * j]; const bf16* dp = X1 + (size_t)t * D + 4 * lane + 256 * j; v[j].x += bf2f(dp[0]); v[j].y += bf2f(dp[1]); v[j].z += bf2f(dp[2]); v[j].w += bf2f(dp[3]); }
    for (int k = 0; k < 4; ++k) { const int te = toke[t * 4 + k], e = te & 255, pos = te >> 8; const float g = tokg[t * 4 + k];
        const fp8* y = YS + (size_t)(moe_rowoff(counts, e) + pos) * 1024;
#pragma unroll
        for (int j = 0; j < 4; ++j) { const fp8* p = y + 4 * lane + 256 * j; v[j].x += g * fp82f(p[0]); v[j].y += g * fp82f(p[1]); v[j].z += g * fp82f(p[2]); v[j].w += g * fp82f(p[3]); } }
    float s = 0.f;
#pragma unroll
    for (int j = 0; j < 4; ++j) s += v[j].x * v[j].x + v[j].y * v[j].y + v[j].z * v[j].z + v[j].w * v[j].w;
    const float rstd = rsqrtf(wave_sum(s) * (1.f / D) + RMS_EPS);
#pragma unroll
    for (int j = 0; j < 4; ++j) { const f32x4 gg = ((const f32x4*)gf)[lane + 64 * j]; f32x4 o = v[j] * rstd * gg; ((f32x4*)(out + (size_t)t * D))[lane + 64 * j] = o; }
}

#define GAS __attribute__((address_space(1)))
#define LAS __attribute__((address_space(3)))
typedef short bf16x8 __attribute__((ext_vector_type(8)));
typedef float f32x16 __attribute__((ext_vector_type(16)));
typedef short s16x4 __attribute__((ext_vector_type(4)));
typedef float f32x2 __attribute__((ext_vector_type(2)));
typedef GAS unsigned gu32;
#define RLX_AGENT __ATOMIC_RELAXED, __HIP_MEMORY_SCOPE_AGENT
#define LDS_WAIT() asm volatile("s_waitcnt lgkmcnt(0)" ::: "memory")
#define VM_WAIT() asm volatile("s_waitcnt vmcnt(0)" ::: "memory")

constexpr int NWAVES = 8, NTHR = 512;
constexpr int RING_BYTES = 131072;
constexpr int HB_STRIDE = 4112, HB_BYTES = 32 * HB_STRIDE;
constexpr int TBL_OFF = 132096;
constexpr int RT_LOGIT = 133120, RT_TOKE = RT_LOGIT + 8448, RT_TOKR = RT_TOKE + 1024, RT_TOKG = RT_TOKR + 1024, RT_HIST = RT_TOKG + 1024, RT_BASE = RT_HIST + 128;
constexpr int BIAS_OFF = 133120;
constexpr int MISC_OFF = 145408;
constexpr int LDS_BYTES = 147456;
static_assert(RT_BASE + 128 <= MISC_OFF && HB_BYTES <= TBL_OFF && MISC_OFF + 128 <= LDS_BYTES, "LDS map");

__device__ __forceinline__ unsigned cvt_pk_bf16(float lo, float hi) { unsigned r; asm volatile("v_cvt_pk_bf16_f32 %0, %1, %2" : "=v"(r) : "v"(lo), "v"(hi)); return r; }
__device__ __forceinline__ float bflo(unsigned w) { return __uint_as_float(w << 16); }
__device__ __forceinline__ float bfhi(unsigned w) { return __uint_as_float(w & 0xffff0000u); }
__device__ __forceinline__ float ub8(unsigned w, int n) { return (float)((w >> (8 * n)) & 255u); }
__device__ __forceinline__ float fast_sigmoid(float v) { return __builtin_amdgcn_rcpf(1.0f + __builtin_amdgcn_exp2f(-1.44269504089f * v)); }
__device__ __forceinline__ float sigmoid_1702(float v) { return __builtin_amdgcn_rcpf(1.0f + __builtin_amdgcn_exp2f(-2.45546695959f * v)); }

#define XB_TMO      128
#define XB_XCNT(j)  (256  + 64 * (j))
#define XB_XSUB(j)  (1280 + 64 * (j))
#define XB_XGEN(j)  (2304 + 64 * (j))
#define XB_TOP      3328
#define XB_TOPGEN   3392
#define XCD_BAR_WORDS 3456
#define XB_SPIN_CAP (1u << 18)
__device__ __forceinline__ unsigned xb_ld(unsigned* p)              { return __hip_atomic_load(p, __ATOMIC_RELAXED, __HIP_MEMORY_SCOPE_AGENT); }
__device__ __forceinline__ unsigned xb_add(unsigned* p, unsigned v) { return __hip_atomic_fetch_add(p, v, __ATOMIC_RELAXED, __HIP_MEMORY_SCOPE_AGENT); }
__device__ __forceinline__ unsigned xb_xcc_id() { return (unsigned)__builtin_amdgcn_s_getreg((3 << 11) | 20) & 0xFu; }
#define XB_SPIN(cond, bar) do { unsigned _sp = 0; while (cond) { __builtin_amdgcn_s_sleep(1); \
    if ((++_sp & 255u) == 0u) { if (xb_ld(&(bar)[XB_TMO])) break; if (_sp > XB_SPIN_CAP) { atomicAdd(&(bar)[XB_TMO], 1u); break; } } } } while (0)
struct XcdBarrier { unsigned* bar; unsigned x; volatile LAS unsigned* st; };
__device__ __forceinline__ XcdBarrier xcd_barrier_post(unsigned* bar, volatile LAS unsigned* st) {
    XcdBarrier b; b.bar = bar; b.x = xb_xcc_id(); b.st = st;
    if (threadIdx.x == 0) (void)xb_add(&bar[XB_XCNT(b.x)], 1u);
    return b;
}
__device__ __forceinline__ void xcd_barrier_complete(unsigned* bar, unsigned x, unsigned& nloc, unsigned& nx) {
    const unsigned G = gridDim.x * gridDim.y * gridDim.z;
    unsigned sum, cnt, mine, sp = 0u;
    for (;;) {
        sum = 0u; cnt = 0u; mine = 0u;
#pragma unroll
        for (unsigned j = 0; j < 16; ++j) { const unsigned c = xb_ld(&bar[XB_XCNT(j)]); sum += c; cnt += (c > 0u) ? 1u : 0u; mine = (j == x) ? c : mine; }
        if (sum == G) break;
        __builtin_amdgcn_s_sleep(1);
        if ((++sp & 255u) == 0u) { if (xb_ld(&bar[XB_TMO])) break; if (sp > XB_SPIN_CAP) { atomicAdd(&bar[XB_TMO], 1u); break; } }
    }
    nloc = mine > 0u ? mine : 1u; nx = cnt > 0u ? cnt : 1u;
}
__device__ __forceinline__ void xcd_barrier(const XcdBarrier& b) {
    asm volatile("s_waitcnt vmcnt(0)" ::: "memory");
    __syncthreads();
    if (threadIdx.x == 0) {
        unsigned* bar = b.bar;
        __builtin_amdgcn_s_waitcnt(0);
        unsigned nloc = b.st[0], nx = b.st[1];
        if (nloc == 0u) { xcd_barrier_complete(bar, b.x, nloc, nx); b.st[0] = nloc; b.st[1] = nx; }
        const unsigned old = xb_add(&bar[XB_XSUB(b.x)], 1u);
        const unsigned gen = old / nloc;
        if (old + 1u == (gen + 1u) * nloc) {
            __builtin_amdgcn_fence(__ATOMIC_RELEASE, "agent");
            asm volatile("s_waitcnt vmcnt(0)" ::: "memory");
            const unsigned og = xb_add(&bar[XB_TOP], 1u);
            const unsigned tg = og / nx;
            if (og + 1u == (tg + 1u) * nx) xb_add(&bar[XB_TOPGEN], 1u);
            else XB_SPIN(xb_ld(&bar[XB_TOPGEN]) == tg, bar);
            __builtin_amdgcn_fence(__ATOMIC_ACQUIRE, "agent");
            xb_add(&bar[XB_XGEN(b.x)], 1u);
            asm volatile("s_waitcnt vmcnt(0)" ::: "memory");
        } else {
            XB_SPIN(xb_ld(&bar[XB_XGEN(b.x)]) == gen, bar);
            __builtin_amdgcn_fence(__ATOMIC_ACQUIRE, "agent");
            asm volatile("s_waitcnt vmcnt(0)" ::: "memory");
        }
        b.st[16] = b.st[16] + 1u;
    }
    __syncthreads();
}
__device__ __forceinline__ void xcd_barrier_arrive(const XcdBarrier& b) {
    asm volatile("s_waitcnt vmcnt(0)" ::: "memory");
    __syncthreads();
    if (threadIdx.x == 0) {
        unsigned* bar = b.bar;
        __builtin_amdgcn_s_waitcnt(0);
        unsigned nloc = b.st[0], nx = b.st[1];
        if (nloc == 0u) { xcd_barrier_complete(bar, b.x, nloc, nx); b.st[0] = nloc; b.st[1] = nx; }
        const unsigned old = xb_add(&bar[XB_XSUB(b.x)], 1u);
        const unsigned gen = old / nloc;
        unsigned role = 0u;
        if (old + 1u == (gen + 1u) * nloc) {
            role = 1u;
            __builtin_amdgcn_fence(__ATOMIC_RELEASE, "agent");
            asm volatile("s_waitcnt vmcnt(0)" ::: "memory");
            const unsigned og = xb_add(&bar[XB_TOP], 1u);
            const unsigned tg = og / nx;
            if (og + 1u == (tg + 1u) * nx) xb_add(&bar[XB_TOPGEN], 1u);
        }
        b.st[17] = role;
    }
}
__device__ __forceinline__ void xcd_barrier_wait(const XcdBarrier& b) {
    asm volatile("s_waitcnt vmcnt(0)" ::: "memory");
    __syncthreads();
    if (threadIdx.x == 0) {
        unsigned* bar = b.bar;
        const unsigned ord = b.st[16];
        XB_SPIN(xb_ld(&bar[XB_TOPGEN]) <= ord, bar);
        __builtin_amdgcn_fence(__ATOMIC_ACQUIRE, "agent");
        if (b.st[17] != 0u) xb_add(&bar[XB_XGEN(b.x)], 1u);
        asm volatile("s_waitcnt vmcnt(0)" ::: "memory");
        b.st[16] = ord + 1u;
    }
    __syncthreads();
}

__device__ __forceinline__ void panel_seam(unsigned* cnt, unsigned* bar) {
    asm volatile("s_waitcnt vmcnt(0)" ::: "memory");
    __syncthreads();
    if (threadIdx.x == 0) {
        (void)xb_add(cnt, 1u);
        XB_SPIN(xb_ld(cnt) < 4u, bar);
        __builtin_amdgcn_fence(__ATOMIC_ACQUIRE, "agent");
        asm volatile("s_waitcnt vmcnt(0)" ::: "memory");
    }
    __syncthreads();
}

__device__ __forceinline__ void panel_seam1(GAS unsigned* ctl, int g, int gp  , int gn  , unsigned* bar) {
    asm volatile("s_waitcnt vmcnt(0)" ::: "memory");
    __syncthreads();
    if (threadIdx.x == 0) {
        unsigned* cnt = (unsigned*)(ctl + CW_PGC + (64 * 3 + g) * 16);
        const unsigned mine = xb_ld((unsigned*)(ctl + CW_PGX + g));
        if (xb_add(cnt, 1u) == 3u && gn >= 0 && xb_ld((unsigned*)(ctl + CW_PGX + gn)) != mine) {
            __builtin_amdgcn_fence(__ATOMIC_RELEASE, "agent"); asm volatile("s_waitcnt vmcnt(0)" ::: "memory");
            (void)xb_add((unsigned*)(ctl + CW_PGF + 16 * g), 1u); }
        XB_SPIN(xb_ld(cnt) < 4u, bar);
        if (gp >= 0) { if (xb_ld((unsigned*)(ctl + CW_PGX + gp)) == mine) { unsigned* cp = (unsigned*)(ctl + CW_PGC + (64 * 3 + gp) * 16); XB_SPIN(xb_ld(cp) < 4u, bar); }
                       else { unsigned* fp = (unsigned*)(ctl + CW_PGF + 16 * gp); XB_SPIN(xb_ld(fp) < 1u, bar); } }
        __builtin_amdgcn_fence(__ATOMIC_ACQUIRE, "agent");
        asm volatile("s_waitcnt vmcnt(0)" ::: "memory");
    }
    __syncthreads();
}

namespace pg8 {
constexpr int BM = 256, BK = 64, HALF = 128, HTB = HALF * BK * 2, STAGE_BYTES = 8 * HTB, NXCD = 8, WGM = 8;
__host__ __device__ __forceinline__ int lds_byte(int r, int c) { const int st = (r >> 4) * 2 + (c >> 5), rr = r & 15, cc = c & 31, ob = rr * 64 + cc * 2; return st * 1024 + (ob ^ (((ob >> 9) & 1) << 5)); }
__host__ __device__ __forceinline__ void stage_rc(int b, int& R, int& C) { const int st = b / 1024, sb = b % 1024, swz = sb ^ (((sb >> 9) & 1) << 5); R = (st >> 1) * 16 + swz / 64; C = (st & 1) * 32 + (swz % 64) / 2; }
__host__ __device__ __forceinline__ int perm32(int rho) { const int n = rho >> 4, i = rho & 15; return 8 * (i >> 2) + 4 * n + (i & 3); }

struct GUnit { int row0, pn, e, grow, nvalid; };

struct DenseOrder {
    int nM, nN, nwg, G, c;
    __device__ void init(int M, int N, int G_, int c_) { nM = M / BM; nN = N / BM; nwg = nM * nN; G = G_; c = c_; }
    __device__ bool next(int i, GUnit& u) const {
        const long L = (long)i * G + c; if (L >= nwg) return false;
        int wgid = (int)L; { const int q = nwg / NXCD, r = nwg % NXCD, xcd = wgid % NXCD, off = wgid / NXCD; wgid = (xcd < r ? xcd * (q + 1) : r * (q + 1) + (xcd - r) * q) + off; }
        const int nig = WGM * nN, gid = wgid / nig, fm = gid * WGM, gsz = (nM - fm) < WGM ? (nM - fm) : WGM;
        u.row0 = (fm + ((wgid % nig) % gsz)) * BM; u.pn = (wgid % nig) / gsz; u.e = 0; u.grow = 0; u.nvalid = BM; return true;
    }
};
struct MoeOrder {
    const LAS int* ust; const LAS int* rowoff; const LAS int* cnt; int lognN, G, c;
    __device__ bool next(int i, GUnit& u) const {
        const int L = i * G + c; const int total = __builtin_amdgcn_readfirstlane(ust[32]); if (L >= total) return false;
        int e = 0;
#pragma unroll
        for (int j = 1; j < 32; ++j) e += (L >= __builtin_amdgcn_readfirstlane(ust[j])) ? 1 : 0;
        const int idx = L - __builtin_amdgcn_readfirstlane(ust[e]); const int r = idx >> lognN, pn = idx & ((1 << lognN) - 1);
        u.row0 = __builtin_amdgcn_readfirstlane(rowoff[e]) + BM * r; u.pn = pn; u.e = e; u.grow = e * CAP + BM * r; u.nvalid = __builtin_amdgcn_readfirstlane(cnt[e]) - BM * r; return true;
    }
};

template <bool VEC> struct MoeOrderX {
    const LAS int* rowoff; const LAS int* cnt; int lognN, G, c;
    __device__ bool next(int i, GUnit& u) const {
        int rem = i;
        for (int v = c; v < 256; v += G) {
            const int x8 = v & 7, j = v >> 3, e = x8 + 8 * (j >> 3), pn = (lognN == 3) ? (j & 7) : ((j & 7) >> 1), r0 = (lognN == 3) ? 0 : (j & 1), rs = (lognN == 3) ? 1 : 2;
            const int ce = __builtin_amdgcn_readfirstlane(cnt[e]), R = (ce + 255) >> 8, n = (R > r0) ? (R - r0 + rs - 1) / rs : 0;
            if (rem < n) { const int r = r0 + rem * rs; u.row0 = __builtin_amdgcn_readfirstlane(rowoff[e]) + BM * r; u.pn = pn; u.e = e; u.grow = e * CAP + BM * r; u.nvalid = ce - BM * r;
                if (VEC) { int ev = e; asm volatile("" : "+v"(ev)); u.e = ev; }
                return true; }
            rem -= n;
        }
        return false;
    }
};
struct MoeOrderOwn {
    const LAS int* rowoff; const LAS int* cnt; unsigned mx, mh; int G, c;
    __device__ bool next(int i, GUnit& u) const {
        int rem = i; const int ns = 8 * __builtin_popcount(mh);
        for (int v = c; v < 256; v += G) {
            const int x8 = v & 7, j = v >> 3, e = x8 + 8 * (j >> 3), jl = j & 7, pn = jl >> 1, rpar = jl & 1;
            const int ce = __builtin_amdgcn_readfirstlane(cnt[e]), R = (ce + 255) >> 8, n2 = R >> 1;
            const bool stolen = ((mx >> e) & 1u) && (4 * __builtin_popcount(mx & ((1u << e) - 1u)) + pn < ns);
            const int n = n2 + (((R & 1) && rpar == 0 && !stolen) ? 1 : 0);
            if (rem < n) { const int r = rem < n2 ? rpar + 2 * rem : R - 1; u.row0 = __builtin_amdgcn_readfirstlane(rowoff[e]) + BM * r; u.pn = pn; u.e = e; u.grow = e * CAP + BM * r; u.nvalid = ce - BM * r; return true; }
            rem -= n;
        }
        return false;
    }
};
struct MoeOrderSteal {
    const LAS int* rowoff; const LAS int* cnt; unsigned mx, mh; int G, c;
    __device__ bool next(int i, GUnit& u) const {
        int rem = i; const int nx = 4 * __builtin_popcount(mx);
        for (int v = c; v < 256; v += G) {
            const int x8 = v & 7, j = v >> 3, e = x8 + 8 * (j >> 3), jl = j & 7;
            if (!((mh >> e) & 1u)) continue;
            const int s = 8 * __builtin_popcount(mh & ((1u << e) - 1u)) + jl;
            if (s >= nx) continue;
            if (rem == 0) { unsigned m = mx; for (int q = 0; q < (s >> 2); ++q) m &= m - 1u;
                const int o = __builtin_ctz(m), pn = s & 3, ce = __builtin_amdgcn_readfirstlane(cnt[o]), r = ((ce + 255) >> 8) - 1;
                u.row0 = __builtin_amdgcn_readfirstlane(rowoff[o]) + BM * r; u.pn = pn; u.e = o; u.grow = o * CAP + BM * r; u.nvalid = ce - BM * r; return true; }
            --rem;
        }
        return false;
    }
};
__host__ __device__ __forceinline__ int sig8(int p) { return (p & 1) | (((p >> 2) & 1) * 6); }
typedef int v8i __attribute__((ext_vector_type(8)));
typedef int i32x4 __attribute__((ext_vector_type(4)));

template <class Epi, class Sched, int K, bool GATHER, bool F8>
__device__ __forceinline__ void gemm_phase(LAS unsigned char* lds, const void* A, const void* Bt, size_t bexp  , const Sched& S, const Epi& E, const int* gidx) {
    const int tid = threadIdx.x, wid = __builtin_amdgcn_readfirstlane(tid >> 6), lane = tid & 63, wr = wid >> 2, wc = wid & 3, fr = lane & 15, fq = lane >> 4;
    constexpr int ES = F8 ? 1 : 2, KB = K * ES, nt = KB / 128;
    static_assert(nt >= 4 && nt % 2 == 0, "K");
    int R0, C0b;
    if constexpr (F8) { R0 = tid >> 3; C0b = ((tid & 7) ^ sig8((R0 >> 1) & 7)) << 4; }
    else { int C0; stage_rc(tid * 16, R0, C0); C0b = C0 * 2; }
    unsigned voffA[2], voffB[2];
#pragma unroll
    for (int i = 0; i < 2; ++i) { const int R = R0 + 64 * i; const int Rb = Epi::PERM ? ((R & ~31) + perm32(R & 31)) : R;
        voffA[i] = (unsigned)(R * KB + C0b); voffB[i] = (unsigned)(Rb * KB + C0b); }
    constexpr size_t kstep = 128, hstep = (size_t)HALF * KB;
    const unsigned ldsw = (unsigned)wid * 1024u;
    int aoff, boff, aoff1 = 0, boff1 = 0;
    if constexpr (F8) { const int sg = sig8((fr >> 1) & 7);
        aoff = (wr * 64 + fr) * 128 + (((2 * fq) ^ sg) << 4); aoff1 = (wr * 64 + fr) * 128 + (((2 * fq + 1) ^ sg) << 4);
        boff = (wc * 32 + fr) * 128 + (((2 * fq) ^ sg) << 4); boff1 = (wc * 32 + fr) * 128 + (((2 * fq + 1) ^ sg) << 4); }
    else { aoff = lds_byte(wr * 64 + fr, fq * 8); boff = lds_byte(wc * 32 + fr, fq * 8); }
    unsigned gcur[2][2], gnxt[2][2];
#define PG8_LOADG(u_, g_) do { _Pragma("unroll") for (int _h = 0; _h < 2; ++_h) _Pragma("unroll") for (int _i = 0; _i < 2; ++_i) { const int _r = _h * HALF + R0 + 64 * _i; int _tok = 0; \
        if (_r < (u_).nvalid) _tok = gidx[(u_).grow + _r]; (g_)[_h][_i] = (unsigned)_tok * (unsigned)KB + (unsigned)C0b; } } while (0)
#define PG8_PING(g_) asm volatile("" : "+v"((g_)[0][0]), "+v"((g_)[0][1]), "+v"((g_)[1][0]), "+v"((g_)[1][1]))
#define PG8_SA(b, h) (((b) * 2 + (h)) * HTB)
#define PG8_SB(b, h) ((4 + (b) * 2 + (h)) * HTB)
#define PG8_STAGE(bufoff, rs, soff, voff) do { const int _so = GATHER ? (int)(soff) : __builtin_amdgcn_readfirstlane((int)(soff));        \
        _Pragma("unroll") for (int _i = 0; _i < 2; ++_i) \
        __builtin_amdgcn_raw_ptr_buffer_load_lds(rs, (LAS void*)(lds + (bufoff) + ldsw + _i * 8192), 16, (int)(voff)[_i], _so, 0, 0); } while (0)
#define PG8_STAGE_A(bufoff, h, nx, kb) do { if constexpr (GATHER) { _Pragma("unroll") for (int _i = 0; _i < 2; ++_i) { const unsigned _o = (nx) ? gnxt[h][_i] : gcur[h][_i]; \
            __builtin_amdgcn_raw_ptr_buffer_load_lds(rsA, (LAS void*)(lds + (bufoff) + ldsw + _i * 8192), 16, (int)_o, (int)(kb), 0, 0); } } \
        else { PG8_STAGE(bufoff, rsA, ((nx) ? nA : cA) + (unsigned)((h) * hstep) + (unsigned)(kb), voffA); } } while (0)
#define PG8_LDA(b, h) do { if constexpr (F8) { _Pragma("unroll") for (int m = 0; m < 4; ++m) { const i32x4 _l = *(const LAS i32x4*)(lds + PG8_SA(b, h) + aoff + m * 2048), _h2 = *(const LAS i32x4*)(lds + PG8_SA(b, h) + aoff1 + m * 2048); \
            At8[m] = __builtin_shufflevector(_l, _h2, 0, 1, 2, 3, 4, 5, 6, 7); } } \
        else { _Pragma("unroll") for (int m = 0; m < 4; ++m) _Pragma("unroll") for (int k = 0; k < 2; ++k) At[m][k] = *(const LAS bf16x8*)(lds + PG8_SA(b, h) + aoff + m * 2048 + k * 1024); } } while (0)
#define PG8_LDB(dst, dst8, b, h) do { if constexpr (F8) { _Pragma("unroll") for (int n = 0; n < 2; ++n) { const i32x4 _l = *(const LAS i32x4*)(lds + PG8_SB(b, h) + boff + n * 2048), _h2 = *(const LAS i32x4*)(lds + PG8_SB(b, h) + boff1 + n * 2048); \
            dst8[n] = __builtin_shufflevector(_l, _h2, 0, 1, 2, 3, 4, 5, 6, 7); } } \
        else { _Pragma("unroll") for (int n = 0; n < 2; ++n) _Pragma("unroll") for (int k = 0; k < 2; ++k) dst[n][k] = *(const LAS bf16x8*)(lds + PG8_SB(b, h) + boff + n * 2048 + k * 1024); } } while (0)
#define PG8_MMA(ai, bj, Bt_, Bt8_) do { __builtin_amdgcn_s_setprio(1); if constexpr (F8) { _Pragma("unroll") for (int m = 0; m < 4; ++m) _Pragma("unroll") for (int n = 0; n < 2; ++n) \
            acc[ai][bj][m][n] = __builtin_amdgcn_mfma_scale_f32_16x16x128_f8f6f4(Bt8_[n], At8[m], acc[ai][bj][m][n], 0, 0, 0, 0, 0, 0); } \
        else { _Pragma("unroll") for (int m = 0; m < 4; ++m) _Pragma("unroll") for (int n = 0; n < 2; ++n) _Pragma("unroll") for (int k = 0; k < 2; ++k) \
            acc[ai][bj][m][n] = __builtin_amdgcn_mfma_f32_16x16x32_bf16(Bt_[n][k], At[m][k], acc[ai][bj][m][n], 0, 0, 0); } __builtin_amdgcn_s_setprio(0); } while (0)
#define PG8_WAIT_V(n) asm volatile("s_waitcnt vmcnt(" #n ")" ::: "memory")
#define PG8_WAIT_L(n) asm volatile("s_waitcnt lgkmcnt(" #n ")" ::: "memory")
#define PG8_BAR __builtin_amdgcn_s_barrier()
#define PG8_SCHED __builtin_amdgcn_sched_barrier(0)
    GUnit cur, nxt, nn; int ui = 0;
    if (!S.next(0, cur)) return;
    bool has_next = S.next(1, nxt);
    f32x4 acc[2][2][4][2];
#pragma unroll
    for (int a = 0; a < 2; ++a)
#pragma unroll
        for (int b = 0; b < 2; ++b)
#pragma unroll
            for (int m = 0; m < 4; ++m)
#pragma unroll
                for (int n = 0; n < 2; ++n) acc[a][b][m][n] = (f32x4){0.f, 0.f, 0.f, 0.f};
    bf16x8 At[4][2], B0[2][2], B1[2][2]; v8i At8[4], B08[2], B18[2];
    const __amdgpu_buffer_rsrc_t rsA = __builtin_amdgcn_make_buffer_rsrc((void*)A, 0, 0x7fffffff, 0x00020000), rsB = __builtin_amdgcn_make_buffer_rsrc((void*)Bt, 0, 0x7fffffff, 0x00020000);
    unsigned cA = (unsigned)cur.row0 * (unsigned)KB;
    unsigned cB = (unsigned)(((size_t)cur.e * bexp + (size_t)cur.pn * BM * K) * ES);
    unsigned nA = cA, nB = cB;
    if constexpr (GATHER) {
        PG8_LOADG(cur, gcur);
        if (has_next) PG8_LOADG(nxt, gnxt); else { gnxt[0][0] = gcur[0][0]; gnxt[0][1] = gcur[0][1]; gnxt[1][0] = gcur[1][0]; gnxt[1][1] = gcur[1][1]; }
        PG8_PING(gcur); PG8_PING(gnxt);
    }
    PG8_STAGE(PG8_SB(0, 0), rsB, cB, voffB); PG8_STAGE(PG8_SB(0, 1), rsB, cB + (unsigned)hstep, voffB); PG8_STAGE_A(PG8_SA(0, 0), 0, false, 0u); PG8_STAGE_A(PG8_SA(0, 1), 1, false, 0u);
    if (wr == 1) PG8_BAR;
    PG8_WAIT_V(2); PG8_BAR;
    PG8_STAGE(PG8_SB(1, 0), rsB, cB + (unsigned)kstep, voffB); PG8_STAGE_A(PG8_SA(1, 0), 0, false, (unsigned)kstep); PG8_STAGE(PG8_SB(1, 1), rsB, cB + (unsigned)(hstep + kstep), voffB);
    PG8_WAIT_V(6); PG8_BAR;
    for (;;) {
        if (has_next) { nA = (unsigned)nxt.row0 * (unsigned)KB; nB = (unsigned)(((size_t)nxt.e * bexp + (size_t)nxt.pn * BM * K) * ES); } else { nA = cA; nB = cB; }
#define PG8_KBODY(LAST, T_) do { \
            const unsigned kb1 = (unsigned)((T_) + 1) * (unsigned)kstep, kb2 = (LAST) ? 0u : (unsigned)((T_) + 2) * (unsigned)kstep, kb3 = kb2 + (unsigned)kstep; \
            const unsigned b2 = ((LAST) ? nB : cB) + kb2, b3 = b2 + (unsigned)kstep; \
              \
            PG8_LDB(B0, B08, 0, 0); PG8_LDB(B1, B18, 0, 1); PG8_SCHED; PG8_LDA(0, 0); PG8_STAGE_A(PG8_SA(1, 1), 1, false, kb1); \
            PG8_WAIT_V(8); PG8_WAIT_L(0); PG8_BAR; PG8_MMA(0, 0, B0, B08); PG8_MMA(0, 1, B1, B18); PG8_BAR; PG8_SCHED; \
              \
            PG8_LDA(0, 1); PG8_STAGE(PG8_SB(0, 0), rsB, b2, voffB); PG8_STAGE(PG8_SB(0, 1), rsB, b2 + (unsigned)hstep, voffB); PG8_STAGE_A(PG8_SA(0, 0), 0, LAST, kb2); \
            PG8_WAIT_V(8); PG8_WAIT_L(0); PG8_BAR; PG8_MMA(1, 0, B0, B08); PG8_MMA(1, 1, B1, B18); PG8_BAR; PG8_SCHED; \
              \
            PG8_LDB(B0, B08, 1, 0); PG8_LDB(B1, B18, 1, 1); PG8_SCHED; PG8_LDA(1, 0); PG8_STAGE_A(PG8_SA(0, 1), 1, LAST, kb2); \
            PG8_WAIT_V(8); PG8_WAIT_L(0); PG8_BAR; PG8_MMA(0, 0, B0, B08); PG8_MMA(0, 1, B1, B18); PG8_BAR; PG8_SCHED; \
              \
            PG8_LDA(1, 1); PG8_STAGE(PG8_SB(1, 0), rsB, b3, voffB); PG8_STAGE(PG8_SB(1, 1), rsB, b3 + (unsigned)hstep, voffB); PG8_STAGE_A(PG8_SA(1, 0), 0, LAST, kb3); \
            PG8_WAIT_V(8); PG8_WAIT_L(0); PG8_BAR; PG8_MMA(1, 0, B0, B08); PG8_MMA(1, 1, B1, B18); PG8_BAR; PG8_SCHED; } while (0)
        bool has_nn = false; unsigned gnn[2][2]; int gtok[2][2] = {{0, 0}, {0, 0}};
#pragma unroll 1
        for (int t = 0; t < nt; t += 2) {
            const bool last = (t == nt - 2);
            if (last) {
                has_nn = has_next && S.next(ui + 2, nn);
                if constexpr (GATHER) { if (has_nn) {
#pragma unroll
                    for (int _h = 0; _h < 2; ++_h)
#pragma unroll
                        for (int _i = 0; _i < 2; ++_i) { const int _r = _h * HALF + R0 + 64 * _i; if (_r < nn.nvalid) gtok[_h][_i] = gidx[nn.grow + _r]; } } }
                if (wid == 0) E.stage(cur, lds + BIAS_OFF, lane);
            }
            PG8_KBODY(last, t);
        }
        if constexpr (GATHER) {
#pragma unroll
            for (int _h = 0; _h < 2; ++_h)
#pragma unroll
                for (int _i = 0; _i < 2; ++_i) gnn[_h][_i] = has_nn ? (unsigned)gtok[_h][_i] * (unsigned)KB + (unsigned)C0b : gnxt[_h][_i];
            PG8_PING(gnn);
        }
        if (wr == 0) PG8_BAR;
        E(acc, cur, wr, wc, fr, fq, (const LAS float*)(lds + BIAS_OFF));
        if (!has_next) break;
        { typedef float f32x2_t __attribute__((ext_vector_type(2))); f32x2_t z2 = {0.f, 0.f}; asm volatile("" : "+v"(z2));
#pragma unroll
        for (int a = 0; a < 2; ++a)
#pragma unroll
            for (int b = 0; b < 2; ++b)
#pragma unroll
                for (int m = 0; m < 4; ++m)
#pragma unroll
                    for (int n = 0; n < 2; ++n) { f32x2_t lo2, hi2; asm volatile("v_pk_mov_b32 %0, %1, %1" : "=v"(lo2) : "v"(z2)); asm volatile("v_pk_mov_b32 %0, %1, %1" : "=v"(hi2) : "v"(z2)); acc[a][b][m][n] = (f32x4){lo2.x, lo2.y, hi2.x, hi2.y}; } }
        cur = nxt; nxt = nn; has_next = has_nn; cA = nA; cB = nB; ++ui;
        if constexpr (GATHER) {
#pragma unroll
            for (int h = 0; h < 2; ++h)
#pragma unroll
                for (int i = 0; i < 2; ++i) { gcur[h][i] = gnxt[h][i]; gnxt[h][i] = gnn[h][i]; }
        }
        if (wr == 1) PG8_BAR;
    }
    PG8_WAIT_V(0);
    PG8_BAR;
    (void)At; (void)B0; (void)B1; (void)At8; (void)B08; (void)B18; (void)aoff1; (void)boff1;
#undef PG8_KBODY
#undef PG8_LOADG
#undef PG8_PING
#undef PG8_SA
#undef PG8_SB
#undef PG8_STAGE
#undef PG8_STAGE_A
#undef PG8_LDA
#undef PG8_LDB
#undef PG8_MMA
#undef PG8_WAIT_V
#undef PG8_WAIT_L
#undef PG8_BAR
#undef PG8_SCHED
}

typedef f32x4 Acc[2][2][4][2];
__device__ __forceinline__ u32x4 pack8(const f32x4 v0, const f32x4 v1) { u32x4 w; w.x = cvt_pk_bf16(v0[0], v0[1]); w.y = cvt_pk_bf16(v0[2], v0[3]); w.z = cvt_pk_bf16(v1[0], v1[1]); w.w = cvt_pk_bf16(v1[2], v1[3]); return w; }

struct EpiInProj {
    static constexpr bool PERM = true;
    const float* bias; const float* cs; bf16 *Q, *KB, *VB, *U, *GA, *GP;
    __device__ __forceinline__ void stage(const GUnit& u, LAS unsigned char* slot, int lane) const {
        const __amdgpu_buffer_rsrc_t rs = __builtin_amdgcn_make_buffer_rsrc((void*)bias, 0, 0x7fffffff, 0x00020000);
        __builtin_amdgcn_raw_ptr_buffer_load_lds(rs, (LAS void*)slot, 16, lane * 16, u.pn * 1024, 0, 0); }
    __device__ __forceinline__ void operator()(const Acc& acc, const GUnit& u, int wr, int wc, int fr, int fq, const LAS float* bl) const {
        const int pn = u.pn; const bool rw = (wc & 1) == 0;
        bf16 *d0, *d1; int c0, pitch; bool rp0, rp1, nt;
        if (pn < 4) { d0 = d1 = Q; c0 = pn * 256; pitch = 1024; rp0 = rp1 = rw; nt = false; }
        else if (pn == 4) { d0 = KB; d1 = VB - 128; c0 = 0; pitch = 128; rp0 = rw; rp1 = false; nt = false; }
        else if (pn < 7) { d0 = d1 = U; c0 = (pn - 5) * 256; pitch = 512; rp0 = rp1 = false; nt = false; }
        else if (pn < 11) { d0 = d1 = GA; c0 = (pn - 7) * 256; pitch = 1024; rp0 = rp1 = false; nt = true; }
        else { d0 = d1 = GP; c0 = (pn - 11) * 256; pitch = 1024; rp0 = rp1 = false; nt = true; }
        const int rowl = wr * 64 + fr;
        const __amdgpu_buffer_rsrc_t r0 = __builtin_amdgcn_make_buffer_rsrc((void*)(d0 + (size_t)u.row0 * (nt ? pitch / 2 : pitch)), 0, 0x7fffffff, 0x00020000);
        const __amdgpu_buffer_rsrc_t r1 = __builtin_amdgcn_make_buffer_rsrc((void*)(d1 + (size_t)u.row0 * pitch), 0, 0x7fffffff, 0x00020000);
        const int vo = (rowl * pitch + c0 + wc * 32 + 8 * fq) * 2;
        f32x4 bb[2][2];
#pragma unroll
        for (int bj = 0; bj < 2; ++bj) { bb[bj][0] = *(const LAS f32x4*)(bl + bj * 128 + wc * 32 + 8 * fq); bb[bj][1] = *(const LAS f32x4*)(bl + bj * 128 + wc * 32 + 8 * fq + 4); }
        const float sg = (fq == 0) ? -1.f : 1.f;
        const int rstep = pitch * 32;
#pragma unroll
        for (int am = 0; am < 8; am += 2) {
            f32x4 csr[2][4];
            if (rp0) {
#pragma unroll
                for (int mm = 0; mm < 2; ++mm)
#pragma unroll
                    for (int q = 0; q < 4; ++q) csr[mm][q] = *(const f32x4*)(cs + (size_t)(u.row0 + rowl + ((am + mm) >> 2) * 128 + ((am + mm) & 3) * 16) * 16 + 4 * q);
            }
#pragma unroll
            for (int mm = 0; mm < 2; ++mm)
#pragma unroll
                for (int bj = 0; bj < 2; ++bj) { const int ai = (am + mm) >> 2, m = (am + mm) & 3;
                    f32x4 v0 = acc[ai][bj][m][0] + bb[bj][0], v1 = acc[ai][bj][m][1] + bb[bj][1];
                    if (bj == 0 ? rp0 : rp1) {
                        f32x4 o0, o1;
#pragma unroll
                        for (int j = 0; j < 4; ++j) { o0[j] = __shfl_xor(v0[j], 16); o1[j] = __shfl_xor(v1[j], 16); }
                        const f32x4 q0 = v0 * csr[mm][0] + (o0 * csr[mm][2]) * sg, q1 = v1 * csr[mm][1] + (o1 * csr[mm][3]) * sg;
                        if (fq < 2) { v0 = q0; v1 = q1; } }
                    const int so = (ai * 8 + m) * rstep;
                    if (nt) {
                        unsigned lo, hi2;
#define Q8(x_) ((unsigned)(fast_sigmoid(x_) * 255.f + 0.5f))
                        lo = Q8(v0[0]) | (Q8(v0[1]) << 8) | (Q8(v0[2]) << 16) | (Q8(v0[3]) << 24);
                        hi2 = Q8(v1[0]) | (Q8(v1[1]) << 8) | (Q8(v1[2]) << 16) | (Q8(v1[3]) << 24);
#undef Q8
                        const u32x2 w8 = {lo, hi2};
                        __builtin_amdgcn_raw_buffer_store_b64(w8, r0, (vo >> 1) + bj * 128, so >> 1, 0);
                    } else { const u32x4 w = pack8(v0, v1); __builtin_amdgcn_raw_buffer_store_b128(w, bj == 0 ? r0 : r1, vo + bj * 256, so, 0); }
                }
        }
    }
};
struct EpiGateA {
    static constexpr bool PERM = true;
    const bf16* GA; bf16* T1;
    __device__ __forceinline__ void stage(const GUnit&, LAS unsigned char*, int) const {}
    __device__ __forceinline__ void operator()(const Acc& acc, const GUnit& u, int wr, int wc, int fr, int fq, const LAS float*) const {
        const int row0 = u.row0 + wr * 64 + fr;
        u32x2 gg[16];
        const unsigned char* G8 = (const unsigned char*)GA;
#pragma unroll
        for (int ai = 0; ai < 2; ++ai)
#pragma unroll
            for (int m = 0; m < 4; ++m)
#pragma unroll
                for (int bj = 0; bj < 2; ++bj) gg[(ai * 4 + m) * 2 + bj] = *(const u32x2*)(G8 + (size_t)(row0 + ai * 128 + m * 16) * 1024 + u.pn * 256 + bj * 128 + wc * 32 + 8 * fq);
#pragma unroll
        for (int ai = 0; ai < 2; ++ai)
#pragma unroll
            for (int m = 0; m < 4; ++m)
#pragma unroll
                for (int bj = 0; bj < 2; ++bj) { const size_t off = (size_t)(row0 + ai * 128 + m * 16) * 1024 + u.pn * 256 + bj * 128 + wc * 32 + 8 * fq;
                    const u32x2 g = gg[(ai * 4 + m) * 2 + bj]; f32x4 v0 = acc[ai][bj][m][0], v1 = acc[ai][bj][m][1]; constexpr float K8 = 1.0f / 255.0f;
                    v0[0] *= ub8(g.x, 0) * K8; v0[1] *= ub8(g.x, 1) * K8; v0[2] *= ub8(g.x, 2) * K8; v0[3] *= ub8(g.x, 3) * K8;
                    v1[0] *= ub8(g.y, 0) * K8; v1[1] *= ub8(g.y, 1) * K8; v1[2] *= ub8(g.y, 2) * K8; v1[3] *= ub8(g.y, 3) * K8;
                    *(u32x4*)(T1 + off) = pack8(v0, v1); }
    }
};
struct EpiMerge {
    static constexpr bool PERM = true;
    const bf16* GP; const bf16* T1; bf16* MG;
    __device__ __forceinline__ void stage(const GUnit&, LAS unsigned char*, int) const {}
    __device__ __forceinline__ void operator()(const Acc& acc, const GUnit& u, int wr, int wc, int fr, int fq, const LAS float*) const {
        const int row0 = u.row0 + wr * 64 + fr;
#pragma unroll
        for (int ai = 0; ai < 2; ++ai) {
            u32x2 gg[8]; u32x4 tt[8];
            const unsigned char* G8 = (const unsigned char*)GP;
#pragma unroll
            for (int m = 0; m < 4; ++m)
#pragma unroll
                for (int bj = 0; bj < 2; ++bj) { const size_t off = (size_t)(row0 + ai * 128 + m * 16) * 1024 + u.pn * 256 + bj * 128 + wc * 32 + 8 * fq;
                    gg[m * 2 + bj] = *(const u32x2*)(G8 + off); tt[m * 2 + bj] = *(const u32x4*)(T1 + off); }
#pragma unroll
            for (int m = 0; m < 4; ++m)
#pragma unroll
                for (int bj = 0; bj < 2; ++bj) { const size_t off = (size_t)(row0 + ai * 128 + m * 16) * 1024 + u.pn * 256 + bj * 128 + wc * 32 + 8 * fq;
                    const u32x2 g = gg[m * 2 + bj]; const u32x4 t = tt[m * 2 + bj]; f32x4 v0 = acc[ai][bj][m][0], v1 = acc[ai][bj][m][1]; constexpr float K8 = 1.0f / 255.0f;
                    v0[0] = v0[0] * (ub8(g.x, 0) * K8) + bflo(t.x); v0[1] = v0[1] * (ub8(g.x, 1) * K8) + bfhi(t.x); v0[2] = v0[2] * (ub8(g.x, 2) * K8) + bflo(t.y); v0[3] = v0[3] * (ub8(g.x, 3) * K8) + bfhi(t.y);
                    v1[0] = v1[0] * (ub8(g.y, 0) * K8) + bflo(t.z); v1[1] = v1[1] * (ub8(g.y, 1) * K8) + bfhi(t.z); v1[2] = v1[2] * (ub8(g.y, 2) * K8) + bflo(t.w); v1[3] = v1[3] * (ub8(g.y, 3) * K8) + bfhi(t.w);
                    *(u32x4*)(MG + off) = pack8(v0, v1); }
        }
    }
};
struct EpiX1 {
    static constexpr bool PERM = true;
    bf16* X1;
    __device__ __forceinline__ void stage(const GUnit&, LAS unsigned char*, int) const {}
    __device__ __forceinline__ void operator()(const Acc& acc, const GUnit& u, int wr, int wc, int fr, int fq, const LAS float*) const {
        const int row0 = u.row0 + wr * 64 + fr;
#pragma unroll
        for (int ai = 0; ai < 2; ++ai)
#pragma unroll
            for (int m = 0; m < 4; ++m)
#pragma unroll
                for (int bj = 0; bj < 2; ++bj) *(u32x4*)(X1 + (size_t)(row0 + ai * 128 + m * 16) * 1024 + u.pn * 256 + bj * 128 + wc * 32 + 8 * fq) = pack8(acc[ai][bj][m][0], acc[ai][bj][m][1]);
    }
};
struct EpiSwiglu {
    static constexpr bool PERM = true;
    const float* bup; fp8* ACT;
    __device__ __forceinline__ void stage(const GUnit& u, LAS unsigned char* slot, int lane) const {
        const __amdgpu_buffer_rsrc_t rs = __builtin_amdgcn_make_buffer_rsrc((void*)bup, 0, 0x7fffffff, 0x00020000);
        __builtin_amdgcn_raw_ptr_buffer_load_lds(rs, (LAS void*)slot, 16, (lane & 31) * 16 + (lane >> 5) * 4096, (u.e * 2048 + u.pn * 128) * 4, 0, 0); }
    __device__ __forceinline__ void operator()(const Acc& acc, const GUnit& u, int wr, int wc, int fr, int fq, const LAS float* bl) const {
        const int row0 = u.row0 + wr * 64 + fr, col = u.pn * 128 + wc * 32 + 8 * fq;
        const LAS float* bg = bl + wc * 32 + 8 * fq;
        const f32x4 g0 = *(const LAS f32x4*)bg, g1 = *(const LAS f32x4*)(bg + 4), l0 = *(const LAS f32x4*)(bg + 128), l1 = *(const LAS f32x4*)(bg + 132);
        f32x2 S2 = {W8_INV, W8_INV}, K2 = {-2.45546695959f, -2.45546695959f}, O2 = {1.f, 1.f};
        asm volatile("" : "+v"(S2), "+v"(K2), "+v"(O2));
#define SWG2(ACC_G, ACC_L, BG, BL, OUT, H) do { \
            const f32x2 xa = __builtin_shufflevector(ACC_G, ACC_G, 2 * (H), 2 * (H) + 1), xc = __builtin_shufflevector(ACC_L, ACC_L, 2 * (H), 2 * (H) + 1); \
            const f32x2 A_ = xa * S2 + __builtin_shufflevector(BG, BG, 2 * (H), 2 * (H) + 1), C_ = xc * S2 + __builtin_shufflevector(BL, BL, 2 * (H), 2 * (H) + 1); \
            const f32x2 ga = {fminf(A_.x, 7.f), fminf(A_.y, 7.f)}, la = {fminf(fmaxf(C_.x, -7.f), 7.f), fminf(fmaxf(C_.y, -7.f), 7.f)}; \
            const f32x2 t_ = ga * K2; const f32x2 e_ = {__builtin_amdgcn_exp2f(t_.x), __builtin_amdgcn_exp2f(t_.y)}; \
            const f32x2 d_ = e_ + O2; const f32x2 r_ = {__builtin_amdgcn_rcpf(d_.x), __builtin_amdgcn_rcpf(d_.y)}; \
            const f32x2 p_ = ga * r_; const f32x2 o_ = p_ * la + p_; OUT[2 * (H)] = o_.x; OUT[2 * (H) + 1] = o_.y; } while (0)
#pragma unroll
        for (int ai = 0; ai < 2; ++ai)
#pragma unroll
            for (int m = 0; m < 4; ++m) {
                f32x4 r0, r1;
                SWG2(acc[ai][0][m][0], acc[ai][1][m][0], g0, l0, r0, 0); SWG2(acc[ai][0][m][0], acc[ai][1][m][0], g0, l0, r0, 1);
                SWG2(acc[ai][0][m][1], acc[ai][1][m][1], g1, l1, r1, 0); SWG2(acc[ai][0][m][1], acc[ai][1][m][1], g1, l1, r1, 1);
                int w0 = 0, w1 = 0;
                w0 = __builtin_amdgcn_cvt_pk_fp8_f32(r0[0], r0[1], w0, false); w0 = __builtin_amdgcn_cvt_pk_fp8_f32(r0[2], r0[3], w0, true);
                w1 = __builtin_amdgcn_cvt_pk_fp8_f32(r1[0], r1[1], w1, false); w1 = __builtin_amdgcn_cvt_pk_fp8_f32(r1[2], r1[3], w1, true);
                u32x2 w; w.x = (unsigned)w0; w.y = (unsigned)w1;
                *(u32x2*)(ACT + (size_t)(row0 + ai * 128 + m * 16) * 1024 + col) = w;
            }
#undef SWG2
    }
};
struct EpiDown {
    static constexpr bool PERM = true;
    const float* bdn; fp8* YS;
    __device__ __forceinline__ void stage(const GUnit& u, LAS unsigned char* slot, int lane) const {
        const __amdgpu_buffer_rsrc_t rs = __builtin_amdgcn_make_buffer_rsrc((void*)bdn, 0, 0x7fffffff, 0x00020000);
        __builtin_amdgcn_raw_ptr_buffer_load_lds(rs, (LAS void*)slot, 16, lane * 16, (u.e * 1024 + u.pn * 256) * 4, 0, 0); }
    __device__ __forceinline__ void operator()(const Acc& acc, const GUnit& u, int wr, int wc, int fr, int fq, const LAS float* bl) const {
        const int row0 = u.row0 + wr * 64 + fr;
#pragma unroll
        for (int bj = 0; bj < 2; ++bj) { const int col = u.pn * 256 + bj * 128 + wc * 32 + 8 * fq;
            const f32x4 b0 = *(const LAS f32x4*)(bl + bj * 128 + wc * 32 + 8 * fq), b1 = *(const LAS f32x4*)(bl + bj * 128 + wc * 32 + 8 * fq + 4);
#pragma unroll
            for (int ai = 0; ai < 2; ++ai)
#pragma unroll
                for (int m = 0; m < 4; ++m) { const f32x4 r0 = acc[ai][bj][m][0] * W8_INV + b0, r1 = acc[ai][bj][m][1] * W8_INV + b1; int w0 = 0, w1 = 0;
                    w0 = __builtin_amdgcn_cvt_pk_fp8_f32(r0[0], r0[1], w0, false); w0 = __builtin_amdgcn_cvt_pk_fp8_f32(r0[2], r0[3], w0, true);
                    w1 = __builtin_amdgcn_cvt_pk_fp8_f32(r1[0], r1[1], w1, false); w1 = __builtin_amdgcn_cvt_pk_fp8_f32(r1[2], r1[3], w1, true);
                    u32x2 w; w.x = (unsigned)w0; w.y = (unsigned)w1; *(u32x2*)(YS + (size_t)(row0 + ai * 128 + m * 16) * 1024 + col) = w; } }
    }
};
}

struct Args { const float* in[19]; float* out; unsigned char* ws; int ph_lo, ph_hi, li, pad; };
struct Frame {
    LAS unsigned char* lds; int tid, lane, wave, G, bx;
    unsigned char* ws; gu32* ctl;
};

__device__ __forceinline__ void conv_item(const float* W, int N, bf16* WT, int K, int k0, int n_src0, int n_dst0, int lane, LAS unsigned char* scr) {
    const int hw = lane >> 5, l5 = lane & 31;
    const float* src = W + (size_t)(k0 + 16 * hw) * N + n_src0 + 4 * l5;
#pragma unroll
    for (int half = 0; half < 2; ++half) {
        f32x4 v[16];
#pragma unroll
        for (int j = 0; j < 16; ++j) v[j] = *(const f32x4*)(src + (size_t)(32 * half + j) * N);
#pragma unroll
        for (int q = 0; q < 4; ++q) { const int row = 4 * l5 + q;
#pragma unroll
            for (int cc = 0; cc < 2; ++cc) { u32x4 w; w.x = cvt_pk_bf16(v[8 * cc + 0][q], v[8 * cc + 1][q]); w.y = cvt_pk_bf16(v[8 * cc + 2][q], v[8 * cc + 3][q]);
                w.z = cvt_pk_bf16(v[8 * cc + 4][q], v[8 * cc + 5][q]); w.w = cvt_pk_bf16(v[8 * cc + 6][q], v[8 * cc + 7][q]);
                const int c = 4 * half + 2 * hw + cc;
                *(LAS u32x4*)(scr + row * 128 + ((c ^ (l5 & 7)) << 4)) = w; } }
    }
    LDS_WAIT(); asm volatile("" ::: "memory");
    bf16* dst = WT + (size_t)(n_dst0 + (lane >> 3)) * K + k0 + 8 * (lane & 7);
#pragma unroll
    for (int i = 0; i < 16; ++i) { const int n = 8 * i + (lane >> 3), c = lane & 7;
        const u32x4 w = *(const LAS u32x4*)(scr + n * 128 + ((c ^ ((n >> 2) & 7)) << 4));
        *(u32x4*)(dst + (size_t)(8 * i) * K) = w; }
    LDS_WAIT(); asm volatile("" ::: "memory");
}
__device__ __forceinline__ int pk4_fp8(float a, float b, float c, float d) { int w = 0; w = __builtin_amdgcn_cvt_pk_fp8_f32(a * W8_SCALE, b * W8_SCALE, w, false); w = __builtin_amdgcn_cvt_pk_fp8_f32(c * W8_SCALE, d * W8_SCALE, w, true); return w; }
template <int UNR, bool NTS = true> __device__ __forceinline__ void conv_item8(const float* W, int N, fp8* WT, int K, int k0, int n_src0, int n_dst0, int lane, LAS unsigned char* scr) {
    const int hw = lane >> 5, l5 = lane & 31;
    const float* src = W + (size_t)(k0 + 16 * hw) * N + n_src0 + 4 * l5;
#pragma unroll UNR
    for (int qt = 0; qt < 4; ++qt) {
        f32x4 v[16];
#pragma unroll
        for (int j = 0; j < 16; ++j) v[j] = __builtin_nontemporal_load((const f32x4*)(src + (size_t)(32 * qt + j) * N));
#pragma unroll
        for (int q = 0; q < 4; ++q) { const int row = 4 * l5 + q; u32x4 w;
            w.x = (unsigned)pk4_fp8(v[0][q], v[1][q], v[2][q], v[3][q]); w.y = (unsigned)pk4_fp8(v[4][q], v[5][q], v[6][q], v[7][q]);
            w.z = (unsigned)pk4_fp8(v[8][q], v[9][q], v[10][q], v[11][q]); w.w = (unsigned)pk4_fp8(v[12][q], v[13][q], v[14][q], v[15][q]);
            const int c = 2 * qt + hw;
            *(LAS u32x4*)(scr + row * 128 + ((c ^ (l5 & 7)) << 4)) = w; }
    }
    LDS_WAIT(); asm volatile("" ::: "memory");
    fp8* dst = WT + (size_t)(n_dst0 + (lane >> 3)) * K + k0 + 16 * (lane & 7);
#pragma unroll
    for (int i = 0; i < 16; ++i) { const int n = 8 * i + (lane >> 3), c = lane & 7;
        const u32x4 w = *(const LAS u32x4*)(scr + n * 128 + ((c ^ ((n >> 2) & 7)) << 4));
        if constexpr (NTS) __builtin_nontemporal_store(w, (u32x4*)(dst + (size_t)(8 * i) * K)); else *(u32x4*)(dst + (size_t)(8 * i) * K) = w; }
    LDS_WAIT(); asm volatile("" ::: "memory");
}
__device__ __forceinline__ void p0b_weights(const Frame& F, const Args& a, int widx, int nw) {
    const int gw = widx * NWAVES + F.wave, NGW = nw * NWAVES, lane = F.lane;
    unsigned char* ws = F.ws;
    bf16* WATT = (bf16*)(ws + WS_WATT); bf16* WEFF = (bf16*)(ws + WS_WEFF); bf16* WOUT = (bf16*)(ws + WS_WOUT);
    LAS unsigned char* scr = F.lds + F.wave * 16384;
    fp8* WUP8 = (fp8*)(ws + WS_WUP);
    constexpr int I_UP = 32 * 8 * 16, I_AT = 16 * 8, I_OUT = 16 * 8;
    for (int it = (gw + NGW - (480 % NGW)) % NGW; it < I_AT + I_OUT; it += NGW) {
        int r = it;
        if (r < I_AT) { const int kb = r >> 3, nb = r & 7; conv_item(a.in[6], 1024, WATT, 1024, kb * 64, nb * 128, nb * 128, lane, scr); continue; } r -= I_AT;
        { const int kb = r >> 3, nb = r & 7; conv_item(a.in[10], 1024, WOUT, 1024, kb * 64, nb * 128, nb * 128, lane, scr); }
    }
    for (int it = NGW - 1 - gw; it < 64 * 16; it += NGW) {
        const int k0 = (it >> 4) * 8, n0 = (it & 15) * 64, g = k0 >> 7, kk0 = k0 & 127;
        const float* pw = a.in[7] + (size_t)(g * 128 + kk0) * 128; const float* ps = a.in[8] + g * 128; const float* wp = a.in[9] + (size_t)(g * 128) * 1024 + n0 + lane;
        float acc8[8];
#pragma unroll
        for (int q = 0; q < 8; ++q) acc8[q] = 0.f;
#pragma unroll 16
        for (int c = 0; c < 128; ++c) { const float wv = wp[(size_t)c * 1024] * ps[c];
#pragma unroll
            for (int q = 0; q < 8; ++q) acc8[q] += pw[q * 128 + c] * wv; }
        u32x4 w; w.x = cvt_pk_bf16(acc8[0], acc8[1]); w.y = cvt_pk_bf16(acc8[2], acc8[3]); w.z = cvt_pk_bf16(acc8[4], acc8[5]); w.w = cvt_pk_bf16(acc8[6], acc8[7]);
        *(u32x4*)(WEFF + (size_t)(n0 + lane) * 512 + k0) = w;
    }
}
__device__ __forceinline__ void p0_prologue_w(const Frame& F, const Args& a) {
    const int gw = F.bx * NWAVES + F.wave, NGW = F.G * NWAVES, lane = F.lane;
    unsigned char* ws = F.ws;
    bf16* WIN = (bf16*)(ws + WS_WIN); float* CS = (float*)(ws + WS_CS); bf16* H = (bf16*)(ws + WS_H);
    LAS unsigned char* scr = F.lds + F.wave * 16384;
    for (int it = gw; it < 16 * 30; it += NGW) { const int kb = it / 30, nb = it % 30; conv_item(a.in[3], INW, WIN, 1024, kb * 64, nb * 128, nb * 128, lane, scr); }
    { const float* wr = a.in[12]; bf16* WRH = (bf16*)(ws + WS_WRH); bf16* WRL = (bf16*)(ws + WS_WRL);
      for (int idx = gw * 64 + lane; idx < 32 * 1024; idx += NGW * 64) { const int e = idx >> 10, k = idx & 1023; const float w = wr[k * 32 + e]; const unsigned h = cvt_pk_bf16(w, 0.f) & 0xffffu;
          WRH[idx] = (bf16)h; WRL[idx] = (bf16)(cvt_pk_bf16(w - __uint_as_float(h << 16), 0.f) & 0xffffu); } }
}
__device__ __forceinline__ void p0_rows(const Frame& F, const Args& a, int own) {
    const int gw = F.bx * NWAVES + F.wave, NGW = F.G * NWAVES, lane = F.lane;
    unsigned char* ws = F.ws;
    float* CS = (float*)(ws + WS_CS); bf16* H = (bf16*)(ws + WS_H);
    { const int* pos = (const int*)a.in[1];
      const int i0 = own < 0 ? gw * 64 + lane : own * 512 + (int)F.tid, i1 = own < 0 ? T * 8 : own * 512 + 512, is = own < 0 ? NGW * 64 : 512;
      for (int idx = i0; idx < i1; idx += is) { const int t = idx >> 3, i = idx & 7; const float inv = powf(500000.0f, -(float)i * 0.125f); const float an = (float)pos[t] * inv;
          CS[t * 16 + i] = cosf(an); CS[t * 16 + 8 + i] = sinf(an); } }
    { const float* x = a.in[0]; const float* g1 = a.in[2];
      f32x4 gg[4];
#pragma unroll
      for (int j = 0; j < 4; ++j) gg[j] = ((const f32x4*)g1)[lane + 64 * j];
      const int r0 = own < 0 ? gw : own * 64 + F.wave * 8, r1 = own < 0 ? T : own * 64 + F.wave * 8 + 8, rs = own < 0 ? 2 * NGW : 2, r2o = own < 0 ? NGW : 1;
      for (int row = r0; row < r1; row += rs) {
          const int row2 = row + r2o;
          const f32x4* xr = (const f32x4*)(x + (size_t)row * D) + lane; const f32x4* xr2 = (const f32x4*)(x + (size_t)(row2 < r1 || own < 0 ? (row2 < T ? row2 : row) : row) * D) + lane; f32x4 v[4], v2[4]; float s = 0.f, s2 = 0.f;
#pragma unroll
          for (int j = 0; j < 4; ++j) { v[j] = __builtin_nontemporal_load(xr + 64 * j); v2[j] = __builtin_nontemporal_load(xr2 + 64 * j); }
#pragma unroll
          for (int j = 0; j < 4; ++j) { s += v[j].x * v[j].x + v[j].y * v[j].y + v[j].z * v[j].z + v[j].w * v[j].w; s2 += v2[j].x * v2[j].x + v2[j].y * v2[j].y + v2[j].z * v2[j].z + v2[j].w * v2[j].w; }
          const float rstd = rsqrtf(wave_sum(s) * (1.f / D) + RMS_EPS), rstd2 = rsqrtf(wave_sum(s2) * (1.f / D) + RMS_EPS);
#pragma unroll
          for (int j = 0; j < 4; ++j) { const f32x4 o = v[j] * rstd * gg[j]; u32x2 w; w.x = cvt_pk_bf16(o[0], o[1]); w.y = cvt_pk_bf16(o[2], o[3]); *(u32x2*)(H + (size_t)row * D + 4 * lane + 256 * j) = w; }
          if (row2 < T) {
#pragma unroll
              for (int j = 0; j < 4; ++j) { const f32x4 o = v2[j] * rstd2 * gg[j]; u32x2 w; w.x = cvt_pk_bf16(o[0], o[1]); w.y = cvt_pk_bf16(o[2], o[3]); *(u32x2*)(H + (size_t)row2 * D + 4 * lane + 256 * j) = w; } }
      } }
}

template <int W> __device__ __forceinline__ void pool_rows(const bf16* U, bf16* PO, int t0, int wave, int lane) {
    const int c4 = 64 * wave + 4 * (lane & 15), r0 = t0 + 16 * (lane >> 4);
    const int pos0 = r0 % SEQ;
    u32x2 v[15 + W];
#pragma unroll
    for (int i = 0; i < 15 + W; ++i) { const int rr = r0 - (W - 1) + i; u32x2 z = {0u, 0u}; if (i >= W - 1 || pos0 != 0) z = *(const u32x2*)(U + (size_t)rr * PW + c4); v[i] = z; }
#pragma unroll
    for (int i = 0; i < 16; ++i) {
        float s0 = 0.f, s1 = 0.f, s2 = 0.f, s3 = 0.f;
#pragma unroll
        for (int jj = 0; jj < W; ++jj) { const u32x2 x = v[i + W - 1 - jj]; s0 += bflo(x.x); s1 += bfhi(x.x); s2 += bflo(x.y); s3 += bfhi(x.y); }
        const int pos = pos0 + i; const float rc = 1.0f / (float)(pos + 1 < W ? pos + 1 : W);
        const u32x2 c = v[i + W - 1]; u32x2 o;
        o.x = cvt_pk_bf16(s0 * rc - bflo(c.x), s1 * rc - bfhi(c.x)); o.y = cvt_pk_bf16(s2 * rc - bflo(c.y), s3 * rc - bfhi(c.y));
        *(u32x2*)(PO + (size_t)(r0 + i) * PW + c4) = o;
    }
}
__device__ __forceinline__ void attn_unit(const Frame& F, int unit, const bf16* Q, const bf16* KB, const bf16* VB, const float* sinks, bf16* AO, const bf16* U, bf16* PO, int pool_chunk, const float* w_down, fp8* WDN8, bool first, int ord  ) {
    const int lane = F.lane, wid = F.wave, r32 = lane & 31, hi = lane >> 5;
    const int b = unit >> 6, n = (unit >> 1) & 31, hkv = unit & 1;
    LAS unsigned char* Kt = F.lds; LAS unsigned char* Vt = F.lds + 32768;
    const int tok0 = b * SEQ + 128 * (n - 1);
    int hq = hkv * 8 + 2 * (wid & 3);
    if (!first) __syncthreads();
    bf16x8 qn[4];
    if (wid >= 4) {
        const int it = unit * 4 + (wid - 4), e = it >> 6, q = it & 63, kb = q >> 3, nb = q & 7;
        conv_item8<1>(w_down + (size_t)e * 1024 * 1024, 1024, WDN8 + (size_t)e * 1024 * 1024, 1024, kb * 128, nb * 128, nb * 128, lane, F.lds + 65536 + (wid - 4) * 16384);
    } else {
        const __amdgpu_buffer_rsrc_t rsK = __builtin_amdgcn_make_buffer_rsrc((void*)KB, 0, 0x7fffffff, 0x00020000), rsV = __builtin_amdgcn_make_buffer_rsrc((void*)VB, 0, 0x7fffffff, 0x00020000);
        int ln = lane; asm volatile("" : "+v"(ln));
#pragma unroll
        for (int i = 0; i < 8; ++i) { const int row = (i * 4 + wid) * 8 + (ln >> 3), pp = ln & 7; int tok = tok0 + row; tok = tok < b * SEQ ? b * SEQ + row : tok;
            const int ck = pp ^ ((row >> 1) & 7), cv = pp ^ (((row >> 1) & 1) << 2);
            __builtin_amdgcn_raw_ptr_buffer_load_lds(rsK, (LAS void*)(Kt + (i * 4 + wid) * 1024), 16, tok * 256 + hkv * 128 + ck * 16, 0, 0, 0);
            __builtin_amdgcn_raw_ptr_buffer_load_lds(rsV, (LAS void*)(Vt + (i * 4 + wid) * 1024), 16, tok * 256 + hkv * 128 + cv * 16, 0, 0, 0); }
        const size_t qrow = (size_t)b * SEQ + 128 * n + r32;
#pragma unroll
        for (int ks = 0; ks < 4; ++ks) qn[ks] = *(const bf16x8*)(Q + qrow * 1024 + hq * 64 + ks * 16 + hi * 8);
    }
    if (pool_chunk >= 0) { const int g = wid >> 1, t0 = pool_chunk * 64;
        if (g == 0) pool_rows<2>(U, PO, t0, wid, lane); else if (g == 1) pool_rows<4>(U, PO, t0, wid, lane); else if (g == 2) pool_rows<8>(U, PO, t0, wid, lane); else pool_rows<16>(U, PO, t0, wid, lane); }
    VM_WAIT();
    if (wid >= 4) {
        const int it = unit * 4 + (wid - 4) + 1024, e = it >> 6, q = it & 63, kb = q >> 3, nb = q & 7;
        conv_item8<1>(w_down + (size_t)e * 1024 * 1024, 1024, WDN8 + (size_t)e * 1024 * 1024, 1024, kb * 128, nb * 128, nb * 128, lane, F.lds + 65536 + (wid - 4) * 16384);
        return;
    }
    {
        LAS unsigned* cw = (LAS unsigned*)(F.lds + MISC_OFF + 64);
        if (lane == 0) { (void)__hip_atomic_fetch_add(cw, 1u, __ATOMIC_RELAXED, __HIP_MEMORY_SCOPE_WORKGROUP);
            while (__hip_atomic_load(cw, __ATOMIC_RELAXED, __HIP_MEMORY_SCOPE_WORKGROUP) < 4u * (unsigned)(ord + 1)) __builtin_amdgcn_s_sleep(1); }
        __builtin_amdgcn_fence(__ATOMIC_ACQUIRE, "workgroup");
    }
    constexpr float LOG2E = 1.44269504089f, C2 = 0.125f * LOG2E;
#pragma unroll 1
    for (int hsel = 0; hsel < 2; ++hsel) {
    const float sink = sinks[hq];
    if (hsel == 1) { const size_t qrow = (size_t)b * SEQ + 128 * n + r32;
#pragma unroll
        for (int ks = 0; ks < 4; ++ks) qn[ks] = *(const bf16x8*)(Q + qrow * 1024 + hq * 64 + ks * 16 + hi * 8); }
#pragma unroll 1
    for (int j = 0; j < 4; ++j) {
        const size_t qrow = (size_t)b * SEQ + 128 * n + 32 * j + r32;
        bf16x8 qf[4];
#pragma unroll
        for (int ks = 0; ks < 4; ++ks) qf[ks] = qn[ks];
        if (j < 3) {
#pragma unroll
            for (int ks = 0; ks < 4; ++ks) qn[ks] = *(const bf16x8*)(Q + (qrow + 32) * 1024 + hq * 64 + ks * 16 + hi * 8); }
        int r32v = r32; asm volatile("" : "+v"(r32v));
        f32x16 s[5];
#pragma unroll
        for (int tau = 0; tau < 5; ++tau) {
            const int kt = j + tau; const int krow = 32 * kt + r32;
            f32x16 a = {0.f, 0.f, 0.f, 0.f, 0.f, 0.f, 0.f, 0.f, 0.f, 0.f, 0.f, 0.f, 0.f, 0.f, 0.f, 0.f};
#pragma unroll
            for (int ks = 0; ks < 4; ++ks) { const bf16x8 kf = *(const LAS bf16x8*)(Kt + krow * 128 + (((2 * ks + hi) ^ ((krow >> 1) & 7)) << 4));
                a = __builtin_amdgcn_mfma_f32_32x32x16_bf16(kf, qf[ks], a, 0, 0, 0); }
            s[tau] = a;
        }
        float mx = -1.0e30f;
#pragma unroll
        for (int tau = 0; tau < 5; ++tau) { const bool dead = (n == 0) && (j + tau < 4);
#pragma unroll
            for (int r = 0; r < 16; ++r) { const int kk = (r & 3) + 8 * (r >> 2) + 4 * hi; bool ok = !dead; if (tau == 0) ok = ok && (kk > r32v); if (tau == 4) ok = ok && (kk <= r32v);
                s[tau][r] = ok ? s[tau][r] : -1.0e30f; mx = fmaxf(mx, s[tau][r]); } }
        mx = fmaxf(mx, __shfl_xor(mx, 32));
        const float mm = fmaxf(mx * 0.125f, sink), mml = mm * LOG2E;
        float sum = 0.f;
#pragma unroll
        for (int tau = 0; tau < 5; ++tau)
#pragma unroll
            for (int r = 0; r < 16; ++r) { const float p = (s[tau][r] > -1.0e29f) ? __builtin_amdgcn_exp2f(s[tau][r] * C2 - mml) : 0.f; s[tau][r] = p; sum += p; }
        sum += __shfl_xor(sum, 32);
        sum += __builtin_amdgcn_exp2f((sink - mm) * LOG2E);
        const float inv = 1.0f / sum;
        bf16* orow = AO + qrow * 1024 + hq * 64;
#pragma unroll
        for (int d0 = 0; d0 < 2; ++d0) {
            f32x16 o = {0.f, 0.f, 0.f, 0.f, 0.f, 0.f, 0.f, 0.f, 0.f, 0.f, 0.f, 0.f, 0.f, 0.f, 0.f, 0.f};
#pragma unroll
            for (int tau = 0; tau < 5; ++tau) {
                const int kt = j + tau;
#pragma unroll
                for (int s2 = 0; s2 < 2; ++s2) {
                    bf16x8 pf; { const unsigned w0 = cvt_pk_bf16(s[tau][8 * s2 + 0], s[tau][8 * s2 + 1]), w1 = cvt_pk_bf16(s[tau][8 * s2 + 2], s[tau][8 * s2 + 3]), w2 = cvt_pk_bf16(s[tau][8 * s2 + 4], s[tau][8 * s2 + 5]), w3 = cvt_pk_bf16(s[tau][8 * s2 + 6], s[tau][8 * s2 + 7]);
                        const u32x4 w = {w0, w1, w2, w3}; pf = __builtin_bit_cast(bf16x8, w); }
                    const int vrow = 32 * kt + 16 * s2 + 4 * hi + ((lane & 15) >> 2);
                    const int vcb = 64 * d0 + 32 * ((lane >> 4) & 1) + 8 * (lane & 3);
                    const int vaddr = vrow * 128 + (vcb ^ (((vrow >> 1) & 1) << 6));
                    const s16x4 lo = __builtin_bit_cast(s16x4, __builtin_amdgcn_ds_read_tr16_b64_v4i16((LAS s16x4*)(Vt + vaddr)));
                    const s16x4 hh = __builtin_bit_cast(s16x4, __builtin_amdgcn_ds_read_tr16_b64_v4i16((LAS s16x4*)(Vt + vaddr + 1024)));
                    const bf16x8 vf = {lo[0], lo[1], lo[2], lo[3], hh[0], hh[1], hh[2], hh[3]};
                    o = __builtin_amdgcn_mfma_f32_32x32x16_bf16(vf, pf, o, 0, 0, 0);
                }
            }
#pragma unroll
            for (int rg = 0; rg < 4; ++rg) { u32x2 w; w.x = cvt_pk_bf16(o[4 * rg] * inv, o[4 * rg + 1] * inv); w.y = cvt_pk_bf16(o[4 * rg + 2] * inv, o[4 * rg + 3] * inv);
                *(u32x2*)(orow + 32 * d0 + 8 * rg + 4 * hi) = w; }
        }
    }
    ++hq;
    }
}

__device__ __forceinline__ void moe_tables(const Frame& F) {
    LAS int* tb = (LAS int*)(F.lds + TBL_OFF);
    __syncthreads();
    if (F.tid < 32) tb[192 + F.tid] = (int)__hip_atomic_load(F.ctl + CW_CNT + F.tid, RLX_AGENT);
    __syncthreads();
    if (F.tid == 0) { int u8 = 0, u4 = 0, ro = 0;
        for (int e = 0; e < 32; ++e) { const int c = tb[192 + e], r = (c + 255) >> 8; tb[e] = u8; tb[64 + e] = u4; tb[128 + e] = ro; u8 += r * 8; u4 += r * 4; ro += r * 256; }
        tb[32] = u8; tb[64 + 32] = u4; tb[128 + 32] = ro; }
    if (F.wave == 0) {
        const int e = F.lane & 31, R = (tb[192 + e] + 255) >> 8, L = R + (R >> 1); const bool odd = (R & 1) != 0;
        int lm = odd ? L : 0;
#pragma unroll
        for (int o = 16; o >= 1; o >>= 1) lm = max(lm, __shfl_xor(lm, o));
        const unsigned long long bx = __ballot(odd && L == lm), bh = __ballot(!odd && L + 1 <= lm);
        if (F.lane == 0) { tb[224] = (int)(unsigned)bx; tb[225] = (int)(unsigned)bh; }
    }
    __syncthreads();
}

__device__ __forceinline__ void router_chunk(const Frame& F, int chunk, const float* x, const bf16* X1, const float* g2, const bf16* WRH, const bf16* WRL, const float* br, fp8* H2, gu32* counts, int* stok, int* toke, float* tokg, bf16* X1B) {
    const int tid = F.tid, lane = F.lane, w = F.wave, i32 = lane & 31, hh = lane >> 5;
    LAS unsigned char* lds = F.lds;
    LAS float* logit = (LAS float*)(lds + RT_LOGIT); LAS int* tokE = (LAS int*)(lds + RT_TOKE); LAS int* tokR = (LAS int*)(lds + RT_TOKR); LAS float* tokG = (LAS float*)(lds + RT_TOKG);
    LAS unsigned* hist = (LAS unsigned*)(lds + RT_HIST); LAS unsigned* base = (LAS unsigned*)(lds + RT_BASE);
    LAS float* g2l = (LAS float*)(lds + RT_LOGIT + 4224);
    const __amdgpu_buffer_rsrc_t rsX = __builtin_amdgcn_make_buffer_rsrc((void*)x, 0, 0x7fffffff, 0x00020000), rsD = __builtin_amdgcn_make_buffer_rsrc((void*)X1, 0, 0x7fffffff, 0x00020000), rsH = __builtin_amdgcn_make_buffer_rsrc((void*)H2, 0, 0x7fffffff, 0x00020000), rsB = __builtin_amdgcn_make_buffer_rsrc((void*)X1B, 0, 0x7fffffff, 0x00020000);
    const int vx = lane * 16, vd = lane * 8, vh = lane * 4;
    f32x4 xv[4][4];
#pragma unroll
    for (int q = 0; q < 4; ++q) { const int so = (chunk * 64 + 4 * w + q) * (D * 4);
#pragma unroll
        for (int j = 0; j < 4; ++j) xv[q][j] = __builtin_bit_cast(f32x4, __builtin_amdgcn_raw_buffer_load_b128(rsX, vx + 1024 * j, so, 0)); }
    bf16x8 bh[8], bl[8];
    __syncthreads();
    if (tid < 32) hist[tid] = 0u;
    *(LAS f32x2*)(g2l + 2 * tid) = *(const f32x2*)(g2 + 2 * tid);
    __syncthreads();
#pragma unroll
    for (int p = 0; p < 2; ++p) {
        const int r0 = chunk * 64 + 32 * p;
#pragma unroll
        for (int qh = 0; qh < 2; ++qh) {
            u32x2 dv[2][4];
#pragma unroll
            for (int q2 = 0; q2 < 2; ++q2)
#pragma unroll
                for (int j = 0; j < 4; ++j) dv[q2][j] = __builtin_bit_cast(u32x2, __builtin_amdgcn_raw_buffer_load_b64(rsD, vd + 512 * j, (r0 + 4 * w + 2 * qh + q2) * (D * 2), 0));
#pragma unroll
            for (int q2 = 0; q2 < 2; ++q2) { const int q = 2 * qh + q2, rl = 4 * w + q, row = r0 + rl; float s = 0.f;
#pragma unroll
                for (int j = 0; j < 4; ++j) { const u32x2 dw = dv[q2][j]; const f32x4 t = xv[q][j] + (f32x4){bflo(dw.x), bfhi(dw.x), bflo(dw.y), bfhi(dw.y)}; xv[q][j] = t; s += t.x * t.x + t.y * t.y + t.z * t.z + t.w * t.w;
                    u32x2 xb; xb.x = cvt_pk_bf16(t.x, t.y); xb.y = cvt_pk_bf16(t.z, t.w); __builtin_amdgcn_raw_buffer_store_b64(xb, rsB, vd + 512 * j, row * (D * 2), 0); }
                const float rstd = rsqrtf(wave_sum(s) * (1.f / D) + RMS_EPS);
#pragma unroll
                for (int j = 0; j < 4; ++j) { const f32x4 o = xv[q][j] * rstd * *(const LAS f32x4*)(g2l + 4 * lane + 256 * j); int pk = 0; pk = __builtin_amdgcn_cvt_pk_fp8_f32(o[0], o[1], pk, false); pk = __builtin_amdgcn_cvt_pk_fp8_f32(o[2], o[3], pk, true);
                    __builtin_amdgcn_raw_buffer_store_b32((unsigned)pk, rsH, vh + 256 * j, row * D, 0); *(LAS f32x4*)(lds + rl * HB_STRIDE + (4 * lane + 256 * j) * 4) = o; } }
        }
        if (p == 0) {
            { const bf16* ph = WRH + (size_t)i32 * 1024 + 128 * w + 8 * hh; const bf16* pl = WRL + (size_t)i32 * 1024 + 128 * w + 8 * hh;
#pragma unroll
              for (int ks = 0; ks < 8; ++ks) { bh[ks] = *(const bf16x8*)(ph + 16 * ks); bl[ks] = *(const bf16x8*)(pl + 16 * ks); } }
#pragma unroll
            for (int q = 0; q < 4; ++q) { const int so = (chunk * 64 + 32 + 4 * w + q) * (D * 4);
#pragma unroll
                for (int j = 0; j < 4; ++j) xv[q][j] = __builtin_bit_cast(f32x4, __builtin_amdgcn_raw_buffer_load_b128(rsX, vx + 1024 * j, so, 0)); } }
        __syncthreads();
        f32x16 acc = {0.f, 0.f, 0.f, 0.f, 0.f, 0.f, 0.f, 0.f, 0.f, 0.f, 0.f, 0.f, 0.f, 0.f, 0.f, 0.f};
#pragma unroll
        for (int ks = 0; ks < 8; ++ks) {
            const LAS float* hp = (const LAS float*)(lds + i32 * HB_STRIDE + (128 * w + 16 * ks + 8 * hh) * 4);
            const f32x4 a0 = *(const LAS f32x4*)hp, a1 = *(const LAS f32x4*)(hp + 4);
            u32x4 whi, wlo;
            whi.x = cvt_pk_bf16(a0[0], a0[1]); whi.y = cvt_pk_bf16(a0[2], a0[3]); whi.z = cvt_pk_bf16(a1[0], a1[1]); whi.w = cvt_pk_bf16(a1[2], a1[3]);
            wlo.x = cvt_pk_bf16(a0[0] - bflo(whi.x), a0[1] - bfhi(whi.x)); wlo.y = cvt_pk_bf16(a0[2] - bflo(whi.y), a0[3] - bfhi(whi.y));
            wlo.z = cvt_pk_bf16(a1[0] - bflo(whi.z), a1[1] - bfhi(whi.z)); wlo.w = cvt_pk_bf16(a1[2] - bflo(whi.w), a1[3] - bfhi(whi.w));
            const bf16x8 ahi = __builtin_bit_cast(bf16x8, whi), alo = __builtin_bit_cast(bf16x8, wlo);
            acc = __builtin_amdgcn_mfma_f32_32x32x16_bf16(ahi, bh[ks], acc, 0, 0, 0);
            acc = __builtin_amdgcn_mfma_f32_32x32x16_bf16(ahi, bl[ks], acc, 0, 0, 0);
            acc = __builtin_amdgcn_mfma_f32_32x32x16_bf16(alo, bh[ks], acc, 0, 0, 0);
        }
        __syncthreads();
        LAS float* part = (LAS float*)lds;
#pragma unroll
        for (int r = 0; r < 16; ++r) { const int tk = (r & 3) + 8 * (r >> 2) + 4 * hh; part[(w * 32 + tk) * 33 + i32] = acc[r]; }
        __syncthreads();
#pragma unroll
        for (int q = 0; q < 2; ++q) { const int o = tid + 512 * q, tk = o >> 5, e = o & 31; float sacc = br[e];
#pragma unroll
            for (int ww = 0; ww < 8; ++ww) sacc += part[(ww * 32 + tk) * 33 + e];
            logit[(32 * p + tk) * 33 + e] = sacc; }
        __syncthreads();
    }
    if (tid < 64) {
        float lg[32];
#pragma unroll
        for (int e = 0; e < 32; ++e) lg[e] = logit[tid * 33 + e];
        int be[4]; float bv[4]; unsigned used = 0u;
#pragma unroll
        for (int k = 0; k < 4; ++k) { float best = -3.0e38f; int bi = 0;
#pragma unroll
            for (int e = 0; e < 32; ++e) { const bool ok = !((used >> e) & 1u) && lg[e] > best; best = ok ? lg[e] : best; bi = ok ? e : bi; }
            be[k] = bi; bv[k] = best; used |= 1u << bi; }
        float ex[4], se = 0.f;
#pragma unroll
        for (int k = 0; k < 4; ++k) { ex[k] = __expf(bv[k] - bv[0]); se += ex[k]; }
        const float rse = 1.0f / se;
#pragma unroll
        for (int k = 0; k < 4; ++k) { const unsigned rk = __hip_atomic_fetch_add(hist + be[k], 1u, __ATOMIC_RELAXED, __HIP_MEMORY_SCOPE_WORKGROUP);
            tokE[tid * 4 + k] = be[k]; tokR[tid * 4 + k] = (int)rk; tokG[tid * 4 + k] = ex[k] * rse; }
    }
    __syncthreads();
    if (tid < 32) { const unsigned hc = hist[tid]; base[tid] = hc ? __hip_atomic_fetch_add(counts + tid, hc, RLX_AGENT) : 0u; }
    __syncthreads();
    if (tid < 256) { const int tk = tid >> 2, k = tid & 3, e = tokE[tk * 4 + k], pos = (int)base[e] + tokR[tk * 4 + k], t = chunk * 64 + tk;
        stok[e * CAP + pos] = t; toke[t * 4 + k] = e | (pos << 8); tokg[t * 4 + k] = tokG[tk * 4 + k]; }
}

__device__ __forceinline__ void combine_rows(const Frame& F, const float* x, const bf16* X1, const fp8* YS, const int* toke, const float* tokg, const float* gf, float* out, const XcdBarrier& bar, bool need) {
    const int lane = F.lane; const LAS int* rowoff = (const LAS int*)(F.lds + TBL_OFF) + 128;
    f32x4 gg[4];
#pragma unroll
    for (int j = 0; j < 4; ++j) gg[j] = ((const f32x4*)gf)[lane + 64 * j];
    for (int t = F.bx * NWAVES + F.wave; t < T; t += F.G * NWAVES) {
        f32x4 v[4];
#pragma unroll
        for (int j = 0; j < 4; ++j) { const u32x2 dw = __builtin_nontemporal_load((const u32x2*)(X1 + (size_t)t * D + 4 * lane + 256 * j)); v[j] = (f32x4){bflo(dw.x), bfhi(dw.x), bflo(dw.y), bfhi(dw.y)}; }
        const int4 te = *(const int4*)(toke + t * 4); const f32x4 tg = *(const f32x4*)(tokg + t * 4);
        if (need) { xcd_barrier_wait(bar); need = false; }
        const int tes[4] = {te.x, te.y, te.z, te.w};
#pragma unroll
        for (int k = 0; k < 4; ++k) { const int e = tes[k] & 255, pos = tes[k] >> 8; const float g = tg[k];
            const fp8* y = YS + (size_t)(rowoff[e] + pos) * 1024 + 4 * lane;
#pragma unroll
            for (int j = 0; j < 4; ++j) { const int pw = __builtin_nontemporal_load((const int*)(y + 256 * j)); const f32x2 lo = __builtin_amdgcn_cvt_pk_f32_fp8(pw, false), hi2 = __builtin_amdgcn_cvt_pk_f32_fp8(pw, true);
                v[j].x += g * lo[0]; v[j].y += g * lo[1]; v[j].z += g * hi2[0]; v[j].w += g * hi2[1]; } }
        float s = 0.f;
#pragma unroll
        for (int j = 0; j < 4; ++j) s += v[j].x * v[j].x + v[j].y * v[j].y + v[j].z * v[j].z + v[j].w * v[j].w;
        const float rstd = rsqrtf(wave_sum(s) * (1.f / D) + RMS_EPS);
#pragma unroll
        for (int j = 0; j < 4; ++j) __builtin_nontemporal_store(v[j] * rstd * gg[j], (f32x4*)(out + (size_t)t * D) + lane + 64 * j);
    }
}

constexpr int N_PHASES = 9;
__global__ void __launch_bounds__(NTHR, 2) fwd(Args a) {
    extern __shared__ __attribute__((aligned(16))) unsigned char lds_raw[];
    Frame F; F.lds = (LAS unsigned char*)lds_raw; F.tid = threadIdx.x; F.lane = F.tid & 63; F.wave = __builtin_amdgcn_readfirstlane(F.tid >> 6); F.G = gridDim.x; F.bx = blockIdx.x;
    F.ws = a.ws; F.ctl = (gu32*)(a.ws + WS_CTL);
    volatile LAS unsigned* MISC = (volatile LAS unsigned*)(F.lds + MISC_OFF);
    if (F.tid < 32) MISC[F.tid] = 0u;
    __syncthreads();
    XcdBarrier bar = xcd_barrier_post((unsigned*)(F.ctl + CW_BAR) + a.li * 4096, MISC + 8);
    if (a.ph_lo == 0 && F.tid == 0)
        for (int v = F.bx; v < 256; v += F.G) { const int e = (v & 7) + 8 * ((v >> 3) >> 3); (void)xb_add((unsigned*)(F.ctl + CW_GRPX + e), bar.x < 8u ? 1u << (4 * bar.x) : 0x11111111u); }
    if (a.ph_lo == 0 && F.tid == 0 && F.G == 256) {
        const unsigned inc = bar.x < 8u ? 1u << (4 * bar.x) : 0x11111111u, old = xb_add((unsigned*)(F.ctl + CW_PGX + (F.bx & 63)), inc), now = old + inc;
        unsigned cnt = 0; for (int d = 0; d < 8; ++d) cnt += (now >> (4 * d)) & 15u;
        if (cnt == 4u && now != (4u << (4 * bar.x))) (void)xb_add((unsigned*)(F.ctl + CW_BAD), 1u);
    }
    unsigned char* const ws = a.ws;
#define WIN ((bf16*)(ws + WS_WIN))
#define WATT ((bf16*)(ws + WS_WATT))
#define WEFF ((bf16*)(ws + WS_WEFF))
#define WOUT ((bf16*)(ws + WS_WOUT))
#define CS ((float*)(ws + WS_CS))
#define WUP ((fp8*)(ws + WS_WUP))
#define WDN ((fp8*)(ws + WS_WDN))
#define H ((bf16*)(ws + WS_H))
#define H2 ((fp8*)(ws + WS_H2))
#define Q ((bf16*)(ws + WS_Q))
#define KB ((bf16*)(ws + WS_KB))
#define VB ((bf16*)(ws + WS_VB))
#define U ((bf16*)(ws + WS_U))
#define PO ((bf16*)(ws + WS_PO))
#define GA ((bf16*)(ws + WS_GA))
#define GP ((bf16*)(ws + WS_GP))
#define AO ((bf16*)(ws + WS_AO))
#define T1 ((bf16*)(ws + WS_T1))
#define MG ((bf16*)(ws + WS_MG))
#define X1 ((bf16*)(ws + WS_X1))
#define STOK ((int*)(ws + WS_STOK))
#define TOKE ((int*)(ws + WS_TOKE))
#define TOKG ((float*)(ws + WS_TOKG))
#define ACT ((fp8*)(ws + WS_ACT))
#define YS ((fp8*)(ws + WS_YS))
    const int lo = a.ph_lo, hi = a.ph_hi;
    bool usegrp = false; int uc = F.bx;
#define IN(k) (lo <= (k) && (k) < hi)
#define SEAM(k) do { if (IN(k) && IN((k) + 1)) { if (usegrp && (k) >= 2 && (k) <= 4) panel_seam((unsigned*)(F.ctl + CW_PGC + (64 * ((k) - 2) + (F.bx & 63)) * 16), bar.bar); else xcd_barrier(bar); } } while (0)
#define FRESH() do { int t_ = (int)threadIdx.x; asm volatile("" : "+v"(t_)); F.tid = t_; F.lane = t_ & 63; F.wave = __builtin_amdgcn_readfirstlane(t_ >> 6); } while (0)

    if (IN(0)) { FRESH(); p0b_weights(F, a, F.bx, F.G); p0_prologue_w(F, a); }
    const bool split0 = IN(0) && IN(1) && F.G == 256 && lo == 0 && hi == N_PHASES;
    if (split0) xcd_barrier_arrive(bar);
    if (IN(0)) { FRESH(); p0_rows(F, a, split0 ? 4 * (8 * (F.bx & 7) + ((F.bx >> 3) & 7)) + (F.bx >> 6) : -1); }
    if (split0) xcd_barrier_wait(bar); else SEAM(0);
    usegrp = (F.G == 256) && lo == 0 && hi == N_PHASES && xb_ld((unsigned*)(F.ctl + CW_BAD)) == 0u && xb_ld((unsigned*)(F.ctl + CW_PGX + (F.bx & 63))) != 0u;
    if (split0) { if (usegrp) panel_seam((unsigned*)(F.ctl + CW_PG0 + 16 * (F.bx & 63)), bar.bar); else xcd_barrier(bar); }
    uc = usegrp ? 4 * (8 * (F.bx & 7) + ((F.bx >> 3) & 7)) + (F.bx >> 6) : F.bx;
    if (IN(1)) { FRESH();
        pg8::DenseOrder S; S.init(T, INW, F.G, F.bx);
        pg8::EpiInProj E{a.in[4], CS, Q, KB, VB, U, GA, GP};
        pg8::gemm_phase<pg8::EpiInProj, pg8::DenseOrder, 1024, false, false>(F.lds, H, WIN, 0, S, E, nullptr);
    }
    if (IN(1) && IN(2)) {
        if (usegrp) { const int rp = 8 * (F.bx & 7) + ((F.bx >> 3) & 7), rq = rp - 1, rn = rp + 1;
            panel_seam1(F.ctl, F.bx & 63, (rp & 15) ? 8 * (rq & 7) + (rq >> 3) : -1, ((rn & 15) ? 8 * (rn & 7) + (rn >> 3) : -1), bar.bar); }
        else xcd_barrier(bar);
    }
    if (IN(2)) { FRESH();
        { int ord = 0; for (int u = uc; u < 256; u += F.G, ++ord) attn_unit(F, u, Q, KB, VB, a.in[5], AO, U, PO, u, a.in[16], WDN, u == uc, ord); }
        __syncthreads();
    }
    SEAM(2);
    if (IN(3)) { FRESH();
        pg8::DenseOrder S; S.init(T, 1024, F.G, F.bx);
        { pg8::EpiGateA E{GA, T1}; pg8::gemm_phase<pg8::EpiGateA, pg8::DenseOrder, 1024, false, false>(F.lds, AO, WATT, 0, S, E, nullptr); }
        VM_WAIT(); __syncthreads();
        { pg8::EpiMerge E{GP, T1, MG}; pg8::gemm_phase<pg8::EpiMerge, pg8::DenseOrder, 512, false, false>(F.lds, PO, WEFF, 0, S, E, nullptr); }
    }
    SEAM(3);
    if (IN(4)) { FRESH();
        pg8::DenseOrder S; S.init(T, 1024, F.G, F.bx);
        pg8::EpiX1 E{X1};
        pg8::gemm_phase<pg8::EpiX1, pg8::DenseOrder, 1024, false, false>(F.lds, MG, WOUT, 0, S, E, nullptr);
    }
    SEAM(4);
    if (IN(5)) { FRESH();
        for (int ch = uc; ch < T / 64; ch += F.G) router_chunk(F, ch, a.in[0], X1, a.in[11], (const bf16*)(ws + WS_WRH), (const bf16*)(ws + WS_WRL), a.in[13], H2, F.ctl + CW_CNT, STOK, TOKE, TOKG, (bf16*)(ws + WS_X1B));
        __syncthreads();
    }
    if (IN(5) && IN(6)) xcd_barrier_arrive(bar);
    if (IN(6)) { FRESH();
        for (int v = F.bx; v < 256; v += F.G) { const int e = (v & 7) + 8 * ((v >> 3) >> 3), pn = (v >> 3) & 7;
#pragma unroll 1
            for (int k = 0; k < 2; ++k) { const int it = F.wave + 8 * k, kb = it >> 1, nb = 2 * pn + (it & 1);
                conv_item8<2, false>(a.in[14] + (size_t)e * 1024 * 2048, 2048, WUP + (size_t)e * 2048 * 1024, 1024, kb * 128, up_src_col(nb * 128), nb * 128, F.lane, F.lds + F.wave * 16384); } }
        VM_WAIT(); __syncthreads();
        if (IN(5)) xcd_barrier_wait(bar);
        moe_tables(F);
        const LAS int* tb = (const LAS int*)(F.lds + TBL_OFF);
        pg8::EpiSwiglu E{a.in[15], ACT};
        pg8::MoeOrderX<true> S{tb + 128, tb + 192, 3, F.G, F.bx};
        pg8::gemm_phase<pg8::EpiSwiglu, pg8::MoeOrderX<true>, 1024, true, true>(F.lds, H2, WUP, (size_t)2048 * 1024, S, E, STOK);
        VM_WAIT(); __syncthreads();
        if (F.tid == 0) {
            bool fenced = false;
            for (int v = F.bx; v < 256; v += F.G) { const int e = (v & 7) + 8 * ((v >> 3) >> 3);
                const bool uni = bar.x < 8u && xb_ld((unsigned*)(F.ctl + CW_GRPX + e)) == (8u << (4 * bar.x));
                const bool last = uni && xb_add((unsigned*)(F.ctl + CW_TK + 16 * e), 1u) == 7u;
                if ((!uni || last) && !fenced) { __builtin_amdgcn_fence(__ATOMIC_RELEASE, "agent"); VM_WAIT(); fenced = true; }
                if (!uni) (void)xb_add((unsigned*)(F.ctl + CW_DONE + 64 * e), 1u); else if (last) (void)xb_add((unsigned*)(F.ctl + CW_DONE + 64 * e), 8u); }
        }
    }
    if (IN(7)) { FRESH();
        moe_tables(F);
        const LAS int* tb = (const LAS int*)(F.lds + TBL_OFF);
        const unsigned mx = (unsigned)__builtin_amdgcn_readfirstlane(tb[224]), mh = (unsigned)__builtin_amdgcn_readfirstlane(tb[225]);
        pg8::EpiDown E{a.in[17], YS};
        {   pg8::MoeOrderOwn S{tb + 128, tb + 192, mx, mh, F.G, F.bx};
            if (F.tid == 0) { pg8::GUnit u; unsigned seen = 0u;
                for (int i = 0; S.next(i, u); ++i) { if ((seen >> u.e) & 1u) continue; seen |= 1u << u.e; unsigned* p = (unsigned*)(F.ctl + CW_DONE + 64 * u.e); XB_SPIN(xb_ld(p) < 8u, bar.bar); }
                __builtin_amdgcn_fence(__ATOMIC_ACQUIRE, "agent"); VM_WAIT(); }
            __syncthreads();
            pg8::gemm_phase<pg8::EpiDown, pg8::MoeOrderOwn, 1024, false, true>(F.lds, ACT, WDN, (size_t)1024 * 1024, S, E, nullptr);
        }
        {   pg8::MoeOrderSteal S{tb + 128, tb + 192, mx, mh, F.G, F.bx};
            pg8::GUnit u0;
            if (S.next(0, u0)) {
                VM_WAIT(); __syncthreads();
                if (F.tid == 0) { pg8::GUnit u;
                    for (int i = 0; S.next(i, u); ++i) { unsigned* p = (unsigned*)(F.ctl + CW_DONE + 64 * u.e); XB_SPIN(xb_ld(p) < 8u, bar.bar); }
                    __builtin_amdgcn_fence(__ATOMIC_ACQUIRE, "agent"); VM_WAIT(); }
                __syncthreads();
                pg8::gemm_phase<pg8::EpiDown, pg8::MoeOrderSteal, 1024, false, true>(F.lds, ACT, WDN, (size_t)1024 * 1024, S, E, nullptr);
            }
        }
    }
    const bool split7 = IN(7) && IN(8);
    if (split7) xcd_barrier_arrive(bar);
    if (IN(8)) { FRESH();
        moe_tables(F);
        combine_rows(F, a.in[0], (const bf16*)(ws + WS_X1B), YS, TOKE, TOKG, a.in[18], a.out, bar, split7);
    }
#undef IN
#undef SEAM
#undef WIN
#undef WATT
#undef WEFF
#undef WOUT
#undef CS
#undef WUP
#undef WDN
#undef H
#undef H2
#undef Q
#undef KB
#undef VB
#undef U
#undef PO
#undef GA
#undef GP
#undef AO
#undef T1
#undef MG
#undef X1
#undef STOK
#undef TOKE
#undef TOKG
#undef ACT
#undef YS
}

#ifndef REPEAT_MASK
#define REPEAT_MASK 0
#endif
#ifndef FAST_MASK
#define FAST_MASK 0x1ff
#endif
#ifndef ONE_LAUNCH
#define ONE_LAUNCH 1
#endif
extern "C" void kernel_launch(void* const* d_in, const int* in_sizes, int n_in, void* d_out, int out_size, void* d_ws, size_t ws_size, hipStream_t stream) {
    if (n_in != 19 || out_size != T * D || ws_size < WS_END) { fprintf(stderr, "kernel_launch: unexpected shapes / workspace (n_in %d, out %d, ws %zu)\n", n_in, out_size, ws_size); return; }
    const float* x = (const float*)d_in[0]; const int* positions = (const int*)d_in[1]; const float* norm1_g = (const float*)d_in[2];
    const float* w_in = (const float*)d_in[3]; const float* b_in = (const float*)d_in[4]; const float* sinks = (const float*)d_in[5];
    const float* w_attn = (const float*)d_in[6]; const float* pool_w = (const float*)d_in[7]; const float* pool_scale = (const float*)d_in[8];
    const float* w_pool = (const float*)d_in[9]; const float* w_out = (const float*)d_in[10]; const float* norm2_g = (const float*)d_in[11];
    const float* w_router = (const float*)d_in[12]; const float* b_router = (const float*)d_in[13]; const float* w_up = (const float*)d_in[14];
    const float* b_up = (const float*)d_in[15]; const float* w_down = (const float*)d_in[16]; const float* b_down = (const float*)d_in[17];
    const float* normf_g = (const float*)d_in[18];
    unsigned char* ws = (unsigned char*)d_ws; float* out = (float*)d_out;
    unsigned* ctl = (unsigned*)(ws + WS_CTL);
    bf16* WIN = (bf16*)(ws + WS_WIN); bf16* WATT = (bf16*)(ws + WS_WATT); bf16* WEFF = (bf16*)(ws + WS_WEFF); bf16* WOUT = (bf16*)(ws + WS_WOUT);
    float* CS = (float*)(ws + WS_CS); fp8* WUP = (fp8*)(ws + WS_WUP); fp8* WDN = (fp8*)(ws + WS_WDN);
    bf16* H = (bf16*)(ws + WS_H); bf16* Q = (bf16*)(ws + WS_Q); bf16* KB = (bf16*)(ws + WS_KB); bf16* VB = (bf16*)(ws + WS_VB);
    bf16* U = (bf16*)(ws + WS_U); bf16* PO = (bf16*)(ws + WS_PO); bf16* GA = (bf16*)(ws + WS_GA); bf16* GP = (bf16*)(ws + WS_GP);
    bf16* AO = (bf16*)(ws + WS_AO); bf16* MG = (bf16*)(ws + WS_MG); bf16* X1 = (bf16*)(ws + WS_X1);
    int* STOK = (int*)(ws + WS_STOK); int* TOKE = (int*)(ws + WS_TOKE); float* TOKG = (float*)(ws + WS_TOKG);
    fp8* ACT = (fp8*)(ws + WS_ACT); fp8* YS = (fp8*)(ws + WS_YS); float* TMP = (float*)(ws + WS_TMP); float* TMP2 = TMP + (size_t)T * D;
    unsigned* counts = ctl + CW_CNT;

    static int grid = 0;
    if (grid == 0) {
        int dev = 0, cus = 0;
        if (hipGetDevice(&dev) != hipSuccess || hipDeviceGetAttribute(&cus, hipDeviceAttributeMultiprocessorCount, dev) != hipSuccess) { fprintf(stderr, "kernel_launch: device query failed\n"); grid = -1; return; }
        if (hipFuncSetAttribute((const void*)fwd, hipFuncAttributeMaxDynamicSharedMemorySize, LDS_BYTES) != hipSuccess) { fprintf(stderr, "kernel_launch: hipFuncSetAttribute failed\n"); grid = -1; return; }
        int per_cu = 0;
        if (hipOccupancyMaxActiveBlocksPerMultiprocessor(&per_cu, (const void*)fwd, NTHR, LDS_BYTES) != hipSuccess || per_cu < 1) fprintf(stderr, "kernel_launch: occupancy query says %d blocks per CU\n", per_cu);
        (void)hipGetLastError();
        grid = cus > 256 ? 256 : cus;
    }
    if (grid < 0) return;
    (void)hipMemsetAsync(ws + WS_CTL, 0, CTL_ZERO_BYTES, stream);
    Args a{};
    for (int i = 0; i < 19; ++i) a.in[i] = (const float*)d_in[i];
    a.out = out; a.ws = ws; a.pad = 0;
    int li = 0;
#define RUN_FAST(lo_, hi_) do { a.ph_lo = (lo_); a.ph_hi = (hi_); a.li = li < 3 ? li : 2; ++li; for (int rep_ = 0; rep_ < ((((hi_) - (lo_)) == 1 && ((REPEAT_MASK >> (lo_)) & 1) && (lo_) != 5) ? 2 : 1); ++rep_) hipLaunchKernelGGL(fwd, dim3(grid), dim3(NTHR), LDS_BYTES, stream, a); } while (0)
#if ONE_LAUNCH
    RUN_FAST(0, N_PHASES);
#else
    if (FAST_MASK & 1) RUN_FAST(0, 1); else {
        n_transpose<<<2048, 256, 0, stream>>>(w_in, 1024, INW, WIN, INW, 0);
        n_transpose<<<1024, 256, 0, stream>>>(w_attn, 1024, 1024, WATT, 1024, 0);
        n_transpose<<<1024, 256, 0, stream>>>(w_out, 1024, 1024, WOUT, 1024, 0);
        for (int e = 0; e < NE; ++e) {
            n_transpose8<<<2048, 256, 0, stream>>>(w_up + (size_t)e * 1024 * 2048, 1024, 2048, WUP + (size_t)e * 2048 * 1024, 2048, 1);
            n_transpose8<<<1024, 256, 0, stream>>>(w_down + (size_t)e * 1024 * 1024, 1024, 1024, WDN + (size_t)e * 1024 * 1024, 1024, 0);
        }
        n_weff<<<(1024 * 512) / 256, 256, 0, stream>>>(pool_w, pool_scale, w_pool, WEFF);
        n_rope_table<<<(T * 8) / 256, 256, 0, stream>>>(positions, CS);
        n_wr_split<<<128, 256, 0, stream>>>(w_router, (bf16*)(ws + WS_WRH), (bf16*)(ws + WS_WRL));
        n_rms_bf16<<<T / 4, 256, 0, stream>>>(x, norm1_g, H);
    }
    if (FAST_MASK & 2) RUN_FAST(1, 2); else {
        n_gemm<<<dim3(INW / 64, T / 64), 256, 0, stream>>>(H, WIN, TMP, T, INW, 1024);
        n_post_inproj<<<(unsigned)(((size_t)T * INW + 255) / 256), 256, 0, stream>>>(TMP, b_in, CS, Q, KB, VB, U, GA, GP);
    }
    if (FAST_MASK & 4) RUN_FAST(2, 3); else {
        if (FAST_MASK & 1) for (int e = 0; e < NE; ++e) n_transpose8<<<1024, 256, 0, stream>>>(w_down + (size_t)e * 1024 * 1024, 1024, 1024, WDN + (size_t)e * 1024 * 1024, 1024, 0);
        n_attn<<<(T * NQH) / 256, 256, 0, stream>>>(Q, KB, VB, sinks, AO);
        n_pool<<<(T * PW) / 256, 256, 0, stream>>>(U, PO);
    }
    if (FAST_MASK & 8) RUN_FAST(3, 4); else {
        n_gemm<<<dim3(1024 / 64, T / 64), 256, 0, stream>>>(AO, WATT, TMP, T, 1024, 1024);
        n_gemm<<<dim3(1024 / 64, T / 64), 256, 0, stream>>>(PO, WEFF, TMP2, T, 1024, 512);
        n_merge<<<(T * D) / 256, 256, 0, stream>>>(TMP, TMP2, GA, GP, MG);
    }
    if (FAST_MASK & 16) RUN_FAST(4, 5); else {
        n_gemm<<<dim3(1024 / 64, T / 64), 256, 0, stream>>>(MG, WOUT, TMP, T, 1024, 1024);
        n_x1<<<(T * D) / 256, 256, 0, stream>>>(x, TMP, X1);
    }
    if (FAST_MASK & 32) { if (REPEAT_MASK & 32) { a.ph_lo = 5; a.ph_hi = 6; a.li = 2; hipLaunchKernelGGL(fwd, dim3(grid), dim3(NTHR), LDS_BYTES, stream, a); (void)hipMemsetAsync(counts, 0, 128, stream); } RUN_FAST(5, 6); } else n_router<<<T / 4, 256, 0, stream>>>(x, X1, norm2_g, w_router, b_router, (fp8*)(ws + WS_H2), counts, STOK, TOKE, TOKG);
    if (FAST_MASK & 64) RUN_FAST(6, 7); else { n_moe_up<<<dim3(1024 / 64, T / 64, NE), 256, 0, stream>>>((const fp8*)(ws + WS_H2), STOK, counts, WUP, b_up, ACT); (void)hipMemsetAsync(ctl + CW_DONE, 8, 32 * 256, stream); }
    if (FAST_MASK & 128) RUN_FAST(7, 8); else n_moe_down<<<dim3(1024 / 64, T / 64, NE), 256, 0, stream>>>(ACT, counts, WDN, b_down, YS);
    if (FAST_MASK & 256) RUN_FAST(8, 9); else n_combine<<<T / 4, 256, 0, stream>>>(x, X1, YS, counts, TOKE, TOKG, normf_g, out);
#endif
    (void)in_sizes; (void)sinks; (void)positions; (void)norm1_g; (void)norm2_g; (void)w_router; (void)b_router; (void)b_up; (void)b_down; (void)normf_g; (void)b_in; (void)pool_w; (void)pool_scale; (void)w_pool;
    (void)w_in; (void)w_attn; (void)w_out; (void)w_up; (void)w_down; (void)x; (void)WIN; (void)WATT; (void)WEFF; (void)WOUT; (void)CS; (void)WUP; (void)WDN; (void)H; (void)Q; (void)KB; (void)VB; (void)U; (void)PO; (void)GA; (void)GP;
    (void)AO; (void)MG; (void)X1; (void)STOK; (void)TOKE; (void)TOKG; (void)ACT; (void)YS; (void)TMP; (void)TMP2; (void)counts;
}
```
